# Optimizing an MI355X kernel written in HIP

```python
import math
import jax, jax.numpy as jnp
from jax import lax
import numpy as np

D_MODEL = 1024
BATCH = 4
SEQ = 4096
DEPTH = 2

N_AB_LAYERS = (DEPTH + 1) // 2
N_C_LAYERS = DEPTH // 2

RG_WIDTH = D_MODEL
RG_BLOCKS = 8
RG_BLOCK_DIM = RG_WIDTH // RG_BLOCKS
RG_CONV = 4
RG_C = 8.0

HG_WIDTH = D_MODEL
HG_HEAD_DIM = 128
HG_HEADS = HG_WIDTH // HG_HEAD_DIM
HG_CHUNK = 64

AB_IN_WIDTH = 2 * RG_WIDTH + 4 * HG_WIDTH
AB_MIX_WIDTH = RG_WIDTH + HG_WIDTH
AB_SPLITS = [RG_WIDTH, 2 * RG_WIDTH, 2 * RG_WIDTH + HG_WIDTH,
             2 * RG_WIDTH + 2 * HG_WIDTH, 2 * RG_WIDTH + 3 * HG_WIDTH]

RW_WIDTH = 2 * D_MODEL
RW_HEAD_DIM = 64
RW_HEADS = RW_WIDTH // RW_HEAD_DIM
RW_LORA = 64

RMS_EPS = 1e-6
GN_EPS = 64e-5

kernel_name = "hybrid_rglru_hgrn2_rwkv7_trunk"


def rms_norm(x, g):
    x32 = x.astype(jnp.float32)
    y = x32 * lax.rsqrt(jnp.mean(x32 * x32, axis=-1, keepdims=True) + RMS_EPS)
    return (y * g.astype(jnp.float32)).astype(x.dtype)


def causal_depthwise_conv(x, w, b):
    c = x.shape[-1]
    y = lax.conv_general_dilated(
        x, w.astype(x.dtype)[:, None, :], window_strides=(1,),
        padding=[(RG_CONV - 1, 0)], dimension_numbers=("NWC", "WIO", "NWC"),
        feature_group_count=c)
    return y + b.astype(x.dtype)


def rg_lru(x, w_a, b_a, w_x, b_x, lam):
    bsz, s, _ = x.shape
    xb = x.reshape(bsz, s, RG_BLOCKS, RG_BLOCK_DIM)
    gate_r = jax.nn.sigmoid(jnp.einsum("bsnc,ncd->bsnd", xb, w_a).reshape(bsz, s, RG_WIDTH) + b_a)
    gate_i = jax.nn.sigmoid(jnp.einsum("bsnc,ncd->bsnd", xb, w_x).reshape(bsz, s, RG_WIDTH) + b_x)
    log_a = -RG_C * gate_r * jax.nn.softplus(-lam)
    a = jnp.exp(log_a)
    mult = jnp.sqrt(-jnp.expm1(2.0 * log_a))
    u = mult * (gate_i * x)

    def combine(left, right):
        return (left[0] * right[0], right[0] * left[1] + right[1])

    _, h = lax.associative_scan(combine, (a, u), axis=1)
    return h


def hgrn2_mix(q, f_pre, v, lb):
    bsz, s, _ = q.shape
    n = s // HG_CHUNK
    log_f = jnp.log(lb + (1.0 - lb) * jax.nn.sigmoid(f_pre))
    k = (1.0 - lb) * jax.nn.sigmoid(-f_pre)

    def to_chunks(t):
        return t.reshape(bsz, n, HG_CHUNK, HG_HEADS, HG_HEAD_DIM).transpose(0, 3, 1, 2, 4)

    q, k, v, log_f = to_chunks(q), to_chunks(k), to_chunks(v), to_chunks(log_f)
    cum = jnp.cumsum(log_f, axis=3)
    total = cum[:, :, :, -1:, :]
    q_dec = q * jnp.exp(cum)
    k_inv = k * jnp.exp(-cum)
    k_end = k * jnp.exp(total - cum)
    causal = jnp.tril(jnp.ones((HG_CHUNK, HG_CHUNK), dtype=bool))
    scores = jnp.where(causal, jnp.einsum("bhnld,bhnmd->bhnlm", q_dec, k_inv), 0.0)
    o_intra = jnp.einsum("bhnlm,bhnme->bhnle", scores, v)

    def step(state, inp):
        q_c, k_c, v_c, dec_c = inp
        o_c = jnp.einsum("bhld,bhde->bhle", q_c, state)
        state = state * dec_c[..., None] + jnp.einsum("bhld,bhle->bhde", k_c, v_c)
        return state, o_c

    xs = (jnp.moveaxis(q_dec, 2, 0), jnp.moveaxis(k_end, 2, 0), jnp.moveaxis(v, 2, 0),
          jnp.moveaxis(jnp.exp(total[:, :, :, 0, :]), 2, 0))
    state0 = jnp.zeros((bsz, HG_HEADS, HG_HEAD_DIM, HG_HEAD_DIM), jnp.float32)
    _, o_inter = lax.scan(step, state0, xs)
    o = o_intra + jnp.moveaxis(o_inter, 0, 2)
    return o.transpose(0, 2, 3, 1, 4).reshape(bsz, s, HG_HEADS, HG_HEAD_DIM)


def rglru_hgrn2_layer(h, norm_g, w_in, conv_w, conv_b, w_a, b_a, w_x, b_x, lam, lb, hg_g, w_out):
    bsz, s, _ = h.shape
    u = rms_norm(h, norm_g).astype(jnp.float32)
    z = u @ w_in
    xa, ga, q, f_pre, iv, gb = jnp.split(z, AB_SPLITS, axis=-1)
    xa = causal_depthwise_conv(xa, conv_w, conv_b)
    ya = rg_lru(xa, w_a, b_a, w_x, b_x, lam) * jax.nn.silu(ga)
    o = hgrn2_mix(q, f_pre, iv, lb)
    o = o * lax.rsqrt(jnp.mean(o * o, axis=-1, keepdims=True) + RMS_EPS) * hg_g
    yb = o.reshape(bsz, s, HG_WIDTH) * jax.nn.silu(gb)
    out = jnp.concatenate([ya, yb], axis=-1) @ w_out
    return h + out.astype(h.dtype)


def rwkv7_scan(r, decay, k, v, kk, a):
    bsz = r.shape[0]

    def step(state, inp):
        r_t, w_t, k_t, v_t, kk_t, a_t = inp
        s_kk = jnp.einsum("bhvk,bhk->bhv", state, kk_t)
        state = (state * w_t[:, :, None, :]
                 - s_kk[..., None] * (kk_t * a_t)[:, :, None, :]
                 + v_t[..., None] * k_t[:, :, None, :])
        y_t = jnp.einsum("bhvk,bhk->bhv", state, r_t)
        return state, y_t

    xs = tuple(jnp.moveaxis(t, 1, 0) for t in (r, decay, k, v, kk, a))
    state0 = jnp.zeros((bsz, RW_HEADS, RW_HEAD_DIM, RW_HEAD_DIM), jnp.float32)
    _, y = lax.scan(step, state0, xs)
    return jnp.moveaxis(y, 0, 1)


def rwkv7_layer(h, norm_g, mu, w_r, w_k, w_v, w_g, w0, w1, w2, a0, a1, a2,
                k_k, k_a, r_k, lnx_g, lnx_b, w_o):
    bsz, s, _ = h.shape
    u = rms_norm(h, norm_g).astype(jnp.float32)
    delta = jnp.pad(u, ((0, 0), (1, 0), (0, 0)))[:, :-1] - u
    mu = mu.astype(jnp.float32)
    x_r, x_w, x_k, x_v, x_a, x_g = (u + delta * mu[i] for i in range(6))

    def heads(t):
        return t.reshape(bsz, s, RW_HEADS, RW_HEAD_DIM)

    r = x_r @ w_r
    k_raw = x_k @ w_k
    v = x_v @ w_v
    gate = jax.nn.silu(x_g @ w_g)
    w_log = -jax.nn.softplus(-(w0 + jnp.tanh(x_w @ w1) @ w2)) - 0.5
    decay = jnp.exp(-jnp.exp(w_log))
    a = jax.nn.sigmoid(a0 + (x_a @ a1) @ a2)
    kk = heads(k_raw * k_k)
    kk = kk / jnp.maximum(jnp.sqrt(jnp.sum(kk * kk, axis=-1, keepdims=True)), 1e-12)
    k = heads(k_raw * (1.0 + (a - 1.0) * k_a))
    r, v, decay, a = heads(r), heads(v), heads(decay), heads(a)
    y = rwkv7_scan(r, decay, k, v, kk, a)
    mean = jnp.mean(y, axis=-1, keepdims=True)
    var = jnp.mean(jnp.square(y - mean), axis=-1, keepdims=True)
    y = ((y - mean) * lax.rsqrt(var + GN_EPS)).reshape(bsz, s, RW_WIDTH) * lnx_g + lnx_b
    bonus = (jnp.sum(r * k * r_k, axis=-1, keepdims=True) * v).reshape(bsz, s, RW_WIDTH)
    out = ((y + bonus) * gate) @ w_o
    return h + out.astype(h.dtype)


def setup_inputs(seed: int = 0) -> dict:
    key = jax.random.key(seed)
    ks = iter(jax.random.split(key, 40))
    f32 = jnp.float32

    def nrm(shape, scale):
        return jax.random.normal(next(ks), shape, f32) * scale

    x = nrm((BATCH, SEQ, D_MODEL), 1.0)
    ab_norm_g = 1.0 + nrm((N_AB_LAYERS, D_MODEL), 0.02)
    ab_w_in = nrm((N_AB_LAYERS, D_MODEL, AB_IN_WIDTH), D_MODEL ** -0.5)
    rg_conv_w = nrm((N_AB_LAYERS, RG_CONV, RG_WIDTH), RG_CONV ** -0.5)
    rg_conv_b = nrm((N_AB_LAYERS, RG_WIDTH), 0.02)
    rg_w_a = nrm((N_AB_LAYERS, RG_BLOCKS, RG_BLOCK_DIM, RG_BLOCK_DIM), RG_BLOCK_DIM ** -0.5)
    rg_b_a = nrm((N_AB_LAYERS, RG_WIDTH), 0.02)
    rg_w_x = nrm((N_AB_LAYERS, RG_BLOCKS, RG_BLOCK_DIM, RG_BLOCK_DIM), RG_BLOCK_DIM ** -0.5)
    rg_b_x = nrm((N_AB_LAYERS, RG_WIDTH), 0.02)
    a_pow = jax.random.uniform(next(ks), (N_AB_LAYERS, RG_WIDTH), f32, minval=0.9, maxval=0.999)
    p = a_pow ** (1.0 / RG_C)
    rg_lambda = jnp.log(p) - jnp.log1p(-p)
    hg_lb_logits = nrm((N_AB_LAYERS + 1, HG_WIDTH), 0.1)
    hg_norm_g = 1.0 + nrm((N_AB_LAYERS, HG_HEAD_DIM), 0.02)
    ab_w_out = nrm((N_AB_LAYERS, AB_MIX_WIDTH, D_MODEL), AB_MIX_WIDTH ** -0.5)

    c_norm_g = 1.0 + nrm((N_C_LAYERS, D_MODEL), 0.02)
    c_mu = jax.random.uniform(next(ks), (N_C_LAYERS, 6, D_MODEL), f32)
    c_w_r = nrm((N_C_LAYERS, D_MODEL, RW_WIDTH), D_MODEL ** -0.5)
    c_w_k = nrm((N_C_LAYERS, D_MODEL, RW_WIDTH), D_MODEL ** -0.5)
    c_w_v = nrm((N_C_LAYERS, D_MODEL, RW_WIDTH), D_MODEL ** -0.5)
    c_w_g = nrm((N_C_LAYERS, D_MODEL, RW_WIDTH), D_MODEL ** -0.5)
    c_w0 = jnp.linspace(-6.0, -1.0, RW_WIDTH, dtype=f32)[None, :] + nrm((N_C_LAYERS, RW_WIDTH), 0.1)
    c_w1 = nrm((N_C_LAYERS, D_MODEL, RW_LORA), D_MODEL ** -0.5)
    c_w2 = nrm((N_C_LAYERS, RW_LORA, RW_WIDTH), 0.5 * RW_LORA ** -0.5)
    c_a0 = nrm((N_C_LAYERS, RW_WIDTH), 0.1)
    c_a1 = nrm((N_C_LAYERS, D_MODEL, RW_LORA), D_MODEL ** -0.5)
    c_a2 = nrm((N_C_LAYERS, RW_LORA, RW_WIDTH), RW_LORA ** -0.5)
    c_k_k = 0.85 + nrm((N_C_LAYERS, RW_WIDTH), 0.02)
    c_k_a = 1.0 + nrm((N_C_LAYERS, RW_WIDTH), 0.02)
    c_r_k = nrm((N_C_LAYERS, RW_HEADS, RW_HEAD_DIM), 0.1)
    c_lnx_g = 1.0 + nrm((N_C_LAYERS, RW_WIDTH), 0.02)
    c_lnx_b = nrm((N_C_LAYERS, RW_WIDTH), 0.02)
    c_w_o = nrm((N_C_LAYERS, RW_WIDTH, D_MODEL), RW_WIDTH ** -0.5)
    final_g = 1.0 + nrm((D_MODEL,), 0.02)
    return {
        "x": x, "ab_norm_g": ab_norm_g, "ab_w_in": ab_w_in, "rg_conv_w": rg_conv_w,
        "rg_conv_b": rg_conv_b, "rg_w_a": rg_w_a, "rg_b_a": rg_b_a, "rg_w_x": rg_w_x,
        "rg_b_x": rg_b_x, "rg_lambda": rg_lambda, "hg_lb_logits": hg_lb_logits,
        "hg_norm_g": hg_norm_g, "ab_w_out": ab_w_out, "c_norm_g": c_norm_g, "c_mu": c_mu,
        "c_w_r": c_w_r, "c_w_k": c_w_k, "c_w_v": c_w_v, "c_w_g": c_w_g, "c_w0": c_w0,
        "c_w1": c_w1, "c_w2": c_w2, "c_a0": c_a0, "c_a1": c_a1, "c_a2": c_a2,
        "c_k_k": c_k_k, "c_k_a": c_k_a, "c_r_k": c_r_k, "c_lnx_g": c_lnx_g,
        "c_lnx_b": c_lnx_b, "c_w_o": c_w_o, "final_g": final_g,
    }


def reference(x, ab_norm_g, ab_w_in, rg_conv_w, rg_conv_b, rg_w_a, rg_b_a, rg_w_x, rg_b_x,
              rg_lambda, hg_lb_logits, hg_norm_g, ab_w_out, c_norm_g, c_mu, c_w_r, c_w_k,
              c_w_v, c_w_g, c_w0, c_w1, c_w2, c_a0, c_a1, c_a2, c_k_k, c_k_a, c_r_k,
              c_lnx_g, c_lnx_b, c_w_o, final_g):
    lb_table = jnp.cumsum(jax.nn.softmax(hg_lb_logits.astype(jnp.float32), axis=0), axis=0)
    h = x
    for layer in range(DEPTH):
        j = layer // 2
        if layer % 2 == 0:
            h = rglru_hgrn2_layer(h, ab_norm_g[j], ab_w_in[j], rg_conv_w[j], rg_conv_b[j],
                                  rg_w_a[j], rg_b_a[j], rg_w_x[j], rg_b_x[j], rg_lambda[j],
                                  lb_table[j], hg_norm_g[j], ab_w_out[j])
        else:
            h = rwkv7_layer(h, c_norm_g[j], c_mu[j], c_w_r[j], c_w_k[j], c_w_v[j], c_w_g[j],
                            c_w0[j], c_w1[j], c_w2[j], c_a0[j], c_a1[j], c_a2[j], c_k_k[j],
                            c_k_a[j], c_r_k[j], c_lnx_g[j], c_lnx_b[j], c_w_o[j])
    return rms_norm(h, final_g)
```

```cpp
#define PROBE 0
#include <hip/hip_runtime.h>
#include <hip/hip_cooperative_groups.h>
#include <cstdio>
#include <cstring>
#include <cstdint>
namespace cg = cooperative_groups;
namespace pg8 {
#define PG8_LAS __attribute__((address_space(3)))
typedef unsigned short bf16_t;
typedef short bf16x8 __attribute__((ext_vector_type(8)));
typedef float f32x4 __attribute__((ext_vector_type(4)));
typedef unsigned u32x4 __attribute__((ext_vector_type(4)));
constexpr int BM = 256, BK = 64, HALF = 128, HTB = HALF * BK * 2  , STAGE_BYTES = 8 * HTB, NXCD = 8, WGM = 8;

__host__ __device__ __forceinline__ int lds_byte(int r, int c) { const int st = (r >> 4) * 2 + (c >> 5), rr = r & 15, cc = c & 31, ob = rr * 64 + cc * 2; return st * 1024 + (ob ^ (((ob >> 9) & 1) << 5)); }
__host__ __device__ __forceinline__ void stage_rc(int b, int& R, int& C) { const int st = b / 1024, sb = b % 1024, swz = sb ^ (((sb >> 9) & 1) << 5); R = (st >> 1) * 16 + swz / 64; C = (st & 1) * 32 + (swz % 64) / 2; }
__host__ __device__ __forceinline__ int perm32(int rho) { const int n = rho >> 4, i = rho & 15; return 8 * (i >> 2) + 4 * n + (i & 3); }

struct Unit { int pm, pn; };
struct Gemm { const bf16_t* A; const bf16_t* Bt; int M, N, K, lda; };

struct StaticOrder {
    int nM, nN, nwg, G, c;
    __host__ __device__ void init(int M, int N, int G_, int c_) { nM = M / BM; nN = N / BM; nwg = nM * nN; G = G_; c = c_; }
    __host__ __device__ bool next(int i, Unit& u) const {
        const long L = (long)i * G + c; if (L >= nwg) return false;
        int wgid = (int)L; { const int q = nwg / NXCD, r = nwg % NXCD, xcd = wgid % NXCD, off = wgid / NXCD; wgid = (xcd < r ? xcd * (q + 1) : r * (q + 1) + (xcd - r) * q) + off; }
        const int nig = WGM * nN, gid = wgid / nig, fm = gid * WGM, gsz = (nM - fm) < WGM ? (nM - fm) : WGM;
        u.pm = fm + ((wgid % nig) % gsz); u.pn = (wgid % nig) / gsz; return true;
    }
    __device__ __forceinline__ void a_ready(const Unit&) const {}
    __device__ __forceinline__ void done(const Unit&) const {}
};


struct LoraOrder {
    StaticOrder so; int extra;
    __host__ __device__ void init(int M, int N, int G_, int c_, int extra_) { so.init(M, N, G_, c_); extra = extra_; }
    __host__ __device__ bool next(int i, Unit& u) const { const long L = (long)i * so.G + so.c; if (L < so.nwg) return so.next(i, u); if (L >= so.nwg + extra) return false; u.pm = so.nM + (int)(L - so.nwg); u.pn = so.nN - 1; return true; }
    __device__ __forceinline__ void a_ready(const Unit&) const {}
    __device__ __forceinline__ void done(const Unit&) const {}
};
__device__ __forceinline__ unsigned cvt_pk_bf16(float lo, float hi) { unsigned r; asm volatile("v_cvt_pk_bf16_f32 %0, %1, %2" : "=v"(r) : "v"(lo), "v"(hi)); return r; }
__device__ __forceinline__ float sigm(float x) { return __builtin_amdgcn_rcpf(1.0f + __expf(-x)); }
struct EpiBf16 {
    static constexpr bool PERM = true, AFTER_DRAIN = false;
    bf16_t* O; int ldc;
    __device__ __forceinline__ void operator()(const f32x4 (&acc)[2][2][4][2], const Unit& u, int wr, int wc, int fr, int fq) const {
        const int row0 = u.pm * BM + wr * 64 + fr; const int col0 = u.pn * BM + wc * 32 + 8 * fq;
#pragma unroll
        for (int ai = 0; ai < 2; ++ai)
#pragma unroll
            for (int m = 0; m < 4; ++m) { bf16_t* rowp = O + (size_t)(row0 + ai * HALF + m * 16) * ldc + col0;
#pragma unroll
                for (int bj = 0; bj < 2; ++bj) { const f32x4 v0 = acc[ai][bj][m][0], v1 = acc[ai][bj][m][1];
                    u32x4 w; w.x = cvt_pk_bf16(v0[0], v0[1]); w.y = cvt_pk_bf16(v0[2], v0[3]); w.z = cvt_pk_bf16(v1[0], v1[1]); w.w = cvt_pk_bf16(v1[2], v1[3]);
                    *(u32x4*)(rowp + bj * HALF) = w; } }
    }
};
struct EpiResF32 {
    static constexpr bool PERM = false, AFTER_DRAIN = false;
    const float* base; float* out; int ldc; int remap; int pass;
    __device__ __forceinline__ void operator()(const f32x4 (&acc)[2][2][4][2], const Unit& u, int wr, int wc, int fr, int fq) const {
        const int col0 = u.pn * BM + wc * 32 + 4 * fq; const int rbase = remap ? ((((u.pm >> 3) & 3) << 12) + (u.pm >> 5) * 2048 + (u.pm & 7) * BM) : u.pm * BM;
#pragma unroll
        for (int ai = 0; ai < 2; ++ai)
#pragma unroll
            for (int m = 0; m < 4; ++m) { const size_t off = (size_t)(rbase + ai * HALF + wr * 64 + m * 16 + fr) * ldc + col0;
#pragma unroll
                for (int bj = 0; bj < 2; ++bj)
#pragma unroll
                    for (int n = 0; n < 2; ++n) { const f32x4 bs = *(const f32x4*)(base + off + bj * HALF + n * 16); *(f32x4*)(out + off + bj * HALF + n * 16) = bs + acc[ai][bj][m][n]; } }
    }
};
struct EpiL1 {
    static constexpr bool PERM = true, AFTER_DRAIN = false;
    bf16_t* R; bf16_t* LW; bf16_t* LA;
    __device__ __forceinline__ void operator()(const f32x4 (&acc)[2][2][4][2], const Unit& u, int wr, int wc, int fr, int fq) const {
        const int row0 = u.pm * BM + wr * 64 + fr;
        if (u.pn < 32) {
            const int buf = u.pn >> 3; bf16_t* base = R + (size_t)buf * (8192u * 2048u); const int col0 = (u.pn & 7) * BM + wc * 32 + 8 * fq;
#pragma unroll
            for (int ai = 0; ai < 2; ++ai)
#pragma unroll
                for (int m = 0; m < 4; ++m) { bf16_t* rowp = base + (size_t)(row0 + ai * HALF + m * 16) * 2048 + col0;
#pragma unroll
                    for (int bj = 0; bj < 2; ++bj) { f32x4 v0 = acc[ai][bj][m][0], v1 = acc[ai][bj][m][1];
                        if (buf == 3) {
#pragma unroll
                            for (int q = 0; q < 4; ++q) { v0[q] = v0[q] * sigm(v0[q]); v1[q] = v1[q] * sigm(v1[q]); } }
                        u32x4 w; w.x = cvt_pk_bf16(v0[0], v0[1]); w.y = cvt_pk_bf16(v0[2], v0[3]); w.z = cvt_pk_bf16(v1[0], v1[1]); w.w = cvt_pk_bf16(v1[2], v1[3]);
                        *(u32x4*)(rowp + bj * HALF) = w; } }
        } else {
            const int c0 = wc * 32 + 8 * fq;
#pragma unroll
            for (int ai = 0; ai < 2; ++ai)
#pragma unroll
                for (int m = 0; m < 4; ++m) { const size_t row = (size_t)(row0 + ai * HALF + m * 16); f32x4 v0 = acc[ai][0][m][0], v1 = acc[ai][0][m][1];
                    if (c0 < 64) {
#pragma unroll
                        for (int q = 0; q < 4; ++q) { v0[q] = tanhf(v0[q]); v1[q] = tanhf(v1[q]); } }
                    u32x4 w; w.x = cvt_pk_bf16(v0[0], v0[1]); w.y = cvt_pk_bf16(v0[2], v0[3]); w.z = cvt_pk_bf16(v1[0], v1[1]); w.w = cvt_pk_bf16(v1[2], v1[3]);
                    if (c0 < 64) *(u32x4*)(LW + row * 64 + c0) = w; else *(u32x4*)(LA + row * 64 + c0 - 64) = w; }
        }
    }
};

struct EpiFinalNorm {
    static constexpr bool PERM = false, AFTER_DRAIN = true;
    float* out; const float* g; unsigned long long* xg; int ldc;
    __device__ __forceinline__ void fused(f32x4 (&acc)[2][2][4][2], const Unit& u, int wr, int wc, int fr, int fq, PG8_LAS unsigned char* lds, int wid, int lane) const {
        PG8_LAS float* P = (PG8_LAS float*)lds; PG8_LAS float* S = (PG8_LAS float*)(lds + 4096);
        const int col0 = u.pn * BM + wc * 32 + 4 * fq; const int rbase = (((u.pm >> 3) & 3) << 12) + (u.pm >> 5) * 2048 + (u.pm & 7) * BM;
#pragma unroll
        for (int ai = 0; ai < 2; ++ai)
#pragma unroll
            for (int m = 0; m < 4; ++m) { const size_t off = (size_t)(rbase + ai * HALF + wr * 64 + m * 16 + fr) * ldc + col0; float s = 0.f;
#pragma unroll
                for (int bj = 0; bj < 2; ++bj)
#pragma unroll
                    for (int n = 0; n < 2; ++n) { const f32x4 v = acc[ai][bj][m][n] + *(const f32x4*)(out + off + bj * HALF + n * 16); acc[ai][bj][m][n] = v; s += (v[0] * v[0] + v[1] * v[1]) + (v[2] * v[2] + v[3] * v[3]); }
                s += __shfl_xor(s, 16); s += __shfl_xor(s, 32);
                if (fq == 0) P[(ai * HALF + wr * 64 + m * 16 + fr) * 4 + wc] = s; }
        asm volatile("s_waitcnt lgkmcnt(0)" ::: "memory"); __builtin_amdgcn_s_barrier(); asm volatile("" ::: "memory");
        const int row = wid * 32 + (lane & 31);
        if (lane < 32) { const float tot = (P[row * 4] + P[row * 4 + 1]) + (P[row * 4 + 2] + P[row * 4 + 3]);
            __hip_atomic_store(xg + ((size_t)(u.pm * 4 + u.pn) * 256 + row), (1ull << 32) | (unsigned long long)__float_as_uint(tot), __ATOMIC_RELAXED, __HIP_MEMORY_SCOPE_AGENT); }
        {
            float tot = 0.f;
            for (unsigned spins = 0;; ++spins) { bool ok = true; tot = 0.f;
                if (lane < 32) {
#pragma unroll
                    for (int q = 0; q < 4; ++q) { const unsigned long long x = __hip_atomic_load(xg + ((size_t)(u.pm * 4 + q) * 256 + row), __ATOMIC_RELAXED, __HIP_MEMORY_SCOPE_AGENT); ok &= (unsigned)(x >> 32) == 1u; tot += __uint_as_float((unsigned)x); } }
                if (__all(ok) || spins > (1u << 22)) break;
                __builtin_amdgcn_s_sleep(1); }
            if (lane < 32) S[row] = rsqrtf(tot * (1.0f / 1024.0f) + 1e-6f);
        }
        asm volatile("s_waitcnt lgkmcnt(0)" ::: "memory"); __builtin_amdgcn_s_barrier(); asm volatile("" ::: "memory");
#pragma unroll
        for (int ai = 0; ai < 2; ++ai)
#pragma unroll
            for (int m = 0; m < 4; ++m) { const int r = ai * HALF + wr * 64 + m * 16 + fr; const float rs = S[r]; const size_t off = (size_t)(rbase + r) * ldc + col0;
#pragma unroll
                for (int bj = 0; bj < 2; ++bj)
#pragma unroll
                    for (int n = 0; n < 2; ++n) { const f32x4 gg = *(const f32x4*)(g + col0 + bj * HALF + n * 16); *(f32x4*)(out + off + bj * HALF + n * 16) = acc[ai][bj][m][n] * rs * gg; } }
    }
};
template <class Epi, class Sched, bool ALIGN_EPI = false, bool SP2 = false>
__device__ __forceinline__ void gemm_phase(PG8_LAS unsigned char* lds, const Gemm g, const Sched& S, const Epi& E) {
    int tid_o = threadIdx.x; asm volatile("" : "+v"(tid_o)); const int tid = tid_o, wid = __builtin_amdgcn_readfirstlane(tid >> 6), lane = tid & 63, wr = wid >> 2, wc = wid & 3, fr = lane & 15, fq = lane >> 4;
    const int K = g.K, nt = K / BK;
    unsigned voffA[2], voffB[2];
#pragma unroll
    for (int i = 0; i < 2; ++i) { int R, C; stage_rc(tid * 16 + i * 8192, R, C); const int Rb = Epi::PERM ? ((R & ~31) + perm32(R & 31)) : R;
        voffA[i] = (unsigned)(R * g.lda + C) * 2u; voffB[i] = (unsigned)(Rb * K + C) * 2u; }
    const size_t kstep = (size_t)(BK * 2);
    const size_t hstep = (size_t)HALF * K * 2;
    const size_t tstep = 2 * hstep; const size_t hstepA = (size_t)HALF * g.lda * 2, tstepA = 2 * hstepA;
    const unsigned ldsw = (unsigned)wid * 1024u;
    const int aoff = lds_byte(wr * 64 + fr, fq * 8), boff = lds_byte(wc * 32 + fr, fq * 8);
#define PG8_SA(b, h) (((b) * 2 + (h)) * HTB)
#define PG8_SB(b, h) ((4 + (b) * 2 + (h)) * HTB)
#define PG8_STAGE(bufoff, gbase, voff) do { _Pragma("unroll") for (int _i = 0; _i < 2; ++_i) \
        __builtin_amdgcn_global_load_lds((const unsigned*)((const char*)(gbase) + (voff)[_i]), (PG8_LAS unsigned*)(lds + (bufoff) + ldsw + _i * 8192), 16, 0, 0); } while (0)
#define PG8_LDA(dst, b, h) do { _Pragma("unroll") for (int m = 0; m < 4; ++m) _Pragma("unroll") for (int k = 0; k < 2; ++k) dst[m][k] = *(const PG8_LAS bf16x8*)(lds + PG8_SA(b, h) + aoff + m * 2048 + k * 1024); } while (0)
#define PG8_LDB(dst, b, h) do { _Pragma("unroll") for (int n = 0; n < 2; ++n) _Pragma("unroll") for (int k = 0; k < 2; ++k) dst[n][k] = *(const PG8_LAS bf16x8*)(lds + PG8_SB(b, h) + boff + n * 2048 + k * 1024); } while (0)
#define PG8_MMA(ai, bj, At, Bt) do { __builtin_amdgcn_s_setprio(1); _Pragma("unroll") for (int m = 0; m < 4; ++m) _Pragma("unroll") for (int n = 0; n < 2; ++n) _Pragma("unroll") for (int k = 0; k < 2; ++k) \
        acc[ai][bj][m][n] = __builtin_amdgcn_mfma_f32_16x16x32_bf16(Bt[n][k], At[m][k], acc[ai][bj][m][n], 0, 0, 0); __builtin_amdgcn_s_setprio(0); } while (0)
#define PG8_WAIT_V(n) asm volatile("s_waitcnt vmcnt(" #n ")" ::: "memory")
#define PG8_WAIT_L(n) asm volatile("s_waitcnt lgkmcnt(" #n ")" ::: "memory")
#define PG8_BAR __builtin_amdgcn_s_barrier()
#define PG8_SCHED __builtin_amdgcn_sched_barrier(0)
    Unit cur, nxt; int ui = 0;
    if (!S.next(0, cur)) return;
    f32x4 acc[2][2][4][2];
#pragma unroll
    for (int a = 0; a < 2; ++a)
#pragma unroll
        for (int b = 0; b < 2; ++b)
#pragma unroll
            for (int m = 0; m < 4; ++m)
#pragma unroll
                for (int n = 0; n < 2; ++n) acc[a][b][m][n] = (f32x4){0.f, 0.f, 0.f, 0.f};
    bf16x8 At[4][2], B0[2][2], B1[2][2];
    const char* cA = (const char*)g.A + (size_t)cur.pm * tstepA; const char* cB = (const char*)g.Bt + (size_t)cur.pn * tstep;
    S.a_ready(cur);
    if constexpr (SP2) {
        PG8_STAGE(PG8_SB(0, 0), cB, voffB); PG8_STAGE(PG8_SB(0, 1), cB + hstep, voffB); PG8_STAGE(PG8_SA(0, 0), cA, voffA); PG8_STAGE(PG8_SA(0, 1), cA + hstepA, voffA);
        if (wr == 1) PG8_BAR;
        PG8_WAIT_V(2); PG8_BAR;
        PG8_STAGE(PG8_SB(1, 0), cB + kstep, voffB); PG8_STAGE(PG8_SA(1, 0), cA + kstep, voffA); PG8_STAGE(PG8_SB(1, 1), cB + hstep + kstep, voffB);
        PG8_WAIT_V(6); PG8_BAR;
    } else {
        PG8_STAGE(PG8_SB(0, 0), cB, voffB); PG8_STAGE(PG8_SA(0, 0), cA, voffA); PG8_STAGE(PG8_SB(0, 1), cB + hstep, voffB); PG8_STAGE(PG8_SA(0, 1), cA + hstepA, voffA);
        if (wr == 1) PG8_BAR;
        PG8_WAIT_V(4); PG8_BAR;
        PG8_STAGE(PG8_SB(1, 0), cB + kstep, voffB); PG8_STAGE(PG8_SA(1, 0), cA + kstep, voffA); PG8_STAGE(PG8_SB(1, 1), cB + hstep + kstep, voffB);
        PG8_WAIT_V(6); PG8_BAR;
    }
    for (;;) {
        const bool has_next = S.next(ui + 1, nxt);
        const char* nA = has_next ? (const char*)g.A + (size_t)nxt.pm * tstepA : cA; const char* nB = has_next ? (const char*)g.Bt + (size_t)nxt.pn * tstep : cB;
        for (int t = 0; t < nt; t += 2) {
            const bool last = (t == nt - 2);
            const char* a1 = cA + (size_t)(t + 1) * kstep;
            const char* a2 = last ? nA : cA + (size_t)(t + 2) * kstep; const char* b2 = last ? nB : cB + (size_t)(t + 2) * kstep;
            const char* a3 = a2 + kstep; const char* b3 = b2 + kstep;
            if (last && has_next) S.a_ready(nxt);
            if constexpr (SP2) {
            PG8_LDB(B0, 0, 0); PG8_LDB(B1, 0, 1); PG8_SCHED; PG8_LDA(At, 0, 0); PG8_STAGE(PG8_SA(1, 1), a1 + hstepA, voffA);
            PG8_WAIT_V(8); PG8_WAIT_L(0); PG8_BAR; PG8_MMA(0, 0, At, B0); PG8_MMA(0, 1, At, B1); PG8_BAR; PG8_SCHED;
            PG8_LDA(At, 0, 1); PG8_STAGE(PG8_SB(0, 0), b2, voffB); PG8_STAGE(PG8_SB(0, 1), b2 + hstep, voffB); PG8_STAGE(PG8_SA(0, 0), a2, voffA);
            PG8_WAIT_V(8); PG8_WAIT_L(0); PG8_BAR; PG8_MMA(1, 0, At, B0); PG8_MMA(1, 1, At, B1); PG8_BAR; PG8_SCHED;
            PG8_LDB(B0, 1, 0); PG8_LDB(B1, 1, 1); PG8_SCHED; PG8_LDA(At, 1, 0); PG8_STAGE(PG8_SA(0, 1), a2 + hstepA, voffA);
            PG8_WAIT_V(8); PG8_WAIT_L(0); PG8_BAR; PG8_MMA(0, 0, At, B0); PG8_MMA(0, 1, At, B1); PG8_BAR; PG8_SCHED;
            PG8_LDA(At, 1, 1); PG8_STAGE(PG8_SB(1, 0), b3, voffB); PG8_STAGE(PG8_SB(1, 1), b3 + hstep, voffB); PG8_STAGE(PG8_SA(1, 0), a3, voffA);
            PG8_WAIT_V(8); PG8_WAIT_L(0); PG8_BAR; PG8_MMA(1, 0, At, B0); PG8_MMA(1, 1, At, B1); PG8_BAR; PG8_SCHED;
            } else {
            PG8_LDB(B0, 0, 0); PG8_SCHED; PG8_LDA(At, 0, 0); PG8_STAGE(PG8_SA(1, 1), a1 + hstepA, voffA);
            PG8_WAIT_L(8); PG8_BAR; PG8_WAIT_L(0); PG8_MMA(0, 0, At, B0); PG8_BAR; PG8_SCHED;
            PG8_LDB(B1, 0, 1); PG8_STAGE(PG8_SB(0, 0), b2, voffB);
            PG8_BAR; PG8_WAIT_L(0); PG8_MMA(0, 1, At, B1); PG8_BAR;
            PG8_LDA(At, 0, 1); PG8_STAGE(PG8_SA(0, 0), a2, voffA);
            PG8_BAR; PG8_WAIT_L(0); PG8_MMA(1, 0, At, B0); PG8_BAR; PG8_SCHED;
            PG8_STAGE(PG8_SB(0, 1), b2 + hstep, voffB);
            PG8_WAIT_V(6); PG8_BAR; PG8_MMA(1, 1, At, B1); PG8_BAR;
            PG8_LDB(B0, 1, 0); PG8_SCHED; PG8_LDA(At, 1, 0); PG8_STAGE(PG8_SA(0, 1), a2 + hstepA, voffA);
            PG8_WAIT_L(8); PG8_BAR; PG8_WAIT_L(0); PG8_MMA(0, 0, At, B0); PG8_BAR; PG8_SCHED;
            PG8_LDB(B1, 1, 1); PG8_STAGE(PG8_SB(1, 0), b3, voffB);
            PG8_BAR; PG8_WAIT_L(0); PG8_MMA(0, 1, At, B1); PG8_BAR;
            PG8_LDA(At, 1, 1); PG8_STAGE(PG8_SA(1, 0), a3, voffA);
            PG8_BAR; PG8_WAIT_L(0); PG8_MMA(1, 0, At, B0); PG8_BAR; PG8_SCHED;
            PG8_STAGE(PG8_SB(1, 1), b3 + hstep, voffB);
            PG8_WAIT_V(6); PG8_BAR; PG8_MMA(1, 1, At, B1); PG8_BAR;
            }
        }
        if constexpr (ALIGN_EPI) { if (wr == 0) PG8_BAR; }
        if constexpr (!Epi::AFTER_DRAIN) { E(acc, cur, wr, wc, fr, fq); S.done(cur); }
        if (!has_next) break;
#pragma unroll
        for (int a = 0; a < 2; ++a)
#pragma unroll
            for (int b = 0; b < 2; ++b)
#pragma unroll
                for (int m = 0; m < 4; ++m)
#pragma unroll
                    for (int n = 0; n < 2; ++n) acc[a][b][m][n] = (f32x4){0.f, 0.f, 0.f, 0.f};
        cur = nxt; cA = nA; cB = nB; ++ui;
        if constexpr (ALIGN_EPI) { if (wr == 1) PG8_BAR; }
    }
    PG8_WAIT_V(0);
    if constexpr (!ALIGN_EPI) { if (wr == 0) PG8_BAR; }
    PG8_BAR;
    if constexpr (Epi::AFTER_DRAIN) { E.fused(acc, cur, wr, wc, fr, fq, lds, wid, lane); S.done(cur); }
#undef PG8_SA
#undef PG8_SB
#undef PG8_STAGE
#undef PG8_LDA
#undef PG8_LDB
#undef PG8_MMA
#undef PG8_WAIT_V
#undef PG8_WAIT_L
#undef PG8_BAR
#undef PG8_SCHED
}
}
#define GAS __attribute__((address_space(1)))
#define LAS __attribute__((address_space(3)))
typedef unsigned short bf16_t;
typedef short bf16x8 __attribute__((ext_vector_type(8)));
typedef float f32x4 __attribute__((ext_vector_type(4)));
typedef unsigned u32x4 __attribute__((ext_vector_type(4)));
typedef unsigned u32x2 __attribute__((ext_vector_type(2)));
typedef float f32x2 __attribute__((ext_vector_type(2)));
constexpr int NT = 512, PROWS6 = 8192;
constexpr int T = 16384, SEQ = 4096, D = 1024, ZW = 6144;
constexpr size_t MiB = 1u << 20;
constexpr size_t WS_DEC = 0;
constexpr size_t WS_Z = 4 * MiB;
constexpr size_t WS_WIN = 196 * MiB, WS_WOUT = 208 * MiB, WS_RGA = 212 * MiB, WS_RGX = 212 * MiB + 256 * 1024;
constexpr size_t WS_OI = 213 * MiB;
constexpr size_t WS_A2 = 4 * MiB;
constexpr size_t WS_R = 68 * MiB;
constexpr size_t WS_V = 132 * MiB;
constexpr size_t WS_WC = 196 * MiB, WS_WO = 229 * MiB, WS_LW = 233 * MiB, WS_LA = 235 * MiB;
constexpr size_t WS_W2T = 237 * MiB, WS_A2T = 237 * MiB + 256 * 1024, WS_GR = 238 * MiB, WS_ST = 239 * MiB, WS_XG = 241 * MiB;
constexpr size_t WS_BAR = 2 * MiB;
constexpr int LDS_BYTES = 147456, LDS_MISC = 147456 - 64;

struct Params { const GAS float* in[32]; GAS float* out; GAS unsigned char* ws; long long dry; };
#ifndef PROBE
#define PROBE 0
#endif
enum { I_X = 0, I_ABG, I_WIN, I_CONVW, I_CONVB, I_RGWA, I_RGBA, I_RGWX, I_RGBX, I_LAM, I_LB, I_HGG, I_WOUT, I_CNG, I_MU, I_WR, I_WK, I_WV, I_WG, I_W0, I_W1, I_W2, I_A0, I_A1, I_A2, I_KK, I_KA, I_RK, I_LNG, I_LNB, I_WO, I_FG };

__device__ __forceinline__ unsigned f2bf(float f) { unsigned u = __float_as_uint(f); return (u + 0x7fffu + ((u >> 16) & 1u)) >> 16; }
__device__ __forceinline__ float bf2f(unsigned h) { return __uint_as_float(h << 16); }
__device__ __forceinline__ unsigned pk2(float lo, float hi) { return f2bf(lo) | (f2bf(hi) << 16); }
__device__ __forceinline__ float sigmf(float x) { return __builtin_amdgcn_rcpf(1.0f + __expf(-x)); }
__device__ __forceinline__ float wave_sum(float v) {
#pragma unroll
    for (int o = 1; o < 64; o <<= 1) v += __shfl_xor(v, o);
    return v;
}
#define OPQ_TID unsigned char* WSP = launder_ws(((unsigned char*)p.ws)); int tid = threadIdx.x; asm volatile("" : "+v"(tid)); const int lane = tid & 63, wave = __builtin_amdgcn_readfirstlane(tid >> 6); (void)lane; (void)wave
__device__ __forceinline__ unsigned char* launder_ws(unsigned char* w) { const unsigned long long v = (unsigned long long)w; unsigned lo = __builtin_amdgcn_readfirstlane((unsigned)v), hi = __builtin_amdgcn_readfirstlane((unsigned)(v >> 32)); asm volatile("" : "+s"(lo), "+s"(hi)); return (unsigned char*)(GAS unsigned char*)(((unsigned long long)hi << 32) | lo); }
#define MFMA16(a, b, c) __builtin_amdgcn_mfma_f32_16x16x32_bf16((a), (b), (c), 0, 0, 0)

__device__ __forceinline__ void tr_item(const float* src, int ld_src, bf16_t* dst, int ld_dst, const float* sc, int scmode, LAS float* scr, int kb, int nb, int lane) {
    const int k0 = 64 * kb, n0 = 32 * nb;
#pragma unroll 8
    for (int i = 0; i < 32; ++i) { const int kk = 2 * i + (lane >> 5); float v = src[(size_t)(k0 + kk) * ld_src + n0 + (lane & 31)];
        if (sc) { const float m = sc[k0 + kk]; v *= scmode ? m : (1.0f - m); }
        scr[kk * 33 + (lane & 31)] = v; }
    asm volatile("s_waitcnt lgkmcnt(0)" ::: "memory");
    const int c = lane & 7;
#pragma unroll
    for (int j = 0; j < 4; ++j) { const int n = (lane >> 3) + 8 * j; const LAS float* s = scr + (8 * c) * 33 + n;
        u32x4 o; o.x = pk2(s[0 * 33], s[1 * 33]); o.y = pk2(s[2 * 33], s[3 * 33]); o.z = pk2(s[4 * 33], s[5 * 33]); o.w = pk2(s[6 * 33], s[7 * 33]);
        *(u32x4*)(dst + (size_t)(n0 + n) * ld_dst + k0 + 8 * c) = o; }
    asm volatile("s_waitcnt lgkmcnt(0)" ::: "memory");
}
__device__ __forceinline__ void rms_row(const float* xrow, const float* g, int lane, u32x2 (&o)[4]) {
    f32x4 v[4]; float s = 0.f;
#pragma unroll
    for (int j = 0; j < 4; ++j) { v[j] = *((const f32x4*)xrow + lane + 64 * j); s += (v[j].x * v[j].x + v[j].y * v[j].y) + (v[j].z * v[j].z + v[j].w * v[j].w); }
    const float rs = rsqrtf(wave_sum(s) * (1.0f / 1024.0f) + 1e-6f);
#pragma unroll
    for (int j = 0; j < 4; ++j) { const f32x4 gg = *((const f32x4*)g + lane + 64 * j); o[j].x = pk2(v[j].x * rs * gg.x, v[j].y * rs * gg.y); o[j].y = pk2(v[j].z * rs * gg.z, v[j].w * rs * gg.w); }
}

__device__ __forceinline__ void p0_prologue(const Params& p, LAS unsigned char* lds, int G, int bid) {
    OPQ_TID; const int gw = bid * 8 + wave, ngw = G * 8;
    LAS float* scr = (LAS float*)(lds + wave * 16384);
    bf16_t* WinT = (bf16_t*)(WSP + WS_WIN); bf16_t* WoutT = (bf16_t*)(WSP + WS_WOUT); bf16_t* RGA = (bf16_t*)(WSP + WS_RGA); bf16_t* RGX = (bf16_t*)(WSP + WS_RGX);
    constexpr int IA = 16 * 192, IB = 32 * 32, IC = 64;
    for (int it = gw; it < IA + IB + 2 * IC; it += ngw) {
        int r = it;
        if (r < IA) { tr_item(((const float*)p.in[I_WIN]), ZW, WinT, 1024, nullptr, 0, scr, r / 192, r % 192, lane); continue; } r -= IA;
        if (r < IB) { tr_item(((const float*)p.in[I_WOUT]), 1024, WoutT, 2048, nullptr, 0, scr, r / 32, r % 32, lane); continue; } r -= IB;
        const float* src = (r < IC) ? ((const float*)p.in[I_RGWA]) : ((const float*)p.in[I_RGWX]); bf16_t* dst = (r < IC) ? RGA : RGX; if (r >= IC) r -= IC;
        const int blk = r >> 3, q = r & 7;
        tr_item(src + blk * 16384, 128, dst + blk * 16384, 128, nullptr, 0, scr, q >> 2, q & 3, lane);
    }
    bf16_t* U0 = (bf16_t*)((float*)p.out);
    for (int m = gw; m < T; m += ngw) { u32x2 o[4]; rms_row(((const float*)p.in[I_X]) + (size_t)m * D, ((const float*)p.in[I_ABG]), lane, o);
#pragma unroll
        for (int j = 0; j < 4; ++j) *((u32x2*)(U0 + (size_t)m * D) + lane + 64 * j) = o[j]; }
}

__device__ __forceinline__ void rg_a_prefetch(const bf16_t* Z, int unit, int tid, u32x4 (&pre)[3]) {
    const int b = unit >> 9, n = (unit >> 3) & 63, j = unit & 7; const int tok0 = b * SEQ + n * 64, ch0 = j * 128;
#pragma unroll
    for (int q = 0; q < 3; ++q) { const int i = tid + q * NT; const int row = i >> 4, cc = i & 15; pre[q] = (u32x4){0u, 0u, 0u, 0u};
        if (i < 67 * 16 && (n > 0 || row >= 3)) pre[q] = *(const u32x4*)(Z + (size_t)(tok0 - 3 + row) * ZW + ch0 + 8 * cc); }
}
__device__ __forceinline__ void rg_a_unit(const Params& p, LAS unsigned char* lds, int unit, int next_unit, u32x4 (&pre)[3]) {
    OPQ_TID;
    LAS float* XC = (LAS float*)lds; LAS float* AA = (LAS float*)(lds + 32768); LAS bf16_t* XB = (LAS bf16_t*)(lds + 65536); LAS bf16_t* XR = (LAS bf16_t*)(lds + 82944);
    LAS float* SUMP = (LAS float*)(lds + 82944); LAS float* SUMH = SUMP + 512; LAS bf16_t* HT = XB; LAS bf16_t* PT = (LAS bf16_t*)(lds + 87040);
    const int b = unit >> 9, n = (unit >> 3) & 63, j = unit & 7;
    const int tok0 = b * SEQ + n * 64, ch0 = j * 128;
    const bf16_t* Z = (const bf16_t*)(WSP + WS_Z);
#pragma unroll
    for (int q = 0; q < 3; ++q) { const int i = tid + q * NT; if (i < 67 * 16) *(LAS u32x4*)(XR + (i >> 4) * 136 + 8 * (i & 15)) = pre[q]; }
    __syncthreads();
    if (next_unit < 2048) rg_a_prefetch(Z, next_unit, tid, pre);
    const int c = tid & 127, sub = tid >> 7;
    {
        const int ch = ch0 + c;
        const float w0 = ((const float*)p.in[I_CONVW])[ch], w1 = ((const float*)p.in[I_CONVW])[1024 + ch], w2 = ((const float*)p.in[I_CONVW])[2048 + ch], w3 = ((const float*)p.in[I_CONVW])[3072 + ch], cb = ((const float*)p.in[I_CONVB])[ch];
        const LAS bf16_t* xr = XR + (sub * 16) * 136 + c;
        float xm3 = bf2f(xr[0]), xm2 = bf2f(xr[136]), xm1 = bf2f(xr[272]);
#pragma unroll
        for (int i = 0; i < 16; ++i) { const float x = bf2f(xr[(i + 3) * 136]); const float y = w0 * xm3 + w1 * xm2 + w2 * xm1 + w3 * x + cb;
            XC[(sub * 16 + i) * 128 + c] = y; XB[(sub * 16 + i) * 136 + c] = (bf16_t)f2bf(y); xm3 = xm2; xm2 = xm1; xm1 = x; }
    }
    __syncthreads();
    {
        const int fr = lane & 15, fq = lane >> 4;
        const bf16_t* WA = (const bf16_t*)(WSP + WS_RGA) + j * 16384 + (16 * wave + fr) * 128 + 8 * fq;
        const bf16_t* WX = (const bf16_t*)(WSP + WS_RGX) + j * 16384 + (16 * wave + fr) * 128 + 8 * fq;
        f32x4 accA[4], accX[4];
#pragma unroll
        for (int m = 0; m < 4; ++m) { accA[m] = (f32x4){0.f, 0.f, 0.f, 0.f}; accX[m] = (f32x4){0.f, 0.f, 0.f, 0.f}; }
#pragma unroll
        for (int k = 0; k < 4; ++k) { const bf16x8 bA = *(const bf16x8*)(WA + 32 * k), bX = *(const bf16x8*)(WX + 32 * k);
#pragma unroll
            for (int m = 0; m < 4; ++m) { const bf16x8 a = *(const LAS bf16x8*)(XB + (16 * m + fr) * 136 + 32 * k + 8 * fq); accA[m] = MFMA16(a, bA, accA[m]); accX[m] = MFMA16(a, bX, accX[m]); } }
        const int cl = 16 * wave + fr, ch = ch0 + cl;
        const float ba = ((const float*)p.in[I_RGBA])[ch], bx = ((const float*)p.in[I_RGBX])[ch], lam = ((const float*)p.in[I_LAM])[ch];
        const float sp = log1pf(expf(-lam));
#pragma unroll
        for (int m = 0; m < 4; ++m)
#pragma unroll
            for (int r = 0; r < 4; ++r) { const int tk = 16 * m + 4 * fq + r; const float gr = sigmf(accA[m][r] + ba), gi = sigmf(accX[m][r] + bx);
                const float la = -8.0f * gr * sp; const float a = __expf(la); const float mult = __builtin_amdgcn_sqrtf(fmaxf(1.0f - a * a, 0.f));
                const float xc = XC[tk * 128 + cl]; AA[tk * 128 + cl] = a; XC[tk * 128 + cl] = mult * gi * xc; }
    }
    __syncthreads();
    {
        float hl[16], pl[16]; float h = 0.f, P = 1.f;
#pragma unroll
        for (int i = 0; i < 16; ++i) { const float a = AA[(sub * 16 + i) * 128 + c], u = XC[(sub * 16 + i) * 128 + c]; h = a * h + u; P *= a; hl[i] = h; pl[i] = P; }
        SUMP[sub * 128 + c] = P; SUMH[sub * 128 + c] = h;
        __syncthreads();
        float chh = 0.f, cp = 1.f;
#pragma unroll
        for (int s = 0; s < 3; ++s) if (s < sub) { const float sp_ = SUMP[s * 128 + c]; chh = chh * sp_ + SUMH[s * 128 + c]; cp *= sp_; }
#pragma unroll
        for (int i = 0; i < 16; ++i) { HT[(sub * 16 + i) * 136 + c] = (bf16_t)f2bf(hl[i] + pl[i] * chh); PT[(sub * 16 + i) * 136 + c] = (bf16_t)f2bf(pl[i] * cp); }
    }
    __syncthreads();
    {
        bf16_t* HL = (bf16_t*)((float*)p.out) + (size_t)tok0 * D + ch0; bf16_t* PC = HL + (size_t)T * D;
        for (int i = tid; i < 1024; i += NT) { const int row = i >> 4, cc = i & 15;
            *(u32x4*)(HL + (size_t)row * D + 8 * cc) = *(const LAS u32x4*)(HT + row * 136 + 8 * cc); *(u32x4*)(PC + (size_t)row * D + 8 * cc) = *(const LAS u32x4*)(PT + row * 136 + 8 * cc); }
    }
    __syncthreads();
}

__device__ __forceinline__ void hg_a_prefetch(const bf16_t* Z, int unit, int tid, u32x4 (&pre)[6]) {
    const int b = unit >> 9, h = (unit >> 6) & 7, n = unit & 63; const int tok0 = b * SEQ + n * 64;
#pragma unroll
    for (int q = 0; q < 6; ++q) { const int i = tid + q * NT; const int arr = i >> 10, row = (i >> 4) & 63, cc = i & 15; pre[q] = *(const u32x4*)(Z + (size_t)(tok0 + row) * ZW + 2048 + 1024 * arr + h * 128 + 8 * cc); }
}
__device__ __forceinline__ void hg_a_unit(const Params& p, LAS unsigned char* lds, int unit, int next_unit, u32x4 (&pre)[6]) {
    OPQ_TID;
    LAS bf16_t* QD = (LAS bf16_t*)lds; LAS bf16_t* KI = (LAS bf16_t*)(lds + 17408); LAS bf16_t* VR = (LAS bf16_t*)(lds + 34816); LAS bf16_t* VT = (LAS bf16_t*)(lds + 52224);
    LAS bf16_t* SC = (LAS bf16_t*)(lds + 70656); LAS float* ST = (LAS float*)(lds + 79872); LAS bf16_t* OT = VR;
    const int b = unit >> 9, h = (unit >> 6) & 7, n = unit & 63;
    const int tok0 = b * SEQ + n * 64;
    bf16_t* Z = (bf16_t*)(WSP + WS_Z);
    const int fr = lane & 15, fq = lane >> 4;
#pragma unroll
    for (int q = 0; q < 6; ++q) { const int i = tid + q * NT; const int arr = i >> 10, row = (i >> 4) & 63, cc = i & 15;
        *(LAS u32x4*)((arr == 0 ? QD : (arr == 1 ? KI : VR)) + row * 136 + 8 * cc) = pre[q]; }
    __syncthreads();
    {
        const int d = tid & 127, sub = tid >> 7, hd = h * 128 + d;
        const float lb = sigmf(((const float*)p.in[I_LB])[hd] - ((const float*)p.in[I_LB])[1024 + hd]), omlb = 1.0f - lb;
        float q[16], kq[16], cl[16]; unsigned short vv[16]; float run = 0.f;
#pragma unroll
        for (int i = 0; i < 16; ++i) { const int t = sub * 16 + i; const float f = bf2f(KI[t * 136 + d]); const float sg = sigmf(f);
            run += __logf(lb + omlb * sg); cl[i] = run; kq[i] = omlb * (1.0f - sg); q[i] = bf2f(QD[t * 136 + d]); vv[i] = VR[t * 136 + d]; }
        ST[sub * 128 + d] = run;
        __syncthreads();
        float off = 0.f, total = 0.f;
#pragma unroll
        for (int s = 0; s < 4; ++s) { const float x = ST[s * 128 + d]; total += x; if (s < sub) off += x; }
        unsigned ke[8], vp[8];
#pragma unroll
        for (int i = 0; i < 16; ++i) { const float cum = off + cl[i]; const unsigned qd = f2bf(q[i] * __expf(cum)), ki = f2bf(kq[i] * __expf(-cum)), kE = f2bf(kq[i] * __expf(total - cum));
            QD[(sub * 16 + i) * 136 + d] = (bf16_t)qd; KI[(sub * 16 + i) * 136 + d] = (bf16_t)ki;
            if (i & 1) { ke[i >> 1] |= kE << 16; vp[i >> 1] |= (unsigned)vv[i] << 16; } else { ke[i >> 1] = kE; vp[i >> 1] = vv[i]; } }
        *(LAS u32x4*)(VT + d * 72 + sub * 16) = (u32x4){vp[0], vp[1], vp[2], vp[3]}; *(LAS u32x4*)(VT + d * 72 + sub * 16 + 8) = (u32x4){vp[4], vp[5], vp[6], vp[7]};
        bf16_t* tb = Z + (size_t)(tok0 + (d >> 1)) * ZW + h * 128 + (d & 1) * 64 + sub * 16;
        *(u32x4*)(tb + 3072) = (u32x4){ke[0], ke[1], ke[2], ke[3]}; *(u32x4*)(tb + 3072 + 8) = (u32x4){ke[4], ke[5], ke[6], ke[7]};
        *(u32x4*)(tb + 4096) = (u32x4){vp[0], vp[1], vp[2], vp[3]}; *(u32x4*)(tb + 4096 + 8) = (u32x4){vp[4], vp[5], vp[6], vp[7]};
        if (sub == 0) ((float*)(WSP + WS_DEC))[unit * 128 + d] = __expf(total);
    }
    __syncthreads();
    if (next_unit < 2048) hg_a_prefetch(Z, next_unit, tid, pre);
    for (int i = tid; i < 1024; i += NT) { const int row = i >> 4, cc = i & 15; *(u32x4*)(Z + (size_t)(tok0 + row) * ZW + 2048 + h * 128 + 8 * cc) = *(const LAS u32x4*)(QD + row * 136 + 8 * cc); }
    {
        const int lt = wave >> 1;
#pragma unroll
        for (int x = 0; x < 2; ++x) { const int mt = (wave & 1) * 2 + x; f32x4 acc = (f32x4){0.f, 0.f, 0.f, 0.f};
            if (mt <= lt) {
#pragma unroll
                for (int k = 0; k < 4; ++k) { const bf16x8 a = *(const LAS bf16x8*)(QD + (16 * lt + fr) * 136 + 32 * k + 8 * fq), bb = *(const LAS bf16x8*)(KI + (16 * mt + fr) * 136 + 32 * k + 8 * fq); acc = MFMA16(a, bb, acc); } }
#pragma unroll
            for (int r = 0; r < 4; ++r) { const int l = 16 * lt + 4 * fq + r, mm = 16 * mt + fr; SC[l * 72 + mm] = (bf16_t)f2bf(mm <= l ? acc[r] : 0.f); } }
    }
    __syncthreads();
    {
#pragma unroll
        for (int lt = 0; lt < 4; ++lt) { f32x4 acc = (f32x4){0.f, 0.f, 0.f, 0.f};
#pragma unroll
            for (int k = 0; k < 2; ++k) { const bf16x8 a = *(const LAS bf16x8*)(SC + (16 * lt + fr) * 72 + 32 * k + 8 * fq), bb = *(const LAS bf16x8*)(VT + (16 * wave + fr) * 72 + 32 * k + 8 * fq); acc = MFMA16(a, bb, acc); }
#pragma unroll
            for (int r = 0; r < 4; ++r) OT[(16 * lt + 4 * fq + r) * 136 + 16 * wave + fr] = (bf16_t)f2bf(acc[r]); }
    }
    __syncthreads();
    { bf16_t* OI = (bf16_t*)(WSP + WS_OI) + (size_t)tok0 * D + h * 128;
      for (int i = tid; i < 1024; i += NT) { const int row = i >> 4, cc = i & 15; *(u32x4*)(OI + (size_t)row * D + 8 * cc) = *(const LAS u32x4*)(OT + row * 136 + 8 * cc); } }
    __syncthreads();
}

__device__ __forceinline__ void hg_b_item(const Params& p, LAS unsigned char* lds, int item, bool dry = false) {
    OPQ_TID;
    LAS bf16_t* SB = (LAS bf16_t*)lds;
    const int b = item >> 6, h = (item >> 3) & 7, es = item & 7;
    const int fr = lane & 15, fq = lane >> 4;
    const bf16_t* Z = (const bf16_t*)(WSP + WS_Z); bf16_t* OI = (bf16_t*)(WSP + WS_OI); const float* DEC = (const float*)(WSP + WS_DEC);
    for (int i = tid; i < 2 * 16 * 136 / 2; i += NT) ((LAS unsigned*)SB)[i] = 0u;
    __syncthreads();
    f32x4 S = (f32x4){0.f, 0.f, 0.f, 0.f};
    const int eg = 16 * es + fr, dg = 16 * wave + fr;
    const bf16_t* pV = Z + (size_t)(b * SEQ + (eg >> 1)) * ZW + 4096 + h * 128 + (eg & 1) * 64 + 8 * fq;
    const bf16_t* pK = Z + (size_t)(b * SEQ + (dg >> 1)) * ZW + 3072 + h * 128 + (dg & 1) * 64 + 8 * fq;
    const bf16_t* pQ = Z + (size_t)(b * SEQ + 16 * (wave & 3) + fr) * ZW + 2048 + h * 128 + 8 * fq;
    bf16_t* pO = OI + (size_t)(b * SEQ + 16 * (wave & 3) + 4 * fq) * D + h * 128 + 16 * es + fr;
    const float* pD = DEC + (size_t)((b * 8 + h) * 64) * 128 + dg;
    bf16x8 nV[2][2], nK[2][2], nQ[2][4]; float ndec[2]; unsigned short nO[2][4];
#define HGB_LOAD(SET, n_) do { const size_t ro_ = (size_t)(n_) * 64 * ZW; ndec[SET] = pD[(n_) * 128]; \
        _Pragma("unroll") for (int k = 0; k < 2; ++k) { nV[SET][k] = *(const bf16x8*)(pV + ro_ + 32 * k); nK[SET][k] = *(const bf16x8*)(pK + ro_ + 32 * k); } \
        if (wave < 4) { _Pragma("unroll") for (int k = 0; k < 4; ++k) nQ[SET][k] = *(const bf16x8*)(pQ + ro_ + 32 * k); \
            _Pragma("unroll") for (int r = 0; r < 4; ++r) nO[SET][r] = pO[(size_t)((n_) * 64 + r) * D]; } } while (0)
#define HGB_STEP(SET, n) do { \
        const float dec = ndec[SET]; bf16x8 aV[2], bK[2]; \
        _Pragma("unroll") for (int k = 0; k < 2; ++k) { aV[k] = nV[SET][k]; bK[k] = nK[SET][k]; } \
        if (wave < 4) { \
            f32x4 acc = (f32x4){0.f, 0.f, 0.f, 0.f}; \
            _Pragma("unroll") for (int k = 0; k < 4; ++k) { const bf16x8 bb = *(const LAS bf16x8*)(SB + ((n) & 1) * 2176 + fr * 136 + 32 * k + 8 * fq); acc = MFMA16(nQ[SET][k], bb, acc); } \
            _Pragma("unroll") for (int r = 0; r < 4; ++r) { const float nv = bf2f(nO[SET][r]) + acc[r]; if (!dry) pO[(size_t)((n) * 64 + r) * D] = (bf16_t)f2bf(nv); else if (nv == 123456.0f) pO[0] = 0; } \
        } \
        if ((n) + 2 < 64) HGB_LOAD(SET, (n) + 2); \
        S = S * dec; \
        _Pragma("unroll") for (int k = 0; k < 2; ++k) S = MFMA16(aV[k], bK[k], S); \
        _Pragma("unroll") for (int r = 0; r < 4; ++r) SB[(((n) + 1) & 1) * 2176 + (4 * fq + r) * 136 + dg] = (bf16_t)f2bf(S[r]); \
        asm volatile("s_waitcnt lgkmcnt(0)" ::: "memory"); __builtin_amdgcn_s_barrier(); asm volatile("" ::: "memory"); } while (0)
    HGB_LOAD(0, 0); HGB_LOAD(1, 1);
#pragma unroll 1
    for (int n2 = 0; n2 < 64; n2 += 2) { HGB_STEP(0, n2); HGB_STEP(1, n2 + 1); }
#undef HGB_LOAD
#undef HGB_STEP
}
__device__ __forceinline__ void rg_b_unit(const Params& p, int unit) {
    OPQ_TID;
    const int b = unit >> 7, n = (unit >> 1) & 63, ch = (unit & 1) * 512 + 8 * (tid & 63), r8 = tid >> 6;
    const bf16_t* HL = (const bf16_t*)((float*)p.out) + (size_t)b * SEQ * D + ch; const bf16_t* PC = HL + (size_t)T * D;
    bf16_t* Z = (bf16_t*)(WSP + WS_Z) + (size_t)(b * SEQ + n * 64) * ZW + ch;
    float carry[8];
#pragma unroll
    for (int i = 0; i < 8; ++i) carry[i] = 0.f;
    int m0 = 0;
    for (; m0 + 4 <= n; m0 += 4) { u32x4 pp[4], hh4[4];
#pragma unroll
        for (int i = 0; i < 4; ++i) { const size_t o = (size_t)((m0 + i) * 64 + 63) * D; pp[i] = *(const u32x4*)(PC + o); hh4[i] = *(const u32x4*)(HL + o); }
#pragma unroll
        for (int i = 0; i < 4; ++i)
#pragma unroll
            for (int c = 0; c < 4; ++c) { carry[2 * c] = carry[2 * c] * bf2f(pp[i][c] & 0xffffu) + bf2f(hh4[i][c] & 0xffffu); carry[2 * c + 1] = carry[2 * c + 1] * bf2f(pp[i][c] >> 16) + bf2f(hh4[i][c] >> 16); } }
    for (; m0 < n; ++m0) { const size_t o = (size_t)(m0 * 64 + 63) * D; const u32x4 pp = *(const u32x4*)(PC + o), hh4 = *(const u32x4*)(HL + o);
#pragma unroll
        for (int c = 0; c < 4; ++c) { carry[2 * c] = carry[2 * c] * bf2f(pp[c] & 0xffffu) + bf2f(hh4[c] & 0xffffu); carry[2 * c + 1] = carry[2 * c + 1] * bf2f(pp[c] >> 16) + bf2f(hh4[c] >> 16); } }
#pragma unroll 4
    for (int tq = 0; tq < 8; ++tq) { const int t = 8 * tq + r8; const size_t o = (size_t)(n * 64 + t) * D;
        const u32x4 hv = *(const u32x4*)(HL + o), pv = *(const u32x4*)(PC + o), gv = *(const u32x4*)(Z + (size_t)t * ZW + 1024); u32x4 ov;
#pragma unroll
        for (int c = 0; c < 4; ++c) { const float h0 = bf2f(hv[c] & 0xffffu) + bf2f(pv[c] & 0xffffu) * carry[2 * c], h1 = bf2f(hv[c] >> 16) + bf2f(pv[c] >> 16) * carry[2 * c + 1];
            const float g0 = bf2f(gv[c] & 0xffffu), g1 = bf2f(gv[c] >> 16); ov[c] = pk2(h0 * g0 * sigmf(g0), h1 * g1 * sigmf(g1)); }
        *(u32x4*)(Z + (size_t)t * ZW) = ov; }
}
__device__ __forceinline__ void p4_finalize(const Params& p, int G, int bid) {
    OPQ_TID; const int gw = bid * 8 + wave, ngw = G * 8;
    bf16_t* Z = (bf16_t*)(WSP + WS_Z); const bf16_t* OI = (const bf16_t*)(WSP + WS_OI);
    const float g0 = ((const float*)p.in[I_HGG])[2 * lane], g1 = ((const float*)p.in[I_HGG])[2 * lane + 1];
    for (int it = gw; it < T * 8; it += ngw) { const int tok = it >> 3, h = it & 7;
        const unsigned o2 = *(const unsigned*)(OI + (size_t)tok * D + h * 128 + 2 * lane); const float o0 = bf2f(o2 & 0xffffu), o1 = bf2f(o2 >> 16);
        const float rs = rsqrtf(wave_sum(o0 * o0 + o1 * o1) * (1.0f / 128.0f) + 1e-6f);
        const unsigned gb = *(const unsigned*)(Z + (size_t)tok * ZW + 5120 + h * 128 + 2 * lane); const float gb0 = bf2f(gb & 0xffffu), gb1 = bf2f(gb >> 16);
        *(unsigned*)(Z + (size_t)tok * ZW + 1024 + h * 128 + 2 * lane) = pk2(o0 * rs * g0 * gb0 * sigmf(gb0), o1 * rs * g1 * gb1 * sigmf(gb1)); }
}
__device__ __forceinline__ void p6_prologue(const Params& p, LAS unsigned char* lds, int G, int bid) {
    OPQ_TID; const int gw = bid * 8 + wave, ngw = G * 8;
    LAS float* scr = (LAS float*)(lds + wave * 16384);
    constexpr int IP = 8192, IL = 128, IO = 1024, I2 = 128;
    for (int i = gw * 64 + lane; i < (int)(MiB / 16); i += ngw * 64) ((u32x4*)(WSP + WS_GR))[i] = (u32x4){0u, 0u, 0u, 0u};
    for (int i = gw * 64 + lane; i < (int)(MiB / 32); i += ngw * 64) ((u32x4*)(WSP + WS_XG))[i] = (u32x4){0u, 0u, 0u, 0u};
    for (int it = gw; it < IP + IL + IO + I2; it += ngw) {
        int r = it;
        if (r < IP) { const int blk = r >> 10, q = r & 1023, pj = blk >> 1, md = blk & 1;
            const int muidx = pj == 0 ? 0 : (pj == 1 ? 2 : (pj == 2 ? 3 : 5));
            bf16_t* dst = (bf16_t*)(WSP + WS_WC) + (size_t)(pj * 2048) * 2048 + md * 1024;
            tr_item(((const float*)p.in[I_WR + pj]), 2048, dst, 2048, ((const float*)p.in[I_MU]) + muidx * 1024, md, scr, q >> 6, q & 63, lane); continue; }
        r -= IP;
        if (r < IL) { const int blk = r >> 5, q = r & 31, wh = blk >> 1, md = blk & 1;
            const float* src = wh ? ((const float*)p.in[I_A1]) : ((const float*)p.in[I_W1]); bf16_t* dst = (bf16_t*)(WSP + WS_WC) + (size_t)(8192 + wh * 64) * 2048 + md * 1024;
            tr_item(src, 64, dst, 2048, ((const float*)p.in[I_MU]) + (wh ? 4 : 1) * 1024, md, scr, q >> 1, q & 1, lane); continue; }
        r -= IL;
        if (r >= IO) { r -= IO; const int wh = r >> 6, nb = r & 63; tr_item(wh ? ((const float*)p.in[I_A2]) : ((const float*)p.in[I_W2]), 2048, (bf16_t*)(WSP + (wh ? WS_A2T : WS_W2T)), 64, nullptr, 0, scr, 0, nb, lane); continue; }
        tr_item(((const float*)p.in[I_WO]), 1024, (bf16_t*)(WSP + WS_WO), 2048, nullptr, 0, scr, r >> 5, r & 31, lane);
    }
    bf16_t* A2 = (bf16_t*)(WSP + WS_A2);
    for (int m = gw; m < T; m += ngw) { u32x2 o[4]; rms_row(((float*)p.out) + (size_t)m * D, ((const float*)p.in[I_CNG]), lane, o); const int bb = m >> 12, t = m & (SEQ - 1);
        const size_t cr = (size_t)(t >> 11) * PROWS6 + bb * 2048 + (t & 2047);
        const size_t cn = (size_t)((t + 1) >> 11) * PROWS6 + bb * 2048 + ((t + 1) & 2047);
#pragma unroll
        for (int j = 0; j < 4; ++j) { *((u32x2*)(A2 + cr * 2048) + lane + 64 * j) = o[j];
            if (t + 1 < SEQ) *((u32x2*)(A2 + cn * 2048 + 1024) + lane + 64 * j) = o[j];
            if (t == 0) *((u32x2*)(A2 + cr * 2048 + 1024) + lane + 64 * j) = (u32x2){0u, 0u}; } }
}
template <int CTRL> __device__ __forceinline__ float dpp_add(float x) { const int y = __builtin_amdgcn_update_dpp(0, __float_as_int(x), CTRL, 0xf, 0xf, true); return x + __int_as_float(y); }
__device__ __forceinline__ f32x4 bf4(u32x2 v) { return (f32x4){bf2f(v.x & 0xffffu), bf2f(v.x >> 16), bf2f(v.y & 0xffffu), bf2f(v.y >> 16)}; }
__device__ __forceinline__ float afma(float a, float b, float c) { float d; asm("v_fma_f32 %0, %1, %2, %3" : "=v"(d) : "v"(a), "v"(b), "v"(c)); return d; }
__device__ __forceinline__ float anfma(float a, float b, float c) { float d; asm("v_fma_f32 %0, -%1, %2, %3" : "=v"(d) : "v"(a), "v"(b), "v"(c)); return d; }
__device__ __forceinline__ float amul(float a, float b) { float d; asm("v_mul_f32 %0, %1, %2" : "=v"(d) : "v"(a), "v"(b)); return d; }
__device__ __forceinline__ f32x2 pkmul(f32x2 a, f32x2 b) { f32x2 d; asm("v_pk_mul_f32 %0, %1, %2" : "=v"(d) : "v"(a), "v"(b)); return d; }
__device__ __forceinline__ f32x2 pkfma(f32x2 a, f32x2 b, f32x2 c) { f32x2 d; asm("v_pk_fma_f32 %0, %1, %2, %3" : "=v"(d) : "v"(a), "v"(b), "v"(c)); return d; }
__device__ __forceinline__ f32x2 pkmul_bl(f32x2 s, f32x2 b) { f32x2 d; asm("v_pk_mul_f32 %0, %1, %2 op_sel_hi:[0,1]" : "=v"(d) : "v"(s), "v"(b)); return d; }
__device__ __forceinline__ f32x2 pknfma_bl(f32x2 s, f32x2 b, f32x2 c) { f32x2 d; asm("v_pk_fma_f32 %0, %1, %2, %3 op_sel_hi:[0,1,1] neg_lo:[1,0,0] neg_hi:[1,0,0]" : "=v"(d) : "v"(s), "v"(b), "v"(c)); return d; }
constexpr int RSTR = 68;
constexpr int REC_ARR = 32 * RSTR;
constexpr int REC_BUF = 5 * REC_ARR;
constexpr int L_REC = 0, L_YY = 87040, L_VV = 103424, L_GG = 119808, L_RKP = 136192, L_SSP = 137216, L_STT = 137728, L_CST = 137984;
constexpr int PROWS = 8192;
#define SCAN_BAR do { asm volatile("s_waitcnt lgkmcnt(0)" ::: "memory"); __builtin_amdgcn_s_barrier(); asm volatile("" ::: "memory"); } while (0)
__device__ __forceinline__ void scan_half(const Params& p, LAS unsigned char* lds, int pi, int rh, int pass) {
    OPQ_TID;
    LAS float* REC = (LAS float*)(lds + L_REC); LAS float* YY = (LAS float*)(lds + L_YY); LAS float* VV = (LAS float*)(lds + L_VV); LAS float* GG = (LAS float*)(lds + L_GG);
    LAS float* RKP = (LAS float*)(lds + L_RKP); LAS float* SSP = (LAS float*)(lds + L_SSP); LAS float* STT = (LAS float*)(lds + L_STT); LAS float* CST = (LAS float*)(lds + L_CST);
    const int b = pi >> 5, hg = pi & 31, colg = hg * 64;
    const bf16_t* Rb = (const bf16_t*)(WSP + WS_R); const bf16_t* Kb = Rb + (size_t)PROWS * 2048; bf16_t* Vb = (bf16_t*)(WSP + WS_V); const bf16_t* Gb = Vb + (size_t)PROWS * 2048;
    const bf16_t* LWb = (const bf16_t*)(WSP + WS_LW) + (size_t)pass * PROWS * 64; const bf16_t* LAb = (const bf16_t*)(WSP + WS_LA) + (size_t)pass * PROWS * 64;
    unsigned long long* GR = (unsigned long long*)(WSP + WS_GR);
    const size_t rowb = (size_t)b * 2048;
    __syncthreads();
    if (tid < 64) { CST[tid] = ((const float*)p.in[I_W0])[colg + tid]; CST[64 + tid] = ((const float*)p.in[I_A0])[colg + tid]; CST[128 + tid] = ((const float*)p.in[I_KK])[colg + tid]; CST[192 + tid] = ((const float*)p.in[I_KA])[colg + tid]; CST[256 + tid] = ((const float*)p.in[I_RK])[colg + tid];
                    CST[320 + tid] = ((const float*)p.in[I_LNG])[colg + tid]; CST[384 + tid] = ((const float*)p.in[I_LNB])[colg + tid]; }
    __syncthreads();
    const int fr = lane & 15, fq = lane >> 4;
    if (wave < 4) {
        const int j = lane & 7, rowl = 8 * wave + (lane >> 3);
        float* stp = (float*)(WSP + WS_ST) + ((size_t)(pi * 64 + 32 * rh + rowl)) * 64 + 8 * j;
        f32x2 P01 = (f32x2){0.f, 0.f}, P23 = P01, P45 = P01, P67 = P01;
        if (pass == 1) { const f32x4 a = *(const f32x4*)stp, c = *(const f32x4*)(stp + 4); P01 = a.xy; P23 = a.zw; P45 = c.xy; P67 = c.zw; }
        const bool first = (lane & 7) == 0;
        SCAN_BAR;
        for (int it = 0; it < 66; ++it) {
            if (it < 64) {
                const LAS float* rec = REC + (it & 1) * REC_BUF + 8 * j; const LAS float* vvp = VV + (it & 3) * 1024 + rowl; LAS float* yyp = YY + (it & 3) * 1024 + rowl;
                const LAS float* ssp = SSP + (it & 1) * 64 + 2 * (lane & 31);
                const float inv2 = __builtin_amdgcn_rcpf(fmaxf(ssp[0] + ssp[1], 1e-24f));
                f32x4 Rkk[2][2], Rw[2][2], Rka[2][2], Rkm[2][2], Rr[2][2]; float Rv[2];
#define LOADREC(slot, s) do { const LAS float* rs_ = rec + (s) * RSTR; \
                    Rkk[slot][0] = *(const LAS f32x4*)(rs_); Rkk[slot][1] = *(const LAS f32x4*)(rs_ + 4); Rw[slot][0] = *(const LAS f32x4*)(rs_ + REC_ARR); Rw[slot][1] = *(const LAS f32x4*)(rs_ + REC_ARR + 4); \
                    Rka[slot][0] = *(const LAS f32x4*)(rs_ + 2 * REC_ARR); Rka[slot][1] = *(const LAS f32x4*)(rs_ + 2 * REC_ARR + 4); Rkm[slot][0] = *(const LAS f32x4*)(rs_ + 3 * REC_ARR); Rkm[slot][1] = *(const LAS f32x4*)(rs_ + 3 * REC_ARR + 4); \
                    Rr[slot][0] = *(const LAS f32x4*)(rs_ + 4 * REC_ARR); Rr[slot][1] = *(const LAS f32x4*)(rs_ + 4 * REC_ARR + 4); Rv[slot] = vvp[(s) * 32]; } while (0)
                LOADREC(0, 0);
                float yp = 0.f, yk0 = 0.f, yk1 = 0.f, yk2 = 0.f, yk3 = 0.f;
#define YSHIFT(YK) do { YK = __int_as_float(__builtin_amdgcn_update_dpp(__float_as_int(yp), __float_as_int(YK), 0x111, 0xf, 0xf, false)); YK = first ? yp : YK; } while (0)
#pragma unroll
                for (int s = 0; s < 32; ++s) {
                    const int c = s & 1;
                    if (s + 1 < 32) LOADREC((s + 1) & 1, s + 1);
                    asm volatile("" ::: "memory");
                    const float si = __int_as_float(__builtin_amdgcn_readlane(__float_as_int(inv2), s));
                    f32x2 px = pkmul(P01, Rkk[c][0].xy); px = pkfma(P23, Rkk[c][0].zw, px); px = pkfma(P45, Rkk[c][1].xy, px); px = pkfma(P67, Rkk[c][1].zw, px);
                    float x = px.x + px.y;
                    f32x2 vv2; vv2.x = Rv[c]; asm volatile("" : "+v"(vv2));
                    x = dpp_add<0xB1>(x); yp = dpp_add<0xB1>(yp);
                    const f32x2 t01 = pkmul_bl(vv2, Rkm[c][0].xy), t23 = pkmul_bl(vv2, Rkm[c][0].zw);
                    x = dpp_add<0x4E>(x); yp = dpp_add<0x4E>(yp);
                    const f32x2 t45 = pkmul_bl(vv2, Rkm[c][1].xy), t67 = pkmul_bl(vv2, Rkm[c][1].zw);
                    x = dpp_add<0x141>(x); yp = dpp_add<0x141>(yp);
                    P01 = pkfma(P01, Rw[c][0].xy, t01); P23 = pkfma(P23, Rw[c][0].zw, t23); P45 = pkfma(P45, Rw[c][1].xy, t45); P67 = pkfma(P67, Rw[c][1].zw, t67);
                    if (s >= 1) { if (s - 1 < 8) YSHIFT(yk0); else if (s - 1 < 16) YSHIFT(yk1); else if (s - 1 < 24) YSHIFT(yk2); else YSHIFT(yk3); }
                    x = x * si;
                    f32x2 x2; x2.x = x; asm volatile("" : "+v"(x2));
                    P01 = pknfma_bl(x2, Rka[c][0].xy, P01); P23 = pknfma_bl(x2, Rka[c][0].zw, P23); P45 = pknfma_bl(x2, Rka[c][1].xy, P45); P67 = pknfma_bl(x2, Rka[c][1].zw, P67);
                    f32x2 py = pkmul(P01, Rr[c][0].xy); py = pkfma(P23, Rr[c][0].zw, py); py = pkfma(P45, Rr[c][1].xy, py); py = pkfma(P67, Rr[c][1].zw, py);
                    yp = py.x + py.y;
                }
                yp = dpp_add<0xB1>(yp); yp = dpp_add<0x4E>(yp); yp = dpp_add<0x141>(yp); YSHIFT(yk3);
                yyp[(7 - j) * 32] = yk0; yyp[(15 - j) * 32] = yk1; yyp[(23 - j) * 32] = yk2; yyp[(31 - j) * 32] = yk3;
#undef LOADREC
#undef YSHIFT
            }
            SCAN_BAR;
        }
        if (pass == 0) { *(f32x4*)stp = (f32x4){P01.x, P01.y, P23.x, P23.y}; *(f32x4*)(stp + 4) = (f32x4){P45.x, P45.y, P67.x, P67.y}; }
    } else {
        const int pw = wave - 4, tt = pw >> 1, kh = pw & 1;
        bf16x8 aWc[2][2], aAc[2][2];
#pragma unroll
        for (int kt = 0; kt < 2; ++kt)
#pragma unroll
            for (int ks = 0; ks < 2; ++ks) { const size_t o = (size_t)(colg + 32 * kh + 16 * kt + fr) * 64 + 32 * ks + 8 * fq; aWc[kt][ks] = *(const bf16x8*)((const bf16_t*)(WSP + WS_W2T) + o); aAc[kt][ks] = *(const bf16x8*)((const bf16_t*)(WSP + WS_A2T) + o); }
        bf16x8 lwf[2][2], laf[2][2]; u32x2 r2[2][2], k2[2][2];
#define ISSUE(SET, tbx) do { const size_t tok_ = rowb + (tbx) * 32 + 16 * tt + fr; \
            _Pragma("unroll") for (int ks = 0; ks < 2; ++ks) { lwf[SET][ks] = *(const bf16x8*)(LWb + tok_ * 64 + 32 * ks + 8 * fq); laf[SET][ks] = *(const bf16x8*)(LAb + tok_ * 64 + 32 * ks + 8 * fq); } \
            _Pragma("unroll") for (int kt = 0; kt < 2; ++kt) { r2[SET][kt] = *(const u32x2*)(Rb + tok_ * 2048 + colg + 32 * kh + 16 * kt + 4 * fq); k2[SET][kt] = *(const u32x2*)(Kb + tok_ * 2048 + colg + 32 * kh + 16 * kt + 4 * fq); } } while (0)
        ISSUE(0, 0); ISSUE(1, 1);
        const int t = lane >> 1, hf = lane & 1;
        const size_t vgo = (size_t)colg + 32 * rh + 16 * hf;
        u32x4 v8a = (u32x4){0u, 0u, 0u, 0u}, v8b = v8a, g8a = v8a, g8b = v8a;
        if (pw == 2) { const size_t eo = (rowb + t) * 2048 + vgo; v8a = *(const u32x4*)(Vb + eo); v8b = *(const u32x4*)(Vb + eo + 8); g8a = *(const u32x4*)(Gb + eo); g8b = *(const u32x4*)(Gb + eo + 8); }
        unsigned long long gx[2] = {0ull, 0ull};
#define PROD_ITER(it, PS) do { \
            { const int tb = (it) + 1; \
              if (tb < 64) { \
                LAS float* rec = REC + (tb & 1) * REC_BUF + (16 * tt + fr) * RSTR + 32 * kh + 4 * fq; \
                float ss = 0.f, rkp = 0.f; \
                _Pragma("unroll") for (int kt = 0; kt < 2; ++kt) { \
                    f32x4 accW = (f32x4){0.f, 0.f, 0.f, 0.f}, accA = (f32x4){0.f, 0.f, 0.f, 0.f}; \
                    _Pragma("unroll") for (int ks = 0; ks < 2; ++ks) { accW = MFMA16(aWc[kt][ks], lwf[PS][ks], accW); accA = MFMA16(aAc[kt][ks], laf[PS][ks], accA); } \
                    const int kc = 32 * kh + 16 * kt + 4 * fq; \
                    const f32x4 w0v = *(const LAS f32x4*)(CST + kc), a0v = *(const LAS f32x4*)(CST + 64 + kc), kkc = *(const LAS f32x4*)(CST + 128 + kc), kac = *(const LAS f32x4*)(CST + 192 + kc), rkc = *(const LAS f32x4*)(CST + 256 + kc); \
                    const f32x4 r4 = bf4(r2[PS][kt]), k4 = bf4(k2[PS][kt]); \
                    f32x4 w4, a4; \
                    _Pragma("unroll") for (int e = 0; e < 4; ++e) { w4[e] = __expf(-0.60653066f * sigmf(accW[e] + w0v[e])); a4[e] = sigmf(accA[e] + a0v[e]); } \
                    const f32x4 kkr = k4 * kkc; ss += (kkr.x * kkr.x + kkr.y * kkr.y) + (kkr.z * kkr.z + kkr.w * kkr.w); \
                    const f32x4 km = k4 * (1.0f + (a4 - 1.0f) * kac); const f32x4 rr = r4 * km * rkc; rkp += (rr.x + rr.y) + (rr.z + rr.w); \
                    *(LAS f32x4*)(rec + 16 * kt) = kkr; *(LAS f32x4*)(rec + REC_ARR + 16 * kt) = w4; *(LAS f32x4*)(rec + 2 * REC_ARR + 16 * kt) = kkr * a4; *(LAS f32x4*)(rec + 3 * REC_ARR + 16 * kt) = km; *(LAS f32x4*)(rec + 4 * REC_ARR + 16 * kt) = r4; \
                } \
                if (tb + 2 < 64) ISSUE(PS, tb + 2); \
                ss += __shfl_xor(ss, 16); ss += __shfl_xor(ss, 32); rkp += __shfl_xor(rkp, 16); rkp += __shfl_xor(rkp, 32); \
                if (fq == 0) { SSP[(tb & 1) * 64 + 2 * (16 * tt + fr) + kh] = ss; RKP[(tb & 3) * 64 + 2 * (16 * tt + fr) + kh] = rkp; } \
              } \
              if (pw == 2 && tb < 64) { \
                LAS float* vp = VV + (tb & 3) * 1024 + t * 32 + 16 * hf; LAS float* gp = GG + (tb & 3) * 1024 + t * 32 + 16 * hf; \
                *(LAS f32x4*)(vp) = bf4((u32x2){v8a.x, v8a.y}); *(LAS f32x4*)(vp + 4) = bf4((u32x2){v8a.z, v8a.w}); *(LAS f32x4*)(vp + 8) = bf4((u32x2){v8b.x, v8b.y}); *(LAS f32x4*)(vp + 12) = bf4((u32x2){v8b.z, v8b.w}); \
                *(LAS f32x4*)(gp) = bf4((u32x2){g8a.x, g8a.y}); *(LAS f32x4*)(gp + 4) = bf4((u32x2){g8a.z, g8a.w}); *(LAS f32x4*)(gp + 8) = bf4((u32x2){g8b.x, g8b.y}); *(LAS f32x4*)(gp + 12) = bf4((u32x2){g8b.z, g8b.w}); \
                if (tb + 1 < 64) { const size_t eo = (rowb + (tb + 1) * 32 + t) * 2048 + vgo; v8a = *(const u32x4*)(Vb + eo); v8b = *(const u32x4*)(Vb + eo + 8); g8a = *(const u32x4*)(Gb + eo); g8b = *(const u32x4*)(Gb + eo + 8); } \
              } \
            } \
            if (pw == 3) { \
              if ((it) >= 2 && (it) <= 65) { const int tb = (it) - 2; const unsigned long long* g = GR + ((size_t)(pi * 8 + (tb & 7)) * 2) * 64 + lane; \
                gx[0] = __hip_atomic_load(g, __ATOMIC_RELAXED, __HIP_MEMORY_SCOPE_AGENT); gx[1] = __hip_atomic_load(g + 64, __ATOMIC_RELAXED, __HIP_MEMORY_SCOPE_AGENT); } \
              if ((it) >= 1 && (it) <= 64) { const int tb = (it) - 1; const LAS float* yp_ = YY + (tb & 3) * 1024 + t * 32 + 16 * hf; float s1 = 0.f, s2 = 0.f; \
                _Pragma("unroll") for (int qd = 0; qd < 4; ++qd) { const f32x4 a = *(const LAS f32x4*)(yp_ + 4 * qd); s1 += (a.x + a.y) + (a.z + a.w); s2 += (a.x * a.x + a.y * a.y) + (a.z * a.z + a.w * a.w); } \
                s1 = dpp_add<0xB1>(s1); s2 = dpp_add<0xB1>(s2); \
                const unsigned epoch = (unsigned)(pass * 64 + tb + 1); \
                __hip_atomic_store(GR + ((size_t)((pi * 8 + (tb & 7)) * 2 + rh) * 64 + hf * 32 + t), ((unsigned long long)epoch << 32) | (unsigned long long)__float_as_uint(hf ? s2 : s1), __ATOMIC_RELAXED, __HIP_MEMORY_SCOPE_AGENT); } \
              if ((it) >= 2 && (it) <= 65) { const int tb = (it) - 2; const unsigned epoch = (unsigned)(pass * 64 + tb + 1); \
                const unsigned long long* g = GR + ((size_t)(pi * 8 + (tb & 7)) * 2) * 64 + lane; float tot; \
                for (unsigned spins = 0;; ++spins) { const bool ok = ((unsigned)(gx[0] >> 32) == epoch) && ((unsigned)(gx[1] >> 32) == epoch); tot = __uint_as_float((unsigned)gx[0]) + __uint_as_float((unsigned)gx[1]); \
                    if (__all(ok) || spins > (1u << 22)) break; \
                    __builtin_amdgcn_s_sleep(1); \
                    gx[0] = __hip_atomic_load(g, __ATOMIC_RELAXED, __HIP_MEMORY_SCOPE_AGENT); gx[1] = __hip_atomic_load(g + 64, __ATOMIC_RELAXED, __HIP_MEMORY_SCOPE_AGENT); } \
                const float oth = __shfl_xor(tot, 32); \
                const float mean = (lane < 32 ? tot : oth) * (1.0f / 64.0f), ex2 = (lane < 32 ? oth : tot) * (1.0f / 64.0f); \
                const float rstd = rsqrtf(fmaxf(ex2 - mean * mean, 0.f) + 64e-5f); \
                if (lane < 32) { STT[2 * lane] = mean; STT[2 * lane + 1] = rstd; } \
                const float mu = STT[2 * t], rsd = STT[2 * t + 1]; \
                const int ro = (tb & 3) * 1024 + t * 32 + 16 * hf; const float rk = RKP[(tb & 3) * 64 + 2 * t] + RKP[(tb & 3) * 64 + 2 * t + 1]; \
                unsigned ow[8]; \
                _Pragma("unroll") for (int qd = 0; qd < 4; ++qd) { const f32x4 lg = *(const LAS f32x4*)(CST + 320 + 32 * rh + 16 * hf + 4 * qd), lb = *(const LAS f32x4*)(CST + 384 + 32 * rh + 16 * hf + 4 * qd); \
                    const f32x4 o = ((*(const LAS f32x4*)(YY + ro + 4 * qd) - mu) * rsd * lg + lb + rk * *(const LAS f32x4*)(VV + ro + 4 * qd)) * *(const LAS f32x4*)(GG + ro + 4 * qd); \
                    ow[2 * qd] = pk2(o.x, o.y); ow[2 * qd + 1] = pk2(o.z, o.w); } \
                bf16_t* dst = (bf16_t*)(WSP + WS_A2) + ((size_t)pass * PROWS + rowb + tb * 32 + t) * 2048 + vgo; \
                *(u32x4*)(dst) = (u32x4){ow[0], ow[1], ow[2], ow[3]}; *(u32x4*)(dst + 8) = (u32x4){ow[4], ow[5], ow[6], ow[7]}; } \
            } \
            SCAN_BAR; } while (0)
        for (int it2 = -1; it2 < 65; it2 += 2) { PROD_ITER(it2, 0); PROD_ITER(it2 + 1, 1); }
        PROD_ITER(65, 0);
#undef PROD_ITER
#undef ISSUE
    }
}
__device__ __forceinline__ void p10_final(const Params& p, int G, int bid) {
    OPQ_TID; const int gw = bid * 8 + wave, ngw = G * 8;
    for (int m = gw; m < T; m += ngw) { float* xr = ((float*)p.out) + (size_t)m * D; f32x4 v[4]; float s = 0.f;
#pragma unroll
        for (int j = 0; j < 4; ++j) { v[j] = *((const f32x4*)xr + lane + 64 * j); s += (v[j].x * v[j].x + v[j].y * v[j].y) + (v[j].z * v[j].z + v[j].w * v[j].w); }
        const float rs = rsqrtf(wave_sum(s) * (1.0f / 1024.0f) + 1e-6f);
#pragma unroll
        for (int j = 0; j < 4; ++j) { const f32x4 gg = *((const f32x4*)((const float*)p.in[I_FG]) + lane + 64 * j); *((f32x4*)xr + lane + 64 * j) = v[j] * rs * gg; } }
}

#define XB_TMO      128
#define XB_XCNT(j)  (256  + 64 * (j))
#define XB_XSUB(j)  (1280 + 64 * (j))
#define XB_XGEN(j)  (2304 + 64 * (j))
#define XB_TOP      3328
#define XB_TOPGEN   3392
#define XCD_BAR_WORDS 3456
#define XB_SPIN_CAP (1u << 18)

__device__ __forceinline__ unsigned xb_ld(unsigned* p)              { return __hip_atomic_load(p, __ATOMIC_RELAXED, __HIP_MEMORY_SCOPE_AGENT); }
__device__ __forceinline__ unsigned xb_add(unsigned* p, unsigned v) { return __hip_atomic_fetch_add(p, v, __ATOMIC_RELAXED, __HIP_MEMORY_SCOPE_AGENT); }
__device__ __forceinline__ unsigned xb_xcc_id() { return (unsigned)__builtin_amdgcn_s_getreg((3 << 11) | 20) & 0xFu; }
#define XB_SPIN(cond, bar) do { unsigned _sp = 0; while (cond) { __builtin_amdgcn_s_sleep(1); \
    if ((++_sp & 255u) == 0u) { if (xb_ld(&(bar)[XB_TMO])) break; if (_sp > XB_SPIN_CAP) { atomicAdd(&(bar)[XB_TMO], 1u); break; } } } } while (0)

struct XcdBarrier {
    unsigned* bar; unsigned x;
    volatile LAS unsigned* st;
};

__device__ __forceinline__ XcdBarrier xcd_barrier_post(unsigned* bar, volatile LAS unsigned* st) {
    XcdBarrier b; b.bar = bar; b.x = xb_xcc_id(); b.st = st;
    if (threadIdx.x == 0) (void)xb_add(&bar[XB_XCNT(b.x)], 1u);
    return b;
}
__device__ __forceinline__ void xcd_barrier_complete(unsigned* bar, unsigned x, unsigned& nloc, unsigned& nx) {
    const unsigned G = gridDim.x * gridDim.y * gridDim.z;
    unsigned sum, cnt, mine, sp = 0u;
    for (;;) {
        sum = 0u; cnt = 0u; mine = 0u;
#pragma unroll
        for (unsigned j = 0; j < 16; ++j) { const unsigned c = xb_ld(&bar[XB_XCNT(j)]); sum += c; cnt += (c > 0u) ? 1u : 0u; mine = (j == x) ? c : mine; }
        if (sum == G) break;
        __builtin_amdgcn_s_sleep(1);
        if ((++sp & 255u) == 0u) { if (xb_ld(&bar[XB_TMO])) break; if (sp > XB_SPIN_CAP) { atomicAdd(&bar[XB_TMO], 1u); break; } }
    }
    nloc = mine > 0u ? mine : 1u; nx = cnt > 0u ? cnt : 1u;
}

__device__ __forceinline__ void xcd_barrier(const XcdBarrier& b) {
    asm volatile("s_waitcnt vmcnt(0)" ::: "memory");
    __syncthreads();
    if (threadIdx.x == 0) {
        unsigned* bar = (unsigned*)(*(volatile LAS unsigned long long*)(b.st + 4)); const unsigned bx_ = xb_xcc_id();
        __builtin_amdgcn_s_waitcnt(0);
        unsigned nloc = b.st[0], nx = b.st[1];
        if (nloc == 0u) { xcd_barrier_complete(bar, bx_, nloc, nx); b.st[0] = nloc; b.st[1] = nx; }
        const unsigned old = xb_add(&bar[XB_XSUB(bx_)], 1u);
        const unsigned gen = old / nloc;
        if (old + 1u == (gen + 1u) * nloc) {
            __builtin_amdgcn_fence(__ATOMIC_RELEASE, "agent");
            asm volatile("s_waitcnt vmcnt(0)" ::: "memory");
            const unsigned og = xb_add(&bar[XB_TOP], 1u);
            const unsigned tg = og / nx;
            if (og + 1u == (tg + 1u) * nx) xb_add(&bar[XB_TOPGEN], 1u);
            else XB_SPIN(xb_ld(&bar[XB_TOPGEN]) == tg, bar);
            __builtin_amdgcn_fence(__ATOMIC_ACQUIRE, "agent");
            xb_add(&bar[XB_XGEN(bx_)], 1u);
            asm volatile("s_waitcnt vmcnt(0)" ::: "memory");
        } else {
            XB_SPIN(xb_ld(&bar[XB_XGEN(bx_)]) == gen, bar);
            __builtin_amdgcn_fence(__ATOMIC_ACQUIRE, "agent");
            asm volatile("s_waitcnt vmcnt(0)" ::: "memory");
        }
    }
    __syncthreads();
}

__global__ void __launch_bounds__(NT, 2) mk_fwd(Params p) {
    auto wsl = [&]() { return launder_ws(((unsigned char*)p.ws)); };
    extern __shared__ __attribute__((aligned(16))) unsigned char lds_raw[];
    LAS unsigned char* lds = (LAS unsigned char*)lds_raw;
    cg::grid_group grid = cg::this_grid();
    const int G = gridDim.x, bid = blockIdx.x;
    if (threadIdx.x < 16) ((LAS unsigned*)(lds + LDS_MISC))[threadIdx.x] = 0u;
    __syncthreads();
    if (threadIdx.x == 0) *(LAS unsigned long long*)(lds + LDS_MISC + 16) = (unsigned long long)(((unsigned char*)p.ws) + WS_BAR);
    __syncthreads();
    (void)xcd_barrier_post((unsigned*)(((unsigned char*)p.ws) + WS_BAR), (volatile LAS unsigned*)(lds + LDS_MISC));
#define XBAR() do { XcdBarrier xb_; xb_.bar = nullptr; xb_.x = 0u; xb_.st = (volatile LAS unsigned*)(lds + LDS_MISC); xcd_barrier(xb_); } while (0)
#if PROBE == 7
    p0_prologue(p, lds, G, bid);
#endif
    p0_prologue(p, lds, G, bid);
    grid.sync();
    { pg8::Gemm g{(const bf16_t*)((float*)p.out), (const bf16_t*)(wsl() + WS_WIN), T, ZW, D, D}; pg8::StaticOrder S; S.init(T, ZW, G, bid); pg8::EpiBf16 E{(bf16_t*)(wsl() + WS_Z), ZW};
      pg8::gemm_phase<pg8::EpiBf16, pg8::StaticOrder, true, true>(lds, g, S, E); }
    XBAR();
#if PROBE == 3
    { u32x4 pre[3]; if (bid < 2048) rg_a_prefetch((const bf16_t*)(wsl() + WS_Z), bid, threadIdx.x, pre); for (int u = bid; u < 2048; u += G) rg_a_unit(p, lds, u, u + G, pre); }
    { u32x4 pre[6]; if (bid < 2048) hg_a_prefetch((const bf16_t*)(wsl() + WS_Z), bid, threadIdx.x, pre); for (int u = bid; u < 2048; u += G) hg_a_unit(p, lds, u, u + G, pre); }
    XBAR();
#endif
    { u32x4 pre[3]; if (bid < 2048) rg_a_prefetch((const bf16_t*)(wsl() + WS_Z), bid, threadIdx.x, pre); for (int u = bid; u < 2048; u += G) rg_a_unit(p, lds, u, u + G, pre); }
    { u32x4 pre[6]; if (bid < 2048) hg_a_prefetch((const bf16_t*)(wsl() + WS_Z), bid, threadIdx.x, pre); for (int u = bid; u < 2048; u += G) hg_a_unit(p, lds, u, u + G, pre); }
    XBAR();
#if PROBE == 2
    for (int u = bid; u < 256; u += G) hg_b_item(p, lds, u, p.dry != 0);
    XBAR();
#endif
#if PROBE == 6
    for (int u = bid; u < 512; u += G) rg_b_unit(p, u);
    XBAR();
#endif
#if PROBE == 4
    for (int q = 0; q < 16; ++q) XBAR();
#endif
    for (int u = bid; u < 256; u += G) hg_b_item(p, lds, u);
    for (int u = bid; u < 512; u += G) rg_b_unit(p, u);
    XBAR();
#if PROBE == 8
    p4_finalize(p, G, bid);
#endif
    p4_finalize(p, G, bid);
    XBAR();
    { pg8::Gemm g{(const bf16_t*)(wsl() + WS_Z), (const bf16_t*)(wsl() + WS_WOUT), T, D, 2048, ZW}; pg8::StaticOrder S; S.init(T, D, G, bid); pg8::EpiResF32 E{((const float*)p.in[I_X]), ((float*)p.out), D, 0, 0};
      pg8::gemm_phase<pg8::EpiResF32, pg8::StaticOrder, true, true>(lds, g, S, E); }
    XBAR();
#if PROBE == 9
    p6_prologue(p, lds, G, bid);
#endif
    p6_prologue(p, lds, G, bid);
    XBAR();
#pragma unroll 1
    for (int pass = 0; pass < 2; ++pass) {
        { const int N = pass ? 8192 : 8448; pg8::Gemm g{(const bf16_t*)(wsl() + WS_A2) + (size_t)pass * 8192 * 2048, (const bf16_t*)(wsl() + WS_WC), 8192, N, 2048, 2048}; pg8::LoraOrder S; S.init(8192, N, G, bid, pass ? 0 : 32);
          pg8::EpiL1 E{(bf16_t*)(wsl() + WS_R), (bf16_t*)(wsl() + WS_LW) + (size_t)pass * 8192 * 64, (bf16_t*)(wsl() + WS_LA) + (size_t)pass * 8192 * 64};
          pg8::gemm_phase<pg8::EpiL1, pg8::LoraOrder, true, true>(lds, g, S, E); }
        XBAR();
        for (int u0 = 0; u0 < 256; u0 += G) { const int u = u0 + bid; if (u < 256) { int pi, rh; if (G == 256) { pi = (u & 7) + 8 * (u >> 4); rh = (u >> 3) & 1; } else { pi = u >> 1; rh = u & 1; } scan_half(p, lds, pi, rh, pass); } }
        XBAR();
    }
    if (G == 256) {
        pg8::Gemm g{(const bf16_t*)(wsl() + WS_A2), (const bf16_t*)(wsl() + WS_WO), T, D, 2048, 2048}; pg8::StaticOrder S; S.init(T, D, G, bid); pg8::EpiFinalNorm E{((float*)p.out), ((const float*)p.in[I_FG]), (unsigned long long*)(wsl() + WS_XG), D};
        pg8::gemm_phase<pg8::EpiFinalNorm, pg8::StaticOrder, false, true>(lds, g, S, E);
    } else {
        { pg8::Gemm g{(const bf16_t*)(wsl() + WS_A2), (const bf16_t*)(wsl() + WS_WO), T, D, 2048, 2048}; pg8::StaticOrder S; S.init(T, D, G, bid); pg8::EpiResF32 E{((float*)p.out), ((float*)p.out), D, 1, 0};
          pg8::gemm_phase<pg8::EpiResF32, pg8::StaticOrder, true, true>(lds, g, S, E); }
        XBAR();
        p10_final(p, G, bid);
    }
}

extern "C" void kernel_launch(void* const* d_in, const int* in_sizes, int n_in, void* d_out, int out_size, void* d_ws, size_t ws_size, hipStream_t stream) {
    static int grid = 0;
    if (grid == 0) {
        int dev = 0, cus = 0, per_cu = 0;
        if (n_in != 32 || out_size != T * D || ws_size < 256 * MiB) { fprintf(stderr, "kernel_launch: unexpected shapes (n_in %d out %d ws %zu)\n", n_in, out_size, ws_size); grid = -1; return; }
        if (hipGetDevice(&dev) != hipSuccess || hipDeviceGetAttribute(&cus, hipDeviceAttributeMultiprocessorCount, dev) != hipSuccess) { grid = -1; return; }
        if (hipFuncSetAttribute((const void*)mk_fwd, hipFuncAttributeMaxDynamicSharedMemorySize, LDS_BYTES) != hipSuccess) { fprintf(stderr, "hipFuncSetAttribute failed\n"); grid = -1; return; }
        if (hipOccupancyMaxActiveBlocksPerMultiprocessor(&per_cu, (const void*)mk_fwd, NT, LDS_BYTES) != hipSuccess || per_cu < 1) fprintf(stderr, "occupancy query: %d\n", per_cu);
        (void)hipGetLastError();
        grid = cus;
    }
    if (grid < 0) return;
    if (hipMemsetAsync((char*)d_ws + WS_BAR, 0, 16384, stream) != hipSuccess) { fprintf(stderr, "memset failed\n"); return; }
    Params p{};
    p.dry = 1;
    for (int i = 0; i < 32; ++i) memcpy(&p.in[i], &d_in[i], sizeof(void*));
    memcpy(&p.out, &d_out, sizeof(void*)); memcpy(&p.ws, &d_ws, sizeof(void*));
    void* args[] = {&p};
    hipError_t e = hipLaunchCooperativeKernel((const void*)mk_fwd, dim3(grid), dim3(NT), args, LDS_BYTES, stream);
    if (e != hipSuccess) fprintf(stderr, "cooperative launch failed: %s (grid %d)\n", hipGetErrorString(e), grid);
}
```

```cpp
#define PROBE 0
#include <hip/hip_runtime.h>
#include <hip/hip_cooperative_groups.h>
#include <cstdio>
#include <cstring>
#include <cstdint>
namespace cg = cooperative_groups;
namespace pg8 {
#define PG8_LAS __attribute__((address_space(3)))
typedef unsigned short bf16_t;
typedef short bf16x8 __attribute__((ext_vector_type(8)));
typedef float f32x4 __attribute__((ext_vector_type(4)));
typedef unsigned u32x4 __attribute__((ext_vector_type(4)));
constexpr int BM = 256, BK = 64, HALF = 128, HTB = HALF * BK * 2  , STAGE_BYTES = 8 * HTB, NXCD = 8, WGM = 8;

__host__ __device__ __forceinline__ int lds_byte(int r, int c) { const int st = (r >> 4) * 2 + (c >> 5), rr = r & 15, cc = c & 31, ob = rr * 64 + cc * 2; return st * 1024 + (ob ^ (((ob >> 9) & 1) << 5)); }
__host__ __device__ __forceinline__ void stage_rc(int b, int& R, int& C) { const int st = b / 1024, sb = b % 1024, swz = sb ^ (((sb >> 9) & 1) << 5); R = (st >> 1) * 16 + swz / 64; C = (st & 1) * 32 + (swz % 64) / 2; }
__host__ __device__ __forceinline__ int perm32(int rho) { const int n = rho >> 4, i = rho & 15; return 8 * (i >> 2) + 4 * n + (i & 3); }

struct Unit { int pm, pn; };
struct Gemm { const bf16_t* A; const bf16_t* Bt; int M, N, K, lda; };

struct StaticOrder {
    int nM, nN, nwg, G, c;
    __host__ __device__ void init(int M, int N, int G_, int c_) { nM = M / BM; nN = N / BM; nwg = nM * nN; G = G_; c = c_; }
    __host__ __device__ bool next(int i, Unit& u) const {
        const long L = (long)i * G + c; if (L >= nwg) return false;
        int wgid = (int)L; { const int q = nwg / NXCD, r = nwg % NXCD, xcd = wgid % NXCD, off = wgid / NXCD; wgid = (xcd < r ? xcd * (q + 1) : r * (q + 1) + (xcd - r) * q) + off; }
        const int nig = WGM * nN, gid = wgid / nig, fm = gid * WGM, gsz = (nM - fm) < WGM ? (nM - fm) : WGM;
        u.pm = fm + ((wgid % nig) % gsz); u.pn = (wgid % nig) / gsz; return true;
    }
    __device__ __forceinline__ void a_ready(const Unit&) const {}
    __device__ __forceinline__ void done(const Unit&) const {}
};


struct LoraOrder {
    StaticOrder so; int extra;
    __host__ __device__ void init(int M, int N, int G_, int c_, int extra_) { so.init(M, N, G_, c_); extra = extra_; }
    __host__ __device__ bool next(int i, Unit& u) const { const long L = (long)i * so.G + so.c; if (L < so.nwg) return so.next(i, u); if (L >= so.nwg + extra) return false; u.pm = so.nM + (int)(L - so.nwg); u.pn = so.nN - 1; return true; }
    __device__ __forceinline__ void a_ready(const Unit&) const {}
    __device__ __forceinline__ void done(const Unit&) const {}
};
__device__ __forceinline__ unsigned cvt_pk_bf16(float lo, float hi) { unsigned r; asm volatile("v_cvt_pk_bf16_f32 %0, %1, %2" : "=v"(r) : "v"(lo), "v"(hi)); return r; }
__device__ __forceinline__ float sigm(float x) { return __builtin_amdgcn_rcpf(1.0f + __expf(-x)); }
struct EpiBf16 {
    static constexpr bool PERM = true, AFTER_DRAIN = false;
    bf16_t* O; int ldc;
    __device__ __forceinline__ void operator()(const f32x4 (&acc)[2][2][4][2], const Unit& u, int wr, int wc, int fr, int fq) const {
        const int row0 = u.pm * BM + wr * 64 + fr; const int col0 = u.pn * BM + wc * 32 + 8 * fq;
#pragma unroll
        for (int ai = 0; ai < 2; ++ai)
#pragma unroll
            for (int m = 0; m < 4; ++m) { bf16_t* rowp = O + (size_t)(row0 + ai * HALF + m * 16) * ldc + col0;
#pragma unroll
                for (int bj = 0; bj < 2; ++bj) { const f32x4 v0 = acc[ai][bj][m][0], v1 = acc[ai][bj][m][1];
                    u32x4 w; w.x = cvt_pk_bf16(v0[0], v0[1]); w.y = cvt_pk_bf16(v0[2], v0[3]); w.z = cvt_pk_bf16(v1[0], v1[1]); w.w = cvt_pk_bf16(v1[2], v1[3]);
                    *(u32x4*)(rowp + bj * HALF) = w; } }
    }
};
struct EpiResF32 {
    static constexpr bool PERM = false, AFTER_DRAIN = false;
    const float* base; float* out; int ldc; int remap; int pass;
    __device__ __forceinline__ void operator()(const f32x4 (&acc)[2][2][4][2], const Unit& u, int wr, int wc, int fr, int fq) const {
        const int col0 = u.pn * BM + wc * 32 + 4 * fq; const int rbase = remap ? ((((u.pm >> 3) & 3) << 12) + (u.pm >> 5) * 2048 + (u.pm & 7) * BM) : u.pm * BM;
#pragma unroll
        for (int ai = 0; ai < 2; ++ai)
#pragma unroll
            for (int m = 0; m < 4; ++m) { const size_t off = (size_t)(rbase + ai * HALF + wr * 64 + m * 16 + fr) * ldc + col0;
#pragma unroll
                for (int bj = 0; bj < 2; ++bj)
#pragma unroll
                    for (int n = 0; n < 2; ++n) { const f32x4 bs = *(const f32x4*)(base + off + bj * HALF + n * 16); *(f32x4*)(out + off + bj * HALF + n * 16) = bs + acc[ai][bj][m][n]; } }
    }
};
struct EpiL1 {
    static constexpr bool PERM = true, AFTER_DRAIN = false;
    bf16_t* R; bf16_t* LW; bf16_t* LA;
    __device__ __forceinline__ void operator()(const f32x4 (&acc)[2][2][4][2], const Unit& u, int wr, int wc, int fr, int fq) const {
        const int row0 = u.pm * BM + wr * 64 + fr;
        if (u.pn < 32) {
            const int buf = u.pn >> 3; bf16_t* base = R + (size_t)buf * (8192u * 2048u); const int col0 = (u.pn & 7) * BM + wc * 32 + 8 * fq;
#pragma unroll
            for (int ai = 0; ai < 2; ++ai)
#pragma unroll
                for (int m = 0; m < 4; ++m) { bf16_t* rowp = base + (size_t)(row0 + ai * HALF + m * 16) * 2048 + col0;
#pragma unroll
                    for (int bj = 0; bj < 2; ++bj) { f32x4 v0 = acc[ai][bj][m][0], v1 = acc[ai][bj][m][1];
                        if (buf == 3) {
#pragma unroll
                            for (int q = 0; q < 4; ++q) { v0[q] = v0[q] * sigm(v0[q]); v1[q] = v1[q] * sigm(v1[q]); } }
                        u32x4 w; w.x = cvt_pk_bf16(v0[0], v0[1]); w.y = cvt_pk_bf16(v0[2], v0[3]); w.z = cvt_pk_bf16(v1[0], v1[1]); w.w = cvt_pk_bf16(v1[2], v1[3]);
                        *(u32x4*)(rowp + bj * HALF) = w; } }
        } else {
            const int c0 = wc * 32 + 8 * fq;
#pragma unroll
            for (int ai = 0; ai < 2; ++ai)
#pragma unroll
                for (int m = 0; m < 4; ++m) { const size_t row = (size_t)(row0 + ai * HALF + m * 16); f32x4 v0 = acc[ai][0][m][0], v1 = acc[ai][0][m][1];
                    if (c0 < 64) {
#pragma unroll
                        for (int q = 0; q < 4; ++q) { v0[q] = tanhf(v0[q]); v1[q] = tanhf(v1[q]); } }
                    u32x4 w; w.x = cvt_pk_bf16(v0[0], v0[1]); w.y = cvt_pk_bf16(v0[2], v0[3]); w.z = cvt_pk_bf16(v1[0], v1[1]); w.w = cvt_pk_bf16(v1[2], v1[3]);
                    if (c0 < 64) *(u32x4*)(LW + row * 64 + c0) = w; else *(u32x4*)(LA + row * 64 + c0 - 64) = w; }
        }
    }
};

struct EpiFinalNorm {
    static constexpr bool PERM = false, AFTER_DRAIN = true;
    float* out; const float* g; unsigned long long* xg; int ldc;
    __device__ __forceinline__ void fused(f32x4 (&acc)[2][2][4][2], const Unit& u, int wr, int wc, int fr, int fq, PG8_LAS unsigned char* lds, int wid, int lane) const {
        PG8_LAS float* P = (PG8_LAS float*)lds; PG8_LAS float* S = (PG8_LAS float*)(lds + 4096);
        const int col0 = u.pn * BM + wc * 32 + 4 * fq; const int rbase = (((u.pm >> 3) & 3) << 12) + (u.pm >> 5) * 2048 + (u.pm & 7) * BM;
#pragma unroll
        for (int ai = 0; ai < 2; ++ai)
#pragma unroll
            for (int m = 0; m < 4; ++m) { const size_t off = (size_t)(rbase + ai * HALF + wr * 64 + m * 16 + fr) * ldc + col0; float s = 0.f;
#pragma unroll
                for (int bj = 0; bj < 2; ++bj)
#pragma unroll
                    for (int n = 0; n < 2; ++n) { const f32x4 v = acc[ai][bj][m][n] + *(const f32x4*)(out + off + bj * HALF + n * 16); acc[ai][bj][m][n] = v; s += (v[0] * v[0] + v[1] * v[1]) + (v[2] * v[2] + v[3] * v[3]); }
                s += __shfl_xor(s, 16); s += __shfl_xor(s, 32);
                if (fq == 0) P[(ai * HALF + wr * 64 + m * 16 + fr) * 4 + wc] = s; }
        asm volatile("s_waitcnt lgkmcnt(0)" ::: "memory"); __builtin_amdgcn_s_barrier(); asm volatile("" ::: "memory");
        const int row = wid * 32 + (lane & 31);
        if (lane < 32) { const float tot = (P[row * 4] + P[row * 4 + 1]) + (P[row * 4 + 2] + P[row * 4 + 3]);
            __hip_atomic_store(xg + ((size_t)(u.pm * 4 + u.pn) * 256 + row), (1ull << 32) | (unsigned long long)__float_as_uint(tot), __ATOMIC_RELAXED, __HIP_MEMORY_SCOPE_AGENT); }
        {
            float tot = 0.f;
            for (unsigned spins = 0;; ++spins) { bool ok = true; tot = 0.f;
                if (lane < 32) {
#pragma unroll
                    for (int q = 0; q < 4; ++q) { const unsigned long long x = __hip_atomic_load(xg + ((size_t)(u.pm * 4 + q) * 256 + row), __ATOMIC_RELAXED, __HIP_MEMORY_SCOPE_AGENT); ok &= (unsigned)(x >> 32) == 1u; tot += __uint_as_float((unsigned)x); } }
                if (__all(ok) || spins > (1u << 22)) break;
                __builtin_amdgcn_s_sleep(1); }
            if (lane < 32) S[row] = rsqrtf(tot * (1.0f / 1024.0f) + 1e-6f);
        }
        asm volatile("s_waitcnt lgkmcnt(0)" ::: "memory"); __builtin_amdgcn_s_barrier(); asm volatile("" ::: "memory");
#pragma unroll
        for (int ai = 0; ai < 2; ++ai)
#pragma unroll
            for (int m = 0; m < 4; ++m) { const int r = ai * HALF + wr * 64 + m * 16 + fr; const float rs = S[r]; const size_t off = (size_t)(rbase + r) * ldc + col0;
#pragma unroll
                for (int bj = 0; bj < 2; ++bj)
#pragma unroll
                    for (int n = 0; n < 2; ++n) { const f32x4 gg = *(const f32x4*)(g + col0 + bj * HALF + n * 16); *(f32x4*)(out + off + bj * HALF + n * 16) = acc[ai][bj][m][n] * rs * gg; } }
    }
};
template <class Epi, class Sched, bool ALIGN_EPI = false, bool SP2 = false>
__device__ __forceinline__ void gemm_phase(PG8_LAS unsigned char* lds, const Gemm g, const Sched& S, const Epi& E) {
    int tid_o = threadIdx.x; asm volatile("" : "+v"(tid_o)); const int tid = tid_o, wid = __builtin_amdgcn_readfirstlane(tid >> 6), lane = tid & 63, wr = wid >> 2, wc = wid & 3, fr = lane & 15, fq = lane >> 4;
    const int K = g.K, nt = K / BK;
    unsigned voffA[2], voffB[2];
#pragma unroll
    for (int i = 0; i < 2; ++i) { int R, C; stage_rc(tid * 16 + i * 8192, R, C); const int Rb = Epi::PERM ? ((R & ~31) + perm32(R & 31)) : R;
        voffA[i] = (unsigned)(R * g.lda + C) * 2u; voffB[i] = (unsigned)(Rb * K + C) * 2u; }
    const size_t kstep = (size_t)(BK * 2);
    const size_t hstep = (size_t)HALF * K * 2;
    const size_t tstep = 2 * hstep; const size_t hstepA = (size_t)HALF * g.lda * 2, tstepA = 2 * hstepA;
    const unsigned ldsw = (unsigned)wid * 1024u;
    const int aoff = lds_byte(wr * 64 + fr, fq * 8), boff = lds_byte(wc * 32 + fr, fq * 8);
#define PG8_SA(b, h) (((b) * 2 + (h)) * HTB)
#define PG8_SB(b, h) ((4 + (b) * 2 + (h)) * HTB)
#define PG8_STAGE(bufoff, gbase, voff) do { _Pragma("unroll") for (int _i = 0; _i < 2; ++_i) \
        __builtin_amdgcn_global_load_lds((const unsigned*)((const char*)(gbase) + (voff)[_i]), (PG8_LAS unsigned*)(lds + (bufoff) + ldsw + _i * 8192), 16, 0, 0); } while (0)
#define PG8_LDA(dst, b, h) do { _Pragma("unroll") for (int m = 0; m < 4; ++m) _Pragma("unroll") for (int k = 0; k < 2; ++k) dst[m][k] = *(const PG8_LAS bf16x8*)(lds + PG8_SA(b, h) + aoff + m * 2048 + k * 1024); } while (0)
#define PG8_LDB(dst, b, h) do { _Pragma("unroll") for (int n = 0; n < 2; ++n) _Pragma("unroll") for (int k = 0; k < 2; ++k) dst[n][k] = *(const PG8_LAS bf16x8*)(lds + PG8_SB(b, h) + boff + n * 2048 + k * 1024); } while (0)
#define PG8_MMA(ai, bj, At, Bt) do { __builtin_amdgcn_s_setprio(1); _Pragma("unroll") for (int m = 0; m < 4; ++m) _Pragma("unroll") for (int n = 0; n < 2; ++n) _Pragma("unroll") for (int k = 0; k < 2; ++k) \
        acc[ai][bj][m][n] = __builtin_amdgcn_mfma_f32_16x16x32_bf16(Bt[n][k], At[m][k], acc[ai][bj][m][n], 0, 0, 0); __builtin_amdgcn_s_setprio(0); } while (0)
#define PG8_WAIT_V(n) asm volatile("s_waitcnt vmcnt(" #n ")" ::: "memory")
#define PG8_WAIT_L(n) asm volatile("s_waitcnt lgkmcnt(" #n ")" ::: "memory")
#define PG8_BAR __builtin_amdgcn_s_barrier()
#define PG8_SCHED __builtin_amdgcn_sched_barrier(0)
    Unit cur, nxt; int ui = 0;
    if (!S.next(0, cur)) return;
    f32x4 acc[2][2][4][2];
#pragma unroll
    for (int a = 0; a < 2; ++a)
#pragma unroll
        for (int b = 0; b < 2; ++b)
#pragma unroll
            for (int m = 0; m < 4; ++m)
#pragma unroll
                for (int n = 0; n < 2; ++n) acc[a][b][m][n] = (f32x4){0.f, 0.f, 0.f, 0.f};
    bf16x8 At[4][2], B0[2][2], B1[2][2];
    const char* cA = (const char*)g.A + (size_t)cur.pm * tstepA; const char* cB = (const char*)g.Bt + (size_t)cur.pn * tstep;
    S.a_ready(cur);
    if constexpr (SP2) {
        PG8_STAGE(PG8_SB(0, 0), cB, voffB); PG8_STAGE(PG8_SB(0, 1), cB + hstep, voffB); PG8_STAGE(PG8_SA(0, 0), cA, voffA); PG8_STAGE(PG8_SA(0, 1), cA + hstepA, voffA);
        if (wr == 1) PG8_BAR;
        PG8_WAIT_V(2); PG8_BAR;
        PG8_STAGE(PG8_SB(1, 0), cB + kstep, voffB); PG8_STAGE(PG8_SA(1, 0), cA + kstep, voffA); PG8_STAGE(PG8_SB(1, 1), cB + hstep + kstep, voffB);
        PG8_WAIT_V(6); PG8_BAR;
    } else {
        PG8_STAGE(PG8_SB(0, 0), cB, voffB); PG8_STAGE(PG8_SA(0, 0), cA, voffA); PG8_STAGE(PG8_SB(0, 1), cB + hstep, voffB); PG8_STAGE(PG8_SA(0, 1), cA + hstepA, voffA);
        if (wr == 1) PG8_BAR;
        PG8_WAIT_V(4); PG8_BAR;
        PG8_STAGE(PG8_SB(1, 0), cB + kstep, voffB); PG8_STAGE(PG8_SA(1, 0), cA + kstep, voffA); PG8_STAGE(PG8_SB(1, 1), cB + hstep + kstep, voffB);
        PG8_WAIT_V(6); PG8_BAR;
    }
    for (;;) {
        const bool has_next = S.next(ui + 1, nxt);
        const char* nA = has_next ? (const char*)g.A + (size_t)nxt.pm * tstepA : cA; const char* nB = has_next ? (const char*)g.Bt + (size_t)nxt.pn * tstep : cB;
        for (int t = 0; t < nt; t += 2) {
            const bool last = (t == nt - 2);
            const char* a1 = cA + (size_t)(t + 1) * kstep;
            const char* a2 = last ? nA : cA + (size_t)(t + 2) * kstep; const char* b2 = last ? nB : cB + (size_t)(t + 2) * kstep;
            const char* a3 = a2 + kstep; const char* b3 = b2 + kstep;
            if (last && has_next) S.a_ready(nxt);
            if constexpr (SP2) {
            PG8_LDB(B0, 0, 0); PG8_LDB(B1, 0, 1); PG8_SCHED; PG8_LDA(At, 0, 0); PG8_STAGE(PG8_SA(1, 1), a1 + hstepA, voffA);
            PG8_WAIT_V(8); PG8_WAIT_L(0); PG8_BAR; PG8_MMA(0, 0, At, B0); PG8_MMA(0, 1, At, B1); PG8_BAR; PG8_SCHED;
            PG8_LDA(At, 0, 1); PG8_STAGE(PG8_SB(0, 0), b2, voffB); PG8_STAGE(PG8_SB(0, 1), b2 + hstep, voffB); PG8_STAGE(PG8_SA(0, 0), a2, voffA);
            PG8_WAIT_V(8); PG8_WAIT_L(0); PG8_BAR; PG8_MMA(1, 0, At, B0); PG8_MMA(1, 1, At, B1); PG8_BAR; PG8_SCHED;
            PG8_LDB(B0, 1, 0); PG8_LDB(B1, 1, 1); PG8_SCHED; PG8_LDA(At, 1, 0); PG8_STAGE(PG8_SA(0, 1), a2 + hstepA, voffA);
            PG8_WAIT_V(8); PG8_WAIT_L(0); PG8_BAR; PG8_MMA(0, 0, At, B0); PG8_MMA(0, 1, At, B1); PG8_BAR; PG8_SCHED;
            PG8_LDA(At, 1, 1); PG8_STAGE(PG8_SB(1, 0), b3, voffB); PG8_STAGE(PG8_SB(1, 1), b3 + hstep, voffB); PG8_STAGE(PG8_SA(1, 0), a3, voffA);
            PG8_WAIT_V(8); PG8_WAIT_L(0); PG8_BAR; PG8_MMA(1, 0, At, B0); PG8_MMA(1, 1, At, B1); PG8_BAR; PG8_SCHED;
            } else {
            PG8_LDB(B0, 0, 0); PG8_SCHED; PG8_LDA(At, 0, 0); PG8_STAGE(PG8_SA(1, 1), a1 + hstepA, voffA);
            PG8_WAIT_L(8); PG8_BAR; PG8_WAIT_L(0); PG8_MMA(0, 0, At, B0); PG8_BAR; PG8_SCHED;
            PG8_LDB(B1, 0, 1); PG8_STAGE(PG8_SB(0, 0), b2, voffB);
            PG8_BAR; PG8_WAIT_L(0); PG8_MMA(0, 1, At, B1); PG8_BAR;
            PG8_LDA(At, 0, 1); PG8_STAGE(PG8_SA(0, 0), a2, voffA);
            PG8_BAR; PG8_WAIT_L(0); PG8_MMA(1, 0, At, B0); PG8_BAR; PG8_SCHED;
            PG8_STAGE(PG8_SB(0, 1), b2 + hstep, voffB);
            PG8_WAIT_V(6); PG8_BAR; PG8_MMA(1, 1, At, B1); PG8_BAR;
            PG8_LDB(B0, 1, 0); PG8_SCHED; PG8_LDA(At, 1, 0); PG8_STAGE(PG8_SA(0, 1), a2 + hstepA, voffA);
            PG8_WAIT_L(8); PG8_BAR; PG8_WAIT_L(0); PG8_MMA(0, 0, At, B0); PG8_BAR; PG8_SCHED;
            PG8_LDB(B1, 1, 1); PG8_STAGE(PG8_SB(1, 0), b3, voffB);
            PG8_BAR; PG8_WAIT_L(0); PG8_MMA(0, 1, At, B1); PG8_BAR;
            PG8_LDA(At, 1, 1); PG8_STAGE(PG8_SA(1, 0), a3, voffA);
            PG8_BAR; PG8_WAIT_L(0); PG8_MMA(1, 0, At, B0); PG8_BAR; PG8_SCHED;
            PG8_STAGE(PG8_SB(1, 1), b3 + hstep, voffB);
            PG8_WAIT_V(6); PG8_BAR; PG8_MMA(1, 1, At, B1); PG8_BAR;
            }
        }
        if constexpr (ALIGN_EPI) { if (wr == 0) PG8_BAR; }
        if constexpr (!Epi::AFTER_DRAIN) { E(acc, cur, wr, wc, fr, fq); S.done(cur); }
        if (!has_next) break;
#pragma unroll
        for (int a = 0; a < 2; ++a)
#pragma unroll
            for (int b = 0; b < 2; ++b)
#pragma unroll
                for (int m = 0; m < 4; ++m)
#pragma unroll
                    for (int n = 0; n < 2; ++n) acc[a][b][m][n] = (f32x4){0.f, 0.f, 0.f, 0.f};
        cur = nxt; cA = nA; cB = nB; ++ui;
        if constexpr (ALIGN_EPI) { if (wr == 1) PG8_BAR; }
    }
    PG8_WAIT_V(0);
    if constexpr (!ALIGN_EPI) { if (wr == 0) PG8_BAR; }
    PG8_BAR;
    if constexpr (Epi::AFTER_DRAIN) { E.fused(acc, cur, wr, wc, fr, fq, lds, wid, lane); S.done(cur); }
#undef PG8_SA
#undef PG8_SB
#undef PG8_STAGE
#undef PG8_LDA
#undef PG8_LDB
#undef PG8_MMA
#undef PG8_WAIT_V
#undef PG8_WAIT_L
#undef PG8_BAR
#undef PG8_SCHED
}
}
#define GAS __attribute__((address_space(1)))
#define LAS __attribute__((address_space(3)))
typedef unsigned short bf16_t;
typedef short bf16x8 __attribute__((ext_vector_type(8)));
typedef float f32x4 __attribute__((ext_vector_type(4)));
typedef unsigned u32x4 __attribute__((ext_vector_type(4)));
typedef unsigned u32x2 __attribute__((ext_vector_type(2)));
typedef float f32x2 __attribute__((ext_vector_type(2)));
constexpr int NT = 512, PROWS6 = 8192;
constexpr int T = 16384, SEQ = 4096, D = 1024, ZW = 6144;
constexpr size_t MiB = 1u << 20;
constexpr size_t WS_DEC = 0;
constexpr size_t WS_Z = 4 * MiB;
constexpr size_t WS_WIN = 196 * MiB, WS_WOUT = 208 * MiB, WS_RGA = 212 * MiB, WS_RGX = 212 * MiB + 256 * 1024;
constexpr size_t WS_OI = 213 * MiB;
constexpr size_t WS_A2 = 4 * MiB;
constexpr size_t WS_R = 68 * MiB;
constexpr size_t WS_V = 132 * MiB;
constexpr size_t WS_WC = 196 * MiB, WS_WO = 229 * MiB, WS_LW = 233 * MiB, WS_LA = 235 * MiB;
constexpr size_t WS_W2T = 237 * MiB, WS_A2T = 237 * MiB + 256 * 1024, WS_GR = 238 * MiB, WS_ST = 239 * MiB, WS_XG = 241 * MiB;
constexpr size_t WS_BAR = 2 * MiB;
constexpr int LDS_BYTES = 147456, LDS_MISC = 147456 - 64;

struct Params { const GAS float* in[32]; GAS float* out; GAS unsigned char* ws; long long dry; };
#ifndef PROBE
#define PROBE 0
#endif
enum { I_X = 0, I_ABG, I_WIN, I_CONVW, I_CONVB, I_RGWA, I_RGBA, I_RGWX, I_RGBX, I_LAM, I_LB, I_HGG, I_WOUT, I_CNG, I_MU, I_WR, I_WK, I_WV, I_WG, I_W0, I_W1, I_W2, I_A0, I_A1, I_A2, I_KK, I_KA, I_RK, I_LNG, I_LNB, I_WO, I_FG };

__device__ __forceinline__ unsigned f2bf(float f) { unsigned u = __float_as_uint(f); return (u + 0x7fffu + ((u >> 16) & 1u)) >> 16; }
__device__ __forceinline__ float bf2f(unsigned h) { return __uint_as_float(h << 16); }
__device__ __forceinline__ unsigned pk2(float lo, float hi) { return f2bf(lo) | (f2bf(hi) << 16); }
__device__ __forceinline__ float sigmf(float x) { return __builtin_amdgcn_rcpf(1.0f + __expf(-x)); }
__device__ __forceinline__ float wave_sum(float v) {
#pragma unroll
    for (int o = 1; o < 64; o <<= 1) v += __shfl_xor(v, o);
    return v;
}
#define OPQ_TID unsigned char* WSP = launder_ws(((unsigned char*)p.ws)); int tid = threadIdx.x; asm volatile("" : "+v"(tid)); const int lane = tid & 63, wave = __builtin_amdgcn_readfirstlane(tid >> 6); (void)lane; (void)wave
__device__ __forceinline__ unsigned char* launder_ws(unsigned char* w) { const unsigned long long v = (unsigned long long)w; unsigned lo = __builtin_amdgcn_readfirstlane((unsigned)v), hi = __builtin_amdgcn_readfirstlane((unsigned)(v >> 32)); asm volatile("" : "+s"(lo), "+s"(hi)); return (unsigned char*)(GAS unsigned char*)(((unsigned long long)hi << 32) | lo); }
#define MFMA16(a, b, c) __builtin_amdgcn_mfma_f32_16x16x32_bf16((a), (b), (c), 0, 0, 0)

__device__ __forceinline__ void tr_item(const float* src, int ld_src, bf16_t* dst, int ld_dst, const float* sc, int scmode, LAS float* scr, int kb, int nb, int lane) {
    const int k0 = 64 * kb, n0 = 32 * nb;
#pragma unroll 8
    for (int i = 0; i < 32; ++i) { const int kk = 2 * i + (lane >> 5); float v = src[(size_t)(k0 + kk) * ld_src + n0 + (lane & 31)];
        if (sc) { const float m = sc[k0 + kk]; v *= scmode ? m : (1.0f - m); }
        scr[kk * 33 + (lane & 31)] = v; }
    asm volatile("s_waitcnt lgkmcnt(0)" ::: "memory");
    const int c = lane & 7;
#pragma unroll
    for (int j = 0; j < 4; ++j) { const int n = (lane >> 3) + 8 * j; const LAS float* s = scr + (8 * c) * 33 + n;
        u32x4 o; o.x = pk2(s[0 * 33], s[1 * 33]); o.y = pk2(s[2 * 33], s[3 * 33]); o.z = pk2(s[4 * 33], s[5 * 33]); o.w = pk2(s[6 * 33], s[7 * 33]);
        *(u32x4*)(dst + (size_t)(n0 + n) * ld_dst + k0 + 8 * c) = o; }
    asm volatile("s_waitcnt lgkmcnt(0)" ::: "memory");
}
__device__ __forceinline__ void rms_row(const float* xrow, const float* g, int lane, u32x2 (&o)[4]) {
    f32x4 v[4]; float s = 0.f;
#pragma unroll
    for (int j = 0; j < 4; ++j) { v[j] = *((const f32x4*)xrow + lane + 64 * j); s += (v[j].x * v[j].x + v[j].y * v[j].y) + (v[j].z * v[j].z + v[j].w * v[j].w); }
    const float rs = rsqrtf(wave_sum(s) * (1.0f / 1024.0f) + 1e-6f);
#pragma unroll
    for (int j = 0; j < 4; ++j) { const f32x4 gg = *((const f32x4*)g + lane + 64 * j); o[j].x = pk2(v[j].x * rs * gg.x, v[j].y * rs * gg.y); o[j].y = pk2(v[j].z * rs * gg.z, v[j].w * rs * gg.w); }
}

__device__ __forceinline__ void p0_prologue(const Params& p, LAS unsigned char* lds, int G, int bid) {
    OPQ_TID; const int gw = bid * 8 + wave, ngw = G * 8;
    LAS float* scr = (LAS float*)(lds + wave * 16384);
    bf16_t* WinT = (bf16_t*)(WSP + WS_WIN); bf16_t* WoutT = (bf16_t*)(WSP + WS_WOUT); bf16_t* RGA = (bf16_t*)(WSP + WS_RGA); bf16_t* RGX = (bf16_t*)(WSP + WS_RGX);
    constexpr int IA = 16 * 192, IB = 32 * 32, IC = 64;
    for (int it = gw; it < IA + IB + 2 * IC; it += ngw) {
        int r = it;
        if (r < IA) { tr_item(((const float*)p.in[I_WIN]), ZW, WinT, 1024, nullptr, 0, scr, r / 192, r % 192, lane); continue; } r -= IA;
        if (r < IB) { tr_item(((const float*)p.in[I_WOUT]), 1024, WoutT, 2048, nullptr, 0, scr, r / 32, r % 32, lane); continue; } r -= IB;
        const float* src = (r < IC) ? ((const float*)p.in[I_RGWA]) : ((const float*)p.in[I_RGWX]); bf16_t* dst = (r < IC) ? RGA : RGX; if (r >= IC) r -= IC;
        const int blk = r >> 3, q = r & 7;
        tr_item(src + blk * 16384, 128, dst + blk * 16384, 128, nullptr, 0, scr, q >> 2, q & 3, lane);
    }
    bf16_t* U0 = (bf16_t*)((float*)p.out);
    for (int m = gw; m < T; m += ngw) { u32x2 o[4]; rms_row(((const float*)p.in[I_X]) + (size_t)m * D, ((const float*)p.in[I_ABG]), lane, o);
#pragma unroll
        for (int j = 0; j < 4; ++j) *((u32x2*)(U0 + (size_t)m * D) + lane + 64 * j) = o[j]; }
}

__device__ __forceinline__ void rg_a_prefetch(const bf16_t* Z, int unit, int tid, u32x4 (&pre)[3]) {
    const int b = unit >> 9, n = (unit >> 3) & 63, j = unit & 7; const int tok0 = b * SEQ + n * 64, ch0 = j * 128;
#pragma unroll
    for (int q = 0; q < 3; ++q) { const int i = tid + q * NT; const int row = i >> 4, cc = i & 15; pre[q] = (u32x4){0u, 0u, 0u, 0u};
        if (i < 67 * 16 && (n > 0 || row >= 3)) pre[q] = *(const u32x4*)(Z + (size_t)(tok0 - 3 + row) * ZW + ch0 + 8 * cc); }
}
__device__ __forceinline__ void rg_a_unit(const Params& p, LAS unsigned char* lds, int unit, int next_unit, u32x4 (&pre)[3]) {
    OPQ_TID;
    LAS float* XC = (LAS float*)lds; LAS float* AA = (LAS float*)(lds + 32768); LAS bf16_t* XB = (LAS bf16_t*)(lds + 65536); LAS bf16_t* XR = (LAS bf16_t*)(lds + 82944);
    LAS float* SUMP = (LAS float*)(lds + 82944); LAS float* SUMH = SUMP + 512; LAS bf16_t* HT = XB; LAS bf16_t* PT = (LAS bf16_t*)(lds + 87040);
    const int b = unit >> 9, n = (unit >> 3) & 63, j = unit & 7;
    const int tok0 = b * SEQ + n * 64, ch0 = j * 128;
    const bf16_t* Z = (const bf16_t*)(WSP + WS_Z);
#pragma unroll
    for (int q = 0; q < 3; ++q) { const int i = tid + q * NT; if (i < 67 * 16) *(LAS u32x4*)(XR + (i >> 4) * 136 + 8 * (i & 15)) = pre[q]; }
    __syncthreads();
    if (next_unit < 2048) rg_a_prefetch(Z, next_unit, tid, pre);
    const int c = tid & 127, sub = tid >> 7;
    {
        const int ch = ch0 + c;
        const float w0 = ((const float*)p.in[I_CONVW])[ch], w1 = ((const float*)p.in[I_CONVW])[1024 + ch], w2 = ((const float*)p.in[I_CONVW])[2048 + ch], w3 = ((const float*)p.in[I_CONVW])[3072 + ch], cb = ((const float*)p.in[I_CONVB])[ch];
        const LAS bf16_t* xr = XR + (sub * 16) * 136 + c;
        float xm3 = bf2f(xr[0]), xm2 = bf2f(xr[136]), xm1 = bf2f(xr[272]);
#pragma unroll
        for (int i = 0; i < 16; ++i) { const float x = bf2f(xr[(i + 3) * 136]); const float y = w0 * xm3 + w1 * xm2 + w2 * xm1 + w3 * x + cb;
            XC[(sub * 16 + i) * 128 + c] = y; XB[(sub * 16 + i) * 136 + c] = (bf16_t)f2bf(y); xm3 = xm2; xm2 = xm1; xm1 = x; }
    }
    __syncthreads();
    {
        const int fr = lane & 15, fq = lane >> 4;
        const bf16_t* WA = (const bf16_t*)(WSP + WS_RGA) + j * 16384 + (16 * wave + fr) * 128 + 8 * fq;
        const bf16_t* WX = (const bf16_t*)(WSP + WS_RGX) + j * 16384 + (16 * wave + fr) * 128 + 8 * fq;
        f32x4 accA[4], accX[4];
#pragma unroll
        for (int m = 0; m < 4; ++m) { accA[m] = (f32x4){0.f, 0.f, 0.f, 0.f}; accX[m] = (f32x4){0.f, 0.f, 0.f, 0.f}; }
#pragma unroll
        for (int k = 0; k < 4; ++k) { const bf16x8 bA = *(const bf16x8*)(WA + 32 * k), bX = *(const bf16x8*)(WX + 32 * k);
#pragma unroll
            for (int m = 0; m < 4; ++m) { const bf16x8 a = *(const LAS bf16x8*)(XB + (16 * m + fr) * 136 + 32 * k + 8 * fq); accA[m] = MFMA16(a, bA, accA[m]); accX[m] = MFMA16(a, bX, accX[m]); } }
        const int cl = 16 * wave + fr, ch = ch0 + cl;
        const float ba = ((const float*)p.in[I_RGBA])[ch], bx = ((const float*)p.in[I_RGBX])[ch], lam = ((const float*)p.in[I_LAM])[ch];
        const float sp = log1pf(expf(-lam));
#pragma unroll
        for (int m = 0; m < 4; ++m)
#pragma unroll
            for (int r = 0; r < 4; ++r) { const int tk = 16 * m + 4 * fq + r; const float gr = sigmf(accA[m][r] + ba), gi = sigmf(accX[m][r] + bx);
                const float la = -8.0f * gr * sp; const float a = __expf(la); const float mult = __builtin_amdgcn_sqrtf(fmaxf(1.0f - a * a, 0.f));
                const float xc = XC[tk * 128 + cl]; AA[tk * 128 + cl] = a; XC[tk * 128 + cl] = mult * gi * xc; }
    }
    __syncthreads();
    {
        float hl[16], pl[16]; float h = 0.f, P = 1.f;
#pragma unroll
        for (int i = 0; i < 16; ++i) { const float a = AA[(sub * 16 + i) * 128 + c], u = XC[(sub * 16 + i) * 128 + c]; h = a * h + u; P *= a; hl[i] = h; pl[i] = P; }
        SUMP[sub * 128 + c] = P; SUMH[sub * 128 + c] = h;
        __syncthreads();
        float chh = 0.f, cp = 1.f;
#pragma unroll
        for (int s = 0; s < 3; ++s) if (s < sub) { const float sp_ = SUMP[s * 128 + c]; chh = chh * sp_ + SUMH[s * 128 + c]; cp *= sp_; }
#pragma unroll
        for (int i = 0; i < 16; ++i) { HT[(sub * 16 + i) * 136 + c] = (bf16_t)f2bf(hl[i] + pl[i] * chh); PT[(sub * 16 + i) * 136 + c] = (bf16_t)f2bf(pl[i] * cp); }
    }
    __syncthreads();
    {
        bf16_t* HL = (bf16_t*)((float*)p.out) + (size_t)tok0 * D + ch0; bf16_t* PC = HL + (size_t)T * D;
        for (int i = tid; i < 1024; i += NT) { const int row = i >> 4, cc = i & 15;
            *(u32x4*)(HL + (size_t)row * D + 8 * cc) = *(const LAS u32x4*)(HT + row * 136 + 8 * cc); *(u32x4*)(PC + (size_t)row * D + 8 * cc) = *(const LAS u32x4*)(PT + row * 136 + 8 * cc); }
    }
    __syncthreads();
}

__device__ __forceinline__ void hg_a_prefetch(const bf16_t* Z, int unit, int tid, u32x4 (&pre)[6]) {
    const int b = unit >> 9, h = (unit >> 6) & 7, n = unit & 63; const int tok0 = b * SEQ + n * 64;
#pragma unroll
    for (int q = 0; q < 6; ++q) { const int i = tid + q * NT; const int arr = i >> 10, row = (i >> 4) & 63, cc = i & 15; pre[q] = *(const u32x4*)(Z + (size_t)(tok0 + row) * ZW + 2048 + 1024 * arr + h * 128 + 8 * cc); }
}
__device__ __forceinline__ void hg_a_unit(const Params& p, LAS unsigned char* lds, int unit, int next_unit, u32x4 (&pre)[6]) {
    OPQ_TID;
    LAS bf16_t* QD = (LAS bf16_t*)lds; LAS bf16_t* KI = (LAS bf16_t*)(lds + 17408); LAS bf16_t* VR = (LAS bf16_t*)(lds + 34816); LAS bf16_t* VT = (LAS bf16_t*)(lds + 52224);
    LAS bf16_t* SC = (LAS bf16_t*)(lds + 70656); LAS float* ST = (LAS float*)(lds + 79872); LAS bf16_t* OT = VR;
    const int b = unit >> 9, h = (unit >> 6) & 7, n = unit & 63;
    const int tok0 = b * SEQ + n * 64;
    bf16_t* Z = (bf16_t*)(WSP + WS_Z);
    const int fr = lane & 15, fq = lane >> 4;
#pragma unroll
    for (int q = 0; q < 6; ++q) { const int i = tid + q * NT; const int arr = i >> 10, row = (i >> 4) & 63, cc = i & 15;
        *(LAS u32x4*)((arr == 0 ? QD : (arr == 1 ? KI : VR)) + row * 136 + 8 * cc) = pre[q]; }
    __syncthreads();
    {
        const int d = tid & 127, sub = tid >> 7, hd = h * 128 + d;
        const float lb = sigmf(((const float*)p.in[I_LB])[hd] - ((const float*)p.in[I_LB])[1024 + hd]), omlb = 1.0f - lb;
        float q[16], kq[16], cl[16]; unsigned short vv[16]; float run = 0.f;
#pragma unroll
        for (int i = 0; i < 16; ++i) { const int t = sub * 16 + i; const float f = bf2f(KI[t * 136 + d]); const float sg = sigmf(f);
            run += __logf(lb + omlb * sg); cl[i] = run; kq[i] = omlb * (1.0f - sg); q[i] = bf2f(QD[t * 136 + d]); vv[i] = VR[t * 136 + d]; }
        ST[sub * 128 + d] = run;
        __syncthreads();
        float off = 0.f, total = 0.f;
#pragma unroll
        for (int s = 0; s < 4; ++s) { const float x = ST[s * 128 + d]; total += x; if (s < sub) off += x; }
        unsigned ke[8], vp[8];
#pragma unroll
        for (int i = 0; i < 16; ++i) { const float cum = off + cl[i]; const unsigned qd = f2bf(q[i] * __expf(cum)), ki = f2bf(kq[i] * __expf(-cum)), kE = f2bf(kq[i] * __expf(total - cum));
            QD[(sub * 16 + i) * 136 + d] = (bf16_t)qd; KI[(sub * 16 + i) * 136 + d] = (bf16_t)ki;
            if (i & 1) { ke[i >> 1] |= kE << 16; vp[i >> 1] |= (unsigned)vv[i] << 16; } else { ke[i >> 1] = kE; vp[i >> 1] = vv[i]; } }
        *(LAS u32x4*)(VT + d * 72 + sub * 16) = (u32x4){vp[0], vp[1], vp[2], vp[3]}; *(LAS u32x4*)(VT + d * 72 + sub * 16 + 8) = (u32x4){vp[4], vp[5], vp[6], vp[7]};
        bf16_t* tb = Z + (size_t)(tok0 + (d >> 1)) * ZW + h * 128 + (d & 1) * 64 + sub * 16;
        *(u32x4*)(tb + 3072) = (u32x4){ke[0], ke[1], ke[2], ke[3]}; *(u32x4*)(tb + 3072 + 8) = (u32x4){ke[4], ke[5], ke[6], ke[7]};
        *(u32x4*)(tb + 4096) = (u32x4){vp[0], vp[1], vp[2], vp[3]}; *(u32x4*)(tb + 4096 + 8) = (u32x4){vp[4], vp[5], vp[6], vp[7]};
        if (sub == 0) ((float*)(WSP + WS_DEC))[unit * 128 + d] = __expf(total);
    }
    __syncthreads();
    if (next_unit < 2048) hg_a_prefetch(Z, next_unit, tid, pre);
    for (int i = tid; i < 1024; i += NT) { const int row = i >> 4, cc = i & 15; *(u32x4*)(Z + (size_t)(tok0 + row) * ZW + 2048 + h * 128 + 8 * cc) = *(const LAS u32x4*)(QD + row * 136 + 8 * cc); }
    {
        const int lt = wave >> 1;
#pragma unroll
        for (int x = 0; x < 2; ++x) { const int mt = (wave & 1) * 2 + x; f32x4 acc = (f32x4){0.f, 0.f, 0.f, 0.f};
            if (mt <= lt) {
#pragma unroll
                for (int k = 0; k < 4; ++k) { const bf16x8 a = *(const LAS bf16x8*)(QD + (16 * lt + fr) * 136 + 32 * k + 8 * fq), bb = *(const LAS bf16x8*)(KI + (16 * mt + fr) * 136 + 32 * k + 8 * fq); acc = MFMA16(a, bb, acc); } }
#pragma unroll
            for (int r = 0; r < 4; ++r) { const int l = 16 * lt + 4 * fq + r, mm = 16 * mt + fr; SC[l * 72 + mm] = (bf16_t)f2bf(mm <= l ? acc[r] : 0.f); } }
    }
    __syncthreads();
    {
#pragma unroll
        for (int lt = 0; lt < 4; ++lt) { f32x4 acc = (f32x4){0.f, 0.f, 0.f, 0.f};
#pragma unroll
            for (int k = 0; k < 2; ++k) { const bf16x8 a = *(const LAS bf16x8*)(SC + (16 * lt + fr) * 72 + 32 * k + 8 * fq), bb = *(const LAS bf16x8*)(VT + (16 * wave + fr) * 72 + 32 * k + 8 * fq); acc = MFMA16(a, bb, acc); }
#pragma unroll
            for (int r = 0; r < 4; ++r) OT[(16 * lt + 4 * fq + r) * 136 + 16 * wave + fr] = (bf16_t)f2bf(acc[r]); }
    }
    __syncthreads();
    { bf16_t* OI = (bf16_t*)(WSP + WS_OI) + (size_t)tok0 * D + h * 128;
      for (int i = tid; i < 1024; i += NT) { const int row = i >> 4, cc = i & 15; *(u32x4*)(OI + (size_t)row * D + 8 * cc) = *(const LAS u32x4*)(OT + row * 136 + 8 * cc); } }
    __syncthreads();
}

__device__ __forceinline__ void hg_b_item(const Params& p, LAS unsigned char* lds, int item, bool dry = false) {
    OPQ_TID;
    LAS bf16_t* SB = (LAS bf16_t*)lds;
    const int b = item >> 6, h = (item >> 3) & 7, es = item & 7;
    const int fr = lane & 15, fq = lane >> 4;
    const bf16_t* Z = (const bf16_t*)(WSP + WS_Z); bf16_t* OI = (bf16_t*)(WSP + WS_OI); const float* DEC = (const float*)(WSP + WS_DEC);
    for (int i = tid; i < 2 * 16 * 136 / 2; i += NT) ((LAS unsigned*)SB)[i] = 0u;
    __syncthreads();
    f32x4 S = (f32x4){0.f, 0.f, 0.f, 0.f};
    const int eg = 16 * es + fr, dg = 16 * wave + fr;
    const bf16_t* pV = Z + (size_t)(b * SEQ + (eg >> 1)) * ZW + 4096 + h * 128 + (eg & 1) * 64 + 8 * fq;
    const bf16_t* pK = Z + (size_t)(b * SEQ + (dg >> 1)) * ZW + 3072 + h * 128 + (dg & 1) * 64 + 8 * fq;
    const bf16_t* pQ = Z + (size_t)(b * SEQ + 16 * (wave & 3) + fr) * ZW + 2048 + h * 128 + 8 * fq;
    bf16_t* pO = OI + (size_t)(b * SEQ + 16 * (wave & 3) + 4 * fq) * D + h * 128 + 16 * es + fr;
    const float* pD = DEC + (size_t)((b * 8 + h) * 64) * 128 + dg;
    bf16x8 nV[2][2], nK[2][2], nQ[2][4]; float ndec[2]; unsigned short nO[2][4];
#define HGB_LOAD(SET, n_) do { const size_t ro_ = (size_t)(n_) * 64 * ZW; ndec[SET] = pD[(n_) * 128]; \
        _Pragma("unroll") for (int k = 0; k < 2; ++k) { nV[SET][k] = *(const bf16x8*)(pV + ro_ + 32 * k); nK[SET][k] = *(const bf16x8*)(pK + ro_ + 32 * k); } \
        if (wave < 4) { _Pragma("unroll") for (int k = 0; k < 4; ++k) nQ[SET][k] = *(const bf16x8*)(pQ + ro_ + 32 * k); \
            _Pragma("unroll") for (int r = 0; r < 4; ++r) nO[SET][r] = pO[(size_t)((n_) * 64 + r) * D]; } } while (0)
#define HGB_STEP(SET, n) do { \
        const float dec = ndec[SET]; bf16x8 aV[2], bK[2]; \
        _Pragma("unroll") for (int k = 0; k < 2; ++k) { aV[k] = nV[SET][k]; bK[k] = nK[SET][k]; } \
        if (wave < 4) { \
            f32x4 acc = (f32x4){0.f, 0.f, 0.f, 0.f}; \
            _Pragma("unroll") for (int k = 0; k < 4; ++k) { const bf16x8 bb = *(const LAS bf16x8*)(SB + ((n) & 1) * 2176 + fr * 136 + 32 * k + 8 * fq); acc = MFMA16(nQ[SET][k], bb, acc); } \
            _Pragma("unroll") for (int r = 0; r < 4; ++r) { const float nv = bf2f(nO[SET][r]) + acc[r]; if (!dry) pO[(size_t)((n) * 64 + r) * D] = (bf16_t)f2bf(nv); else if (nv == 123456.0f) pO[0] = 0; } \
        } \
        if ((n) + 2 < 64) HGB_LOAD(SET, (n) + 2); \
        S = S * dec; \
        _Pragma("unroll") for (int k = 0; k < 2; ++k) S = MFMA16(aV[k], bK[k], S); \
        _Pragma("unroll") for (int r = 0; r < 4; ++r) SB[(((n) + 1) & 1) * 2176 + (4 * fq + r) * 136 + dg] = (bf16_t)f2bf(S[r]); \
        asm volatile("s_waitcnt lgkmcnt(0)" ::: "memory"); __builtin_amdgcn_s_barrier(); asm volatile("" ::: "memory"); } while (0)
    HGB_LOAD(0, 0); HGB_LOAD(1, 1);
#pragma unroll 1
    for (int n2 = 0; n2 < 64; n2 += 2) { HGB_STEP(0, n2); HGB_STEP(1, n2 + 1); }
#undef HGB_LOAD
#undef HGB_STEP
}
__device__ __forceinline__ void rg_b_unit(const Params& p, int unit) {
    OPQ_TID;
    const int b = unit >> 7, n = (unit >> 1) & 63, ch = (unit & 1) * 512 + 8 * (tid & 63), r8 = tid >> 6;
    const bf16_t* HL = (const bf16_t*)((float*)p.out) + (size_t)b * SEQ * D + ch; const bf16_t* PC = HL + (size_t)T * D;
    bf16_t* Z = (bf16_t*)(WSP + WS_Z) + (size_t)(b * SEQ + n * 64) * ZW + ch;
    float carry[8];
#pragma unroll
    for (int i = 0; i < 8; ++i) carry[i] = 0.f;
    int m0 = 0;
    for (; m0 + 4 <= n; m0 += 4) { u32x4 pp[4], hh4[4];
#pragma unroll
        for (int i = 0; i < 4; ++i) { const size_t o = (size_t)((m0 + i) * 64 + 63) * D; pp[i] = *(const u32x4*)(PC + o); hh4[i] = *(const u32x4*)(HL + o); }
#pragma unroll
        for (int i = 0; i < 4; ++i)
#pragma unroll
            for (int c = 0; c < 4; ++c) { carry[2 * c] = carry[2 * c] * bf2f(pp[i][c] & 0xffffu) + bf2f(hh4[i][c] & 0xffffu); carry[2 * c + 1] = carry[2 * c + 1] * bf2f(pp[i][c] >> 16) + bf2f(hh4[i][c] >> 16); } }
    for (; m0 < n; ++m0) { const size_t o = (size_t)(m0 * 64 + 63) * D; const u32x4 pp = *(const u32x4*)(PC + o), hh4 = *(const u32x4*)(HL + o);
#pragma unroll
        for (int c = 0; c < 4; ++c) { carry[2 * c] = carry[2 * c] * bf2f(pp[c] & 0xffffu) + bf2f(hh4[c] & 0xffffu); carry[2 * c + 1] = carry[2 * c + 1] * bf2f(pp[c] >> 16) + bf2f(hh4[c] >> 16); } }
#pragma unroll 4
    for (int tq = 0; tq < 8; ++tq) { const int t = 8 * tq + r8; const size_t o = (size_t)(n * 64 + t) * D;
        const u32x4 hv = *(const u32x4*)(HL + o), pv = *(const u32x4*)(PC + o), gv = *(const u32x4*)(Z + (size_t)t * ZW + 1024); u32x4 ov;
#pragma unroll
        for (int c = 0; c < 4; ++c) { const float h0 = bf2f(hv[c] & 0xffffu) + bf2f(pv[c] & 0xffffu) * carry[2 * c], h1 = bf2f(hv[c] >> 16) + bf2f(pv[c] >> 16) * carry[2 * c + 1];
            const float g0 = bf2f(gv[c] & 0xffffu), g1 = bf2f(gv[c] >> 16); ov[c] = pk2(h0 * g0 * sigmf(g0), h1 * g1 * sigmf(g1)); }
        *(u32x4*)(Z + (size_t)t * ZW) = ov; }
}
__device__ __forceinline__ void p4_finalize(const Params& p, int G, int bid) {
    OPQ_TID; const int gw = bid * 8 + wave, ngw = G * 8;
    bf16_t* Z = (bf16_t*)(WSP + WS_Z); const bf16_t* OI = (const bf16_t*)(WSP + WS_OI);
    const float g0 = ((const float*)p.in[I_HGG])[2 * lane], g1 = ((const float*)p.in[I_HGG])[2 * lane + 1];
    for (int it = gw; it < T * 8; it += ngw) { const int tok = it >> 3, h = it & 7;
        const unsigned o2 = *(const unsigned*)(OI + (size_t)tok * D + h * 128 + 2 * lane); const float o0 = bf2f(o2 & 0xffffu), o1 = bf2f(o2 >> 16);
        const float rs = rsqrtf(wave_sum(o0 * o0 + o1 * o1) * (1.0f / 128.0f) + 1e-6f);
        const unsigned gb = *(const unsigned*)(Z + (size_t)tok * ZW + 5120 + h * 128 + 2 * lane); const float gb0 = bf2f(gb & 0xffffu), gb1 = bf2f(gb >> 16);
        *(unsigned*)(Z + (size_t)tok * ZW + 1024 + h * 128 + 2 * lane) = pk2(o0 * rs * g0 * gb0 * sigmf(gb0), o1 * rs * g1 * gb1 * sigmf(gb1)); }
}
__device__ __forceinline__ void p6_prologue(const Params& p, LAS unsigned char* lds, int G, int bid) {
    OPQ_TID; const int gw = bid * 8 + wave, ngw = G * 8;
    LAS float* scr = (LAS float*)(lds + wave * 16384);
    constexpr int IP = 8192, IL = 128, IO = 1024, I2 = 128;
    for (int i = gw * 64 + lane; i < (int)(MiB / 16); i += ngw * 64) ((u32x4*)(WSP + WS_GR))[i] = (u32x4){0u, 0u, 0u, 0u};
    for (int i = gw * 64 + lane; i < (int)(MiB / 32); i += ngw * 64) ((u32x4*)(WSP + WS_XG))[i] = (u32x4){0u, 0u, 0u, 0u};
    for (int it = gw; it < IP + IL + IO + I2; it += ngw) {
        int r = it;
        if (r < IP) { const int blk = r >> 10, q = r & 1023, pj = blk >> 1, md = blk & 1;
            const int muidx = pj == 0 ? 0 : (pj == 1 ? 2 : (pj == 2 ? 3 : 5));
            bf16_t* dst = (bf16_t*)(WSP + WS_WC) + (size_t)(pj * 2048) * 2048 + md * 1024;
            tr_item(((const float*)p.in[I_WR + pj]), 2048, dst, 2048, ((const float*)p.in[I_MU]) + muidx * 1024, md, scr, q >> 6, q & 63, lane); continue; }
        r -= IP;
        if (r < IL) { const int blk = r >> 5, q = r & 31, wh = blk >> 1, md = blk & 1;
            const float* src = wh ? ((const float*)p.in[I_A1]) : ((const float*)p.in[I_W1]); bf16_t* dst = (bf16_t*)(WSP + WS_WC) + (size_t)(8192 + wh * 64) * 2048 + md * 1024;
            tr_item(src, 64, dst, 2048, ((const float*)p.in[I_MU]) + (wh ? 4 : 1) * 1024, md, scr, q >> 1, q & 1, lane); continue; }
        r -= IL;
        if (r >= IO) { r -= IO; const int wh = r >> 6, nb = r & 63; tr_item(wh ? ((const float*)p.in[I_A2]) : ((const float*)p.in[I_W2]), 2048, (bf16_t*)(WSP + (wh ? WS_A2T : WS_W2T)), 64, nullptr, 0, scr, 0, nb, lane); continue; }
        tr_item(((const float*)p.in[I_WO]), 1024, (bf16_t*)(WSP + WS_WO), 2048, nullptr, 0, scr, r >> 5, r & 31, lane);
    }
    bf16_t* A2 = (bf16_t*)(WSP + WS_A2);
    for (int m = gw; m < T; m += ngw) { u32x2 o[4]; rms_row(((float*)p.out) + (size_t)m * D, ((const float*)p.in[I_CNG]), lane, o); const int bb = m >> 12, t = m & (SEQ - 1);
        const size_t cr = (size_t)(t >> 11) * PROWS6 + bb * 2048 + (t & 2047);
        const size_t cn = (size_t)((t + 1) >> 11) * PROWS6 + bb * 2048 + ((t + 1) & 2047);
#pragma unroll
        for (int j = 0; j < 4; ++j) { *((u32x2*)(A2 + cr * 2048) + lane + 64 * j) = o[j];
            if (t + 1 < SEQ) *((u32x2*)(A2 + cn * 2048 + 1024) + lane + 64 * j) = o[j];
            if (t == 0) *((u32x2*)(A2 + cr * 2048 + 1024) + lane + 64 * j) = (u32x2){0u, 0u}; } }
}
template <int CTRL> __device__ __forceinline__ float dpp_add(float x) { const int y = __builtin_amdgcn_update_dpp(0, __float_as_int(x), CTRL, 0xf, 0xf, true); return x + __int_as_float(y); }
__device__ __forceinline__ f32x4 bf4(u32x2 v) { return (f32x4){bf2f(v.x & 0xffffu), bf2f(v.x >> 16), bf2f(v.y & 0xffffu), bf2f(v.y >> 16)}; }
__device__ __forceinline__ float afma(float a, float b, float c) { float d; asm("v_fma_f32 %0, %1, %2, %3" : "=v"(d) : "v"(a), "v"(b), "v"(c)); return d; }
__device__ __forceinline__ float anfma(float a, float b, float c) { float d; asm("v_fma_f32 %0, -%1, %2, %3" : "=v"(d) : "v"(a), "v"(b), "v"(c)); return d; }
__device__ __forceinline__ float amul(float a, float b) { float d; asm("v_mul_f32 %0, %1, %2" : "=v"(d) : "v"(a), "v"(b)); return d; }
__device__ __forceinline__ f32x2 pkmul(f32x2 a, f32x2 b) { f32x2 d; asm("v_pk_mul_f32 %0, %1, %2" : "=v"(d) : "v"(a), "v"(b)); return d; }
__device__ __forceinline__ f32x2 pkfma(f32x2 a, f32x2 b, f32x2 c) { f32x2 d; asm("v_pk_fma_f32 %0, %1, %2, %3" : "=v"(d) : "v"(a), "v"(b), "v"(c)); return d; }
__device__ __forceinline__ f32x2 pkmul_bl(f32x2 s, f32x2 b) { f32x2 d; asm("v_pk_mul_f32 %0, %1, %2 op_sel_hi:[0,1]" : "=v"(d) : "v"(s), "v"(b)); return d; }
__device__ __forceinline__ f32x2 pknfma_bl(f32x2 s, f32x2 b, f32x2 c) { f32x2 d; asm("v_pk_fma_f32 %0, %1, %2, %3 op_sel_hi:[0,1,1] neg_lo:[1,0,0] neg_hi:[1,0,0]" : "=v"(d) : "v"(s), "v"(b), "v"(c)); return d; }
constexpr int RSTR = 68;
constexpr int REC_ARR = 32 * RSTR;
constexpr int REC_BUF = 5 * REC_ARR;
constexpr int L_REC = 0, L_YY = 87040, L_VV = 103424, L_GG = 119808, L_RKP = 136192, L_SSP = 137216, L_STT = 137728, L_CST = 137984;
constexpr int PROWS = 8192;
#define SCAN_BAR do { asm volatile("s_waitcnt lgkmcnt(0)" ::: "memory"); __builtin_amdgcn_s_barrier(); asm volatile("" ::: "memory"); } while (0)
__device__ __forceinline__ void scan_half(const Params& p, LAS unsigned char* lds, int pi, int rh, int pass) {
    OPQ_TID;
    LAS float* REC = (LAS float*)(lds + L_REC); LAS float* YY = (LAS float*)(lds + L_YY); LAS float* VV = (LAS float*)(lds + L_VV); LAS float* GG = (LAS float*)(lds + L_GG);
    LAS float* RKP = (LAS float*)(lds + L_RKP); LAS float* SSP = (LAS float*)(lds + L_SSP); LAS float* STT = (LAS float*)(lds + L_STT); LAS float* CST = (LAS float*)(lds + L_CST);
    const int b = pi >> 5, hg = pi & 31, colg = hg * 64;
    const bf16_t* Rb = (const bf16_t*)(WSP + WS_R); const bf16_t* Kb = Rb + (size_t)PROWS * 2048; bf16_t* Vb = (bf16_t*)(WSP + WS_V); const bf16_t* Gb = Vb + (size_t)PROWS * 2048;
    const bf16_t* LWb = (const bf16_t*)(WSP + WS_LW) + (size_t)pass * PROWS * 64; const bf16_t* LAb = (const bf16_t*)(WSP + WS_LA) + (size_t)pass * PROWS * 64;
    unsigned long long* GR = (unsigned long long*)(WSP + WS_GR);
    const size_t rowb = (size_t)b * 2048;
    __syncthreads();
    if (tid < 64) { CST[tid] = ((const float*)p.in[I_W0])[colg + tid]; CST[64 + tid] = ((const float*)p.in[I_A0])[colg + tid]; CST[128 + tid] = ((const float*)p.in[I_KK])[colg + tid]; CST[192 + tid] = ((const float*)p.in[I_KA])[colg + tid]; CST[256 + tid] = ((const float*)p.in[I_RK])[colg + tid];
                    CST[320 + tid] = ((const float*)p.in[I_LNG])[colg + tid]; CST[384 + tid] = ((const float*)p.in[I_LNB])[colg + tid]; }
    __syncthreads();
    const int fr = lane & 15, fq = lane >> 4;
    if (wave < 4) {
        const int j = lane & 7, rowl = 8 * wave + (lane >> 3);
        float* stp = (float*)(WSP + WS_ST) + ((size_t)(pi * 64 + 32 * rh + rowl)) * 64 + 8 * j;
        f32x2 P01 = (f32x2){0.f, 0.f}, P23 = P01, P45 = P01, P67 = P01;
        if (pass == 1) { const f32x4 a = *(const f32x4*)stp, c = *(const f32x4*)(stp + 4); P01 = a.xy; P23 = a.zw; P45 = c.xy; P67 = c.zw; }
        const bool first = (lane & 7) == 0;
        SCAN_BAR;
        for (int it = 0; it < 66; ++it) {
            if (it < 64) {
                const LAS float* rec = REC + (it & 1) * REC_BUF + 8 * j; const LAS float* vvp = VV + (it & 3) * 1024 + rowl; LAS float* yyp = YY + (it & 3) * 1024 + rowl;
                const LAS float* ssp = SSP + (it & 1) * 64 + 2 * (lane & 31);
                const float inv2 = __builtin_amdgcn_rcpf(fmaxf(ssp[0] + ssp[1], 1e-24f));
                f32x4 Rkk[2][2], Rw[2][2], Rka[2][2], Rkm[2][2], Rr[2][2]; float Rv[2];
#define LOADREC(slot, s) do { const LAS float* rs_ = rec + (s) * RSTR; \
                    Rkk[slot][0] = *(const LAS f32x4*)(rs_); Rkk[slot][1] = *(const LAS f32x4*)(rs_ + 4); Rw[slot][0] = *(const LAS f32x4*)(rs_ + REC_ARR); Rw[slot][1] = *(const LAS f32x4*)(rs_ + REC_ARR + 4); \
                    Rka[slot][0] = *(const LAS f32x4*)(rs_ + 2 * REC_ARR); Rka[slot][1] = *(const LAS f32x4*)(rs_ + 2 * REC_ARR + 4); Rkm[slot][0] = *(const LAS f32x4*)(rs_ + 3 * REC_ARR); Rkm[slot][1] = *(const LAS f32x4*)(rs_ + 3 * REC_ARR + 4); \
                    Rr[slot][0] = *(const LAS f32x4*)(rs_ + 4 * REC_ARR); Rr[slot][1] = *(const LAS f32x4*)(rs_ + 4 * REC_ARR + 4); Rv[slot] = vvp[(s) * 32]; } while (0)
                LOADREC(0, 0);
                float yp = 0.f, yk0 = 0.f, yk1 = 0.f, yk2 = 0.f, yk3 = 0.f;
#define YSHIFT(YK) do { YK = __int_as_float(__builtin_amdgcn_update_dpp(__float_as_int(yp), __float_as_int(YK), 0x111, 0xf, 0xf, false)); YK = first ? yp : YK; } while (0)
#pragma unroll
                for (int s = 0; s < 32; ++s) {
                    const int c = s & 1;
                    if (s + 1 < 32) LOADREC((s + 1) & 1, s + 1);
                    asm volatile("" ::: "memory");
                    const float si = __int_as_float(__builtin_amdgcn_readlane(__float_as_int(inv2), s));
                    f32x2 px = pkmul(P01, Rkk[c][0].xy); px = pkfma(P23, Rkk[c][0].zw, px); px = pkfma(P45, Rkk[c][1].xy, px); px = pkfma(P67, Rkk[c][1].zw, px);
                    float x = px.x + px.y;
                    f32x2 vv2; vv2.x = Rv[c]; asm volatile("" : "+v"(vv2));
                    x = dpp_add<0xB1>(x); yp = dpp_add<0xB1>(yp);
                    const f32x2 t01 = pkmul_bl(vv2, Rkm[c][0].xy), t23 = pkmul_bl(vv2, Rkm[c][0].zw);
                    x = dpp_add<0x4E>(x); yp = dpp_add<0x4E>(yp);
                    const f32x2 t45 = pkmul_bl(vv2, Rkm[c][1].xy), t67 = pkmul_bl(vv2, Rkm[c][1].zw);
                    x = dpp_add<0x141>(x); yp = dpp_add<0x141>(yp);
                    P01 = pkfma(P01, Rw[c][0].xy, t01); P23 = pkfma(P23, Rw[c][0].zw, t23); P45 = pkfma(P45, Rw[c][1].xy, t45); P67 = pkfma(P67, Rw[c][1].zw, t67);
                    if (s >= 1) { if (s - 1 < 8) YSHIFT(yk0); else if (s - 1 < 16) YSHIFT(yk1); else if (s - 1 < 24) YSHIFT(yk2); else YSHIFT(yk3); }
                    x = x * si;
                    f32x2 x2; x2.x = x; asm volatile("" : "+v"(x2));
                    P01 = pknfma_bl(x2, Rka[c][0].xy, P01); P23 = pknfma_bl(x2, Rka[c][0].zw, P23); P45 = pknfma_bl(x2, Rka[c][1].xy, P45); P67 = pknfma_bl(x2, Rka[c][1].zw, P67);
                    f32x2 py = pkmul(P01, Rr[c][0].xy); py = pkfma(P23, Rr[c][0].zw, py); py = pkfma(P45, Rr[c][1].xy, py); py = pkfma(P67, Rr[c][1].zw, py);
                    yp = py.x + py.y;
                }
                yp = dpp_add<0xB1>(yp); yp = dpp_add<0x4E>(yp); yp = dpp_add<0x141>(yp); YSHIFT(yk3);
                yyp[(7 - j) * 32] = yk0; yyp[(15 - j) * 32] = yk1; yyp[(23 - j) * 32] = yk2; yyp[(31 - j) * 32] = yk3;
#undef LOADREC
#undef YSHIFT
            }
            SCAN_BAR;
        }
        if (pass == 0) { *(f32x4*)stp = (f32x4){P01.x, P01.y, P23.x, P23.y}; *(f32x4*)(stp + 4) = (f32x4){P45.x, P45.y, P67.x, P67.y}; }
    } else {
        const int pw = wave - 4, tt = pw >> 1, kh = pw & 1;
        bf16x8 aWc[2][2], aAc[2][2];
#pragma unroll
        for (int kt = 0; kt < 2; ++kt)
#pragma unroll
            for (int ks = 0; ks < 2; ++ks) { const size_t o = (size_t)(colg + 32 * kh + 16 * kt + fr) * 64 + 32 * ks + 8 * fq; aWc[kt][ks] = *(const bf16x8*)((const bf16_t*)(WSP + WS_W2T) + o); aAc[kt][ks] = *(const bf16x8*)((const bf16_t*)(WSP + WS_A2T) + o); }
        bf16x8 lwf[2][2], laf[2][2]; u32x2 r2[2][2], k2[2][2];
#define ISSUE(SET, tbx) do { const size_t tok_ = rowb + (tbx) * 32 + 16 * tt + fr; \
            _Pragma("unroll") for (int ks = 0; ks < 2; ++ks) { lwf[SET][ks] = *(const bf16x8*)(LWb + tok_ * 64 + 32 * ks + 8 * fq); laf[SET][ks] = *(const bf16x8*)(LAb + tok_ * 64 + 32 * ks + 8 * fq); } \
            _Pragma("unroll") for (int kt = 0; kt < 2; ++kt) { r2[SET][kt] = *(const u32x2*)(Rb + tok_ * 2048 + colg + 32 * kh + 16 * kt + 4 * fq); k2[SET][kt] = *(const u32x2*)(Kb + tok_ * 2048 + colg + 32 * kh + 16 * kt + 4 * fq); } } while (0)
        ISSUE(0, 0); ISSUE(1, 1);
        const int t = lane >> 1, hf = lane & 1;
        const size_t vgo = (size_t)colg + 32 * rh + 16 * hf;
        u32x4 v8a = (u32x4){0u, 0u, 0u, 0u}, v8b = v8a, g8a = v8a, g8b = v8a;
        if (pw == 2) { const size_t eo = (rowb + t) * 2048 + vgo; v8a = *(const u32x4*)(Vb + eo); v8b = *(const u32x4*)(Vb + eo + 8); g8a = *(const u32x4*)(Gb + eo); g8b = *(const u32x4*)(Gb + eo + 8); }
        unsigned long long gx[2] = {0ull, 0ull};
#define PROD_ITER(it, PS) do { \
            { const int tb = (it) + 1; \
              if (tb < 64) { \
                LAS float* rec = REC + (tb & 1) * REC_BUF + (16 * tt + fr) * RSTR + 32 * kh + 4 * fq; \
                float ss = 0.f, rkp = 0.f; \
                _Pragma("unroll") for (int kt = 0; kt < 2; ++kt) { \
                    f32x4 accW = (f32x4){0.f, 0.f, 0.f, 0.f}, accA = (f32x4){0.f, 0.f, 0.f, 0.f}; \
                    _Pragma("unroll") for (int ks = 0; ks < 2; ++ks) { accW = MFMA16(aWc[kt][ks], lwf[PS][ks], accW); accA = MFMA16(aAc[kt][ks], laf[PS][ks], accA); } \
                    const int kc = 32 * kh + 16 * kt + 4 * fq; \
                    const f32x4 w0v = *(const LAS f32x4*)(CST + kc), a0v = *(const LAS f32x4*)(CST + 64 + kc), kkc = *(const LAS f32x4*)(CST + 128 + kc), kac = *(const LAS f32x4*)(CST + 192 + kc), rkc = *(const LAS f32x4*)(CST + 256 + kc); \
                    const f32x4 r4 = bf4(r2[PS][kt]), k4 = bf4(k2[PS][kt]); \
                    f32x4 w4, a4; \
                    _Pragma("unroll") for (int e = 0; e < 4; ++e) { w4[e] = __expf(-0.60653066f * sigmf(accW[e] + w0v[e])); a4[e] = sigmf(accA[e] + a0v[e]); } \
                    const f32x4 kkr = k4 * kkc; ss += (kkr.x * kkr.x + kkr.y * kkr.y) + (kkr.z * kkr.z + kkr.w * kkr.w); \
                    const f32x4 km = k4 * (1.0f + (a4 - 1.0f) * kac); const f32x4 rr = r4 * km * rkc; rkp += (rr.x + rr.y) + (rr.z + rr.w); \
                    *(LAS f32x4*)(rec + 16 * kt) = kkr; *(LAS f32x4*)(rec + REC_ARR + 16 * kt) = w4; *(LAS f32x4*)(rec + 2 * REC_ARR + 16 * kt) = kkr * a4; *(LAS f32x4*)(rec + 3 * REC_ARR + 16 * kt) = km; *(LAS f32x4*)(rec + 4 * REC_ARR + 16 * kt) = r4; \
                } \
                if (tb + 2 < 64) ISSUE(PS, tb + 2); \
                ss += __shfl_xor(ss, 16); ss += __shfl_xor(ss, 32); rkp += __shfl_xor(rkp, 16); rkp += __shfl_xor(rkp, 32); \
                if (fq == 0) { SSP[(tb & 1) * 64 + 2 * (16 * tt + fr) + kh] = ss; RKP[(tb & 3) * 64 + 2 * (16 * tt + fr) + kh] = rkp; } \
              } \
              if (pw == 2 && tb < 64) { \
                LAS float* vp = VV + (tb & 3) * 1024 + t * 32 + 16 * hf; LAS float* gp = GG + (tb & 3) * 1024 + t * 32 + 16 * hf; \
                *(LAS f32x4*)(vp) = bf4((u32x2){v8a.x, v8a.y}); *(LAS f32x4*)(vp + 4) = bf4((u32x2){v8a.z, v8a.w}); *(LAS f32x4*)(vp + 8) = bf4((u32x2){v8b.x, v8b.y}); *(LAS f32x4*)(vp + 12) = bf4((u32x2){v8b.z, v8b.w}); \
                *(LAS f32x4*)(gp) = bf4((u32x2){g8a.x, g8a.y}); *(LAS f32x4*)(gp + 4) = bf4((u32x2){g8a.z, g8a.w}); *(LAS f32x4*)(gp + 8) = bf4((u32x2){g8b.x, g8b.y}); *(LAS f32x4*)(gp + 12) = bf4((u32x2){g8b.z, g8b.w}); \
                if (tb + 1 < 64) { const size_t eo = (rowb + (tb + 1) * 32 + t) * 2048 + vgo; v8a = *(const u32x4*)(Vb + eo); v8b = *(const u32x4*)(Vb + eo + 8); g8a = *(const u32x4*)(Gb + eo); g8b = *(const u32x4*)(Gb + eo + 8); } \
              } \
            } \
            if (pw == 3) { \
              if ((it) >= 2 && (it) <= 65) { const int tb = (it) - 2; const unsigned long long* g = GR + ((size_t)(pi * 8 + (tb & 7)) * 2) * 64 + lane; \
                gx[0] = __hip_atomic_load(g, __ATOMIC_RELAXED, __HIP_MEMORY_SCOPE_AGENT); gx[1] = __hip_atomic_load(g + 64, __ATOMIC_RELAXED, __HIP_MEMORY_SCOPE_AGENT); } \
              if ((it) >= 1 && (it) <= 64) { const int tb = (it) - 1; const LAS float* yp_ = YY + (tb & 3) * 1024 + t * 32 + 16 * hf; float s1 = 0.f, s2 = 0.f; \
                _Pragma("unroll") for (int qd = 0; qd < 4; ++qd) { const f32x4 a = *(const LAS f32x4*)(yp_ + 4 * qd); s1 += (a.x + a.y) + (a.z + a.w); s2 += (a.x * a.x + a.y * a.y) + (a.z * a.z + a.w * a.w); } \
                s1 = dpp_add<0xB1>(s1); s2 = dpp_add<0xB1>(s2); \
                const unsigned epoch = (unsigned)(pass * 64 + tb + 1); \
                __hip_atomic_store(GR + ((size_t)((pi * 8 + (tb & 7)) * 2 + rh) * 64 + hf * 32 + t), ((unsigned long long)epoch << 32) | (unsigned long long)__float_as_uint(hf ? s2 : s1), __ATOMIC_RELAXED, __HIP_MEMORY_SCOPE_AGENT); } \
              if ((it) >= 2 && (it) <= 65) { const int tb = (it) - 2; const unsigned epoch = (unsigned)(pass * 64 + tb + 1); \
                const unsigned long long* g = GR + ((size_t)(pi * 8 + (tb & 7)) * 2) * 64 + lane; float tot; \
                for (unsigned spins = 0;; ++spins) { const bool ok = ((unsigned)(gx[0] >> 32) == epoch) && ((unsigned)(gx[1] >> 32) == epoch); tot = __uint_as_float((unsigned)gx[0]) + __uint_as_float((unsigned)gx[1]); \
                    if (__all(ok) || spins > (1u << 22)) break; \
                    __builtin_amdgcn_s_sleep(1); \
                    gx[0] = __hip_atomic_load(g, __ATOMIC_RELAXED, __HIP_MEMORY_SCOPE_AGENT); gx[1] = __hip_atomic_load(g + 64, __ATOMIC_RELAXED, __HIP_MEMORY_SCOPE_AGENT); } \
                const float oth = __shfl_xor(tot, 32); \
                const float mean = (lane < 32 ? tot : oth) * (1.0f / 64.0f), ex2 = (lane < 32 ? oth : tot) * (1.0f / 64.0f); \
                const float rstd = rsqrtf(fmaxf(ex2 - mean * mean, 0.f) + 64e-5f); \
                if (lane < 32) { STT[2 * lane] = mean; STT[2 * lane + 1] = rstd; } \
                const float mu = STT[2 * t], rsd = STT[2 * t + 1]; \
                const int ro = (tb & 3) * 1024 + t * 32 + 16 * hf; const float rk = RKP[(tb & 3) * 64 + 2 * t] + RKP[(tb & 3) * 64 + 2 * t + 1]; \
                unsigned ow[8]; \
                _Pragma("unroll") for (int qd = 0; qd < 4; ++qd) { const f32x4 lg = *(const LAS f32x4*)(CST + 320 + 32 * rh + 16 * hf + 4 * qd), lb = *(const LAS f32x4*)(CST + 384 + 32 * rh + 16 * hf + 4 * qd); \
                    const f32x4 o = ((*(const LAS f32x4*)(YY + ro + 4 * qd) - mu) * rsd * lg + lb + rk * *(const LAS f32x4*)(VV + ro + 4 * qd)) * *(const LAS f32x4*)(GG + ro + 4 * qd); \
                    ow[2 * qd] = pk2(o.x, o.y); ow[2 * qd + 1] = pk2(o.z, o.w); } \
                bf16_t* dst = (bf16_t*)(WSP + WS_A2) + ((size_t)pass * PROWS + rowb + tb * 32 + t) * 2048 + vgo; \
                *(u32x4*)(dst) = (u32x4){ow[0], ow[1], ow[2], ow[3]}; *(u32x4*)(dst + 8) = (u32x4){ow[4], ow[5], ow[6], ow[7]}; } \
            } \
            SCAN_BAR; } while (0)
        for (int it2 = -1; it2 < 65; it2 += 2) { PROD_ITER(it2, 0); PROD_ITER(it2 + 1, 1); }
        PROD_ITER(65, 0);
#undef PROD_ITER
#undef ISSUE
    }
}
__device__ __forceinline__ void p10_final(const Params& p, int G, int bid) {
    OPQ_TID; const int gw = bid * 8 + wave, ngw = G * 8;
    for (int m = gw; m < T; m += ngw) { float* xr = ((float*)p.out) + (size_t)m * D; f32x4 v[4]; float s = 0.f;
#pragma unroll
        for (int j = 0; j < 4; ++j) { v[j] = *((const f32x4*)xr + lane + 64 * j); s += (v[j].x * v[j].x + v[j].y * v[j].y) + (v[j].z * v[j].z + v[j].w * v[j].w); }
        const float rs = rsqrtf(wave_sum(s) * (1.0f / 1024.0f) + 1e-6f);
#pragma unroll
        for (int j = 0; j < 4; ++j) { const f32x4 gg = *((const f32x4*)((const float*)p.in[I_FG]) + lane + 64 * j); *((f32x4*)xr + lane + 64 * j) = v[j] * rs * gg; } }
}

#define XB_TMO      128
#define XB_XCNT(j)  (256  + 64 * (j))
#define XB_XSUB(j)  (1280 + 64 * (j))
#define XB_XGEN(j)  (2304 + 64 * (j))
#define XB_TOP      3328
#define XB_TOPGEN   3392
#define XCD_BAR_WORDS 3456
#define XB_SPIN_CAP (1u << 18)

__device__ __forceinline__ unsigned xb_ld(unsigned* p)              { return __hip_atomic_load(p, __ATOMIC_RELAXED, __HIP_MEMORY_SCOPE_AGENT); }
__device__ __forceinline__ unsigned xb_add(unsigned* p, unsigned v) { return __hip_atomic_fetch_add(p, v, __ATOMIC_RELAXED, __HIP_MEMORY_SCOPE_AGENT); }
__device__ __forceinline__ unsigned xb_xcc_id() { return (unsigned)__builtin_amdgcn_s_getreg((3 << 11) | 20) & 0xFu; }
#define XB_SPIN(cond, bar) do { unsigned _sp = 0; while (cond) { __builtin_amdgcn_s_sleep(1); \
    if ((++_sp & 255u) == 0u) { if (xb_ld(&(bar)[XB_TMO])) break; if (_sp > XB_SPIN_CAP) { atomicAdd(&(bar)[XB_TMO], 1u); break; } } } } while (0)

struct XcdBarrier {
    unsigned* bar; unsigned x;
    volatile LAS unsigned* st;
};

__device__ __forceinline__ XcdBarrier xcd_barrier_post(unsigned* bar, volatile LAS unsigned* st) {
    XcdBarrier b; b.bar = bar; b.x = xb_xcc_id(); b.st = st;
    if (threadIdx.x == 0) (void)xb_add(&bar[XB_XCNT(b.x)], 1u);
    return b;
}
__device__ __forceinline__ void xcd_barrier_complete(unsigned* bar, unsigned x, unsigned& nloc, unsigned& nx) {
    const unsigned G = gridDim.x * gridDim.y * gridDim.z;
    unsigned sum, cnt, mine, sp = 0u;
    for (;;) {
        sum = 0u; cnt = 0u; mine = 0u;
#pragma unroll
        for (unsigned j = 0; j < 16; ++j) { const unsigned c = xb_ld(&bar[XB_XCNT(j)]); sum += c; cnt += (c > 0u) ? 1u : 0u; mine = (j == x) ? c : mine; }
        if (sum == G) break;
        __builtin_amdgcn_s_sleep(1);
        if ((++sp & 255u) == 0u) { if (xb_ld(&bar[XB_TMO])) break; if (sp > XB_SPIN_CAP) { atomicAdd(&bar[XB_TMO], 1u); break; } }
    }
    nloc = mine > 0u ? mine : 1u; nx = cnt > 0u ? cnt : 1u;
}

__device__ __forceinline__ void xcd_barrier(const XcdBarrier& b) {
    asm volatile("s_waitcnt vmcnt(0)" ::: "memory");
    __syncthreads();
    if (threadIdx.x == 0) {
        unsigned* bar = (unsigned*)(*(volatile LAS unsigned long long*)(b.st + 4)); const unsigned bx_ = xb_xcc_id();
        __builtin_amdgcn_s_waitcnt(0);
        unsigned nloc = b.st[0], nx = b.st[1];
        if (nloc == 0u) { xcd_barrier_complete(bar, bx_, nloc, nx); b.st[0] = nloc; b.st[1] = nx; }
        const unsigned old = xb_add(&bar[XB_XSUB(bx_)], 1u);
        const unsigned gen = old / nloc;
        if (old + 1u == (gen + 1u) * nloc) {
            __builtin_amdgcn_fence(__ATOMIC_RELEASE, "agent");
            asm volatile("s_waitcnt vmcnt(0)" ::: "memory");
            const unsigned og = xb_add(&bar[XB_TOP], 1u);
            const unsigned tg = og / nx;
            if (og + 1u == (tg + 1u) * nx) xb_add(&bar[XB_TOPGEN], 1u);
            else XB_SPIN(xb_ld(&bar[XB_TOPGEN]) == tg, bar);
            __builtin_amdgcn_fence(__ATOMIC_ACQUIRE, "agent");
            xb_add(&bar[XB_XGEN(bx_)], 1u);
            asm volatile("s_waitcnt vmcnt(0)" ::: "memory");
        } else {
            XB_SPIN(xb_ld(&bar[XB_XGEN(bx_)]) == gen, bar);
            __builtin_amdgcn_fence(__ATOMIC_ACQUIRE, "agent");
            asm volatile("s_waitcnt vmcnt(0)" ::: "memory");
        }
    }
    __syncthreads();
}

__global__ void __launch_bounds__(NT, 2) mk_fwd(Params p) {
    auto wsl = [&]() { return launder_ws(((unsigned char*)p.ws)); };
    extern __shared__ __attribute__((aligned(16))) unsigned char lds_raw[];
    LAS unsigned char* lds = (LAS unsigned char*)lds_raw;
    cg::grid_group grid = cg::this_grid();
    const int G = gridDim.x, bid = blockIdx.x;
    if (threadIdx.x < 16) ((LAS unsigned*)(lds + LDS_MISC))[threadIdx.x] = 0u;
    __syncthreads();
    if (threadIdx.x == 0) *(LAS unsigned long long*)(lds + LDS_MISC + 16) = (unsigned long long)(((unsigned char*)p.ws) + WS_BAR);
    __syncthreads();
    (void)xcd_barrier_post((unsigned*)(((unsigned char*)p.ws) + WS_BAR), (volatile LAS unsigned*)(lds + LDS_MISC));
#define XBAR() do { XcdBarrier xb_; xb_.bar = nullptr; xb_.x = 0u; xb_.st = (volatile LAS unsigned*)(lds + LDS_MISC); xcd_barrier(xb_); } while (0)
#if PROBE == 7
    p0_prologue(p, lds, G, bid);
#endif
    p0_prologue(p, lds, G, bid);
    grid.sync();
    { pg8::Gemm g{(const bf16_t*)((float*)p.out), (const bf16_t*)(wsl() + WS_WIN), T, ZW, D, D}; pg8::StaticOrder S; S.init(T, ZW, G, bid); pg8::EpiBf16 E{(bf16_t*)(wsl() + WS_Z), ZW};
      pg8::gemm_phase<pg8::EpiBf16, pg8::StaticOrder, true, true>(lds, g, S, E); }
    XBAR();
#if PROBE == 3
    { u32x4 pre[3]; if (bid < 2048) rg_a_prefetch((const bf16_t*)(wsl() + WS_Z), bid, threadIdx.x, pre); for (int u = bid; u < 2048; u += G) rg_a_unit(p, lds, u, u + G, pre); }
    { u32x4 pre[6]; if (bid < 2048) hg_a_prefetch((const bf16_t*)(wsl() + WS_Z), bid, threadIdx.x, pre); for (int u = bid; u < 2048; u += G) hg_a_unit(p, lds, u, u + G, pre); }
    XBAR();
#endif
    { u32x4 pre[3]; if (bid < 2048) rg_a_prefetch((const bf16_t*)(wsl() + WS_Z), bid, threadIdx.x, pre); for (int u = bid; u < 2048; u += G) rg_a_unit(p, lds, u, u + G, pre); }
    { u32x4 pre[6]; if (bid < 2048) hg_a_prefetch((const bf16_t*)(wsl() + WS_Z), bid, threadIdx.x, pre); for (int u = bid; u < 2048; u += G) hg_a_unit(p, lds, u, u + G, pre); }
    XBAR();
#if PROBE == 2
    for (int u = bid; u < 256; u += G) hg_b_item(p, lds, u, p.dry != 0);
    XBAR();
#endif
#if PROBE == 6
    for (int u = bid; u < 512; u += G) rg_b_unit(p, u);
    XBAR();
#endif
#if PROBE == 4
    for (int q = 0; q < 16; ++q) XBAR();
#endif
    for (int u = bid; u < 256; u += G) { const int it_ = (G == 256) ? ((((u & 7) + 8 * (u >> 6)) << 3) | ((u >> 3) & 7)) : u; hg_b_item(p, lds, it_); }
    for (int u = bid; u < 512; u += G) rg_b_unit(p, u);
    XBAR();
#if PROBE == 8
    p4_finalize(p, G, bid);
#endif
    p4_finalize(p, G, bid);
    XBAR();
    { pg8::Gemm g{(const bf16_t*)(wsl() + WS_Z), (const bf16_t*)(wsl() + WS_WOUT), T, D, 2048, ZW}; pg8::StaticOrder S; S.init(T, D, G, bid); pg8::EpiResF32 E{((const float*)p.in[I_X]), ((float*)p.out), D, 0, 0};
      pg8::gemm_phase<pg8::EpiResF32, pg8::StaticOrder, true, true>(lds, g, S, E); }
    XBAR();
#if PROBE == 9
    p6_prologue(p, lds, G, bid);
#endif
    p6_prologue(p, lds, G, bid);
    XBAR();
#pragma unroll 1
    for (int pass = 0; pass < 2; ++pass) {
        { const int N = pass ? 8192 : 8448; pg8::Gemm g{(const bf16_t*)(wsl() + WS_A2) + (size_t)pass * 8192 * 2048, (const bf16_t*)(wsl() + WS_WC), 8192, N, 2048, 2048}; pg8::LoraOrder S; S.init(8192, N, G, bid, pass ? 0 : 32);
          pg8::EpiL1 E{(bf16_t*)(wsl() + WS_R), (bf16_t*)(wsl() + WS_LW) + (size_t)pass * 8192 * 64, (bf16_t*)(wsl() + WS_LA) + (size_t)pass * 8192 * 64};
          pg8::gemm_phase<pg8::EpiL1, pg8::LoraOrder, true, true>(lds, g, S, E); }
        XBAR();
        for (int u0 = 0; u0 < 256; u0 += G) { const int u = u0 + bid; if (u < 256) { int pi, rh; if (G == 256) { pi = (u & 7) + 8 * (u >> 4); rh = (u >> 3) & 1; } else { pi = u >> 1; rh = u & 1; } scan_half(p, lds, pi, rh, pass); } }
        XBAR();
    }
    if (G == 256) {
        pg8::Gemm g{(const bf16_t*)(wsl() + WS_A2), (const bf16_t*)(wsl() + WS_WO), T, D, 2048, 2048}; pg8::StaticOrder S; S.init(T, D, G, bid); pg8::EpiFinalNorm E{((float*)p.out), ((const float*)p.in[I_FG]), (unsigned long long*)(wsl() + WS_XG), D};
        pg8::gemm_phase<pg8::EpiFinalNorm, pg8::StaticOrder, false, true>(lds, g, S, E);
    } else {
        { pg8::Gemm g{(const bf16_t*)(wsl() + WS_A2), (const bf16_t*)(wsl() + WS_WO), T, D, 2048, 2048}; pg8::StaticOrder S; S.init(T, D, G, bid); pg8::EpiResF32 E{((float*)p.out), ((float*)p.out), D, 1, 0};
          pg8::gemm_phase<pg8::EpiResF32, pg8::StaticOrder, true, true>(lds, g, S, E); }
        XBAR();
        p10_final(p, G, bid);
    }
}

extern "C" void kernel_launch(void* const* d_in, const int* in_sizes, int n_in, void* d_out, int out_size, void* d_ws, size_t ws_size, hipStream_t stream) {
    static int grid = 0;
    if (grid == 0) {
        int dev = 0, cus = 0, per_cu = 0;
        if (n_in != 32 || out_size != T * D || ws_size < 256 * MiB) { fprintf(stderr, "kernel_launch: unexpected shapes (n_in %d out %d ws %zu)\n", n_in, out_size, ws_size); grid = -1; return; }
        if (hipGetDevice(&dev) != hipSuccess || hipDeviceGetAttribute(&cus, hipDeviceAttributeMultiprocessorCount, dev) != hipSuccess) { grid = -1; return; }
        if (hipFuncSetAttribute((const void*)mk_fwd, hipFuncAttributeMaxDynamicSharedMemorySize, LDS_BYTES) != hipSuccess) { fprintf(stderr, "hipFuncSetAttribute failed\n"); grid = -1; return; }
        if (hipOccupancyMaxActiveBlocksPerMultiprocessor(&per_cu, (const void*)mk_fwd, NT, LDS_BYTES) != hipSuccess || per_cu < 1) fprintf(stderr, "occupancy query: %d\n", per_cu);
        (void)hipGetLastError();
        grid = cus;
    }
    if (grid < 0) return;
    if (hipMemsetAsync((char*)d_ws + WS_BAR, 0, 16384, stream) != hipSuccess) { fprintf(stderr, "memset failed\n"); return; }
    Params p{};
    p.dry = 1;
    for (int i = 0; i < 32; ++i) memcpy(&p.in[i], &d_in[i], sizeof(void*));
    memcpy(&p.out, &d_out, sizeof(void*)); memcpy(&p.ws, &d_ws, sizeof(void*));
    void* args[] = {&p};
    hipError_t e = hipLaunchCooperativeKernel((const void*)mk_fwd, dim3(grid), dim3(NT), args, LDS_BYTES, stream);
    if (e != hipSuccess) fprintf(stderr, "cooperative launch failed: %s (grid %d)\n", hipGetErrorString(e), grid);
}
```

```cpp
#define PROBE 0
#include <hip/hip_runtime.h>
#include <hip/hip_cooperative_groups.h>
#include <cstdio>
#include <cstring>
#include <cstdint>
namespace cg = cooperative_groups;
namespace pg8 {
#define PG8_LAS __attribute__((address_space(3)))
typedef unsigned short bf16_t;
typedef short bf16x8 __attribute__((ext_vector_type(8)));
typedef float f32x4 __attribute__((ext_vector_type(4)));
typedef unsigned u32x4 __attribute__((ext_vector_type(4)));
constexpr int BM = 256, BK = 64, HALF = 128, HTB = HALF * BK * 2  , STAGE_BYTES = 8 * HTB, NXCD = 8, WGM = 8;

__host__ __device__ __forceinline__ int lds_byte(int r, int c) { const int st = (r >> 4) * 2 + (c >> 5), rr = r & 15, cc = c & 31, ob = rr * 64 + cc * 2; return st * 1024 + (ob ^ (((ob >> 9) & 1) << 5)); }
__host__ __device__ __forceinline__ void stage_rc(int b, int& R, int& C) { const int st = b / 1024, sb = b % 1024, swz = sb ^ (((sb >> 9) & 1) << 5); R = (st >> 1) * 16 + swz / 64; C = (st & 1) * 32 + (swz % 64) / 2; }
__host__ __device__ __forceinline__ int perm32(int rho) { const int n = rho >> 4, i = rho & 15; return 8 * (i >> 2) + 4 * n + (i & 3); }

struct Unit { int pm, pn; };
struct Gemm { const bf16_t* A; const bf16_t* Bt; int M, N, K, lda; };

struct StaticOrder {
    int nM, nN, nwg, G, c;
    __host__ __device__ void init(int M, int N, int G_, int c_) { nM = M / BM; nN = N / BM; nwg = nM * nN; G = G_; c = c_; }
    __host__ __device__ bool next(int i, Unit& u) const {
        const long L = (long)i * G + c; if (L >= nwg) return false;
        int wgid = (int)L; { const int q = nwg / NXCD, r = nwg % NXCD, xcd = wgid % NXCD, off = wgid / NXCD; wgid = (xcd < r ? xcd * (q + 1) : r * (q + 1) + (xcd - r) * q) + off; }
        const int nig = WGM * nN, gid = wgid / nig, fm = gid * WGM, gsz = (nM - fm) < WGM ? (nM - fm) : WGM;
        u.pm = fm + ((wgid % nig) % gsz); u.pn = (wgid % nig) / gsz; return true;
    }
    __device__ __forceinline__ void a_ready(const Unit&) const {}
    __device__ __forceinline__ void done(const Unit&) const {}
};


struct LoraOrder {
    StaticOrder so; int extra;
    __host__ __device__ void init(int M, int N, int G_, int c_, int extra_) { so.init(M, N, G_, c_); extra = extra_; }
    __host__ __device__ bool next(int i, Unit& u) const { const long L = (long)i * so.G + so.c; if (L < so.nwg) return so.next(i, u); if (L >= so.nwg + extra) return false; u.pm = so.nM + (int)(L - so.nwg); u.pn = so.nN - 1; return true; }
    __device__ __forceinline__ void a_ready(const Unit&) const {}
    __device__ __forceinline__ void done(const Unit&) const {}
};
__device__ __forceinline__ unsigned cvt_pk_bf16(float lo, float hi) { unsigned r; asm volatile("v_cvt_pk_bf16_f32 %0, %1, %2" : "=v"(r) : "v"(lo), "v"(hi)); return r; }
__device__ __forceinline__ float sigm(float x) { return __builtin_amdgcn_rcpf(1.0f + __expf(-x)); }
struct EpiBf16 {
    static constexpr bool PERM = true, AFTER_DRAIN = false;
    bf16_t* O; int ldc;
    __device__ __forceinline__ void operator()(const f32x4 (&acc)[2][2][4][2], const Unit& u, int wr, int wc, int fr, int fq) const {
        const int row0 = u.pm * BM + wr * 64 + fr; const int col0 = u.pn * BM + wc * 32 + 8 * fq;
#pragma unroll
        for (int ai = 0; ai < 2; ++ai)
#pragma unroll
            for (int m = 0; m < 4; ++m) { bf16_t* rowp = O + (size_t)(row0 + ai * HALF + m * 16) * ldc + col0;
#pragma unroll
                for (int bj = 0; bj < 2; ++bj) { const f32x4 v0 = acc[ai][bj][m][0], v1 = acc[ai][bj][m][1];
                    u32x4 w; w.x = cvt_pk_bf16(v0[0], v0[1]); w.y = cvt_pk_bf16(v0[2], v0[3]); w.z = cvt_pk_bf16(v1[0], v1[1]); w.w = cvt_pk_bf16(v1[2], v1[3]);
                    *(u32x4*)(rowp + bj * HALF) = w; } }
    }
};
struct EpiResF32 {
    static constexpr bool PERM = false, AFTER_DRAIN = false;
    const float* base; float* out; int ldc; int remap; int pass;
    __device__ __forceinline__ void operator()(const f32x4 (&acc)[2][2][4][2], const Unit& u, int wr, int wc, int fr, int fq) const {
        const int col0 = u.pn * BM + wc * 32 + 4 * fq; const int rbase = remap ? ((((u.pm >> 3) & 3) << 12) + (u.pm >> 5) * 2048 + (u.pm & 7) * BM) : u.pm * BM;
#pragma unroll
        for (int ai = 0; ai < 2; ++ai)
#pragma unroll
            for (int m = 0; m < 4; ++m) { const size_t off = (size_t)(rbase + ai * HALF + wr * 64 + m * 16 + fr) * ldc + col0;
#pragma unroll
                for (int bj = 0; bj < 2; ++bj)
#pragma unroll
                    for (int n = 0; n < 2; ++n) { const f32x4 bs = *(const f32x4*)(base + off + bj * HALF + n * 16); *(f32x4*)(out + off + bj * HALF + n * 16) = bs + acc[ai][bj][m][n]; } }
    }
};
struct EpiL1 {
    static constexpr bool PERM = true, AFTER_DRAIN = false;
    bf16_t* R; bf16_t* LW; bf16_t* LA;
    __device__ __forceinline__ void operator()(const f32x4 (&acc)[2][2][4][2], const Unit& u, int wr, int wc, int fr, int fq) const {
        const int row0 = u.pm * BM + wr * 64 + fr;
        if (u.pn < 32) {
            const int buf = u.pn >> 3; bf16_t* base = R + (size_t)buf * (8192u * 2048u); const int col0 = (u.pn & 7) * BM + wc * 32 + 8 * fq;
#pragma unroll
            for (int ai = 0; ai < 2; ++ai)
#pragma unroll
                for (int m = 0; m < 4; ++m) { bf16_t* rowp = base + (size_t)(row0 + ai * HALF + m * 16) * 2048 + col0;
#pragma unroll
                    for (int bj = 0; bj < 2; ++bj) { f32x4 v0 = acc[ai][bj][m][0], v1 = acc[ai][bj][m][1];
                        if (buf == 3) {
#pragma unroll
                            for (int q = 0; q < 4; ++q) { v0[q] = v0[q] * sigm(v0[q]); v1[q] = v1[q] * sigm(v1[q]); } }
                        u32x4 w; w.x = cvt_pk_bf16(v0[0], v0[1]); w.y = cvt_pk_bf16(v0[2], v0[3]); w.z = cvt_pk_bf16(v1[0], v1[1]); w.w = cvt_pk_bf16(v1[2], v1[3]);
                        *(u32x4*)(rowp + bj * HALF) = w; } }
        } else {
            const int c0 = wc * 32 + 8 * fq;
#pragma unroll
            for (int ai = 0; ai < 2; ++ai)
#pragma unroll
                for (int m = 0; m < 4; ++m) { const size_t row = (size_t)(row0 + ai * HALF + m * 16); f32x4 v0 = acc[ai][0][m][0], v1 = acc[ai][0][m][1];
                    if (c0 < 64) {
#pragma unroll
                        for (int q = 0; q < 4; ++q) { v0[q] = tanhf(v0[q]); v1[q] = tanhf(v1[q]); } }
                    u32x4 w; w.x = cvt_pk_bf16(v0[0], v0[1]); w.y = cvt_pk_bf16(v0[2], v0[3]); w.z = cvt_pk_bf16(v1[0], v1[1]); w.w = cvt_pk_bf16(v1[2], v1[3]);
                    if (c0 < 64) *(u32x4*)(LW + row * 64 + c0) = w; else *(u32x4*)(LA + row * 64 + c0 - 64) = w; }
        }
    }
};

struct EpiFinalNorm {
    static constexpr bool PERM = false, AFTER_DRAIN = true;
    float* out; const float* g; unsigned long long* xg; int ldc;
    __device__ __forceinline__ void fused(f32x4 (&acc)[2][2][4][2], const Unit& u, int wr, int wc, int fr, int fq, PG8_LAS unsigned char* lds, int wid, int lane) const {
        PG8_LAS float* P = (PG8_LAS float*)lds; PG8_LAS float* S = (PG8_LAS float*)(lds + 4096);
        const int col0 = u.pn * BM + wc * 32 + 4 * fq; const int rbase = (((u.pm >> 3) & 3) << 12) + (u.pm >> 5) * 2048 + (u.pm & 7) * BM;
#pragma unroll
        for (int ai = 0; ai < 2; ++ai)
#pragma unroll
            for (int m = 0; m < 4; ++m) { const size_t off = (size_t)(rbase + ai * HALF + wr * 64 + m * 16 + fr) * ldc + col0; float s = 0.f;
#pragma unroll
                for (int bj = 0; bj < 2; ++bj)
#pragma unroll
                    for (int n = 0; n < 2; ++n) { const f32x4 v = acc[ai][bj][m][n] + *(const f32x4*)(out + off + bj * HALF + n * 16); acc[ai][bj][m][n] = v; s += (v[0] * v[0] + v[1] * v[1]) + (v[2] * v[2] + v[3] * v[3]); }
                s += __shfl_xor(s, 16); s += __shfl_xor(s, 32);
                if (fq == 0) P[(ai * HALF + wr * 64 + m * 16 + fr) * 4 + wc] = s; }
        asm volatile("s_waitcnt lgkmcnt(0)" ::: "memory"); __builtin_amdgcn_s_barrier(); asm volatile("" ::: "memory");
        const int row = wid * 32 + (lane & 31);
        if (lane < 32) { const float tot = (P[row * 4] + P[row * 4 + 1]) + (P[row * 4 + 2] + P[row * 4 + 3]);
            __hip_atomic_store(xg + ((size_t)(u.pm * 4 + u.pn) * 256 + row), (1ull << 32) | (unsigned long long)__float_as_uint(tot), __ATOMIC_RELAXED, __HIP_MEMORY_SCOPE_AGENT); }
        {
            float tot = 0.f;
            for (unsigned spins = 0;; ++spins) { bool ok = true; tot = 0.f;
                if (lane < 32) {
#pragma unroll
                    for (int q = 0; q < 4; ++q) { const unsigned long long x = __hip_atomic_load(xg + ((size_t)(u.pm * 4 + q) * 256 + row), __ATOMIC_RELAXED, __HIP_MEMORY_SCOPE_AGENT); ok &= (unsigned)(x >> 32) == 1u; tot += __uint_as_float((unsigned)x); } }
                if (__all(ok) || spins > (1u << 22)) break;
                __builtin_amdgcn_s_sleep(1); }
            if (lane < 32) S[row] = rsqrtf(tot * (1.0f / 1024.0f) + 1e-6f);
        }
        asm volatile("s_waitcnt lgkmcnt(0)" ::: "memory"); __builtin_amdgcn_s_barrier(); asm volatile("" ::: "memory");
#pragma unroll
        for (int ai = 0; ai < 2; ++ai)
#pragma unroll
            for (int m = 0; m < 4; ++m) { const int r = ai * HALF + wr * 64 + m * 16 + fr; const float rs = S[r]; const size_t off = (size_t)(rbase + r) * ldc + col0;
#pragma unroll
                for (int bj = 0; bj < 2; ++bj)
#pragma unroll
                    for (int n = 0; n < 2; ++n) { const f32x4 gg = *(const f32x4*)(g + col0 + bj * HALF + n * 16); *(f32x4*)(out + off + bj * HALF + n * 16) = acc[ai][bj][m][n] * rs * gg; } }
    }
};
template <class Epi, class Sched, bool ALIGN_EPI = false, bool SP2 = false>
__device__ __forceinline__ void gemm_phase(PG8_LAS unsigned char* lds, const Gemm g, const Sched& S, const Epi& E) {
    int tid_o = threadIdx.x; asm volatile("" : "+v"(tid_o)); const int tid = tid_o, wid = __builtin_amdgcn_readfirstlane(tid >> 6), lane = tid & 63, wr = wid >> 2, wc = wid & 3, fr = lane & 15, fq = lane >> 4;
    const int K = g.K, nt = K / BK;
    unsigned voffA[2], voffB[2];
#pragma unroll
    for (int i = 0; i < 2; ++i) { int R, C; stage_rc(tid * 16 + i * 8192, R, C); const int Rb = Epi::PERM ? ((R & ~31) + perm32(R & 31)) : R;
        voffA[i] = (unsigned)(R * g.lda + C) * 2u; voffB[i] = (unsigned)(Rb * K + C) * 2u; }
    const size_t kstep = (size_t)(BK * 2);
    const size_t hstep = (size_t)HALF * K * 2;
    const size_t tstep = 2 * hstep; const size_t hstepA = (size_t)HALF * g.lda * 2, tstepA = 2 * hstepA;
    const unsigned ldsw = (unsigned)wid * 1024u;
    const int aoff = lds_byte(wr * 64 + fr, fq * 8), boff = lds_byte(wc * 32 + fr, fq * 8);
#define PG8_SA(b, h) (((b) * 2 + (h)) * HTB)
#define PG8_SB(b, h) ((4 + (b) * 2 + (h)) * HTB)
#define PG8_STAGE(bufoff, gbase, voff) do { _Pragma("unroll") for (int _i = 0; _i < 2; ++_i) \
        __builtin_amdgcn_global_load_lds((const unsigned*)((const char*)(gbase) + (voff)[_i]), (PG8_LAS unsigned*)(lds + (bufoff) + ldsw + _i * 8192), 16, 0, 0); } while (0)
#define PG8_LDA(dst, b, h) do { _Pragma("unroll") for (int m = 0; m < 4; ++m) _Pragma("unroll") for (int k = 0; k < 2; ++k) dst[m][k] = *(const PG8_LAS bf16x8*)(lds + PG8_SA(b, h) + aoff + m * 2048 + k * 1024); } while (0)
#define PG8_LDB(dst, b, h) do { _Pragma("unroll") for (int n = 0; n < 2; ++n) _Pragma("unroll") for (int k = 0; k < 2; ++k) dst[n][k] = *(const PG8_LAS bf16x8*)(lds + PG8_SB(b, h) + boff + n * 2048 + k * 1024); } while (0)
#define PG8_MMA(ai, bj, At, Bt) do { __builtin_amdgcn_s_setprio(1); _Pragma("unroll") for (int m = 0; m < 4; ++m) _Pragma("unroll") for (int n = 0; n < 2; ++n) _Pragma("unroll") for (int k = 0; k < 2; ++k) \
        acc[ai][bj][m][n] = __builtin_amdgcn_mfma_f32_16x16x32_bf16(Bt[n][k], At[m][k], acc[ai][bj][m][n], 0, 0, 0); __builtin_amdgcn_s_setprio(0); } while (0)
#define PG8_WAIT_V(n) asm volatile("s_waitcnt vmcnt(" #n ")" ::: "memory")
#define PG8_WAIT_L(n) asm volatile("s_waitcnt lgkmcnt(" #n ")" ::: "memory")
#define PG8_BAR __builtin_amdgcn_s_barrier()
#define PG8_SCHED __builtin_amdgcn_sched_barrier(0)
    Unit cur, nxt; int ui = 0;
    if (!S.next(0, cur)) return;
    f32x4 acc[2][2][4][2];
#pragma unroll
    for (int a = 0; a < 2; ++a)
#pragma unroll
        for (int b = 0; b < 2; ++b)
#pragma unroll
            for (int m = 0; m < 4; ++m)
#pragma unroll
                for (int n = 0; n < 2; ++n) acc[a][b][m][n] = (f32x4){0.f, 0.f, 0.f, 0.f};
    bf16x8 At[4][2], B0[2][2], B1[2][2];
    const char* cA = (const char*)g.A + (size_t)cur.pm * tstepA; const char* cB = (const char*)g.Bt + (size_t)cur.pn * tstep;
    S.a_ready(cur);
    if constexpr (SP2) {
        PG8_STAGE(PG8_SB(0, 0), cB, voffB); PG8_STAGE(PG8_SB(0, 1), cB + hstep, voffB); PG8_STAGE(PG8_SA(0, 0), cA, voffA); PG8_STAGE(PG8_SA(0, 1), cA + hstepA, voffA);
        if (wr == 1) PG8_BAR;
        PG8_WAIT_V(2); PG8_BAR;
        PG8_STAGE(PG8_SB(1, 0), cB + kstep, voffB); PG8_STAGE(PG8_SA(1, 0), cA + kstep, voffA); PG8_STAGE(PG8_SB(1, 1), cB + hstep + kstep, voffB);
        PG8_WAIT_V(6); PG8_BAR;
    } else {
        PG8_STAGE(PG8_SB(0, 0), cB, voffB); PG8_STAGE(PG8_SA(0, 0), cA, voffA); PG8_STAGE(PG8_SB(0, 1), cB + hstep, voffB); PG8_STAGE(PG8_SA(0, 1), cA + hstepA, voffA);
        if (wr == 1) PG8_BAR;
        PG8_WAIT_V(4); PG8_BAR;
        PG8_STAGE(PG8_SB(1, 0), cB + kstep, voffB); PG8_STAGE(PG8_SA(1, 0), cA + kstep, voffA); PG8_STAGE(PG8_SB(1, 1), cB + hstep + kstep, voffB);
        PG8_WAIT_V(6); PG8_BAR;
    }
    for (;;) {
        const bool has_next = S.next(ui + 1, nxt);
        const char* nA = has_next ? (const char*)g.A + (size_t)nxt.pm * tstepA : cA; const char* nB = has_next ? (const char*)g.Bt + (size_t)nxt.pn * tstep : cB;
        for (int t = 0; t < nt; t += 2) {
            const bool last = (t == nt - 2);
            const char* a1 = cA + (size_t)(t + 1) * kstep;
            const char* a2 = last ? nA : cA + (size_t)(t + 2) * kstep; const char* b2 = last ? nB : cB + (size_t)(t + 2) * kstep;
            const char* a3 = a2 + kstep; const char* b3 = b2 + kstep;
            if (last && has_next) S.a_ready(nxt);
            if constexpr (SP2) {
            PG8_LDB(B0, 0, 0); PG8_LDB(B1, 0, 1); PG8_SCHED; PG8_LDA(At, 0, 0); PG8_STAGE(PG8_SA(1, 1), a1 + hstepA, voffA);
            PG8_WAIT_V(8); PG8_WAIT_L(0); PG8_BAR; PG8_MMA(0, 0, At, B0); PG8_MMA(0, 1, At, B1); PG8_BAR; PG8_SCHED;
            PG8_LDA(At, 0, 1); PG8_STAGE(PG8_SB(0, 0), b2, voffB); PG8_STAGE(PG8_SB(0, 1), b2 + hstep, voffB); PG8_STAGE(PG8_SA(0, 0), a2, voffA);
            PG8_WAIT_V(8); PG8_WAIT_L(0); PG8_BAR; PG8_MMA(1, 0, At, B0); PG8_MMA(1, 1, At, B1); PG8_BAR; PG8_SCHED;
            PG8_LDB(B0, 1, 0); PG8_LDB(B1, 1, 1); PG8_SCHED; PG8_LDA(At, 1, 0); PG8_STAGE(PG8_SA(0, 1), a2 + hstepA, voffA);
            PG8_WAIT_V(8); PG8_WAIT_L(0); PG8_BAR; PG8_MMA(0, 0, At, B0); PG8_MMA(0, 1, At, B1); PG8_BAR; PG8_SCHED;
            PG8_LDA(At, 1, 1); PG8_STAGE(PG8_SB(1, 0), b3, voffB); PG8_STAGE(PG8_SB(1, 1), b3 + hstep, voffB); PG8_STAGE(PG8_SA(1, 0), a3, voffA);
            PG8_WAIT_V(8); PG8_WAIT_L(0); PG8_BAR; PG8_MMA(1, 0, At, B0); PG8_MMA(1, 1, At, B1); PG8_BAR; PG8_SCHED;
            } else {
            PG8_LDB(B0, 0, 0); PG8_SCHED; PG8_LDA(At, 0, 0); PG8_STAGE(PG8_SA(1, 1), a1 + hstepA, voffA);
            PG8_WAIT_L(8); PG8_BAR; PG8_WAIT_L(0); PG8_MMA(0, 0, At, B0); PG8_BAR; PG8_SCHED;
            PG8_LDB(B1, 0, 1); PG8_STAGE(PG8_SB(0, 0), b2, voffB);
            PG8_BAR; PG8_WAIT_L(0); PG8_MMA(0, 1, At, B1); PG8_BAR;
            PG8_LDA(At, 0, 1); PG8_STAGE(PG8_SA(0, 0), a2, voffA);
            PG8_BAR; PG8_WAIT_L(0); PG8_MMA(1, 0, At, B0); PG8_BAR; PG8_SCHED;
            PG8_STAGE(PG8_SB(0, 1), b2 + hstep, voffB);
            PG8_WAIT_V(6); PG8_BAR; PG8_MMA(1, 1, At, B1); PG8_BAR;
            PG8_LDB(B0, 1, 0); PG8_SCHED; PG8_LDA(At, 1, 0); PG8_STAGE(PG8_SA(0, 1), a2 + hstepA, voffA);
            PG8_WAIT_L(8); PG8_BAR; PG8_WAIT_L(0); PG8_MMA(0, 0, At, B0); PG8_BAR; PG8_SCHED;
            PG8_LDB(B1, 1, 1); PG8_STAGE(PG8_SB(1, 0), b3, voffB);
            PG8_BAR; PG8_WAIT_L(0); PG8_MMA(0, 1, At, B1); PG8_BAR;
            PG8_LDA(At, 1, 1); PG8_STAGE(PG8_SA(1, 0), a3, voffA);
            PG8_BAR; PG8_WAIT_L(0); PG8_MMA(1, 0, At, B0); PG8_BAR; PG8_SCHED;
            PG8_STAGE(PG8_SB(1, 1), b3 + hstep, voffB);
            PG8_WAIT_V(6); PG8_BAR; PG8_MMA(1, 1, At, B1); PG8_BAR;
            }
        }
        if constexpr (ALIGN_EPI) { if (wr == 0) PG8_BAR; }
        if constexpr (!Epi::AFTER_DRAIN) { E(acc, cur, wr, wc, fr, fq); S.done(cur); }
        if (!has_next) break;
#pragma unroll
        for (int a = 0; a < 2; ++a)
#pragma unroll
            for (int b = 0; b < 2; ++b)
#pragma unroll
                for (int m = 0; m < 4; ++m)
#pragma unroll
                    for (int n = 0; n < 2; ++n) acc[a][b][m][n] = (f32x4){0.f, 0.f, 0.f, 0.f};
        cur = nxt; cA = nA; cB = nB; ++ui;
        if constexpr (ALIGN_EPI) { if (wr == 1) PG8_BAR; }
    }
    PG8_WAIT_V(0);
    if constexpr (!ALIGN_EPI) { if (wr == 0) PG8_BAR; }
    PG8_BAR;
    if constexpr (Epi::AFTER_DRAIN) { E.fused(acc, cur, wr, wc, fr, fq, lds, wid, lane); S.done(cur); }
#undef PG8_SA
#undef PG8_SB
#undef PG8_STAGE
#undef PG8_LDA
#undef PG8_LDB
#undef PG8_MMA
#undef PG8_WAIT_V
#undef PG8_WAIT_L
#undef PG8_BAR
#undef PG8_SCHED
}
}
#define GAS __attribute__((address_space(1)))
#define LAS __attribute__((address_space(3)))
typedef unsigned short bf16_t;
typedef short bf16x8 __attribute__((ext_vector_type(8)));
typedef float f32x4 __attribute__((ext_vector_type(4)));
typedef unsigned u32x4 __attribute__((ext_vector_type(4)));
typedef unsigned u32x2 __attribute__((ext_vector_type(2)));
typedef float f32x2 __attribute__((ext_vector_type(2)));
constexpr int NT = 512, PROWS6 = 8192;
constexpr int T = 16384, SEQ = 4096, D = 1024, ZW = 6144;
constexpr size_t MiB = 1u << 20;
constexpr size_t WS_DEC = 0;
constexpr size_t WS_Z = 4 * MiB;
constexpr size_t WS_WIN = 196 * MiB, WS_WOUT = 208 * MiB, WS_RGA = 212 * MiB, WS_RGX = 212 * MiB + 256 * 1024;
constexpr size_t WS_OI = 213 * MiB;
constexpr size_t WS_A2 = 4 * MiB;
constexpr size_t WS_R = 68 * MiB;
constexpr size_t WS_V = 132 * MiB;
constexpr size_t WS_WC = 196 * MiB, WS_WO = 229 * MiB, WS_LW = 233 * MiB, WS_LA = 235 * MiB;
constexpr size_t WS_W2T = 237 * MiB, WS_A2T = 237 * MiB + 256 * 1024, WS_GR = 238 * MiB, WS_ST = 239 * MiB, WS_XG = 241 * MiB;
constexpr size_t WS_BAR = 2 * MiB;
constexpr int LDS_BYTES = 147456, LDS_MISC = 147456 - 64;

struct Params { const GAS float* in[32]; GAS float* out; GAS unsigned char* ws; long long dry; };
#ifndef PROBE
#define PROBE 0
#endif
enum { I_X = 0, I_ABG, I_WIN, I_CONVW, I_CONVB, I_RGWA, I_RGBA, I_RGWX, I_RGBX, I_LAM, I_LB, I_HGG, I_WOUT, I_CNG, I_MU, I_WR, I_WK, I_WV, I_WG, I_W0, I_W1, I_W2, I_A0, I_A1, I_A2, I_KK, I_KA, I_RK, I_LNG, I_LNB, I_WO, I_FG };

__device__ __forceinline__ unsigned f2bf(float f) { unsigned u = __float_as_uint(f); return (u + 0x7fffu + ((u >> 16) & 1u)) >> 16; }
__device__ __forceinline__ float bf2f(unsigned h) { return __uint_as_float(h << 16); }
__device__ __forceinline__ unsigned pk2(float lo, float hi) { return f2bf(lo) | (f2bf(hi) << 16); }
__device__ __forceinline__ float sigmf(float x) { return __builtin_amdgcn_rcpf(1.0f + __expf(-x)); }
__device__ __forceinline__ float wave_sum(float v) {
#pragma unroll
    for (int o = 1; o < 64; o <<= 1) v += __shfl_xor(v, o);
    return v;
}
#define OPQ_TID unsigned char* WSP = launder_ws(((unsigned char*)p.ws)); int tid = threadIdx.x; asm volatile("" : "+v"(tid)); const int lane = tid & 63, wave = __builtin_amdgcn_readfirstlane(tid >> 6); (void)lane; (void)wave
__device__ __forceinline__ unsigned char* launder_ws(unsigned char* w) { const unsigned long long v = (unsigned long long)w; unsigned lo = __builtin_amdgcn_readfirstlane((unsigned)v), hi = __builtin_amdgcn_readfirstlane((unsigned)(v >> 32)); asm volatile("" : "+s"(lo), "+s"(hi)); return (unsigned char*)(GAS unsigned char*)(((unsigned long long)hi << 32) | lo); }
#define MFMA16(a, b, c) __builtin_amdgcn_mfma_f32_16x16x32_bf16((a), (b), (c), 0, 0, 0)

__device__ __forceinline__ void tr_item(const float* src, int ld_src, bf16_t* dst, int ld_dst, const float* sc, int scmode, LAS float* scr, int kb, int nb, int lane) {
    const int k0 = 64 * kb, n0 = 32 * nb;
#pragma unroll
    for (int i = 0; i < 8; ++i) { const int kk = 8 * i + (lane >> 3), c4 = (lane & 7) * 4; f32x4 v = *(const f32x4*)(src + (size_t)(k0 + kk) * ld_src + n0 + c4);
        if (sc) { const float m_ = sc[k0 + kk]; v = v * (scmode ? m_ : (1.0f - m_)); }
        scr[kk * 33 + c4] = v.x; scr[kk * 33 + c4 + 1] = v.y; scr[kk * 33 + c4 + 2] = v.z; scr[kk * 33 + c4 + 3] = v.w; }
    asm volatile("s_waitcnt lgkmcnt(0)" ::: "memory");
    const int c = lane & 7;
#pragma unroll
    for (int j = 0; j < 4; ++j) { const int n = (lane >> 3) + 8 * j; const LAS float* s = scr + (8 * c) * 33 + n;
        u32x4 o; o.x = pk2(s[0 * 33], s[1 * 33]); o.y = pk2(s[2 * 33], s[3 * 33]); o.z = pk2(s[4 * 33], s[5 * 33]); o.w = pk2(s[6 * 33], s[7 * 33]);
        *(u32x4*)(dst + (size_t)(n0 + n) * ld_dst + k0 + 8 * c) = o; }
    asm volatile("s_waitcnt lgkmcnt(0)" ::: "memory");
}
__device__ __forceinline__ void tr_item2(const float* src, int ld_src, bf16_t* dst0, bf16_t* dst1, int ld_dst, const float* mu, LAS float* scr, int kb, int nb, int lane) {
    const int k0 = 64 * kb, n0 = 32 * nb;
#pragma unroll
    for (int i = 0; i < 8; ++i) { const int kk = 8 * i + (lane >> 3), c4 = (lane & 7) * 4; const f32x4 v = *(const f32x4*)(src + (size_t)(k0 + kk) * ld_src + n0 + c4);
        scr[kk * 33 + c4] = v.x; scr[kk * 33 + c4 + 1] = v.y; scr[kk * 33 + c4 + 2] = v.z; scr[kk * 33 + c4 + 3] = v.w; }
    asm volatile("s_waitcnt lgkmcnt(0)" ::: "memory");
    const int c = lane & 7;
    const f32x4 m0 = *(const f32x4*)(mu + k0 + 8 * c), m1 = *(const f32x4*)(mu + k0 + 8 * c + 4);
#pragma unroll
    for (int j = 0; j < 4; ++j) { const int n = (lane >> 3) + 8 * j; const LAS float* s = scr + (8 * c) * 33 + n;
        const float s0 = s[0], s1 = s[33], s2 = s[66], s3 = s[99], s4 = s[132], s5 = s[165], s6 = s[198], s7 = s[231];
        u32x4 o; o.x = pk2(s0 * m0.x, s1 * m0.y); o.y = pk2(s2 * m0.z, s3 * m0.w); o.z = pk2(s4 * m1.x, s5 * m1.y); o.w = pk2(s6 * m1.z, s7 * m1.w);
        *(u32x4*)(dst1 + (size_t)(n0 + n) * ld_dst + k0 + 8 * c) = o;
        o.x = pk2(s0 * (1.0f - m0.x), s1 * (1.0f - m0.y)); o.y = pk2(s2 * (1.0f - m0.z), s3 * (1.0f - m0.w)); o.z = pk2(s4 * (1.0f - m1.x), s5 * (1.0f - m1.y)); o.w = pk2(s6 * (1.0f - m1.z), s7 * (1.0f - m1.w));
        *(u32x4*)(dst0 + (size_t)(n0 + n) * ld_dst + k0 + 8 * c) = o; }
    asm volatile("s_waitcnt lgkmcnt(0)" ::: "memory");
}
__device__ __forceinline__ void rms_row(const float* xrow, const float* g, int lane, u32x2 (&o)[4]) {
    f32x4 v[4]; float s = 0.f;
#pragma unroll
    for (int j = 0; j < 4; ++j) { v[j] = *((const f32x4*)xrow + lane + 64 * j); s += (v[j].x * v[j].x + v[j].y * v[j].y) + (v[j].z * v[j].z + v[j].w * v[j].w); }
    const float rs = rsqrtf(wave_sum(s) * (1.0f / 1024.0f) + 1e-6f);
#pragma unroll
    for (int j = 0; j < 4; ++j) { const f32x4 gg = *((const f32x4*)g + lane + 64 * j); o[j].x = pk2(v[j].x * rs * gg.x, v[j].y * rs * gg.y); o[j].y = pk2(v[j].z * rs * gg.z, v[j].w * rs * gg.w); }
}

__device__ __forceinline__ void p0_prologue(const Params& p, LAS unsigned char* lds, int G, int bid) {
    OPQ_TID; const int gw = bid * 8 + wave, ngw = G * 8;
    LAS float* scr = (LAS float*)(lds + wave * 16384);
    bf16_t* WinT = (bf16_t*)(WSP + WS_WIN); bf16_t* WoutT = (bf16_t*)(WSP + WS_WOUT); bf16_t* RGA = (bf16_t*)(WSP + WS_RGA); bf16_t* RGX = (bf16_t*)(WSP + WS_RGX);
    constexpr int IA = 16 * 192, IB = 32 * 32, IC = 64;
    for (int it = gw; it < IA + IB + 2 * IC; it += ngw) {
        int r = it;
        if (r < IA) { tr_item(((const float*)p.in[I_WIN]), ZW, WinT, 1024, nullptr, 0, scr, r / 192, r % 192, lane); continue; } r -= IA;
        if (r < IB) { tr_item(((const float*)p.in[I_WOUT]), 1024, WoutT, 2048, nullptr, 0, scr, r / 32, r % 32, lane); continue; } r -= IB;
        const float* src = (r < IC) ? ((const float*)p.in[I_RGWA]) : ((const float*)p.in[I_RGWX]); bf16_t* dst = (r < IC) ? RGA : RGX; if (r >= IC) r -= IC;
        const int blk = r >> 3, q = r & 7;
        tr_item(src + blk * 16384, 128, dst + blk * 16384, 128, nullptr, 0, scr, q >> 2, q & 3, lane);
    }
    bf16_t* U0 = (bf16_t*)((float*)p.out);
    for (int m = gw; m < T; m += ngw) { u32x2 o[4]; rms_row(((const float*)p.in[I_X]) + (size_t)m * D, ((const float*)p.in[I_ABG]), lane, o);
#pragma unroll
        for (int j = 0; j < 4; ++j) *((u32x2*)(U0 + (size_t)m * D) + lane + 64 * j) = o[j]; }
}

__device__ __forceinline__ void rg_a_prefetch(const bf16_t* Z, int unit, int tid, u32x4 (&pre)[3]) {
    const int b = unit >> 9, n = (unit >> 3) & 63, j = unit & 7; const int tok0 = b * SEQ + n * 64, ch0 = j * 128;
#pragma unroll
    for (int q = 0; q < 3; ++q) { const int i = tid + q * NT; const int row = i >> 4, cc = i & 15; pre[q] = (u32x4){0u, 0u, 0u, 0u};
        if (i < 67 * 16 && (n > 0 || row >= 3)) pre[q] = *(const u32x4*)(Z + (size_t)(tok0 - 3 + row) * ZW + ch0 + 8 * cc); }
}
__device__ __forceinline__ void rg_a_unit(const Params& p, LAS unsigned char* lds, int unit, int next_unit, u32x4 (&pre)[3]) {
    OPQ_TID;
    LAS float* XC = (LAS float*)lds; LAS float* AA = (LAS float*)(lds + 32768); LAS bf16_t* XB = (LAS bf16_t*)(lds + 65536); LAS bf16_t* XR = (LAS bf16_t*)(lds + 82944);
    LAS float* SUMP = (LAS float*)(lds + 82944); LAS float* SUMH = SUMP + 512; LAS bf16_t* HT = XB; LAS bf16_t* PT = (LAS bf16_t*)(lds + 87040);
    const int b = unit >> 9, n = (unit >> 3) & 63, j = unit & 7;
    const int tok0 = b * SEQ + n * 64, ch0 = j * 128;
    const bf16_t* Z = (const bf16_t*)(WSP + WS_Z);
#pragma unroll
    for (int q = 0; q < 3; ++q) { const int i = tid + q * NT; if (i < 67 * 16) *(LAS u32x4*)(XR + (i >> 4) * 136 + 8 * (i & 15)) = pre[q]; }
    __syncthreads();
    if (next_unit < 2048) rg_a_prefetch(Z, next_unit, tid, pre);
    const int c = tid & 127, sub = tid >> 7;
    {
        const int ch = ch0 + c;
        const float w0 = ((const float*)p.in[I_CONVW])[ch], w1 = ((const float*)p.in[I_CONVW])[1024 + ch], w2 = ((const float*)p.in[I_CONVW])[2048 + ch], w3 = ((const float*)p.in[I_CONVW])[3072 + ch], cb = ((const float*)p.in[I_CONVB])[ch];
        const LAS bf16_t* xr = XR + (sub * 16) * 136 + c;
        float xm3 = bf2f(xr[0]), xm2 = bf2f(xr[136]), xm1 = bf2f(xr[272]);
#pragma unroll
        for (int i = 0; i < 16; ++i) { const float x = bf2f(xr[(i + 3) * 136]); const float y = w0 * xm3 + w1 * xm2 + w2 * xm1 + w3 * x + cb;
            XC[(sub * 16 + i) * 128 + c] = y; XB[(sub * 16 + i) * 136 + c] = (bf16_t)f2bf(y); xm3 = xm2; xm2 = xm1; xm1 = x; }
    }
    __syncthreads();
    {
        const int fr = lane & 15, fq = lane >> 4;
        const bf16_t* WA = (const bf16_t*)(WSP + WS_RGA) + j * 16384 + (16 * wave + fr) * 128 + 8 * fq;
        const bf16_t* WX = (const bf16_t*)(WSP + WS_RGX) + j * 16384 + (16 * wave + fr) * 128 + 8 * fq;
        f32x4 accA[4], accX[4];
#pragma unroll
        for (int m = 0; m < 4; ++m) { accA[m] = (f32x4){0.f, 0.f, 0.f, 0.f}; accX[m] = (f32x4){0.f, 0.f, 0.f, 0.f}; }
#pragma unroll
        for (int k = 0; k < 4; ++k) { const bf16x8 bA = *(const bf16x8*)(WA + 32 * k), bX = *(const bf16x8*)(WX + 32 * k);
#pragma unroll
            for (int m = 0; m < 4; ++m) { const bf16x8 a = *(const LAS bf16x8*)(XB + (16 * m + fr) * 136 + 32 * k + 8 * fq); accA[m] = MFMA16(a, bA, accA[m]); accX[m] = MFMA16(a, bX, accX[m]); } }
        const int cl = 16 * wave + fr, ch = ch0 + cl;
        const float ba = ((const float*)p.in[I_RGBA])[ch], bx = ((const float*)p.in[I_RGBX])[ch], lam = ((const float*)p.in[I_LAM])[ch];
        const float sp = log1pf(expf(-lam));
#pragma unroll
        for (int m = 0; m < 4; ++m)
#pragma unroll
            for (int r = 0; r < 4; ++r) { const int tk = 16 * m + 4 * fq + r; const float gr = sigmf(accA[m][r] + ba), gi = sigmf(accX[m][r] + bx);
                const float la = -8.0f * gr * sp; const float a = __expf(la); const float mult = __builtin_amdgcn_sqrtf(fmaxf(1.0f - a * a, 0.f));
                const float xc = XC[tk * 128 + cl]; AA[tk * 128 + cl] = a; XC[tk * 128 + cl] = mult * gi * xc; }
    }
    __syncthreads();
    {
        float hl[16], pl[16]; float h = 0.f, P = 1.f;
#pragma unroll
        for (int i = 0; i < 16; ++i) { const float a = AA[(sub * 16 + i) * 128 + c], u = XC[(sub * 16 + i) * 128 + c]; h = a * h + u; P *= a; hl[i] = h; pl[i] = P; }
        SUMP[sub * 128 + c] = P; SUMH[sub * 128 + c] = h;
        __syncthreads();
        float chh = 0.f, cp = 1.f;
#pragma unroll
        for (int s = 0; s < 3; ++s) if (s < sub) { const float sp_ = SUMP[s * 128 + c]; chh = chh * sp_ + SUMH[s * 128 + c]; cp *= sp_; }
#pragma unroll
        for (int i = 0; i < 16; ++i) { HT[(sub * 16 + i) * 136 + c] = (bf16_t)f2bf(hl[i] + pl[i] * chh); PT[(sub * 16 + i) * 136 + c] = (bf16_t)f2bf(pl[i] * cp); }
    }
    __syncthreads();
    {
        bf16_t* HL = (bf16_t*)((float*)p.out) + (size_t)tok0 * D + ch0; bf16_t* PC = HL + (size_t)T * D;
        for (int i = tid; i < 1024; i += NT) { const int row = i >> 4, cc = i & 15;
            *(u32x4*)(HL + (size_t)row * D + 8 * cc) = *(const LAS u32x4*)(HT + row * 136 + 8 * cc); *(u32x4*)(PC + (size_t)row * D + 8 * cc) = *(const LAS u32x4*)(PT + row * 136 + 8 * cc); }
    }
    __syncthreads();
}

__device__ __forceinline__ void hg_a_prefetch(const bf16_t* Z, int unit, int tid, u32x4 (&pre)[6]) {
    const int b = unit >> 9, h = (unit >> 6) & 7, n = unit & 63; const int tok0 = b * SEQ + n * 64;
#pragma unroll
    for (int q = 0; q < 6; ++q) { const int i = tid + q * NT; const int arr = i >> 10, row = (i >> 4) & 63, cc = i & 15; pre[q] = *(const u32x4*)(Z + (size_t)(tok0 + row) * ZW + 2048 + 1024 * arr + h * 128 + 8 * cc); }
}
__device__ __forceinline__ void hg_a_unit(const Params& p, LAS unsigned char* lds, int unit, int next_unit, u32x4 (&pre)[6]) {
    OPQ_TID;
    LAS bf16_t* QD = (LAS bf16_t*)lds; LAS bf16_t* KI = (LAS bf16_t*)(lds + 17408); LAS bf16_t* VR = (LAS bf16_t*)(lds + 34816); LAS bf16_t* VT = (LAS bf16_t*)(lds + 52224);
    LAS bf16_t* SC = (LAS bf16_t*)(lds + 70656); LAS float* ST = (LAS float*)(lds + 79872); LAS bf16_t* OT = VR;
    const int b = unit >> 9, h = (unit >> 6) & 7, n = unit & 63;
    const int tok0 = b * SEQ + n * 64;
    bf16_t* Z = (bf16_t*)(WSP + WS_Z);
    const int fr = lane & 15, fq = lane >> 4;
#pragma unroll
    for (int q = 0; q < 6; ++q) { const int i = tid + q * NT; const int arr = i >> 10, row = (i >> 4) & 63, cc = i & 15;
        *(LAS u32x4*)((arr == 0 ? QD : (arr == 1 ? KI : VR)) + row * 136 + 8 * cc) = pre[q]; }
    __syncthreads();
    {
        const int d = tid & 127, sub = tid >> 7, hd = h * 128 + d;
        const float lb = sigmf(((const float*)p.in[I_LB])[hd] - ((const float*)p.in[I_LB])[1024 + hd]), omlb = 1.0f - lb;
        float q[16], kq[16], cl[16]; unsigned short vv[16]; float run = 0.f;
#pragma unroll
        for (int i = 0; i < 16; ++i) { const int t = sub * 16 + i; const float f = bf2f(KI[t * 136 + d]); const float sg = sigmf(f);
            run += __logf(lb + omlb * sg); cl[i] = run; kq[i] = omlb * (1.0f - sg); q[i] = bf2f(QD[t * 136 + d]); vv[i] = VR[t * 136 + d]; }
        ST[sub * 128 + d] = run;
        __syncthreads();
        float off = 0.f, total = 0.f;
#pragma unroll
        for (int s = 0; s < 4; ++s) { const float x = ST[s * 128 + d]; total += x; if (s < sub) off += x; }
        unsigned ke[8], vp[8];
#pragma unroll
        for (int i = 0; i < 16; ++i) { const float cum = off + cl[i]; const unsigned qd = f2bf(q[i] * __expf(cum)), ki = f2bf(kq[i] * __expf(-cum)), kE = f2bf(kq[i] * __expf(total - cum));
            QD[(sub * 16 + i) * 136 + d] = (bf16_t)qd; KI[(sub * 16 + i) * 136 + d] = (bf16_t)ki;
            if (i & 1) { ke[i >> 1] |= kE << 16; vp[i >> 1] |= (unsigned)vv[i] << 16; } else { ke[i >> 1] = kE; vp[i >> 1] = vv[i]; } }
        *(LAS u32x4*)(VT + d * 72 + sub * 16) = (u32x4){vp[0], vp[1], vp[2], vp[3]}; *(LAS u32x4*)(VT + d * 72 + sub * 16 + 8) = (u32x4){vp[4], vp[5], vp[6], vp[7]};
        bf16_t* tb = Z + (size_t)(tok0 + (d >> 1)) * ZW + h * 128 + (d & 1) * 64 + sub * 16;
        *(u32x4*)(tb + 3072) = (u32x4){ke[0], ke[1], ke[2], ke[3]}; *(u32x4*)(tb + 3072 + 8) = (u32x4){ke[4], ke[5], ke[6], ke[7]};
        *(u32x4*)(tb + 4096) = (u32x4){vp[0], vp[1], vp[2], vp[3]}; *(u32x4*)(tb + 4096 + 8) = (u32x4){vp[4], vp[5], vp[6], vp[7]};
        if (sub == 0) ((float*)(WSP + WS_DEC))[unit * 128 + d] = __expf(total);
    }
    __syncthreads();
    if (next_unit < 2048) hg_a_prefetch(Z, next_unit, tid, pre);
    for (int i = tid; i < 1024; i += NT) { const int row = i >> 4, cc = i & 15; *(u32x4*)(Z + (size_t)(tok0 + row) * ZW + 2048 + h * 128 + 8 * cc) = *(const LAS u32x4*)(QD + row * 136 + 8 * cc); }
    {
        const int lt = wave >> 1;
#pragma unroll
        for (int x = 0; x < 2; ++x) { const int mt = (wave & 1) * 2 + x; f32x4 acc = (f32x4){0.f, 0.f, 0.f, 0.f};
            if (mt <= lt) {
#pragma unroll
                for (int k = 0; k < 4; ++k) { const bf16x8 a = *(const LAS bf16x8*)(QD + (16 * lt + fr) * 136 + 32 * k + 8 * fq), bb = *(const LAS bf16x8*)(KI + (16 * mt + fr) * 136 + 32 * k + 8 * fq); acc = MFMA16(a, bb, acc); } }
#pragma unroll
            for (int r = 0; r < 4; ++r) { const int l = 16 * lt + 4 * fq + r, mm = 16 * mt + fr; SC[l * 72 + mm] = (bf16_t)f2bf(mm <= l ? acc[r] : 0.f); } }
    }
    __syncthreads();
    {
#pragma unroll
        for (int lt = 0; lt < 4; ++lt) { f32x4 acc = (f32x4){0.f, 0.f, 0.f, 0.f};
#pragma unroll
            for (int k = 0; k < 2; ++k) { const bf16x8 a = *(const LAS bf16x8*)(SC + (16 * lt + fr) * 72 + 32 * k + 8 * fq), bb = *(const LAS bf16x8*)(VT + (16 * wave + fr) * 72 + 32 * k + 8 * fq); acc = MFMA16(a, bb, acc); }
#pragma unroll
            for (int r = 0; r < 4; ++r) OT[(16 * lt + 4 * fq + r) * 136 + 16 * wave + fr] = (bf16_t)f2bf(acc[r]); }
    }
    __syncthreads();
    { bf16_t* OI = (bf16_t*)(WSP + WS_OI) + (size_t)tok0 * D + h * 128;
      for (int i = tid; i < 1024; i += NT) { const int row = i >> 4, cc = i & 15; *(u32x4*)(OI + (size_t)row * D + 8 * cc) = *(const LAS u32x4*)(OT + row * 136 + 8 * cc); } }
    __syncthreads();
}

__device__ __forceinline__ void hg_b_item(const Params& p, LAS unsigned char* lds, int item, bool dry = false) {
    OPQ_TID;
    LAS bf16_t* SB = (LAS bf16_t*)lds;
    const int b = item >> 6, h = (item >> 3) & 7, es = item & 7;
    const int fr = lane & 15, fq = lane >> 4;
    const bf16_t* Z = (const bf16_t*)(WSP + WS_Z); bf16_t* OI = (bf16_t*)(WSP + WS_OI); const float* DEC = (const float*)(WSP + WS_DEC);
    for (int i = tid; i < 2 * 16 * 136 / 2; i += NT) ((LAS unsigned*)SB)[i] = 0u;
    __syncthreads();
    f32x4 S = (f32x4){0.f, 0.f, 0.f, 0.f};
    const int eg = 16 * es + fr, dg = 16 * wave + fr;
    const bf16_t* pV = Z + (size_t)(b * SEQ + (eg >> 1)) * ZW + 4096 + h * 128 + (eg & 1) * 64 + 8 * fq;
    const bf16_t* pK = Z + (size_t)(b * SEQ + (dg >> 1)) * ZW + 3072 + h * 128 + (dg & 1) * 64 + 8 * fq;
    const bf16_t* pQ = Z + (size_t)(b * SEQ + 16 * (wave & 3) + fr) * ZW + 2048 + h * 128 + 8 * fq;
    bf16_t* pO = OI + (size_t)(b * SEQ + 16 * (wave & 3) + 4 * fq) * D + h * 128 + 16 * es + fr;
    const float* pD = DEC + (size_t)((b * 8 + h) * 64) * 128 + dg;
    bf16x8 nV[2][2], nK[2][2], nQ[2][4]; float ndec[2]; unsigned short nO[2][4];
#define HGB_LOAD(SET, n_) do { const size_t ro_ = (size_t)(n_) * 64 * ZW; ndec[SET] = pD[(n_) * 128]; \
        _Pragma("unroll") for (int k = 0; k < 2; ++k) { nV[SET][k] = *(const bf16x8*)(pV + ro_ + 32 * k); nK[SET][k] = *(const bf16x8*)(pK + ro_ + 32 * k); } \
        if (wave < 4) { _Pragma("unroll") for (int k = 0; k < 4; ++k) nQ[SET][k] = *(const bf16x8*)(pQ + ro_ + 32 * k); \
            _Pragma("unroll") for (int r = 0; r < 4; ++r) nO[SET][r] = pO[(size_t)((n_) * 64 + r) * D]; } } while (0)
#define HGB_STEP(SET, n) do { \
        const float dec = ndec[SET]; bf16x8 aV[2], bK[2]; \
        _Pragma("unroll") for (int k = 0; k < 2; ++k) { aV[k] = nV[SET][k]; bK[k] = nK[SET][k]; } \
        if (wave < 4) { \
            f32x4 acc = (f32x4){0.f, 0.f, 0.f, 0.f}; \
            _Pragma("unroll") for (int k = 0; k < 4; ++k) { const bf16x8 bb = *(const LAS bf16x8*)(SB + ((n) & 1) * 2176 + fr * 136 + 32 * k + 8 * fq); acc = MFMA16(nQ[SET][k], bb, acc); } \
            _Pragma("unroll") for (int r = 0; r < 4; ++r) { const float nv = bf2f(nO[SET][r]) + acc[r]; if (!dry) pO[(size_t)((n) * 64 + r) * D] = (bf16_t)f2bf(nv); else if (nv == 123456.0f) pO[0] = 0; } \
        } \
        if ((n) + 2 < 64) HGB_LOAD(SET, (n) + 2); \
        S = S * dec; \
        _Pragma("unroll") for (int k = 0; k < 2; ++k) S = MFMA16(aV[k], bK[k], S); \
        _Pragma("unroll") for (int r = 0; r < 4; ++r) SB[(((n) + 1) & 1) * 2176 + (4 * fq + r) * 136 + dg] = (bf16_t)f2bf(S[r]); \
        asm volatile("s_waitcnt lgkmcnt(0)" ::: "memory"); __builtin_amdgcn_s_barrier(); asm volatile("" ::: "memory"); } while (0)
    HGB_LOAD(0, 0); HGB_LOAD(1, 1);
#pragma unroll 1
    for (int n2 = 0; n2 < 64; n2 += 2) { HGB_STEP(0, n2); HGB_STEP(1, n2 + 1); }
#undef HGB_LOAD
#undef HGB_STEP
}
__device__ __forceinline__ void rg_b_unit(const Params& p, int unit) {
    OPQ_TID;
    const int b = unit >> 7, n = (unit >> 1) & 63, ch = (unit & 1) * 512 + 8 * (tid & 63), r8 = tid >> 6;
    const bf16_t* HL = (const bf16_t*)((float*)p.out) + (size_t)b * SEQ * D + ch; const bf16_t* PC = HL + (size_t)T * D;
    bf16_t* Z = (bf16_t*)(WSP + WS_Z) + (size_t)(b * SEQ + n * 64) * ZW + ch;
    float carry[8];
#pragma unroll
    for (int i = 0; i < 8; ++i) carry[i] = 0.f;
    int m0 = 0;
    for (; m0 + 4 <= n; m0 += 4) { u32x4 pp[4], hh4[4];
#pragma unroll
        for (int i = 0; i < 4; ++i) { const size_t o = (size_t)((m0 + i) * 64 + 63) * D; pp[i] = *(const u32x4*)(PC + o); hh4[i] = *(const u32x4*)(HL + o); }
#pragma unroll
        for (int i = 0; i < 4; ++i)
#pragma unroll
            for (int c = 0; c < 4; ++c) { carry[2 * c] = carry[2 * c] * bf2f(pp[i][c] & 0xffffu) + bf2f(hh4[i][c] & 0xffffu); carry[2 * c + 1] = carry[2 * c + 1] * bf2f(pp[i][c] >> 16) + bf2f(hh4[i][c] >> 16); } }
    for (; m0 < n; ++m0) { const size_t o = (size_t)(m0 * 64 + 63) * D; const u32x4 pp = *(const u32x4*)(PC + o), hh4 = *(const u32x4*)(HL + o);
#pragma unroll
        for (int c = 0; c < 4; ++c) { carry[2 * c] = carry[2 * c] * bf2f(pp[c] & 0xffffu) + bf2f(hh4[c] & 0xffffu); carry[2 * c + 1] = carry[2 * c + 1] * bf2f(pp[c] >> 16) + bf2f(hh4[c] >> 16); } }
#pragma unroll 4
    for (int tq = 0; tq < 8; ++tq) { const int t = 8 * tq + r8; const size_t o = (size_t)(n * 64 + t) * D;
        const u32x4 hv = *(const u32x4*)(HL + o), pv = *(const u32x4*)(PC + o), gv = *(const u32x4*)(Z + (size_t)t * ZW + 1024); u32x4 ov;
#pragma unroll
        for (int c = 0; c < 4; ++c) { const float h0 = bf2f(hv[c] & 0xffffu) + bf2f(pv[c] & 0xffffu) * carry[2 * c], h1 = bf2f(hv[c] >> 16) + bf2f(pv[c] >> 16) * carry[2 * c + 1];
            const float g0 = bf2f(gv[c] & 0xffffu), g1 = bf2f(gv[c] >> 16); ov[c] = pk2(h0 * g0 * sigmf(g0), h1 * g1 * sigmf(g1)); }
        *(u32x4*)(Z + (size_t)t * ZW) = ov; }
}
__device__ __forceinline__ float row16_sum_p4(float x) {
    x += __int_as_float(__builtin_amdgcn_update_dpp(0, __float_as_int(x), 0xB1, 0xf, 0xf, true)); x += __int_as_float(__builtin_amdgcn_update_dpp(0, __float_as_int(x), 0x4E, 0xf, 0xf, true));
    x += __int_as_float(__builtin_amdgcn_update_dpp(0, __float_as_int(x), 0x141, 0xf, 0xf, true)); x += __int_as_float(__builtin_amdgcn_update_dpp(0, __float_as_int(x), 0x140, 0xf, 0xf, true)); return x; }
__device__ __forceinline__ void p4_finalize(const Params& p, int G, int bid) {
    OPQ_TID; const int gw = bid * 8 + wave, ngw = G * 8;
    bf16_t* Z = (bf16_t*)(WSP + WS_Z); const bf16_t* OI = (const bf16_t*)(WSP + WS_OI);
    const int l16 = lane & 15, pr = lane >> 4;
    const f32x4 g0 = *(const f32x4*)(((const float*)p.in[I_HGG]) + 8 * l16), g1 = *(const f32x4*)(((const float*)p.in[I_HGG]) + 8 * l16 + 4);
    for (int it = gw; it < T * 2; it += ngw) { const int tok = it >> 1, h = (it & 1) * 4 + pr;
        const u32x4 ov = *(const u32x4*)(OI + (size_t)tok * D + h * 128 + 8 * l16); const u32x4 gv = *(const u32x4*)(Z + (size_t)tok * ZW + 5120 + h * 128 + 8 * l16);
        float o[8], gb[8]; float ss = 0.f;
#pragma unroll
        for (int c = 0; c < 4; ++c) { o[2 * c] = bf2f(ov[c] & 0xffffu); o[2 * c + 1] = bf2f(ov[c] >> 16); gb[2 * c] = bf2f(gv[c] & 0xffffu); gb[2 * c + 1] = bf2f(gv[c] >> 16); ss += o[2 * c] * o[2 * c] + o[2 * c + 1] * o[2 * c + 1]; }
        const float rs = rsqrtf(row16_sum_p4(ss) * (1.0f / 128.0f) + 1e-6f);
        u32x4 w;
#pragma unroll
        for (int c = 0; c < 4; ++c) { const float ga = c < 2 ? g0[2 * c] : g1[2 * c - 4], gbq = c < 2 ? g0[2 * c + 1] : g1[2 * c - 3];
            w[c] = pk2(o[2 * c] * rs * ga * gb[2 * c] * sigmf(gb[2 * c]), o[2 * c + 1] * rs * gbq * gb[2 * c + 1] * sigmf(gb[2 * c + 1])); }
        *(u32x4*)(Z + (size_t)tok * ZW + 1024 + h * 128 + 8 * l16) = w; }
}
__device__ __forceinline__ void p6_prologue(const Params& p, LAS unsigned char* lds, int G, int bid) {
    OPQ_TID; const int gw = bid * 8 + wave, ngw = G * 8;
    LAS float* scr = (LAS float*)(lds + wave * 16384);
    constexpr int IP = 4096, IL = 64, IO = 1024, I2 = 128;
    for (int i = gw * 64 + lane; i < (int)(MiB / 16); i += ngw * 64) ((u32x4*)(WSP + WS_GR))[i] = (u32x4){0u, 0u, 0u, 0u};
    for (int i = gw * 64 + lane; i < (int)(MiB / 32); i += ngw * 64) ((u32x4*)(WSP + WS_XG))[i] = (u32x4){0u, 0u, 0u, 0u};
    for (int it = gw; it < IP + IL + IO + I2; it += ngw) {
        int r = it;
        if (r < IP) { const int pj = r >> 10, q = r & 1023;
            const int muidx = pj == 0 ? 0 : (pj == 1 ? 2 : (pj == 2 ? 3 : 5));
            bf16_t* dst = (bf16_t*)(WSP + WS_WC) + (size_t)(pj * 2048) * 2048;
            tr_item2(((const float*)p.in[I_WR + pj]), 2048, dst, dst + 1024, 2048, ((const float*)p.in[I_MU]) + muidx * 1024, scr, q >> 6, q & 63, lane); continue; }
        r -= IP;
        if (r < IL) { const int wh = r >> 5, q = r & 31;
            const float* src = wh ? ((const float*)p.in[I_A1]) : ((const float*)p.in[I_W1]); bf16_t* dst = (bf16_t*)(WSP + WS_WC) + (size_t)(8192 + wh * 64) * 2048;
            tr_item2(src, 64, dst, dst + 1024, 2048, ((const float*)p.in[I_MU]) + (wh ? 4 : 1) * 1024, scr, q >> 1, q & 1, lane); continue; }
        r -= IL;
        if (r >= IO) { r -= IO; const int wh = r >> 6, nb = r & 63; tr_item(wh ? ((const float*)p.in[I_A2]) : ((const float*)p.in[I_W2]), 2048, (bf16_t*)(WSP + (wh ? WS_A2T : WS_W2T)), 64, nullptr, 0, scr, 0, nb, lane); continue; }
        tr_item(((const float*)p.in[I_WO]), 1024, (bf16_t*)(WSP + WS_WO), 2048, nullptr, 0, scr, r >> 5, r & 31, lane);
    }
    bf16_t* A2 = (bf16_t*)(WSP + WS_A2);
    for (int m = gw; m < T; m += ngw) { u32x2 o[4]; rms_row(((float*)p.out) + (size_t)m * D, ((const float*)p.in[I_CNG]), lane, o); const int bb = m >> 12, t = m & (SEQ - 1);
        const size_t cr = (size_t)(t >> 11) * PROWS6 + bb * 2048 + (t & 2047);
        const size_t cn = (size_t)((t + 1) >> 11) * PROWS6 + bb * 2048 + ((t + 1) & 2047);
#pragma unroll
        for (int j = 0; j < 4; ++j) { *((u32x2*)(A2 + cr * 2048) + lane + 64 * j) = o[j];
            if (t + 1 < SEQ) *((u32x2*)(A2 + cn * 2048 + 1024) + lane + 64 * j) = o[j];
            if (t == 0) *((u32x2*)(A2 + cr * 2048 + 1024) + lane + 64 * j) = (u32x2){0u, 0u}; } }
}
template <int CTRL> __device__ __forceinline__ float dpp_add(float x) { const int y = __builtin_amdgcn_update_dpp(0, __float_as_int(x), CTRL, 0xf, 0xf, true); return x + __int_as_float(y); }
__device__ __forceinline__ f32x4 bf4(u32x2 v) { return (f32x4){bf2f(v.x & 0xffffu), bf2f(v.x >> 16), bf2f(v.y & 0xffffu), bf2f(v.y >> 16)}; }
__device__ __forceinline__ float afma(float a, float b, float c) { float d; asm("v_fma_f32 %0, %1, %2, %3" : "=v"(d) : "v"(a), "v"(b), "v"(c)); return d; }
__device__ __forceinline__ float anfma(float a, float b, float c) { float d; asm("v_fma_f32 %0, -%1, %2, %3" : "=v"(d) : "v"(a), "v"(b), "v"(c)); return d; }
__device__ __forceinline__ float amul(float a, float b) { float d; asm("v_mul_f32 %0, %1, %2" : "=v"(d) : "v"(a), "v"(b)); return d; }
__device__ __forceinline__ f32x2 pkmul(f32x2 a, f32x2 b) { f32x2 d; asm("v_pk_mul_f32 %0, %1, %2" : "=v"(d) : "v"(a), "v"(b)); return d; }
__device__ __forceinline__ f32x2 pkfma(f32x2 a, f32x2 b, f32x2 c) { f32x2 d; asm("v_pk_fma_f32 %0, %1, %2, %3" : "=v"(d) : "v"(a), "v"(b), "v"(c)); return d; }
__device__ __forceinline__ f32x2 pkmul_bl(f32x2 s, f32x2 b) { f32x2 d; asm("v_pk_mul_f32 %0, %1, %2 op_sel_hi:[0,1]" : "=v"(d) : "v"(s), "v"(b)); return d; }
__device__ __forceinline__ f32x2 pknfma_bl(f32x2 s, f32x2 b, f32x2 c) { f32x2 d; asm("v_pk_fma_f32 %0, %1, %2, %3 op_sel_hi:[0,1,1] neg_lo:[1,0,0] neg_hi:[1,0,0]" : "=v"(d) : "v"(s), "v"(b), "v"(c)); return d; }
constexpr int RSTR = 68;
constexpr int REC_ARR = 32 * RSTR;
constexpr int REC_BUF = 5 * REC_ARR;
constexpr int L_REC = 0, L_YY = 87040, L_VV = 103424, L_GG = 119808, L_RKP = 136192, L_SSP = 137216, L_STT = 137728, L_CST = 137984;
constexpr int PROWS = 8192;
#define SCAN_BAR do { asm volatile("s_waitcnt lgkmcnt(0)" ::: "memory"); __builtin_amdgcn_s_barrier(); asm volatile("" ::: "memory"); } while (0)
__device__ __forceinline__ void scan_half(const Params& p, LAS unsigned char* lds, int pi, int rh, int pass) {
    OPQ_TID;
    LAS float* REC = (LAS float*)(lds + L_REC); LAS float* YY = (LAS float*)(lds + L_YY); LAS float* VV = (LAS float*)(lds + L_VV); LAS float* GG = (LAS float*)(lds + L_GG);
    LAS float* RKP = (LAS float*)(lds + L_RKP); LAS float* SSP = (LAS float*)(lds + L_SSP); LAS float* STT = (LAS float*)(lds + L_STT); LAS float* CST = (LAS float*)(lds + L_CST);
    const int b = pi >> 5, hg = pi & 31, colg = hg * 64;
    const bf16_t* Rb = (const bf16_t*)(WSP + WS_R); const bf16_t* Kb = Rb + (size_t)PROWS * 2048; bf16_t* Vb = (bf16_t*)(WSP + WS_V); const bf16_t* Gb = Vb + (size_t)PROWS * 2048;
    const bf16_t* LWb = (const bf16_t*)(WSP + WS_LW) + (size_t)pass * PROWS * 64; const bf16_t* LAb = (const bf16_t*)(WSP + WS_LA) + (size_t)pass * PROWS * 64;
    unsigned long long* GR = (unsigned long long*)(WSP + WS_GR);
    const size_t rowb = (size_t)b * 2048;
    __syncthreads();
    if (tid < 64) { CST[tid] = ((const float*)p.in[I_W0])[colg + tid]; CST[64 + tid] = ((const float*)p.in[I_A0])[colg + tid]; CST[128 + tid] = ((const float*)p.in[I_KK])[colg + tid]; CST[192 + tid] = ((const float*)p.in[I_KA])[colg + tid]; CST[256 + tid] = ((const float*)p.in[I_RK])[colg + tid];
                    CST[320 + tid] = ((const float*)p.in[I_LNG])[colg + tid]; CST[384 + tid] = ((const float*)p.in[I_LNB])[colg + tid]; }
    __syncthreads();
    const int fr = lane & 15, fq = lane >> 4;
    if (wave < 4) {
        const int j = lane & 7, rowl = 8 * wave + (lane >> 3);
        float* stp = (float*)(WSP + WS_ST) + ((size_t)(pi * 64 + 32 * rh + rowl)) * 64 + 8 * j;
        f32x2 P01 = (f32x2){0.f, 0.f}, P23 = P01, P45 = P01, P67 = P01;
        if (pass == 1) { const f32x4 a = *(const f32x4*)stp, c = *(const f32x4*)(stp + 4); P01 = a.xy; P23 = a.zw; P45 = c.xy; P67 = c.zw; }
        const bool first = (lane & 7) == 0;
        SCAN_BAR;
        for (int it = 0; it < 66; ++it) {
            if (it < 64) {
                const LAS float* rec = REC + (it & 1) * REC_BUF + 8 * j; const LAS float* vvp = VV + (it & 3) * 1024 + rowl; LAS float* yyp = YY + (it & 3) * 1024 + rowl;
                const LAS float* ssp = SSP + (it & 1) * 64 + 2 * (lane & 31);
                const float inv2 = __builtin_amdgcn_rcpf(fmaxf(ssp[0] + ssp[1], 1e-24f));
                f32x4 Rkk[2][2], Rw[2][2], Rka[2][2], Rkm[2][2], Rr[2][2]; float Rv[2];
#define LOADREC(slot, s) do { const LAS float* rs_ = rec + (s) * RSTR; \
                    Rkk[slot][0] = *(const LAS f32x4*)(rs_); Rkk[slot][1] = *(const LAS f32x4*)(rs_ + 4); Rw[slot][0] = *(const LAS f32x4*)(rs_ + REC_ARR); Rw[slot][1] = *(const LAS f32x4*)(rs_ + REC_ARR + 4); \
                    Rka[slot][0] = *(const LAS f32x4*)(rs_ + 2 * REC_ARR); Rka[slot][1] = *(const LAS f32x4*)(rs_ + 2 * REC_ARR + 4); Rkm[slot][0] = *(const LAS f32x4*)(rs_ + 3 * REC_ARR); Rkm[slot][1] = *(const LAS f32x4*)(rs_ + 3 * REC_ARR + 4); \
                    Rr[slot][0] = *(const LAS f32x4*)(rs_ + 4 * REC_ARR); Rr[slot][1] = *(const LAS f32x4*)(rs_ + 4 * REC_ARR + 4); Rv[slot] = vvp[(s) * 32]; } while (0)
                LOADREC(0, 0);
                float yp = 0.f, yk0 = 0.f, yk1 = 0.f, yk2 = 0.f, yk3 = 0.f;
#define YSHIFT(YK) do { YK = __int_as_float(__builtin_amdgcn_update_dpp(__float_as_int(yp), __float_as_int(YK), 0x111, 0xf, 0xf, false)); YK = first ? yp : YK; } while (0)
#pragma unroll
                for (int s = 0; s < 32; ++s) {
                    const int c = s & 1;
                    if (s + 1 < 32) LOADREC((s + 1) & 1, s + 1);
                    asm volatile("" ::: "memory");
                    const float si = __int_as_float(__builtin_amdgcn_readlane(__float_as_int(inv2), s));
                    f32x2 px = pkmul(P01, Rkk[c][0].xy); px = pkfma(P23, Rkk[c][0].zw, px); px = pkfma(P45, Rkk[c][1].xy, px); px = pkfma(P67, Rkk[c][1].zw, px);
                    float x = px.x + px.y;
                    f32x2 vv2; vv2.x = Rv[c]; asm volatile("" : "+v"(vv2));
                    x = dpp_add<0xB1>(x); yp = dpp_add<0xB1>(yp);
                    const f32x2 t01 = pkmul_bl(vv2, Rkm[c][0].xy), t23 = pkmul_bl(vv2, Rkm[c][0].zw);
                    x = dpp_add<0x4E>(x); yp = dpp_add<0x4E>(yp);
                    const f32x2 t45 = pkmul_bl(vv2, Rkm[c][1].xy), t67 = pkmul_bl(vv2, Rkm[c][1].zw);
                    x = dpp_add<0x141>(x); yp = dpp_add<0x141>(yp);
                    P01 = pkfma(P01, Rw[c][0].xy, t01); P23 = pkfma(P23, Rw[c][0].zw, t23); P45 = pkfma(P45, Rw[c][1].xy, t45); P67 = pkfma(P67, Rw[c][1].zw, t67);
                    if (s >= 1) { if (s - 1 < 8) YSHIFT(yk0); else if (s - 1 < 16) YSHIFT(yk1); else if (s - 1 < 24) YSHIFT(yk2); else YSHIFT(yk3); }
                    x = x * si;
                    f32x2 x2; x2.x = x; asm volatile("" : "+v"(x2));
                    P01 = pknfma_bl(x2, Rka[c][0].xy, P01); P23 = pknfma_bl(x2, Rka[c][0].zw, P23); P45 = pknfma_bl(x2, Rka[c][1].xy, P45); P67 = pknfma_bl(x2, Rka[c][1].zw, P67);
                    f32x2 py = pkmul(P01, Rr[c][0].xy); py = pkfma(P23, Rr[c][0].zw, py); py = pkfma(P45, Rr[c][1].xy, py); py = pkfma(P67, Rr[c][1].zw, py);
                    yp = py.x + py.y;
                }
                yp = dpp_add<0xB1>(yp); yp = dpp_add<0x4E>(yp); yp = dpp_add<0x141>(yp); YSHIFT(yk3);
                yyp[(7 - j) * 32] = yk0; yyp[(15 - j) * 32] = yk1; yyp[(23 - j) * 32] = yk2; yyp[(31 - j) * 32] = yk3;
#undef LOADREC
#undef YSHIFT
            }
            SCAN_BAR;
        }
        if (pass == 0) { *(f32x4*)stp = (f32x4){P01.x, P01.y, P23.x, P23.y}; *(f32x4*)(stp + 4) = (f32x4){P45.x, P45.y, P67.x, P67.y}; }
    } else {
        const int pw = wave - 4, tt = pw >> 1, kh = pw & 1;
        bf16x8 aWc[2][2], aAc[2][2];
#pragma unroll
        for (int kt = 0; kt < 2; ++kt)
#pragma unroll
            for (int ks = 0; ks < 2; ++ks) { const size_t o = (size_t)(colg + 32 * kh + 16 * kt + fr) * 64 + 32 * ks + 8 * fq; aWc[kt][ks] = *(const bf16x8*)((const bf16_t*)(WSP + WS_W2T) + o); aAc[kt][ks] = *(const bf16x8*)((const bf16_t*)(WSP + WS_A2T) + o); }
        bf16x8 lwf[2][2], laf[2][2]; u32x2 r2[2][2], k2[2][2];
#define ISSUE(SET, tbx) do { const size_t tok_ = rowb + (tbx) * 32 + 16 * tt + fr; \
            _Pragma("unroll") for (int ks = 0; ks < 2; ++ks) { lwf[SET][ks] = *(const bf16x8*)(LWb + tok_ * 64 + 32 * ks + 8 * fq); laf[SET][ks] = *(const bf16x8*)(LAb + tok_ * 64 + 32 * ks + 8 * fq); } \
            _Pragma("unroll") for (int kt = 0; kt < 2; ++kt) { r2[SET][kt] = *(const u32x2*)(Rb + tok_ * 2048 + colg + 32 * kh + 16 * kt + 4 * fq); k2[SET][kt] = *(const u32x2*)(Kb + tok_ * 2048 + colg + 32 * kh + 16 * kt + 4 * fq); } } while (0)
        ISSUE(0, 0); ISSUE(1, 1);
        const int t = lane >> 1, hf = lane & 1;
        const size_t vgo = (size_t)colg + 32 * rh + 16 * hf;
        u32x4 v8a = (u32x4){0u, 0u, 0u, 0u}, v8b = v8a, g8a = v8a, g8b = v8a;
        if (pw == 2) { const size_t eo = (rowb + t) * 2048 + vgo; v8a = *(const u32x4*)(Vb + eo); v8b = *(const u32x4*)(Vb + eo + 8); g8a = *(const u32x4*)(Gb + eo); g8b = *(const u32x4*)(Gb + eo + 8); }
        unsigned long long gx[2] = {0ull, 0ull};
#define PROD_ITER(it, PS) do { \
            { const int tb = (it) + 1; \
              if (tb < 64) { \
                LAS float* rec = REC + (tb & 1) * REC_BUF + (16 * tt + fr) * RSTR + 32 * kh + 4 * fq; \
                float ss = 0.f, rkp = 0.f; \
                _Pragma("unroll") for (int kt = 0; kt < 2; ++kt) { \
                    f32x4 accW = (f32x4){0.f, 0.f, 0.f, 0.f}, accA = (f32x4){0.f, 0.f, 0.f, 0.f}; \
                    _Pragma("unroll") for (int ks = 0; ks < 2; ++ks) { accW = MFMA16(aWc[kt][ks], lwf[PS][ks], accW); accA = MFMA16(aAc[kt][ks], laf[PS][ks], accA); } \
                    const int kc = 32 * kh + 16 * kt + 4 * fq; \
                    const f32x4 w0v = *(const LAS f32x4*)(CST + kc), a0v = *(const LAS f32x4*)(CST + 64 + kc), kkc = *(const LAS f32x4*)(CST + 128 + kc), kac = *(const LAS f32x4*)(CST + 192 + kc), rkc = *(const LAS f32x4*)(CST + 256 + kc); \
                    const f32x4 r4 = bf4(r2[PS][kt]), k4 = bf4(k2[PS][kt]); \
                    f32x4 w4, a4; \
                    _Pragma("unroll") for (int e = 0; e < 4; ++e) { w4[e] = __expf(-0.60653066f * sigmf(accW[e] + w0v[e])); a4[e] = sigmf(accA[e] + a0v[e]); } \
                    const f32x4 kkr = k4 * kkc; ss += (kkr.x * kkr.x + kkr.y * kkr.y) + (kkr.z * kkr.z + kkr.w * kkr.w); \
                    const f32x4 km = k4 * (1.0f + (a4 - 1.0f) * kac); const f32x4 rr = r4 * km * rkc; rkp += (rr.x + rr.y) + (rr.z + rr.w); \
                    *(LAS f32x4*)(rec + 16 * kt) = kkr; *(LAS f32x4*)(rec + REC_ARR + 16 * kt) = w4; *(LAS f32x4*)(rec + 2 * REC_ARR + 16 * kt) = kkr * a4; *(LAS f32x4*)(rec + 3 * REC_ARR + 16 * kt) = km; *(LAS f32x4*)(rec + 4 * REC_ARR + 16 * kt) = r4; \
                } \
                if (tb + 2 < 64) ISSUE(PS, tb + 2); \
                ss += __shfl_xor(ss, 16); ss += __shfl_xor(ss, 32); rkp += __shfl_xor(rkp, 16); rkp += __shfl_xor(rkp, 32); \
                if (fq == 0) { SSP[(tb & 1) * 64 + 2 * (16 * tt + fr) + kh] = ss; RKP[(tb & 3) * 64 + 2 * (16 * tt + fr) + kh] = rkp; } \
              } \
              if (pw == 2 && tb < 64) { \
                LAS float* vp = VV + (tb & 3) * 1024 + t * 32 + 16 * hf; LAS float* gp = GG + (tb & 3) * 1024 + t * 32 + 16 * hf; \
                *(LAS f32x4*)(vp) = bf4((u32x2){v8a.x, v8a.y}); *(LAS f32x4*)(vp + 4) = bf4((u32x2){v8a.z, v8a.w}); *(LAS f32x4*)(vp + 8) = bf4((u32x2){v8b.x, v8b.y}); *(LAS f32x4*)(vp + 12) = bf4((u32x2){v8b.z, v8b.w}); \
                *(LAS f32x4*)(gp) = bf4((u32x2){g8a.x, g8a.y}); *(LAS f32x4*)(gp + 4) = bf4((u32x2){g8a.z, g8a.w}); *(LAS f32x4*)(gp + 8) = bf4((u32x2){g8b.x, g8b.y}); *(LAS f32x4*)(gp + 12) = bf4((u32x2){g8b.z, g8b.w}); \
                if (tb + 1 < 64) { const size_t eo = (rowb + (tb + 1) * 32 + t) * 2048 + vgo; v8a = *(const u32x4*)(Vb + eo); v8b = *(const u32x4*)(Vb + eo + 8); g8a = *(const u32x4*)(Gb + eo); g8b = *(const u32x4*)(Gb + eo + 8); } \
              } \
            } \
            if (pw == 3) { \
              if ((it) >= 2 && (it) <= 65) { const int tb = (it) - 2; const unsigned long long* g = GR + ((size_t)(pi * 8 + (tb & 7)) * 2) * 64 + lane; \
                gx[0] = __hip_atomic_load(g, __ATOMIC_RELAXED, __HIP_MEMORY_SCOPE_AGENT); gx[1] = __hip_atomic_load(g + 64, __ATOMIC_RELAXED, __HIP_MEMORY_SCOPE_AGENT); } \
              if ((it) >= 1 && (it) <= 64) { const int tb = (it) - 1; const LAS float* yp_ = YY + (tb & 3) * 1024 + t * 32 + 16 * hf; float s1 = 0.f, s2 = 0.f; \
                _Pragma("unroll") for (int qd = 0; qd < 4; ++qd) { const f32x4 a = *(const LAS f32x4*)(yp_ + 4 * qd); s1 += (a.x + a.y) + (a.z + a.w); s2 += (a.x * a.x + a.y * a.y) + (a.z * a.z + a.w * a.w); } \
                s1 = dpp_add<0xB1>(s1); s2 = dpp_add<0xB1>(s2); \
                const unsigned epoch = (unsigned)(pass * 64 + tb + 1); \
                __hip_atomic_store(GR + ((size_t)((pi * 8 + (tb & 7)) * 2 + rh) * 64 + hf * 32 + t), ((unsigned long long)epoch << 32) | (unsigned long long)__float_as_uint(hf ? s2 : s1), __ATOMIC_RELAXED, __HIP_MEMORY_SCOPE_AGENT); } \
              if ((it) >= 2 && (it) <= 65) { const int tb = (it) - 2; const unsigned epoch = (unsigned)(pass * 64 + tb + 1); \
                const unsigned long long* g = GR + ((size_t)(pi * 8 + (tb & 7)) * 2) * 64 + lane; float tot; \
                for (unsigned spins = 0;; ++spins) { const bool ok = ((unsigned)(gx[0] >> 32) == epoch) && ((unsigned)(gx[1] >> 32) == epoch); tot = __uint_as_float((unsigned)gx[0]) + __uint_as_float((unsigned)gx[1]); \
                    if (__all(ok) || spins > (1u << 22)) break; \
                    __builtin_amdgcn_s_sleep(1); \
                    gx[0] = __hip_atomic_load(g, __ATOMIC_RELAXED, __HIP_MEMORY_SCOPE_AGENT); gx[1] = __hip_atomic_load(g + 64, __ATOMIC_RELAXED, __HIP_MEMORY_SCOPE_AGENT); } \
                const float oth = __shfl_xor(tot, 32); \
                const float mean = (lane < 32 ? tot : oth) * (1.0f / 64.0f), ex2 = (lane < 32 ? oth : tot) * (1.0f / 64.0f); \
                const float rstd = rsqrtf(fmaxf(ex2 - mean * mean, 0.f) + 64e-5f); \
                if (lane < 32) { STT[2 * lane] = mean; STT[2 * lane + 1] = rstd; } \
                const float mu = STT[2 * t], rsd = STT[2 * t + 1]; \
                const int ro = (tb & 3) * 1024 + t * 32 + 16 * hf; const float rk = RKP[(tb & 3) * 64 + 2 * t] + RKP[(tb & 3) * 64 + 2 * t + 1]; \
                unsigned ow[8]; \
                _Pragma("unroll") for (int qd = 0; qd < 4; ++qd) { const f32x4 lg = *(const LAS f32x4*)(CST + 320 + 32 * rh + 16 * hf + 4 * qd), lb = *(const LAS f32x4*)(CST + 384 + 32 * rh + 16 * hf + 4 * qd); \
                    const f32x4 o = ((*(const LAS f32x4*)(YY + ro + 4 * qd) - mu) * rsd * lg + lb + rk * *(const LAS f32x4*)(VV + ro + 4 * qd)) * *(const LAS f32x4*)(GG + ro + 4 * qd); \
                    ow[2 * qd] = pk2(o.x, o.y); ow[2 * qd + 1] = pk2(o.z, o.w); } \
                bf16_t* dst = (bf16_t*)(WSP + WS_A2) + ((size_t)pass * PROWS + rowb + tb * 32 + t) * 2048 + vgo; \
                *(u32x4*)(dst) = (u32x4){ow[0], ow[1], ow[2], ow[3]}; *(u32x4*)(dst + 8) = (u32x4){ow[4], ow[5], ow[6], ow[7]}; } \
            } \
            SCAN_BAR; } while (0)
        for (int it2 = -1; it2 < 65; it2 += 2) { PROD_ITER(it2, 0); PROD_ITER(it2 + 1, 1); }
        PROD_ITER(65, 0);
#undef PROD_ITER
#undef ISSUE
    }
}
__device__ __forceinline__ void p10_final(const Params& p, int G, int bid) {
    OPQ_TID; const int gw = bid * 8 + wave, ngw = G * 8;
    for (int m = gw; m < T; m += ngw) { float* xr = ((float*)p.out) + (size_t)m * D; f32x4 v[4]; float s = 0.f;
#pragma unroll
        for (int j = 0; j < 4; ++j) { v[j] = *((const f32x4*)xr + lane + 64 * j); s += (v[j].x * v[j].x + v[j].y * v[j].y) + (v[j].z * v[j].z + v[j].w * v[j].w); }
        const float rs = rsqrtf(wave_sum(s) * (1.0f / 1024.0f) + 1e-6f);
#pragma unroll
        for (int j = 0; j < 4; ++j) { const f32x4 gg = *((const f32x4*)((const float*)p.in[I_FG]) + lane + 64 * j); *((f32x4*)xr + lane + 64 * j) = v[j] * rs * gg; } }
}

#define XB_TMO      128
#define XB_XCNT(j)  (256  + 64 * (j))
#define XB_XSUB(j)  (1280 + 64 * (j))
#define XB_XGEN(j)  (2304 + 64 * (j))
#define XB_TOP      3328
#define XB_TOPGEN   3392
#define XCD_BAR_WORDS 3456
#define XB_SPIN_CAP (1u << 18)

__device__ __forceinline__ unsigned xb_ld(unsigned* p)              { return __hip_atomic_load(p, __ATOMIC_RELAXED, __HIP_MEMORY_SCOPE_AGENT); }
__device__ __forceinline__ unsigned xb_add(unsigned* p, unsigned v) { return __hip_atomic_fetch_add(p, v, __ATOMIC_RELAXED, __HIP_MEMORY_SCOPE_AGENT); }
__device__ __forceinline__ unsigned xb_xcc_id() { return (unsigned)__builtin_amdgcn_s_getreg((3 << 11) | 20) & 0xFu; }
#define XB_SPIN(cond, bar) do { unsigned _sp = 0; while (cond) { __builtin_amdgcn_s_sleep(1); \
    if ((++_sp & 255u) == 0u) { if (xb_ld(&(bar)[XB_TMO])) break; if (_sp > XB_SPIN_CAP) { atomicAdd(&(bar)[XB_TMO], 1u); break; } } } } while (0)

struct XcdBarrier {
    unsigned* bar; unsigned x;
    volatile LAS unsigned* st;
};

__device__ __forceinline__ XcdBarrier xcd_barrier_post(unsigned* bar, volatile LAS unsigned* st) {
    XcdBarrier b; b.bar = bar; b.x = xb_xcc_id(); b.st = st;
    if (threadIdx.x == 0) (void)xb_add(&bar[XB_XCNT(b.x)], 1u);
    return b;
}
__device__ __forceinline__ void xcd_barrier_complete(unsigned* bar, unsigned x, unsigned& nloc, unsigned& nx) {
    const unsigned G = gridDim.x * gridDim.y * gridDim.z;
    unsigned sum, cnt, mine, sp = 0u;
    for (;;) {
        sum = 0u; cnt = 0u; mine = 0u;
#pragma unroll
        for (unsigned j = 0; j < 16; ++j) { const unsigned c = xb_ld(&bar[XB_XCNT(j)]); sum += c; cnt += (c > 0u) ? 1u : 0u; mine = (j == x) ? c : mine; }
        if (sum == G) break;
        __builtin_amdgcn_s_sleep(1);
        if ((++sp & 255u) == 0u) { if (xb_ld(&bar[XB_TMO])) break; if (sp > XB_SPIN_CAP) { atomicAdd(&bar[XB_TMO], 1u); break; } }
    }
    nloc = mine > 0u ? mine : 1u; nx = cnt > 0u ? cnt : 1u;
}

__device__ __forceinline__ void xcd_barrier(const XcdBarrier& b) {
    asm volatile("s_waitcnt vmcnt(0)" ::: "memory");
    __syncthreads();
    if (threadIdx.x == 0) {
        unsigned* bar = (unsigned*)(*(volatile LAS unsigned long long*)(b.st + 4)); const unsigned bx_ = xb_xcc_id();
        __builtin_amdgcn_s_waitcnt(0);
        unsigned nloc = b.st[0], nx = b.st[1];
        if (nloc == 0u) { xcd_barrier_complete(bar, bx_, nloc, nx); b.st[0] = nloc; b.st[1] = nx; }
        const unsigned old = xb_add(&bar[XB_XSUB(bx_)], 1u);
        const unsigned gen = old / nloc;
        if (old + 1u == (gen + 1u) * nloc) {
            __builtin_amdgcn_fence(__ATOMIC_RELEASE, "agent");
            asm volatile("s_waitcnt vmcnt(0)" ::: "memory");
            const unsigned og = xb_add(&bar[XB_TOP], 1u);
            const unsigned tg = og / nx;
            if (og + 1u == (tg + 1u) * nx) xb_add(&bar[XB_TOPGEN], 1u);
            else XB_SPIN(xb_ld(&bar[XB_TOPGEN]) == tg, bar);
            __builtin_amdgcn_fence(__ATOMIC_ACQUIRE, "agent");
            xb_add(&bar[XB_XGEN(bx_)], 1u);
            asm volatile("s_waitcnt vmcnt(0)" ::: "memory");
        } else {
            XB_SPIN(xb_ld(&bar[XB_XGEN(bx_)]) == gen, bar);
            __builtin_amdgcn_fence(__ATOMIC_ACQUIRE, "agent");
            asm volatile("s_waitcnt vmcnt(0)" ::: "memory");
        }
    }
    __syncthreads();
}

__global__ void __launch_bounds__(NT, 2) mk_fwd(Params p) {
    auto wsl = [&]() { return launder_ws(((unsigned char*)p.ws)); };
    extern __shared__ __attribute__((aligned(16))) unsigned char lds_raw[];
    LAS unsigned char* lds = (LAS unsigned char*)lds_raw;
    cg::grid_group grid = cg::this_grid();
    const int G = gridDim.x, bid = blockIdx.x;
    if (threadIdx.x < 16) ((LAS unsigned*)(lds + LDS_MISC))[threadIdx.x] = 0u;
    __syncthreads();
    if (threadIdx.x == 0) *(LAS unsigned long long*)(lds + LDS_MISC + 16) = (unsigned long long)(((unsigned char*)p.ws) + WS_BAR);
    __syncthreads();
    (void)xcd_barrier_post((unsigned*)(((unsigned char*)p.ws) + WS_BAR), (volatile LAS unsigned*)(lds + LDS_MISC));
#define XBAR() do { XcdBarrier xb_; xb_.bar = nullptr; xb_.x = 0u; xb_.st = (volatile LAS unsigned*)(lds + LDS_MISC); xcd_barrier(xb_); } while (0)
#if PROBE == 7
    p0_prologue(p, lds, G, bid);
#endif
    p0_prologue(p, lds, G, bid);
    grid.sync();
    { pg8::Gemm g{(const bf16_t*)((float*)p.out), (const bf16_t*)(wsl() + WS_WIN), T, ZW, D, D}; pg8::StaticOrder S; S.init(T, ZW, G, bid); pg8::EpiBf16 E{(bf16_t*)(wsl() + WS_Z), ZW};
      pg8::gemm_phase<pg8::EpiBf16, pg8::StaticOrder, true, true>(lds, g, S, E); }
    XBAR();
#if PROBE == 3
    { u32x4 pre[3]; if (bid < 2048) rg_a_prefetch((const bf16_t*)(wsl() + WS_Z), bid, threadIdx.x, pre); for (int u = bid; u < 2048; u += G) rg_a_unit(p, lds, u, u + G, pre); }
    { u32x4 pre[6]; if (bid < 2048) hg_a_prefetch((const bf16_t*)(wsl() + WS_Z), bid, threadIdx.x, pre); for (int u = bid; u < 2048; u += G) hg_a_unit(p, lds, u, u + G, pre); }
    XBAR();
#endif
    { u32x4 pre[3]; if (bid < 2048) rg_a_prefetch((const bf16_t*)(wsl() + WS_Z), bid, threadIdx.x, pre); for (int u = bid; u < 2048; u += G) rg_a_unit(p, lds, u, u + G, pre); }
    { u32x4 pre[6]; if (bid < 2048) hg_a_prefetch((const bf16_t*)(wsl() + WS_Z), bid, threadIdx.x, pre); for (int u = bid; u < 2048; u += G) hg_a_unit(p, lds, u, u + G, pre); }
    XBAR();
#if PROBE == 2
    for (int u = bid; u < 256; u += G) hg_b_item(p, lds, u, p.dry != 0);
    XBAR();
#endif
#if PROBE == 6
    for (int u = bid; u < 512; u += G) rg_b_unit(p, u);
    XBAR();
#endif
#if PROBE == 4
    for (int q = 0; q < 16; ++q) XBAR();
#endif
    for (int u = bid; u < 256; u += G) { const int it_ = (G == 256) ? ((((u & 7) + 8 * (u >> 6)) << 3) | ((u >> 3) & 7)) : u; hg_b_item(p, lds, it_); }
    for (int u = bid; u < 512; u += G) rg_b_unit(p, u);
    XBAR();
#if PROBE == 8
    p4_finalize(p, G, bid);
#endif
    p4_finalize(p, G, bid);
    XBAR();
    { pg8::Gemm g{(const bf16_t*)(wsl() + WS_Z), (const bf16_t*)(wsl() + WS_WOUT), T, D, 2048, ZW}; pg8::StaticOrder S; S.init(T, D, G, bid); pg8::EpiResF32 E{((const float*)p.in[I_X]), ((float*)p.out), D, 0, 0};
      pg8::gemm_phase<pg8::EpiResF32, pg8::StaticOrder, true, true>(lds, g, S, E); }
    XBAR();
#if PROBE == 9
    p6_prologue(p, lds, G, bid);
#endif
    p6_prologue(p, lds, G, bid);
    XBAR();
#pragma unroll 1
    for (int pass = 0; pass < 2; ++pass) {
        { const int N = pass ? 8192 : 8448; pg8::Gemm g{(const bf16_t*)(wsl() + WS_A2) + (size_t)pass * 8192 * 2048, (const bf16_t*)(wsl() + WS_WC), 8192, N, 2048, 2048}; pg8::LoraOrder S; S.init(8192, N, G, bid, pass ? 0 : 32);
          pg8::EpiL1 E{(bf16_t*)(wsl() + WS_R), (bf16_t*)(wsl() + WS_LW) + (size_t)pass * 8192 * 64, (bf16_t*)(wsl() + WS_LA) + (size_t)pass * 8192 * 64};
          pg8::gemm_phase<pg8::EpiL1, pg8::LoraOrder, true, true>(lds, g, S, E); }
        XBAR();
        for (int u0 = 0; u0 < 256; u0 += G) { const int u = u0 + bid; if (u < 256) { int pi, rh; if (G == 256) { pi = (u & 7) + 8 * (u >> 4); rh = (u >> 3) & 1; } else { pi = u >> 1; rh = u & 1; } scan_half(p, lds, pi, rh, pass); } }
        XBAR();
    }
    if (G == 256) {
        pg8::Gemm g{(const bf16_t*)(wsl() + WS_A2), (const bf16_t*)(wsl() + WS_WO), T, D, 2048, 2048}; pg8::StaticOrder S; S.init(T, D, G, bid); pg8::EpiFinalNorm E{((float*)p.out), ((const float*)p.in[I_FG]), (unsigned long long*)(wsl() + WS_XG), D};
        pg8::gemm_phase<pg8::EpiFinalNorm, pg8::StaticOrder, false, true>(lds, g, S, E);
    } else {
        { pg8::Gemm g{(const bf16_t*)(wsl() + WS_A2), (const bf16_t*)(wsl() + WS_WO), T, D, 2048, 2048}; pg8::StaticOrder S; S.init(T, D, G, bid); pg8::EpiResF32 E{((float*)p.out), ((float*)p.out), D, 1, 0};
          pg8::gemm_phase<pg8::EpiResF32, pg8::StaticOrder, true, true>(lds, g, S, E); }
        XBAR();
        p10_final(p, G, bid);
    }
}

extern "C" void kernel_launch(void* const* d_in, const int* in_sizes, int n_in, void* d_out, int out_size, void* d_ws, size_t ws_size, hipStream_t stream) {
    static int grid = 0;
    if (grid == 0) {
        int dev = 0, cus = 0, per_cu = 0;
        if (n_in != 32 || out_size != T * D || ws_size < 256 * MiB) { fprintf(stderr, "kernel_launch: unexpected shapes (n_in %d out %d ws %zu)\n", n_in, out_size, ws_size); grid = -1; return; }
        if (hipGetDevice(&dev) != hipSuccess || hipDeviceGetAttribute(&cus, hipDeviceAttributeMultiprocessorCount, dev) != hipSuccess) { grid = -1; return; }
        if (hipFuncSetAttribute((const void*)mk_fwd, hipFuncAttributeMaxDynamicSharedMemorySize, LDS_BYTES) != hipSuccess) { fprintf(stderr, "hipFuncSetAttribute failed\n"); grid = -1; return; }
        if (hipOccupancyMaxActiveBlocksPerMultiprocessor(&per_cu, (const void*)mk_fwd, NT, LDS_BYTES) != hipSuccess || per_cu < 1) fprintf(stderr, "occupancy query: %d\n", per_cu);
        (void)hipGetLastError();
        grid = cus;
    }
    if (grid < 0) return;
    if (hipMemsetAsync((char*)d_ws + WS_BAR, 0, 16384, stream) != hipSuccess) { fprintf(stderr, "memset failed\n"); return; }
    Params p{};
    p.dry = 1;
    for (int i = 0; i < 32; ++i) memcpy(&p.in[i], &d_in[i], sizeof(void*));
    memcpy(&p.out, &d_out, sizeof(void*)); memcpy(&p.ws, &d_ws, sizeof(void*));
    void* args[] = {&p};
    hipError_t e = hipLaunchCooperativeKernel((const void*)mk_fwd, dim3(grid), dim3(NT), args, LDS_BYTES, stream);
    if (e != hipSuccess) fprintf(stderr, "cooperative launch failed: %s (grid %d)\n", hipGetErrorString(e), grid);
}
```

```cpp
#define PROBE 0
#include <hip/hip_runtime.h>
#include <hip/hip_cooperative_groups.h>
#include <cstdio>
#include <cstring>
#include <cstdint>
namespace cg = cooperative_groups;
namespace pg8 {
#define PG8_LAS __attribute__((address_space(3)))
typedef unsigned short bf16_t;
typedef short bf16x8 __attribute__((ext_vector_type(8)));
typedef float f32x4 __attribute__((ext_vector_type(4)));
typedef unsigned u32x4 __attribute__((ext_vector_type(4)));
constexpr int BM = 256, BK = 64, HALF = 128, HTB = HALF * BK * 2  , STAGE_BYTES = 8 * HTB, NXCD = 8, WGM = 8;

__host__ __device__ __forceinline__ int lds_byte(int r, int c) { const int st = (r >> 4) * 2 + (c >> 5), rr = r & 15, cc = c & 31, ob = rr * 64 + cc * 2; return st * 1024 + (ob ^ (((ob >> 9) & 1) << 5)); }
__host__ __device__ __forceinline__ void stage_rc(int b, int& R, int& C) { const int st = b / 1024, sb = b % 1024, swz = sb ^ (((sb >> 9) & 1) << 5); R = (st >> 1) * 16 + swz / 64; C = (st & 1) * 32 + (swz % 64) / 2; }
__host__ __device__ __forceinline__ int perm32(int rho) { const int n = rho >> 4, i = rho & 15; return 8 * (i >> 2) + 4 * n + (i & 3); }

struct Unit { int pm, pn; };
struct Gemm { const bf16_t* A; const bf16_t* Bt; int M, N, K, lda; };

struct StaticOrder {
    int nM, nN, nwg, G, c;
    __host__ __device__ void init(int M, int N, int G_, int c_) { nM = M / BM; nN = N / BM; nwg = nM * nN; G = G_; c = c_; }
    __host__ __device__ bool next(int i, Unit& u) const {
        const long L = (long)i * G + c; if (L >= nwg) return false;
        int wgid = (int)L; { const int q = nwg / NXCD, r = nwg % NXCD, xcd = wgid % NXCD, off = wgid / NXCD; wgid = (xcd < r ? xcd * (q + 1) : r * (q + 1) + (xcd - r) * q) + off; }
        const int nig = WGM * nN, gid = wgid / nig, fm = gid * WGM, gsz = (nM - fm) < WGM ? (nM - fm) : WGM;
        u.pm = fm + ((wgid % nig) % gsz); u.pn = (wgid % nig) / gsz; return true;
    }
    __device__ __forceinline__ void a_ready(const Unit&) const {}
    __device__ __forceinline__ void done(const Unit&) const {}
};


struct LoraOrder {
    StaticOrder so; int extra;
    __host__ __device__ void init(int M, int N, int G_, int c_, int extra_) { so.init(M, N, G_, c_); extra = extra_; }
    __host__ __device__ bool next(int i, Unit& u) const { const long L = (long)i * so.G + so.c; if (L < so.nwg) return so.next(i, u); if (L >= so.nwg + extra) return false; u.pm = so.nM + (int)(L - so.nwg); u.pn = so.nN - 1; return true; }
    __device__ __forceinline__ void a_ready(const Unit&) const {}
    __device__ __forceinline__ void done(const Unit&) const {}
};
__device__ __forceinline__ unsigned cvt_pk_bf16(float lo, float hi) { unsigned r; asm volatile("v_cvt_pk_bf16_f32 %0, %1, %2" : "=v"(r) : "v"(lo), "v"(hi)); return r; }
__device__ __forceinline__ float sigm(float x) { return __builtin_amdgcn_rcpf(1.0f + __expf(-x)); }
struct EpiBf16 {
    static constexpr bool PERM = true, AFTER_DRAIN = false;
    bf16_t* O; int ldc;
    __device__ __forceinline__ void operator()(const f32x4 (&acc)[2][2][4][2], const Unit& u, int wr, int wc, int fr, int fq) const {
        const int row0 = u.pm * BM + wr * 64 + fr; const int col0 = u.pn * BM + wc * 32 + 8 * fq;
#pragma unroll
        for (int ai = 0; ai < 2; ++ai)
#pragma unroll
            for (int m = 0; m < 4; ++m) { bf16_t* rowp = O + (size_t)(row0 + ai * HALF + m * 16) * ldc + col0;
#pragma unroll
                for (int bj = 0; bj < 2; ++bj) { const f32x4 v0 = acc[ai][bj][m][0], v1 = acc[ai][bj][m][1];
                    u32x4 w; w.x = cvt_pk_bf16(v0[0], v0[1]); w.y = cvt_pk_bf16(v0[2], v0[3]); w.z = cvt_pk_bf16(v1[0], v1[1]); w.w = cvt_pk_bf16(v1[2], v1[3]);
                    *(u32x4*)(rowp + bj * HALF) = w; } }
    }
};
struct EpiResF32 {
    static constexpr bool PERM = false, AFTER_DRAIN = false;
    const float* base; float* out; int ldc; int remap; int pass;
    __device__ __forceinline__ void operator()(const f32x4 (&acc)[2][2][4][2], const Unit& u, int wr, int wc, int fr, int fq) const {
        const int col0 = u.pn * BM + wc * 32 + 4 * fq; const int rbase = remap ? ((((u.pm >> 3) & 3) << 12) + (u.pm >> 5) * 2048 + (u.pm & 7) * BM) : u.pm * BM;
#pragma unroll
        for (int ai = 0; ai < 2; ++ai)
#pragma unroll
            for (int m = 0; m < 4; ++m) { const size_t off = (size_t)(rbase + ai * HALF + wr * 64 + m * 16 + fr) * ldc + col0;
#pragma unroll
                for (int bj = 0; bj < 2; ++bj)
#pragma unroll
                    for (int n = 0; n < 2; ++n) { const f32x4 bs = *(const f32x4*)(base + off + bj * HALF + n * 16); *(f32x4*)(out + off + bj * HALF + n * 16) = bs + acc[ai][bj][m][n]; } }
    }
};
struct EpiL1 {
    static constexpr bool PERM = true, AFTER_DRAIN = false;
    bf16_t* R; bf16_t* LW; bf16_t* LA;
    __device__ __forceinline__ void operator()(const f32x4 (&acc)[2][2][4][2], const Unit& u, int wr, int wc, int fr, int fq) const {
        const int row0 = u.pm * BM + wr * 64 + fr;
        if (u.pn < 32) {
            const int buf = u.pn >> 3; bf16_t* base = R + (size_t)buf * (8192u * 2048u); const int col0 = (u.pn & 7) * BM + wc * 32 + 8 * fq;
#pragma unroll
            for (int ai = 0; ai < 2; ++ai)
#pragma unroll
                for (int m = 0; m < 4; ++m) { bf16_t* rowp = base + (size_t)(row0 + ai * HALF + m * 16) * 2048 + col0;
#pragma unroll
                    for (int bj = 0; bj < 2; ++bj) { f32x4 v0 = acc[ai][bj][m][0], v1 = acc[ai][bj][m][1];
                        if (buf == 3) {
#pragma unroll
                            for (int q = 0; q < 4; ++q) { v0[q] = v0[q] * sigm(v0[q]); v1[q] = v1[q] * sigm(v1[q]); } }
                        u32x4 w; w.x = cvt_pk_bf16(v0[0], v0[1]); w.y = cvt_pk_bf16(v0[2], v0[3]); w.z = cvt_pk_bf16(v1[0], v1[1]); w.w = cvt_pk_bf16(v1[2], v1[3]);
                        *(u32x4*)(rowp + bj * HALF) = w; } }
        } else {
            const int c0 = wc * 32 + 8 * fq;
#pragma unroll
            for (int ai = 0; ai < 2; ++ai)
#pragma unroll
                for (int m = 0; m < 4; ++m) { const size_t row = (size_t)(row0 + ai * HALF + m * 16); f32x4 v0 = acc[ai][0][m][0], v1 = acc[ai][0][m][1];
                    if (c0 < 64) {
#pragma unroll
                        for (int q = 0; q < 4; ++q) { v0[q] = tanhf(v0[q]); v1[q] = tanhf(v1[q]); } }
                    u32x4 w; w.x = cvt_pk_bf16(v0[0], v0[1]); w.y = cvt_pk_bf16(v0[2], v0[3]); w.z = cvt_pk_bf16(v1[0], v1[1]); w.w = cvt_pk_bf16(v1[2], v1[3]);
                    if (c0 < 64) *(u32x4*)(LW + row * 64 + c0) = w; else *(u32x4*)(LA + row * 64 + c0 - 64) = w; }
        }
    }
};

struct EpiFinalNorm {
    static constexpr bool PERM = false, AFTER_DRAIN = true;
    float* out; const float* g; unsigned long long* xg; int ldc;
    __device__ __forceinline__ void fused(f32x4 (&acc)[2][2][4][2], const Unit& u, int wr, int wc, int fr, int fq, PG8_LAS unsigned char* lds, int wid, int lane) const {
        PG8_LAS float* P = (PG8_LAS float*)lds; PG8_LAS float* S = (PG8_LAS float*)(lds + 4096);
        const int col0 = u.pn * BM + wc * 32 + 4 * fq; const int rbase = (((u.pm >> 3) & 3) << 12) + (u.pm >> 5) * 2048 + (u.pm & 7) * BM;
#pragma unroll
        for (int ai = 0; ai < 2; ++ai)
#pragma unroll
            for (int m = 0; m < 4; ++m) { const size_t off = (size_t)(rbase + ai * HALF + wr * 64 + m * 16 + fr) * ldc + col0; float s = 0.f;
#pragma unroll
                for (int bj = 0; bj < 2; ++bj)
#pragma unroll
                    for (int n = 0; n < 2; ++n) { const f32x4 v = acc[ai][bj][m][n] + *(const f32x4*)(out + off + bj * HALF + n * 16); acc[ai][bj][m][n] = v; s += (v[0] * v[0] + v[1] * v[1]) + (v[2] * v[2] + v[3] * v[3]); }
                s += __shfl_xor(s, 16); s += __shfl_xor(s, 32);
                if (fq == 0) P[(ai * HALF + wr * 64 + m * 16 + fr) * 4 + wc] = s; }
        asm volatile("s_waitcnt lgkmcnt(0)" ::: "memory"); __builtin_amdgcn_s_barrier(); asm volatile("" ::: "memory");
        const int row = wid * 32 + (lane & 31);
        if (lane < 32) { const float tot = (P[row * 4] + P[row * 4 + 1]) + (P[row * 4 + 2] + P[row * 4 + 3]);
            __hip_atomic_store(xg + ((size_t)(u.pm * 4 + u.pn) * 256 + row), (1ull << 32) | (unsigned long long)__float_as_uint(tot), __ATOMIC_RELAXED, __HIP_MEMORY_SCOPE_AGENT); }
        {
            float tot = 0.f;
            for (unsigned spins = 0;; ++spins) { bool ok = true; tot = 0.f;
                if (lane < 32) {
#pragma unroll
                    for (int q = 0; q < 4; ++q) { const unsigned long long x = __hip_atomic_load(xg + ((size_t)(u.pm * 4 + q) * 256 + row), __ATOMIC_RELAXED, __HIP_MEMORY_SCOPE_AGENT); ok &= (unsigned)(x >> 32) == 1u; tot += __uint_as_float((unsigned)x); } }
                if (__all(ok) || spins > (1u << 22)) break;
                __builtin_amdgcn_s_sleep(1); }
            if (lane < 32) S[row] = rsqrtf(tot * (1.0f / 1024.0f) + 1e-6f);
        }
        asm volatile("s_waitcnt lgkmcnt(0)" ::: "memory"); __builtin_amdgcn_s_barrier(); asm volatile("" ::: "memory");
#pragma unroll
        for (int ai = 0; ai < 2; ++ai)
#pragma unroll
            for (int m = 0; m < 4; ++m) { const int r = ai * HALF + wr * 64 + m * 16 + fr; const float rs = S[r]; const size_t off = (size_t)(rbase + r) * ldc + col0;
#pragma unroll
                for (int bj = 0; bj < 2; ++bj)
#pragma unroll
                    for (int n = 0; n < 2; ++n) { const f32x4 gg = *(const f32x4*)(g + col0 + bj * HALF + n * 16); *(f32x4*)(out + off + bj * HALF + n * 16) = acc[ai][bj][m][n] * rs * gg; } }
    }
};
template <class Epi, class Sched, bool ALIGN_EPI = false, bool SP2 = false>
__device__ __forceinline__ void gemm_phase(PG8_LAS unsigned char* lds, const Gemm g, const Sched& S, const Epi& E) {
    int tid_o = threadIdx.x; asm volatile("" : "+v"(tid_o)); const int tid = tid_o, wid = __builtin_amdgcn_readfirstlane(tid >> 6), lane = tid & 63, wr = wid >> 2, wc = wid & 3, fr = lane & 15, fq = lane >> 4;
    const int K = g.K, nt = K / BK;
    unsigned voffA[2], voffB[2];
#pragma unroll
    for (int i = 0; i < 2; ++i) { int R, C; stage_rc(tid * 16 + i * 8192, R, C); const int Rb = Epi::PERM ? ((R & ~31) + perm32(R & 31)) : R;
        voffA[i] = (unsigned)(R * g.lda + C) * 2u; voffB[i] = (unsigned)(Rb * K + C) * 2u; }
    const size_t kstep = (size_t)(BK * 2);
    const size_t hstep = (size_t)HALF * K * 2;
    const size_t tstep = 2 * hstep; const size_t hstepA = (size_t)HALF * g.lda * 2, tstepA = 2 * hstepA;
    const unsigned ldsw = (unsigned)wid * 1024u;
    const int aoff = lds_byte(wr * 64 + fr, fq * 8), boff = lds_byte(wc * 32 + fr, fq * 8);
#define PG8_SA(b, h) (((b) * 2 + (h)) * HTB)
#define PG8_SB(b, h) ((4 + (b) * 2 + (h)) * HTB)
#define PG8_STAGE(bufoff, gbase, voff) do { _Pragma("unroll") for (int _i = 0; _i < 2; ++_i) \
        __builtin_amdgcn_global_load_lds((const unsigned*)((const char*)(gbase) + (voff)[_i]), (PG8_LAS unsigned*)(lds + (bufoff) + ldsw + _i * 8192), 16, 0, 0); } while (0)
#define PG8_LDA(dst, b, h) do { _Pragma("unroll") for (int m = 0; m < 4; ++m) _Pragma("unroll") for (int k = 0; k < 2; ++k) dst[m][k] = *(const PG8_LAS bf16x8*)(lds + PG8_SA(b, h) + aoff + m * 2048 + k * 1024); } while (0)
#define PG8_LDB(dst, b, h) do { _Pragma("unroll") for (int n = 0; n < 2; ++n) _Pragma("unroll") for (int k = 0; k < 2; ++k) dst[n][k] = *(const PG8_LAS bf16x8*)(lds + PG8_SB(b, h) + boff + n * 2048 + k * 1024); } while (0)
#define PG8_MMA(ai, bj, At, Bt) do { __builtin_amdgcn_s_setprio(1); _Pragma("unroll") for (int m = 0; m < 4; ++m) _Pragma("unroll") for (int n = 0; n < 2; ++n) _Pragma("unroll") for (int k = 0; k < 2; ++k) \
        acc[ai][bj][m][n] = __builtin_amdgcn_mfma_f32_16x16x32_bf16(Bt[n][k], At[m][k], acc[ai][bj][m][n], 0, 0, 0); __builtin_amdgcn_s_setprio(0); } while (0)
#define PG8_WAIT_V(n) asm volatile("s_waitcnt vmcnt(" #n ")" ::: "memory")
#define PG8_WAIT_L(n) asm volatile("s_waitcnt lgkmcnt(" #n ")" ::: "memory")
#define PG8_BAR __builtin_amdgcn_s_barrier()
#define PG8_SCHED __builtin_amdgcn_sched_barrier(0)
    Unit cur, nxt; int ui = 0;
    if (!S.next(0, cur)) return;
    f32x4 acc[2][2][4][2];
#pragma unroll
    for (int a = 0; a < 2; ++a)
#pragma unroll
        for (int b = 0; b < 2; ++b)
#pragma unroll
            for (int m = 0; m < 4; ++m)
#pragma unroll
                for (int n = 0; n < 2; ++n) acc[a][b][m][n] = (f32x4){0.f, 0.f, 0.f, 0.f};
    bf16x8 At[4][2], B0[2][2], B1[2][2];
    const char* cA = (const char*)g.A + (size_t)cur.pm * tstepA; const char* cB = (const char*)g.Bt + (size_t)cur.pn * tstep;
    S.a_ready(cur);
    if constexpr (SP2) {
        PG8_STAGE(PG8_SB(0, 0), cB, voffB); PG8_STAGE(PG8_SB(0, 1), cB + hstep, voffB); PG8_STAGE(PG8_SA(0, 0), cA, voffA); PG8_STAGE(PG8_SA(0, 1), cA + hstepA, voffA);
        if (wr == 1) PG8_BAR;
        PG8_WAIT_V(2); PG8_BAR;
        PG8_STAGE(PG8_SB(1, 0), cB + kstep, voffB); PG8_STAGE(PG8_SA(1, 0), cA + kstep, voffA); PG8_STAGE(PG8_SB(1, 1), cB + hstep + kstep, voffB);
        PG8_WAIT_V(6); PG8_BAR;
    } else {
        PG8_STAGE(PG8_SB(0, 0), cB, voffB); PG8_STAGE(PG8_SA(0, 0), cA, voffA); PG8_STAGE(PG8_SB(0, 1), cB + hstep, voffB); PG8_STAGE(PG8_SA(0, 1), cA + hstepA, voffA);
        if (wr == 1) PG8_BAR;
        PG8_WAIT_V(4); PG8_BAR;
        PG8_STAGE(PG8_SB(1, 0), cB + kstep, voffB); PG8_STAGE(PG8_SA(1, 0), cA + kstep, voffA); PG8_STAGE(PG8_SB(1, 1), cB + hstep + kstep, voffB);
        PG8_WAIT_V(6); PG8_BAR;
    }
    for (;;) {
        const bool has_next = S.next(ui + 1, nxt);
        const char* nA = has_next ? (const char*)g.A + (size_t)nxt.pm * tstepA : cA; const char* nB = has_next ? (const char*)g.Bt + (size_t)nxt.pn * tstep : cB;
        for (int t = 0; t < nt; t += 2) {
            const bool last = (t == nt - 2);
            const char* a1 = cA + (size_t)(t + 1) * kstep;
            const char* a2 = last ? nA : cA + (size_t)(t + 2) * kstep; const char* b2 = last ? nB : cB + (size_t)(t + 2) * kstep;
            const char* a3 = a2 + kstep; const char* b3 = b2 + kstep;
            if (last && has_next) S.a_ready(nxt);
            if constexpr (SP2) {
            PG8_LDB(B0, 0, 0); PG8_LDB(B1, 0, 1); PG8_SCHED; PG8_LDA(At, 0, 0); PG8_STAGE(PG8_SA(1, 1), a1 + hstepA, voffA);
            PG8_WAIT_V(8); PG8_WAIT_L(0); PG8_BAR; PG8_MMA(0, 0, At, B0); PG8_MMA(0, 1, At, B1); PG8_BAR; PG8_SCHED;
            PG8_LDA(At, 0, 1); PG8_STAGE(PG8_SB(0, 0), b2, voffB); PG8_STAGE(PG8_SB(0, 1), b2 + hstep, voffB); PG8_STAGE(PG8_SA(0, 0), a2, voffA);
            PG8_WAIT_V(8); PG8_WAIT_L(0); PG8_BAR; PG8_MMA(1, 0, At, B0); PG8_MMA(1, 1, At, B1); PG8_BAR; PG8_SCHED;
            PG8_LDB(B0, 1, 0); PG8_LDB(B1, 1, 1); PG8_SCHED; PG8_LDA(At, 1, 0); PG8_STAGE(PG8_SA(0, 1), a2 + hstepA, voffA);
            PG8_WAIT_V(8); PG8_WAIT_L(0); PG8_BAR; PG8_MMA(0, 0, At, B0); PG8_MMA(0, 1, At, B1); PG8_BAR; PG8_SCHED;
            PG8_LDA(At, 1, 1); PG8_STAGE(PG8_SB(1, 0), b3, voffB); PG8_STAGE(PG8_SB(1, 1), b3 + hstep, voffB); PG8_STAGE(PG8_SA(1, 0), a3, voffA);
            PG8_WAIT_V(8); PG8_WAIT_L(0); PG8_BAR; PG8_MMA(1, 0, At, B0); PG8_MMA(1, 1, At, B1); PG8_BAR; PG8_SCHED;
            } else {
            PG8_LDB(B0, 0, 0); PG8_SCHED; PG8_LDA(At, 0, 0); PG8_STAGE(PG8_SA(1, 1), a1 + hstepA, voffA);
            PG8_WAIT_L(8); PG8_BAR; PG8_WAIT_L(0); PG8_MMA(0, 0, At, B0); PG8_BAR; PG8_SCHED;
            PG8_LDB(B1, 0, 1); PG8_STAGE(PG8_SB(0, 0), b2, voffB);
            PG8_BAR; PG8_WAIT_L(0); PG8_MMA(0, 1, At, B1); PG8_BAR;
            PG8_LDA(At, 0, 1); PG8_STAGE(PG8_SA(0, 0), a2, voffA);
            PG8_BAR; PG8_WAIT_L(0); PG8_MMA(1, 0, At, B0); PG8_BAR; PG8_SCHED;
            PG8_STAGE(PG8_SB(0, 1), b2 + hstep, voffB);
            PG8_WAIT_V(6); PG8_BAR; PG8_MMA(1, 1, At, B1); PG8_BAR;
            PG8_LDB(B0, 1, 0); PG8_SCHED; PG8_LDA(At, 1, 0); PG8_STAGE(PG8_SA(0, 1), a2 + hstepA, voffA);
            PG8_WAIT_L(8); PG8_BAR; PG8_WAIT_L(0); PG8_MMA(0, 0, At, B0); PG8_BAR; PG8_SCHED;
            PG8_LDB(B1, 1, 1); PG8_STAGE(PG8_SB(1, 0), b3, voffB);
            PG8_BAR; PG8_WAIT_L(0); PG8_MMA(0, 1, At, B1); PG8_BAR;
            PG8_LDA(At, 1, 1); PG8_STAGE(PG8_SA(1, 0), a3, voffA);
            PG8_BAR; PG8_WAIT_L(0); PG8_MMA(1, 0, At, B0); PG8_BAR; PG8_SCHED;
            PG8_STAGE(PG8_SB(1, 1), b3 + hstep, voffB);
            PG8_WAIT_V(6); PG8_BAR; PG8_MMA(1, 1, At, B1); PG8_BAR;
            }
        }
        if constexpr (ALIGN_EPI) { if (wr == 0) PG8_BAR; }
        if constexpr (!Epi::AFTER_DRAIN) { E(acc, cur, wr, wc, fr, fq); S.done(cur); }
        if (!has_next) break;
#pragma unroll
        for (int a = 0; a < 2; ++a)
#pragma unroll
            for (int b = 0; b < 2; ++b)
#pragma unroll
                for (int m = 0; m < 4; ++m)
#pragma unroll
                    for (int n = 0; n < 2; ++n) acc[a][b][m][n] = (f32x4){0.f, 0.f, 0.f, 0.f};
        cur = nxt; cA = nA; cB = nB; ++ui;
        if constexpr (ALIGN_EPI) { if (wr == 1) PG8_BAR; }
    }
    PG8_WAIT_V(0);
    if constexpr (!ALIGN_EPI) { if (wr == 0) PG8_BAR; }
    PG8_BAR;
    if constexpr (Epi::AFTER_DRAIN) { E.fused(acc, cur, wr, wc, fr, fq, lds, wid, lane); S.done(cur); }
#undef PG8_SA
#undef PG8_SB
#undef PG8_STAGE
#undef PG8_LDA
#undef PG8_LDB
#undef PG8_MMA
#undef PG8_WAIT_V
#undef PG8_WAIT_L
#undef PG8_BAR
#undef PG8_SCHED
}
}
#define GAS __attribute__((address_space(1)))
#define LAS __attribute__((address_space(3)))
typedef unsigned short bf16_t;
typedef short bf16x8 __attribute__((ext_vector_type(8)));
typedef float f32x4 __attribute__((ext_vector_type(4)));
typedef unsigned u32x4 __attribute__((ext_vector_type(4)));
typedef unsigned u32x2 __attribute__((ext_vector_type(2)));
typedef float f32x2 __attribute__((ext_vector_type(2)));
constexpr int NT = 512, PROWS6 = 8192;
constexpr int T = 16384, SEQ = 4096, D = 1024, ZW = 6144;
constexpr size_t MiB = 1u << 20;
constexpr size_t WS_DEC = 0;
constexpr size_t WS_Z = 4 * MiB;
constexpr size_t WS_WIN = 196 * MiB, WS_WOUT = 208 * MiB, WS_RGA = 212 * MiB, WS_RGX = 212 * MiB + 256 * 1024;
constexpr size_t WS_OI = 213 * MiB;
constexpr size_t WS_A2 = 4 * MiB;
constexpr size_t WS_R = 68 * MiB;
constexpr size_t WS_V = 132 * MiB;
constexpr size_t WS_WC = 196 * MiB, WS_WO = 229 * MiB, WS_LW = 233 * MiB, WS_LA = 235 * MiB;
constexpr size_t WS_W2T = 237 * MiB, WS_A2T = 237 * MiB + 256 * 1024, WS_GR = 238 * MiB, WS_ST = 239 * MiB, WS_XG = 241 * MiB;
constexpr size_t WS_WL = 246 * MiB;
constexpr size_t WS_BAR = 2 * MiB;
constexpr int LDS_BYTES = 147456, LDS_MISC = 147456 - 64;

struct Params { const GAS float* in[32]; GAS float* out; GAS unsigned char* ws; long long dry; };
#ifndef PROBE
#define PROBE 0
#endif
enum { I_X = 0, I_ABG, I_WIN, I_CONVW, I_CONVB, I_RGWA, I_RGBA, I_RGWX, I_RGBX, I_LAM, I_LB, I_HGG, I_WOUT, I_CNG, I_MU, I_WR, I_WK, I_WV, I_WG, I_W0, I_W1, I_W2, I_A0, I_A1, I_A2, I_KK, I_KA, I_RK, I_LNG, I_LNB, I_WO, I_FG };

__device__ __forceinline__ unsigned f2bf(float f) { unsigned u = __float_as_uint(f); return (u + 0x7fffu + ((u >> 16) & 1u)) >> 16; }
__device__ __forceinline__ float bf2f(unsigned h) { return __uint_as_float(h << 16); }
__device__ __forceinline__ unsigned pk2(float lo, float hi) { return f2bf(lo) | (f2bf(hi) << 16); }
__device__ __forceinline__ float sigmf(float x) { return __builtin_amdgcn_rcpf(1.0f + __expf(-x)); }
__device__ __forceinline__ float wave_sum(float v) {
#pragma unroll
    for (int o = 1; o < 64; o <<= 1) v += __shfl_xor(v, o);
    return v;
}
#define OPQ_TID unsigned char* WSP = launder_ws(((unsigned char*)p.ws)); int tid = threadIdx.x; asm volatile("" : "+v"(tid)); const int lane = tid & 63, wave = __builtin_amdgcn_readfirstlane(tid >> 6); (void)lane; (void)wave
__device__ __forceinline__ unsigned char* launder_ws(unsigned char* w) { const unsigned long long v = (unsigned long long)w; unsigned lo = __builtin_amdgcn_readfirstlane((unsigned)v), hi = __builtin_amdgcn_readfirstlane((unsigned)(v >> 32)); asm volatile("" : "+s"(lo), "+s"(hi)); return (unsigned char*)(GAS unsigned char*)(((unsigned long long)hi << 32) | lo); }
#define MFMA16(a, b, c) __builtin_amdgcn_mfma_f32_16x16x32_bf16((a), (b), (c), 0, 0, 0)

__device__ __forceinline__ void tr_item(const float* src, int ld_src, bf16_t* dst, int ld_dst, const float* sc, int scmode, LAS float* scr, int kb, int nb, int lane) {
    const int k0 = 64 * kb, n0 = 32 * nb;
#pragma unroll
    for (int i = 0; i < 8; ++i) { const int kk = 8 * i + (lane >> 3), c4 = (lane & 7) * 4; f32x4 v = *(const f32x4*)(src + (size_t)(k0 + kk) * ld_src + n0 + c4);
        if (sc) { const float m_ = sc[k0 + kk]; v = v * (scmode ? m_ : (1.0f - m_)); }
        scr[kk * 33 + c4] = v.x; scr[kk * 33 + c4 + 1] = v.y; scr[kk * 33 + c4 + 2] = v.z; scr[kk * 33 + c4 + 3] = v.w; }
    asm volatile("s_waitcnt lgkmcnt(0)" ::: "memory");
    const int c = lane & 7;
#pragma unroll
    for (int j = 0; j < 4; ++j) { const int n = (lane >> 3) + 8 * j; const LAS float* s = scr + (8 * c) * 33 + n;
        u32x4 o; o.x = pk2(s[0 * 33], s[1 * 33]); o.y = pk2(s[2 * 33], s[3 * 33]); o.z = pk2(s[4 * 33], s[5 * 33]); o.w = pk2(s[6 * 33], s[7 * 33]);
        *(u32x4*)(dst + (size_t)(n0 + n) * ld_dst + k0 + 8 * c) = o; }
    asm volatile("s_waitcnt lgkmcnt(0)" ::: "memory");
}
__device__ __forceinline__ void tr_item2(const float* src, int ld_src, bf16_t* dst0, bf16_t* dst1, int ld_dst, const float* mu, LAS float* scr, int kb, int nb, int lane) {
    const int k0 = 64 * kb, n0 = 32 * nb;
#pragma unroll
    for (int i = 0; i < 8; ++i) { const int kk = 8 * i + (lane >> 3), c4 = (lane & 7) * 4; const f32x4 v = *(const f32x4*)(src + (size_t)(k0 + kk) * ld_src + n0 + c4);
        scr[kk * 33 + c4] = v.x; scr[kk * 33 + c4 + 1] = v.y; scr[kk * 33 + c4 + 2] = v.z; scr[kk * 33 + c4 + 3] = v.w; }
    asm volatile("s_waitcnt lgkmcnt(0)" ::: "memory");
    const int c = lane & 7;
    const f32x4 m0 = *(const f32x4*)(mu + k0 + 8 * c), m1 = *(const f32x4*)(mu + k0 + 8 * c + 4);
#pragma unroll
    for (int j = 0; j < 4; ++j) { const int n = (lane >> 3) + 8 * j; const LAS float* s = scr + (8 * c) * 33 + n;
        const float s0 = s[0], s1 = s[33], s2 = s[66], s3 = s[99], s4 = s[132], s5 = s[165], s6 = s[198], s7 = s[231];
        u32x4 o; o.x = pk2(s0 * m0.x, s1 * m0.y); o.y = pk2(s2 * m0.z, s3 * m0.w); o.z = pk2(s4 * m1.x, s5 * m1.y); o.w = pk2(s6 * m1.z, s7 * m1.w);
        *(u32x4*)(dst1 + (size_t)(n0 + n) * ld_dst + k0 + 8 * c) = o;
        o.x = pk2(s0 * (1.0f - m0.x), s1 * (1.0f - m0.y)); o.y = pk2(s2 * (1.0f - m0.z), s3 * (1.0f - m0.w)); o.z = pk2(s4 * (1.0f - m1.x), s5 * (1.0f - m1.y)); o.w = pk2(s6 * (1.0f - m1.z), s7 * (1.0f - m1.w));
        *(u32x4*)(dst0 + (size_t)(n0 + n) * ld_dst + k0 + 8 * c) = o; }
    asm volatile("s_waitcnt lgkmcnt(0)" ::: "memory");
}
__device__ __forceinline__ void rms_row(const float* xrow, const float* g, int lane, u32x2 (&o)[4]) {
    f32x4 v[4]; float s = 0.f;
#pragma unroll
    for (int j = 0; j < 4; ++j) { v[j] = *((const f32x4*)xrow + lane + 64 * j); s += (v[j].x * v[j].x + v[j].y * v[j].y) + (v[j].z * v[j].z + v[j].w * v[j].w); }
    const float rs = rsqrtf(wave_sum(s) * (1.0f / 1024.0f) + 1e-6f);
#pragma unroll
    for (int j = 0; j < 4; ++j) { const f32x4 gg = *((const f32x4*)g + lane + 64 * j); o[j].x = pk2(v[j].x * rs * gg.x, v[j].y * rs * gg.y); o[j].y = pk2(v[j].z * rs * gg.z, v[j].w * rs * gg.w); }
}

__device__ __forceinline__ void p0_prologue(const Params& p, LAS unsigned char* lds, int G, int bid) {
    OPQ_TID; const int gw = bid * 8 + wave, ngw = G * 8;
    LAS float* scr = (LAS float*)(lds + wave * 16384);
    bf16_t* WinT = (bf16_t*)(WSP + WS_WIN); bf16_t* WoutT = (bf16_t*)(WSP + WS_WOUT); bf16_t* RGA = (bf16_t*)(WSP + WS_RGA); bf16_t* RGX = (bf16_t*)(WSP + WS_RGX);
    constexpr int IA = 16 * 192, IB = 32 * 32, IC = 64, IL0 = 64;
    for (int it = gw; it < IA + IB + 2 * IC + IL0; it += ngw) {
        int r = it;
        if (r >= IA + IB + 2 * IC) { r -= IA + IB + 2 * IC; const int wh = r >> 5, q = r & 31;
            bf16_t* dst = (bf16_t*)(WSP + WS_WL) + (size_t)(wh * 64) * 2048;
            tr_item2(wh ? ((const float*)p.in[I_A1]) : ((const float*)p.in[I_W1]), 64, dst, dst + 1024, 2048, ((const float*)p.in[I_MU]) + (wh ? 4 : 1) * 1024, scr, q >> 1, q & 1, lane); continue; }
        if (r < IA) { tr_item(((const float*)p.in[I_WIN]), ZW, WinT, 1024, nullptr, 0, scr, r / 192, r % 192, lane); continue; } r -= IA;
        if (r < IB) { tr_item(((const float*)p.in[I_WOUT]), 1024, WoutT, 2048, nullptr, 0, scr, r / 32, r % 32, lane); continue; } r -= IB;
        const float* src = (r < IC) ? ((const float*)p.in[I_RGWA]) : ((const float*)p.in[I_RGWX]); bf16_t* dst = (r < IC) ? RGA : RGX; if (r >= IC) r -= IC;
        const int blk = r >> 3, q = r & 7;
        tr_item(src + blk * 16384, 128, dst + blk * 16384, 128, nullptr, 0, scr, q >> 2, q & 3, lane);
    }
    bf16_t* U0 = (bf16_t*)((float*)p.out);
    for (int m = gw; m < T; m += ngw) { u32x2 o[4]; rms_row(((const float*)p.in[I_X]) + (size_t)m * D, ((const float*)p.in[I_ABG]), lane, o);
#pragma unroll
        for (int j = 0; j < 4; ++j) *((u32x2*)(U0 + (size_t)m * D) + lane + 64 * j) = o[j]; }
}

__device__ __forceinline__ void rg_a_prefetch(const bf16_t* Z, int unit, int tid, u32x4 (&pre)[3]) {
    const int b = unit >> 9, n = (unit >> 3) & 63, j = unit & 7; const int tok0 = b * SEQ + n * 64, ch0 = j * 128;
#pragma unroll
    for (int q = 0; q < 3; ++q) { const int i = tid + q * NT; const int row = i >> 4, cc = i & 15; pre[q] = (u32x4){0u, 0u, 0u, 0u};
        if (i < 67 * 16 && (n > 0 || row >= 3)) pre[q] = *(const u32x4*)(Z + (size_t)(tok0 - 3 + row) * ZW + ch0 + 8 * cc); }
}
__device__ __forceinline__ void rg_a_unit(const Params& p, LAS unsigned char* lds, int unit, int next_unit, u32x4 (&pre)[3]) {
    OPQ_TID;
    LAS float* XC = (LAS float*)lds; LAS float* AA = (LAS float*)(lds + 32768); LAS bf16_t* XB = (LAS bf16_t*)(lds + 65536); LAS bf16_t* XR = (LAS bf16_t*)(lds + 82944);
    LAS float* SUMP = (LAS float*)(lds + 82944); LAS float* SUMH = SUMP + 512; LAS bf16_t* HT = XB; LAS bf16_t* PT = (LAS bf16_t*)(lds + 87040);
    const int b = unit >> 9, n = (unit >> 3) & 63, j = unit & 7;
    const int tok0 = b * SEQ + n * 64, ch0 = j * 128;
    const bf16_t* Z = (const bf16_t*)(WSP + WS_Z);
#pragma unroll
    for (int q = 0; q < 3; ++q) { const int i = tid + q * NT; if (i < 67 * 16) *(LAS u32x4*)(XR + (i >> 4) * 136 + 8 * (i & 15)) = pre[q]; }
    __syncthreads();
    if (next_unit < 2048) rg_a_prefetch(Z, next_unit, tid, pre);
    const int c = tid & 127, sub = tid >> 7;
    {
        const int ch = ch0 + c;
        const float w0 = ((const float*)p.in[I_CONVW])[ch], w1 = ((const float*)p.in[I_CONVW])[1024 + ch], w2 = ((const float*)p.in[I_CONVW])[2048 + ch], w3 = ((const float*)p.in[I_CONVW])[3072 + ch], cb = ((const float*)p.in[I_CONVB])[ch];
        const LAS bf16_t* xr = XR + (sub * 16) * 136 + c;
        float xm3 = bf2f(xr[0]), xm2 = bf2f(xr[136]), xm1 = bf2f(xr[272]);
#pragma unroll
        for (int i = 0; i < 16; ++i) { const float x = bf2f(xr[(i + 3) * 136]); const float y = w0 * xm3 + w1 * xm2 + w2 * xm1 + w3 * x + cb;
            XC[(sub * 16 + i) * 128 + c] = y; XB[(sub * 16 + i) * 136 + c] = (bf16_t)f2bf(y); xm3 = xm2; xm2 = xm1; xm1 = x; }
    }
    __syncthreads();
    {
        const int fr = lane & 15, fq = lane >> 4;
        const bf16_t* WA = (const bf16_t*)(WSP + WS_RGA) + j * 16384 + (16 * wave + fr) * 128 + 8 * fq;
        const bf16_t* WX = (const bf16_t*)(WSP + WS_RGX) + j * 16384 + (16 * wave + fr) * 128 + 8 * fq;
        f32x4 accA[4], accX[4];
#pragma unroll
        for (int m = 0; m < 4; ++m) { accA[m] = (f32x4){0.f, 0.f, 0.f, 0.f}; accX[m] = (f32x4){0.f, 0.f, 0.f, 0.f}; }
#pragma unroll
        for (int k = 0; k < 4; ++k) { const bf16x8 bA = *(const bf16x8*)(WA + 32 * k), bX = *(const bf16x8*)(WX + 32 * k);
#pragma unroll
            for (int m = 0; m < 4; ++m) { const bf16x8 a = *(const LAS bf16x8*)(XB + (16 * m + fr) * 136 + 32 * k + 8 * fq); accA[m] = MFMA16(a, bA, accA[m]); accX[m] = MFMA16(a, bX, accX[m]); } }
        const int cl = 16 * wave + fr, ch = ch0 + cl;
        const float ba = ((const float*)p.in[I_RGBA])[ch], bx = ((const float*)p.in[I_RGBX])[ch], lam = ((const float*)p.in[I_LAM])[ch];
        const float sp = log1pf(expf(-lam));
#pragma unroll
        for (int m = 0; m < 4; ++m)
#pragma unroll
            for (int r = 0; r < 4; ++r) { const int tk = 16 * m + 4 * fq + r; const float gr = sigmf(accA[m][r] + ba), gi = sigmf(accX[m][r] + bx);
                const float la = -8.0f * gr * sp; const float a = __expf(la); const float mult = __builtin_amdgcn_sqrtf(fmaxf(1.0f - a * a, 0.f));
                const float xc = XC[tk * 128 + cl]; AA[tk * 128 + cl] = a; XC[tk * 128 + cl] = mult * gi * xc; }
    }
    __syncthreads();
    {
        float hl[16], pl[16]; float h = 0.f, P = 1.f;
#pragma unroll
        for (int i = 0; i < 16; ++i) { const float a = AA[(sub * 16 + i) * 128 + c], u = XC[(sub * 16 + i) * 128 + c]; h = a * h + u; P *= a; hl[i] = h; pl[i] = P; }
        SUMP[sub * 128 + c] = P; SUMH[sub * 128 + c] = h;
        __syncthreads();
        float chh = 0.f, cp = 1.f;
#pragma unroll
        for (int s = 0; s < 3; ++s) if (s < sub) { const float sp_ = SUMP[s * 128 + c]; chh = chh * sp_ + SUMH[s * 128 + c]; cp *= sp_; }
#pragma unroll
        for (int i = 0; i < 16; ++i) { HT[(sub * 16 + i) * 136 + c] = (bf16_t)f2bf(hl[i] + pl[i] * chh); PT[(sub * 16 + i) * 136 + c] = (bf16_t)f2bf(pl[i] * cp); }
    }
    __syncthreads();
    {
        bf16_t* HL = (bf16_t*)((float*)p.out) + (size_t)tok0 * D + ch0; bf16_t* PC = HL + (size_t)T * D;
        for (int i = tid; i < 1024; i += NT) { const int row = i >> 4, cc = i & 15;
            *(u32x4*)(HL + (size_t)row * D + 8 * cc) = *(const LAS u32x4*)(HT + row * 136 + 8 * cc); *(u32x4*)(PC + (size_t)row * D + 8 * cc) = *(const LAS u32x4*)(PT + row * 136 + 8 * cc); }
    }
    __syncthreads();
}

__device__ __forceinline__ void hg_a_prefetch(const bf16_t* Z, int unit, int tid, u32x4 (&pre)[6]) {
    const int b = unit >> 9, h = (unit >> 6) & 7, n = unit & 63; const int tok0 = b * SEQ + n * 64;
#pragma unroll
    for (int q = 0; q < 6; ++q) { const int i = tid + q * NT; const int arr = i >> 10, row = (i >> 4) & 63, cc = i & 15; pre[q] = *(const u32x4*)(Z + (size_t)(tok0 + row) * ZW + 2048 + 1024 * arr + h * 128 + 8 * cc); }
}
__device__ __forceinline__ void hg_a_unit(const Params& p, LAS unsigned char* lds, int unit, int next_unit, u32x4 (&pre)[6]) {
    OPQ_TID;
    LAS bf16_t* QD = (LAS bf16_t*)lds; LAS bf16_t* KI = (LAS bf16_t*)(lds + 17408); LAS bf16_t* VR = (LAS bf16_t*)(lds + 34816); LAS bf16_t* VT = (LAS bf16_t*)(lds + 52224);
    LAS bf16_t* SC = (LAS bf16_t*)(lds + 70656); LAS float* ST = (LAS float*)(lds + 79872); LAS bf16_t* OT = VR;
    const int b = unit >> 9, h = (unit >> 6) & 7, n = unit & 63;
    const int tok0 = b * SEQ + n * 64;
    bf16_t* Z = (bf16_t*)(WSP + WS_Z);
    const int fr = lane & 15, fq = lane >> 4;
#pragma unroll
    for (int q = 0; q < 6; ++q) { const int i = tid + q * NT; const int arr = i >> 10, row = (i >> 4) & 63, cc = i & 15;
        *(LAS u32x4*)((arr == 0 ? QD : (arr == 1 ? KI : VR)) + row * 136 + 8 * cc) = pre[q]; }
    __syncthreads();
    {
        const int d = tid & 127, sub = tid >> 7, hd = h * 128 + d;
        const float lb = sigmf(((const float*)p.in[I_LB])[hd] - ((const float*)p.in[I_LB])[1024 + hd]), omlb = 1.0f - lb;
        float q[16], kq[16], cl[16]; unsigned short vv[16]; float run = 0.f;
#pragma unroll
        for (int i = 0; i < 16; ++i) { const int t = sub * 16 + i; const float f = bf2f(KI[t * 136 + d]); const float sg = sigmf(f);
            run += __logf(lb + omlb * sg); cl[i] = run; kq[i] = omlb * (1.0f - sg); q[i] = bf2f(QD[t * 136 + d]); vv[i] = VR[t * 136 + d]; }
        ST[sub * 128 + d] = run;
        __syncthreads();
        float off = 0.f, total = 0.f;
#pragma unroll
        for (int s = 0; s < 4; ++s) { const float x = ST[s * 128 + d]; total += x; if (s < sub) off += x; }
        unsigned ke[8], vp[8];
#pragma unroll
        for (int i = 0; i < 16; ++i) { const float cum = off + cl[i]; const unsigned qd = f2bf(q[i] * __expf(cum)), ki = f2bf(kq[i] * __expf(-cum)), kE = f2bf(kq[i] * __expf(total - cum));
            QD[(sub * 16 + i) * 136 + d] = (bf16_t)qd; KI[(sub * 16 + i) * 136 + d] = (bf16_t)ki;
            if (i & 1) { ke[i >> 1] |= kE << 16; vp[i >> 1] |= (unsigned)vv[i] << 16; } else { ke[i >> 1] = kE; vp[i >> 1] = vv[i]; } }
        *(LAS u32x4*)(VT + d * 72 + sub * 16) = (u32x4){vp[0], vp[1], vp[2], vp[3]}; *(LAS u32x4*)(VT + d * 72 + sub * 16 + 8) = (u32x4){vp[4], vp[5], vp[6], vp[7]};
        bf16_t* tb = Z + (size_t)(tok0 + (d >> 1)) * ZW + h * 128 + (d & 1) * 64 + sub * 16;
        *(u32x4*)(tb + 3072) = (u32x4){ke[0], ke[1], ke[2], ke[3]}; *(u32x4*)(tb + 3072 + 8) = (u32x4){ke[4], ke[5], ke[6], ke[7]};
        *(u32x4*)(tb + 4096) = (u32x4){vp[0], vp[1], vp[2], vp[3]}; *(u32x4*)(tb + 4096 + 8) = (u32x4){vp[4], vp[5], vp[6], vp[7]};
        if (sub == 0) ((float*)(WSP + WS_DEC))[unit * 128 + d] = __expf(total);
    }
    __syncthreads();
    if (next_unit < 2048) hg_a_prefetch(Z, next_unit, tid, pre);
    for (int i = tid; i < 1024; i += NT) { const int row = i >> 4, cc = i & 15; *(u32x4*)(Z + (size_t)(tok0 + row) * ZW + 2048 + h * 128 + 8 * cc) = *(const LAS u32x4*)(QD + row * 136 + 8 * cc); }
    {
        const int lt = wave >> 1;
#pragma unroll
        for (int x = 0; x < 2; ++x) { const int mt = (wave & 1) * 2 + x; f32x4 acc = (f32x4){0.f, 0.f, 0.f, 0.f};
            if (mt <= lt) {
#pragma unroll
                for (int k = 0; k < 4; ++k) { const bf16x8 a = *(const LAS bf16x8*)(QD + (16 * lt + fr) * 136 + 32 * k + 8 * fq), bb = *(const LAS bf16x8*)(KI + (16 * mt + fr) * 136 + 32 * k + 8 * fq); acc = MFMA16(a, bb, acc); } }
#pragma unroll
            for (int r = 0; r < 4; ++r) { const int l = 16 * lt + 4 * fq + r, mm = 16 * mt + fr; SC[l * 72 + mm] = (bf16_t)f2bf(mm <= l ? acc[r] : 0.f); } }
    }
    __syncthreads();
    {
#pragma unroll
        for (int lt = 0; lt < 4; ++lt) { f32x4 acc = (f32x4){0.f, 0.f, 0.f, 0.f};
#pragma unroll
            for (int k = 0; k < 2; ++k) { const bf16x8 a = *(const LAS bf16x8*)(SC + (16 * lt + fr) * 72 + 32 * k + 8 * fq), bb = *(const LAS bf16x8*)(VT + (16 * wave + fr) * 72 + 32 * k + 8 * fq); acc = MFMA16(a, bb, acc); }
#pragma unroll
            for (int r = 0; r < 4; ++r) OT[(16 * lt + 4 * fq + r) * 136 + 16 * wave + fr] = (bf16_t)f2bf(acc[r]); }
    }
    __syncthreads();
    { bf16_t* OI = (bf16_t*)(WSP + WS_OI) + (size_t)tok0 * D + h * 128;
      for (int i = tid; i < 1024; i += NT) { const int row = i >> 4, cc = i & 15; *(u32x4*)(OI + (size_t)row * D + 8 * cc) = *(const LAS u32x4*)(OT + row * 136 + 8 * cc); } }
    __syncthreads();
}

__device__ __forceinline__ void hg_b_item(const Params& p, LAS unsigned char* lds, int item, bool dry = false) {
    OPQ_TID;
    LAS bf16_t* SB = (LAS bf16_t*)lds;
    const int b = item >> 6, h = (item >> 3) & 7, es = item & 7;
    const int fr = lane & 15, fq = lane >> 4;
    const bf16_t* Z = (const bf16_t*)(WSP + WS_Z); bf16_t* OI = (bf16_t*)(WSP + WS_OI); const float* DEC = (const float*)(WSP + WS_DEC);
    for (int i = tid; i < 2 * 16 * 136 / 2; i += NT) ((LAS unsigned*)SB)[i] = 0u;
    __syncthreads();
    f32x4 S = (f32x4){0.f, 0.f, 0.f, 0.f};
    const int eg = 16 * es + fr, dg = 16 * wave + fr;
    const bf16_t* pV = Z + (size_t)(b * SEQ + (eg >> 1)) * ZW + 4096 + h * 128 + (eg & 1) * 64 + 8 * fq;
    const bf16_t* pK = Z + (size_t)(b * SEQ + (dg >> 1)) * ZW + 3072 + h * 128 + (dg & 1) * 64 + 8 * fq;
    const bf16_t* pQ = Z + (size_t)(b * SEQ + 16 * (wave & 3) + fr) * ZW + 2048 + h * 128 + 8 * fq;
    bf16_t* pO = OI + (size_t)(b * SEQ + 16 * (wave & 3) + 4 * fq) * D + h * 128 + 16 * es + fr;
    const float* pD = DEC + (size_t)((b * 8 + h) * 64) * 128 + dg;
    bf16x8 nV[2][2], nK[2][2], nQ[2][4]; float ndec[2]; unsigned short nO[2][4];
#define HGB_LOAD(SET, n_) do { const size_t ro_ = (size_t)(n_) * 64 * ZW; ndec[SET] = pD[(n_) * 128]; \
        _Pragma("unroll") for (int k = 0; k < 2; ++k) { nV[SET][k] = *(const bf16x8*)(pV + ro_ + 32 * k); nK[SET][k] = *(const bf16x8*)(pK + ro_ + 32 * k); } \
        if (wave < 4) { _Pragma("unroll") for (int k = 0; k < 4; ++k) nQ[SET][k] = *(const bf16x8*)(pQ + ro_ + 32 * k); \
            _Pragma("unroll") for (int r = 0; r < 4; ++r) nO[SET][r] = pO[(size_t)((n_) * 64 + r) * D]; } } while (0)
#define HGB_STEP(SET, n) do { \
        const float dec = ndec[SET]; bf16x8 aV[2], bK[2]; \
        _Pragma("unroll") for (int k = 0; k < 2; ++k) { aV[k] = nV[SET][k]; bK[k] = nK[SET][k]; } \
        if (wave < 4) { \
            f32x4 acc = (f32x4){0.f, 0.f, 0.f, 0.f}; \
            _Pragma("unroll") for (int k = 0; k < 4; ++k) { const bf16x8 bb = *(const LAS bf16x8*)(SB + ((n) & 1) * 2176 + fr * 136 + 32 * k + 8 * fq); acc = MFMA16(nQ[SET][k], bb, acc); } \
            _Pragma("unroll") for (int r = 0; r < 4; ++r) { const float nv = bf2f(nO[SET][r]) + acc[r]; if (!dry) pO[(size_t)((n) * 64 + r) * D] = (bf16_t)f2bf(nv); else if (nv == 123456.0f) pO[0] = 0; } \
        } \
        if ((n) + 2 < 64) HGB_LOAD(SET, (n) + 2); \
        S = S * dec; \
        _Pragma("unroll") for (int k = 0; k < 2; ++k) S = MFMA16(aV[k], bK[k], S); \
        _Pragma("unroll") for (int r = 0; r < 4; ++r) SB[(((n) + 1) & 1) * 2176 + (4 * fq + r) * 136 + dg] = (bf16_t)f2bf(S[r]); \
        asm volatile("s_waitcnt lgkmcnt(0)" ::: "memory"); __builtin_amdgcn_s_barrier(); asm volatile("" ::: "memory"); } while (0)
    HGB_LOAD(0, 0); HGB_LOAD(1, 1);
#pragma unroll 1
    for (int n2 = 0; n2 < 64; n2 += 2) { HGB_STEP(0, n2); HGB_STEP(1, n2 + 1); }
#undef HGB_LOAD
#undef HGB_STEP
}
__device__ __forceinline__ void rg_b_unit(const Params& p, int unit) {
    OPQ_TID;
    const int b = unit >> 7, n = (unit >> 1) & 63, ch = (unit & 1) * 512 + 8 * (tid & 63), r8 = tid >> 6;
    const bf16_t* HL = (const bf16_t*)((float*)p.out) + (size_t)b * SEQ * D + ch; const bf16_t* PC = HL + (size_t)T * D;
    bf16_t* Z = (bf16_t*)(WSP + WS_Z) + (size_t)(b * SEQ + n * 64) * ZW + ch;
    float carry[8];
#pragma unroll
    for (int i = 0; i < 8; ++i) carry[i] = 0.f;
    int m0 = 0;
    for (; m0 + 4 <= n; m0 += 4) { u32x4 pp[4], hh4[4];
#pragma unroll
        for (int i = 0; i < 4; ++i) { const size_t o = (size_t)((m0 + i) * 64 + 63) * D; pp[i] = *(const u32x4*)(PC + o); hh4[i] = *(const u32x4*)(HL + o); }
#pragma unroll
        for (int i = 0; i < 4; ++i)
#pragma unroll
            for (int c = 0; c < 4; ++c) { carry[2 * c] = carry[2 * c] * bf2f(pp[i][c] & 0xffffu) + bf2f(hh4[i][c] & 0xffffu); carry[2 * c + 1] = carry[2 * c + 1] * bf2f(pp[i][c] >> 16) + bf2f(hh4[i][c] >> 16); } }
    for (; m0 < n; ++m0) { const size_t o = (size_t)(m0 * 64 + 63) * D; const u32x4 pp = *(const u32x4*)(PC + o), hh4 = *(const u32x4*)(HL + o);
#pragma unroll
        for (int c = 0; c < 4; ++c) { carry[2 * c] = carry[2 * c] * bf2f(pp[c] & 0xffffu) + bf2f(hh4[c] & 0xffffu); carry[2 * c + 1] = carry[2 * c + 1] * bf2f(pp[c] >> 16) + bf2f(hh4[c] >> 16); } }
#pragma unroll 4
    for (int tq = 0; tq < 8; ++tq) { const int t = 8 * tq + r8; const size_t o = (size_t)(n * 64 + t) * D;
        const u32x4 hv = *(const u32x4*)(HL + o), pv = *(const u32x4*)(PC + o), gv = *(const u32x4*)(Z + (size_t)t * ZW + 1024); u32x4 ov;
#pragma unroll
        for (int c = 0; c < 4; ++c) { const float h0 = bf2f(hv[c] & 0xffffu) + bf2f(pv[c] & 0xffffu) * carry[2 * c], h1 = bf2f(hv[c] >> 16) + bf2f(pv[c] >> 16) * carry[2 * c + 1];
            const float g0 = bf2f(gv[c] & 0xffffu), g1 = bf2f(gv[c] >> 16); ov[c] = pk2(h0 * g0 * sigmf(g0), h1 * g1 * sigmf(g1)); }
        *(u32x4*)(Z + (size_t)t * ZW) = ov; }
}
__device__ __forceinline__ float row16_sum_p4(float x) {
    x += __int_as_float(__builtin_amdgcn_update_dpp(0, __float_as_int(x), 0xB1, 0xf, 0xf, true)); x += __int_as_float(__builtin_amdgcn_update_dpp(0, __float_as_int(x), 0x4E, 0xf, 0xf, true));
    x += __int_as_float(__builtin_amdgcn_update_dpp(0, __float_as_int(x), 0x141, 0xf, 0xf, true)); x += __int_as_float(__builtin_amdgcn_update_dpp(0, __float_as_int(x), 0x140, 0xf, 0xf, true)); return x; }
__device__ __forceinline__ void p4_finalize(const Params& p, int G, int bid) {
    OPQ_TID; const int gw = bid * 8 + wave, ngw = G * 8;
    bf16_t* Z = (bf16_t*)(WSP + WS_Z); const bf16_t* OI = (const bf16_t*)(WSP + WS_OI);
    const int l16 = lane & 15, pr = lane >> 4;
    const f32x4 g0 = *(const f32x4*)(((const float*)p.in[I_HGG]) + 8 * l16), g1 = *(const f32x4*)(((const float*)p.in[I_HGG]) + 8 * l16 + 4);
    for (int it = gw; it < T * 2; it += ngw) { const int tok = it >> 1, h = (it & 1) * 4 + pr;
        const u32x4 ov = *(const u32x4*)(OI + (size_t)tok * D + h * 128 + 8 * l16); const u32x4 gv = *(const u32x4*)(Z + (size_t)tok * ZW + 5120 + h * 128 + 8 * l16);
        float o[8], gb[8]; float ss = 0.f;
#pragma unroll
        for (int c = 0; c < 4; ++c) { o[2 * c] = bf2f(ov[c] & 0xffffu); o[2 * c + 1] = bf2f(ov[c] >> 16); gb[2 * c] = bf2f(gv[c] & 0xffffu); gb[2 * c + 1] = bf2f(gv[c] >> 16); ss += o[2 * c] * o[2 * c] + o[2 * c + 1] * o[2 * c + 1]; }
        const float rs = rsqrtf(row16_sum_p4(ss) * (1.0f / 128.0f) + 1e-6f);
        u32x4 w;
#pragma unroll
        for (int c = 0; c < 4; ++c) { const float ga = c < 2 ? g0[2 * c] : g1[2 * c - 4], gbq = c < 2 ? g0[2 * c + 1] : g1[2 * c - 3];
            w[c] = pk2(o[2 * c] * rs * ga * gb[2 * c] * sigmf(gb[2 * c]), o[2 * c + 1] * rs * gbq * gb[2 * c + 1] * sigmf(gb[2 * c + 1])); }
        *(u32x4*)(Z + (size_t)tok * ZW + 1024 + h * 128 + 8 * l16) = w; }
}
__device__ __forceinline__ void p6_prologue(const Params& p, LAS unsigned char* lds, int G, int bid) {
    OPQ_TID; const int gw = bid * 8 + wave, ngw = G * 8;
    LAS float* scr = (LAS float*)(lds + wave * 16384);
    constexpr int IP = 4096, IL = 0, IO = 1024, I2 = 128;
    for (int i = gw * 64 + lane; i < (int)(MiB / 16); i += ngw * 64) ((u32x4*)(WSP + WS_GR))[i] = (u32x4){0u, 0u, 0u, 0u};
    for (int i = gw * 64 + lane; i < (int)(MiB / 32); i += ngw * 64) ((u32x4*)(WSP + WS_XG))[i] = (u32x4){0u, 0u, 0u, 0u};
    for (int it = gw; it < IP + IL + IO + I2; it += ngw) {
        int r = it;
        if (r < IP) { const int pj = r >> 10, q = r & 1023;
            const int muidx = pj == 0 ? 0 : (pj == 1 ? 2 : (pj == 2 ? 3 : 5));
            bf16_t* dst = (bf16_t*)(WSP + WS_WC) + (size_t)(pj * 2048) * 2048;
            tr_item2(((const float*)p.in[I_WR + pj]), 2048, dst, dst + 1024, 2048, ((const float*)p.in[I_MU]) + muidx * 1024, scr, q >> 6, q & 63, lane); continue; }
        r -= IP;
        if (r >= IO) { r -= IO; const int wh = r >> 6, nb = r & 63; tr_item(wh ? ((const float*)p.in[I_A2]) : ((const float*)p.in[I_W2]), 2048, (bf16_t*)(WSP + (wh ? WS_A2T : WS_W2T)), 64, nullptr, 0, scr, 0, nb, lane); continue; }
        tr_item(((const float*)p.in[I_WO]), 1024, (bf16_t*)(WSP + WS_WO), 2048, nullptr, 0, scr, r >> 5, r & 31, lane);
    }
    bf16_t* A2 = (bf16_t*)(WSP + WS_A2);
    const int fr = lane & 15, fq = lane >> 4;
    for (int tile = bid; tile < T / 64; tile += G) {
        const int m0 = tile * 64;
        for (int i = (wave == 0 && (m0 & (SEQ - 1)) != 0) ? -1 : 0; i < 8; ++i) { const int m = (i < 0) ? m0 - 1 : m0 + 8 * wave + i;
            u32x2 o[4]; rms_row(((float*)p.out) + (size_t)m * D, ((const float*)p.in[I_CNG]), lane, o); const int bb = m >> 12, t = m & (SEQ - 1);
            const size_t cr = (size_t)(t >> 11) * PROWS6 + bb * 2048 + (t & 2047);
            const size_t cn = (size_t)((t + 1) >> 11) * PROWS6 + bb * 2048 + ((t + 1) & 2047);
#pragma unroll
            for (int j = 0; j < 4; ++j) { if (i >= 0) *((u32x2*)(A2 + cr * 2048) + lane + 64 * j) = o[j];
                if (t + 1 < SEQ) *((u32x2*)(A2 + cn * 2048 + 1024) + lane + 64 * j) = o[j];
                if (t == 0) *((u32x2*)(A2 + cr * 2048 + 1024) + lane + 64 * j) = (u32x2){0u, 0u}; } }
        __syncthreads();
        { const int t0 = m0 & (SEQ - 1), bb = m0 >> 12; const size_t cr0 = (size_t)(t0 >> 11) * PROWS6 + bb * 2048 + (t0 & 2047);
          const int mt = wave & 3, nh = wave >> 2;
          LAS bf16_t* LA_ = (LAS bf16_t*)lds; LAS bf16_t* LB_ = (LAS bf16_t*)(lds + 64 * 264 * 2);
          const bf16_t* ga = A2 + cr0 * 2048; const bf16_t* gb = (const bf16_t*)(WSP + WS_WL);
          u32x4 pa_[4], pb_[8];
#define LORA_LOAD(kc) do { _Pragma("unroll") for (int q = 0; q < 4; ++q) { const int i = tid + q * NT; pa_[q] = *(const u32x4*)(ga + (size_t)(i >> 5) * 2048 + (kc) * 256 + 8 * (i & 31)); } \
              _Pragma("unroll") for (int q = 0; q < 8; ++q) { const int i = tid + q * NT; pb_[q] = *(const u32x4*)(gb + (size_t)(i >> 5) * 2048 + (kc) * 256 + 8 * (i & 31)); } } while (0)
          LORA_LOAD(0);
          f32x4 acc[4];
#pragma unroll
          for (int nt = 0; nt < 4; ++nt) acc[nt] = (f32x4){0.f, 0.f, 0.f, 0.f};
#pragma unroll 1
          for (int kc = 0; kc < 8; ++kc) {
#pragma unroll
              for (int q = 0; q < 4; ++q) { const int i = tid + q * NT; *(LAS u32x4*)(LA_ + (i >> 5) * 264 + 8 * (i & 31)) = pa_[q]; }
#pragma unroll
              for (int q = 0; q < 8; ++q) { const int i = tid + q * NT; *(LAS u32x4*)(LB_ + (i >> 5) * 264 + 8 * (i & 31)) = pb_[q]; }
              __syncthreads();
              if (kc + 1 < 8) LORA_LOAD(kc + 1);
#pragma unroll
              for (int ks = 0; ks < 8; ++ks) { const bf16x8 a = *(const LAS bf16x8*)(LA_ + (16 * mt + fr) * 264 + 32 * ks + 8 * fq);
#pragma unroll
                  for (int nt = 0; nt < 4; ++nt) { const bf16x8 bfr = *(const LAS bf16x8*)(LB_ + (64 * nh + 16 * nt + fr) * 264 + 32 * ks + 8 * fq); acc[nt] = MFMA16(a, bfr, acc[nt]); } }
              __syncthreads();
          }
#undef LORA_LOAD
          bf16_t* dstb = (bf16_t*)(WSP + (nh ? WS_LA : WS_LW));
#pragma unroll
          for (int nt = 0; nt < 4; ++nt)
#pragma unroll
              for (int r = 0; r < 4; ++r) { const float v = acc[nt][r]; dstb[(cr0 + 16 * mt + 4 * fq + r) * 64 + 16 * nt + fr] = (bf16_t)f2bf(nh ? v : tanhf(v)); } }
        __syncthreads();
    }
}
template <int CTRL> __device__ __forceinline__ float dpp_add(float x) { const int y = __builtin_amdgcn_update_dpp(0, __float_as_int(x), CTRL, 0xf, 0xf, true); return x + __int_as_float(y); }
__device__ __forceinline__ f32x4 bf4(u32x2 v) { return (f32x4){bf2f(v.x & 0xffffu), bf2f(v.x >> 16), bf2f(v.y & 0xffffu), bf2f(v.y >> 16)}; }
__device__ __forceinline__ float afma(float a, float b, float c) { float d; asm("v_fma_f32 %0, %1, %2, %3" : "=v"(d) : "v"(a), "v"(b), "v"(c)); return d; }
__device__ __forceinline__ float anfma(float a, float b, float c) { float d; asm("v_fma_f32 %0, -%1, %2, %3" : "=v"(d) : "v"(a), "v"(b), "v"(c)); return d; }
__device__ __forceinline__ float amul(float a, float b) { float d; asm("v_mul_f32 %0, %1, %2" : "=v"(d) : "v"(a), "v"(b)); return d; }
__device__ __forceinline__ f32x2 pkmul(f32x2 a, f32x2 b) { f32x2 d; asm("v_pk_mul_f32 %0, %1, %2" : "=v"(d) : "v"(a), "v"(b)); return d; }
__device__ __forceinline__ f32x2 pkfma(f32x2 a, f32x2 b, f32x2 c) { f32x2 d; asm("v_pk_fma_f32 %0, %1, %2, %3" : "=v"(d) : "v"(a), "v"(b), "v"(c)); return d; }
__device__ __forceinline__ f32x2 pkmul_bl(f32x2 s, f32x2 b) { f32x2 d; asm("v_pk_mul_f32 %0, %1, %2 op_sel_hi:[0,1]" : "=v"(d) : "v"(s), "v"(b)); return d; }
__device__ __forceinline__ f32x2 pknfma_bl(f32x2 s, f32x2 b, f32x2 c) { f32x2 d; asm("v_pk_fma_f32 %0, %1, %2, %3 op_sel_hi:[0,1,1] neg_lo:[1,0,0] neg_hi:[1,0,0]" : "=v"(d) : "v"(s), "v"(b), "v"(c)); return d; }
constexpr int RSTR = 68;
constexpr int REC_ARR = 32 * RSTR;
constexpr int REC_BUF = 5 * REC_ARR;
constexpr int L_REC = 0, L_YY = 87040, L_VV = 103424, L_GG = 119808, L_RKP = 136192, L_SSP = 137216, L_STT = 137728, L_CST = 137984;
constexpr int PROWS = 8192;
#define SCAN_BAR do { asm volatile("s_waitcnt lgkmcnt(0)" ::: "memory"); __builtin_amdgcn_s_barrier(); asm volatile("" ::: "memory"); } while (0)
__device__ __forceinline__ void scan_half(const Params& p, LAS unsigned char* lds, int pi, int rh, int pass) {
    OPQ_TID;
    LAS float* REC = (LAS float*)(lds + L_REC); LAS float* YY = (LAS float*)(lds + L_YY); LAS float* VV = (LAS float*)(lds + L_VV); LAS float* GG = (LAS float*)(lds + L_GG);
    LAS float* RKP = (LAS float*)(lds + L_RKP); LAS float* SSP = (LAS float*)(lds + L_SSP); LAS float* STT = (LAS float*)(lds + L_STT); LAS float* CST = (LAS float*)(lds + L_CST);
    const int b = pi >> 5, hg = pi & 31, colg = hg * 64;
    const bf16_t* Rb = (const bf16_t*)(WSP + WS_R); const bf16_t* Kb = Rb + (size_t)PROWS * 2048; bf16_t* Vb = (bf16_t*)(WSP + WS_V); const bf16_t* Gb = Vb + (size_t)PROWS * 2048;
    const bf16_t* LWb = (const bf16_t*)(WSP + WS_LW) + (size_t)pass * PROWS * 64; const bf16_t* LAb = (const bf16_t*)(WSP + WS_LA) + (size_t)pass * PROWS * 64;
    unsigned long long* GR = (unsigned long long*)(WSP + WS_GR);
    const size_t rowb = (size_t)b * 2048;
    __syncthreads();
    if (tid < 64) { CST[tid] = ((const float*)p.in[I_W0])[colg + tid]; CST[64 + tid] = ((const float*)p.in[I_A0])[colg + tid]; CST[128 + tid] = ((const float*)p.in[I_KK])[colg + tid]; CST[192 + tid] = ((const float*)p.in[I_KA])[colg + tid]; CST[256 + tid] = ((const float*)p.in[I_RK])[colg + tid];
                    CST[320 + tid] = ((const float*)p.in[I_LNG])[colg + tid]; CST[384 + tid] = ((const float*)p.in[I_LNB])[colg + tid]; }
    __syncthreads();
    const int fr = lane & 15, fq = lane >> 4;
    if (wave < 4) {
        const int j = lane & 7, rowl = 8 * wave + (lane >> 3);
        float* stp = (float*)(WSP + WS_ST) + ((size_t)(pi * 64 + 32 * rh + rowl)) * 64 + 8 * j;
        f32x2 P01 = (f32x2){0.f, 0.f}, P23 = P01, P45 = P01, P67 = P01;
        if (pass == 1) { const f32x4 a = *(const f32x4*)stp, c = *(const f32x4*)(stp + 4); P01 = a.xy; P23 = a.zw; P45 = c.xy; P67 = c.zw; }
        const bool first = (lane & 7) == 0;
        SCAN_BAR;
        for (int it = 0; it < 66; ++it) {
            if (it < 64) {
                const LAS float* rec = REC + (it & 1) * REC_BUF + 8 * j; const LAS float* vvp = VV + (it & 3) * 1024 + rowl; LAS float* yyp = YY + (it & 3) * 1024 + rowl;
                const LAS float* ssp = SSP + (it & 1) * 64 + 2 * (lane & 31);
                const float inv2 = __builtin_amdgcn_rcpf(fmaxf(ssp[0] + ssp[1], 1e-24f));
                f32x4 Rkk[2][2], Rw[2][2], Rka[2][2], Rkm[2][2], Rr[2][2]; float Rv[2];
#define LOADREC(slot, s) do { const LAS float* rs_ = rec + (s) * RSTR; \
                    Rkk[slot][0] = *(const LAS f32x4*)(rs_); Rkk[slot][1] = *(const LAS f32x4*)(rs_ + 4); Rw[slot][0] = *(const LAS f32x4*)(rs_ + REC_ARR); Rw[slot][1] = *(const LAS f32x4*)(rs_ + REC_ARR + 4); \
                    Rka[slot][0] = *(const LAS f32x4*)(rs_ + 2 * REC_ARR); Rka[slot][1] = *(const LAS f32x4*)(rs_ + 2 * REC_ARR + 4); Rkm[slot][0] = *(const LAS f32x4*)(rs_ + 3 * REC_ARR); Rkm[slot][1] = *(const LAS f32x4*)(rs_ + 3 * REC_ARR + 4); \
                    Rr[slot][0] = *(const LAS f32x4*)(rs_ + 4 * REC_ARR); Rr[slot][1] = *(const LAS f32x4*)(rs_ + 4 * REC_ARR + 4); Rv[slot] = vvp[(s) * 32]; } while (0)
                LOADREC(0, 0);
                float yp = 0.f, yk0 = 0.f, yk1 = 0.f, yk2 = 0.f, yk3 = 0.f;
#define YSHIFT(YK) do { YK = __int_as_float(__builtin_amdgcn_update_dpp(__float_as_int(yp), __float_as_int(YK), 0x111, 0xf, 0xf, false)); YK = first ? yp : YK; } while (0)
#pragma unroll
                for (int s = 0; s < 32; ++s) {
                    const int c = s & 1;
                    if (s + 1 < 32) LOADREC((s + 1) & 1, s + 1);
                    asm volatile("" ::: "memory");
                    const float si = __int_as_float(__builtin_amdgcn_readlane(__float_as_int(inv2), s));
                    f32x2 px = pkmul(P01, Rkk[c][0].xy); px = pkfma(P23, Rkk[c][0].zw, px); px = pkfma(P45, Rkk[c][1].xy, px); px = pkfma(P67, Rkk[c][1].zw, px);
                    float x = px.x + px.y;
                    f32x2 vv2; vv2.x = Rv[c]; asm volatile("" : "+v"(vv2));
                    x = dpp_add<0xB1>(x); yp = dpp_add<0xB1>(yp);
                    const f32x2 t01 = pkmul_bl(vv2, Rkm[c][0].xy), t23 = pkmul_bl(vv2, Rkm[c][0].zw);
                    x = dpp_add<0x4E>(x); yp = dpp_add<0x4E>(yp);
                    const f32x2 t45 = pkmul_bl(vv2, Rkm[c][1].xy), t67 = pkmul_bl(vv2, Rkm[c][1].zw);
                    x = dpp_add<0x141>(x); yp = dpp_add<0x141>(yp);
                    P01 = pkfma(P01, Rw[c][0].xy, t01); P23 = pkfma(P23, Rw[c][0].zw, t23); P45 = pkfma(P45, Rw[c][1].xy, t45); P67 = pkfma(P67, Rw[c][1].zw, t67);
                    if (s >= 1) { if (s - 1 < 8) YSHIFT(yk0); else if (s - 1 < 16) YSHIFT(yk1); else if (s - 1 < 24) YSHIFT(yk2); else YSHIFT(yk3); }
                    x = x * si;
                    f32x2 x2; x2.x = x; asm volatile("" : "+v"(x2));
                    P01 = pknfma_bl(x2, Rka[c][0].xy, P01); P23 = pknfma_bl(x2, Rka[c][0].zw, P23); P45 = pknfma_bl(x2, Rka[c][1].xy, P45); P67 = pknfma_bl(x2, Rka[c][1].zw, P67);
                    f32x2 py = pkmul(P01, Rr[c][0].xy); py = pkfma(P23, Rr[c][0].zw, py); py = pkfma(P45, Rr[c][1].xy, py); py = pkfma(P67, Rr[c][1].zw, py);
                    yp = py.x + py.y;
                }
                yp = dpp_add<0xB1>(yp); yp = dpp_add<0x4E>(yp); yp = dpp_add<0x141>(yp); YSHIFT(yk3);
                yyp[(7 - j) * 32] = yk0; yyp[(15 - j) * 32] = yk1; yyp[(23 - j) * 32] = yk2; yyp[(31 - j) * 32] = yk3;
#undef LOADREC
#undef YSHIFT
            }
            SCAN_BAR;
        }
        if (pass == 0) { *(f32x4*)stp = (f32x4){P01.x, P01.y, P23.x, P23.y}; *(f32x4*)(stp + 4) = (f32x4){P45.x, P45.y, P67.x, P67.y}; }
    } else {
        const int pw = wave - 4, tt = pw >> 1, kh = pw & 1;
        bf16x8 aWc[2][2], aAc[2][2];
#pragma unroll
        for (int kt = 0; kt < 2; ++kt)
#pragma unroll
            for (int ks = 0; ks < 2; ++ks) { const size_t o = (size_t)(colg + 32 * kh + 16 * kt + fr) * 64 + 32 * ks + 8 * fq; aWc[kt][ks] = *(const bf16x8*)((const bf16_t*)(WSP + WS_W2T) + o); aAc[kt][ks] = *(const bf16x8*)((const bf16_t*)(WSP + WS_A2T) + o); }
        bf16x8 lwf[2][2], laf[2][2]; u32x2 r2[2][2], k2[2][2];
#define ISSUE(SET, tbx) do { const size_t tok_ = rowb + (tbx) * 32 + 16 * tt + fr; \
            _Pragma("unroll") for (int ks = 0; ks < 2; ++ks) { lwf[SET][ks] = *(const bf16x8*)(LWb + tok_ * 64 + 32 * ks + 8 * fq); laf[SET][ks] = *(const bf16x8*)(LAb + tok_ * 64 + 32 * ks + 8 * fq); } \
            _Pragma("unroll") for (int kt = 0; kt < 2; ++kt) { r2[SET][kt] = *(const u32x2*)(Rb + tok_ * 2048 + colg + 32 * kh + 16 * kt + 4 * fq); k2[SET][kt] = *(const u32x2*)(Kb + tok_ * 2048 + colg + 32 * kh + 16 * kt + 4 * fq); } } while (0)
        ISSUE(0, 0); ISSUE(1, 1);
        const int t = lane >> 1, hf = lane & 1;
        const size_t vgo = (size_t)colg + 32 * rh + 16 * hf;
        u32x4 v8a = (u32x4){0u, 0u, 0u, 0u}, v8b = v8a, g8a = v8a, g8b = v8a;
        if (pw == 2) { const size_t eo = (rowb + t) * 2048 + vgo; v8a = *(const u32x4*)(Vb + eo); v8b = *(const u32x4*)(Vb + eo + 8); g8a = *(const u32x4*)(Gb + eo); g8b = *(const u32x4*)(Gb + eo + 8); }
        unsigned long long gx[2] = {0ull, 0ull};
#define PROD_ITER(it, PS) do { \
            { const int tb = (it) + 1; \
              if (tb < 64) { \
                LAS float* rec = REC + (tb & 1) * REC_BUF + (16 * tt + fr) * RSTR + 32 * kh + 4 * fq; \
                float ss = 0.f, rkp = 0.f; \
                _Pragma("unroll") for (int kt = 0; kt < 2; ++kt) { \
                    f32x4 accW = (f32x4){0.f, 0.f, 0.f, 0.f}, accA = (f32x4){0.f, 0.f, 0.f, 0.f}; \
                    _Pragma("unroll") for (int ks = 0; ks < 2; ++ks) { accW = MFMA16(aWc[kt][ks], lwf[PS][ks], accW); accA = MFMA16(aAc[kt][ks], laf[PS][ks], accA); } \
                    const int kc = 32 * kh + 16 * kt + 4 * fq; \
                    const f32x4 w0v = *(const LAS f32x4*)(CST + kc), a0v = *(const LAS f32x4*)(CST + 64 + kc), kkc = *(const LAS f32x4*)(CST + 128 + kc), kac = *(const LAS f32x4*)(CST + 192 + kc), rkc = *(const LAS f32x4*)(CST + 256 + kc); \
                    const f32x4 r4 = bf4(r2[PS][kt]), k4 = bf4(k2[PS][kt]); \
                    f32x4 w4, a4; \
                    _Pragma("unroll") for (int e = 0; e < 4; ++e) { w4[e] = __expf(-0.60653066f * sigmf(accW[e] + w0v[e])); a4[e] = sigmf(accA[e] + a0v[e]); } \
                    const f32x4 kkr = k4 * kkc; ss += (kkr.x * kkr.x + kkr.y * kkr.y) + (kkr.z * kkr.z + kkr.w * kkr.w); \
                    const f32x4 km = k4 * (1.0f + (a4 - 1.0f) * kac); const f32x4 rr = r4 * km * rkc; rkp += (rr.x + rr.y) + (rr.z + rr.w); \
                    *(LAS f32x4*)(rec + 16 * kt) = kkr; *(LAS f32x4*)(rec + REC_ARR + 16 * kt) = w4; *(LAS f32x4*)(rec + 2 * REC_ARR + 16 * kt) = kkr * a4; *(LAS f32x4*)(rec + 3 * REC_ARR + 16 * kt) = km; *(LAS f32x4*)(rec + 4 * REC_ARR + 16 * kt) = r4; \
                } \
                if (tb + 2 < 64) ISSUE(PS, tb + 2); \
                ss += __shfl_xor(ss, 16); ss += __shfl_xor(ss, 32); rkp += __shfl_xor(rkp, 16); rkp += __shfl_xor(rkp, 32); \
                if (fq == 0) { SSP[(tb & 1) * 64 + 2 * (16 * tt + fr) + kh] = ss; RKP[(tb & 3) * 64 + 2 * (16 * tt + fr) + kh] = rkp; } \
              } \
              if (pw == 2 && tb < 64) { \
                LAS float* vp = VV + (tb & 3) * 1024 + t * 32 + 16 * hf; LAS float* gp = GG + (tb & 3) * 1024 + t * 32 + 16 * hf; \
                *(LAS f32x4*)(vp) = bf4((u32x2){v8a.x, v8a.y}); *(LAS f32x4*)(vp + 4) = bf4((u32x2){v8a.z, v8a.w}); *(LAS f32x4*)(vp + 8) = bf4((u32x2){v8b.x, v8b.y}); *(LAS f32x4*)(vp + 12) = bf4((u32x2){v8b.z, v8b.w}); \
                *(LAS f32x4*)(gp) = bf4((u32x2){g8a.x, g8a.y}); *(LAS f32x4*)(gp + 4) = bf4((u32x2){g8a.z, g8a.w}); *(LAS f32x4*)(gp + 8) = bf4((u32x2){g8b.x, g8b.y}); *(LAS f32x4*)(gp + 12) = bf4((u32x2){g8b.z, g8b.w}); \
                if (tb + 1 < 64) { const size_t eo = (rowb + (tb + 1) * 32 + t) * 2048 + vgo; v8a = *(const u32x4*)(Vb + eo); v8b = *(const u32x4*)(Vb + eo + 8); g8a = *(const u32x4*)(Gb + eo); g8b = *(const u32x4*)(Gb + eo + 8); } \
              } \
            } \
            if (pw == 3) { \
              if ((it) >= 2 && (it) <= 65) { const int tb = (it) - 2; const unsigned long long* g = GR + ((size_t)(pi * 8 + (tb & 7)) * 2) * 64 + lane; \
                gx[0] = __hip_atomic_load(g, __ATOMIC_RELAXED, __HIP_MEMORY_SCOPE_AGENT); gx[1] = __hip_atomic_load(g + 64, __ATOMIC_RELAXED, __HIP_MEMORY_SCOPE_AGENT); } \
              if ((it) >= 1 && (it) <= 64) { const int tb = (it) - 1; const LAS float* yp_ = YY + (tb & 3) * 1024 + t * 32 + 16 * hf; float s1 = 0.f, s2 = 0.f; \
                _Pragma("unroll") for (int qd = 0; qd < 4; ++qd) { const f32x4 a = *(const LAS f32x4*)(yp_ + 4 * qd); s1 += (a.x + a.y) + (a.z + a.w); s2 += (a.x * a.x + a.y * a.y) + (a.z * a.z + a.w * a.w); } \
                s1 = dpp_add<0xB1>(s1); s2 = dpp_add<0xB1>(s2); \
                const unsigned epoch = (unsigned)(pass * 64 + tb + 1); \
                __hip_atomic_store(GR + ((size_t)((pi * 8 + (tb & 7)) * 2 + rh) * 64 + hf * 32 + t), ((unsigned long long)epoch << 32) | (unsigned long long)__float_as_uint(hf ? s2 : s1), __ATOMIC_RELAXED, __HIP_MEMORY_SCOPE_AGENT); } \
              if ((it) >= 2 && (it) <= 65) { const int tb = (it) - 2; const unsigned epoch = (unsigned)(pass * 64 + tb + 1); \
                const unsigned long long* g = GR + ((size_t)(pi * 8 + (tb & 7)) * 2) * 64 + lane; float tot; \
                for (unsigned spins = 0;; ++spins) { const bool ok = ((unsigned)(gx[0] >> 32) == epoch) && ((unsigned)(gx[1] >> 32) == epoch); tot = __uint_as_float((unsigned)gx[0]) + __uint_as_float((unsigned)gx[1]); \
                    if (__all(ok) || spins > (1u << 22)) break; \
                    __builtin_amdgcn_s_sleep(1); \
                    gx[0] = __hip_atomic_load(g, __ATOMIC_RELAXED, __HIP_MEMORY_SCOPE_AGENT); gx[1] = __hip_atomic_load(g + 64, __ATOMIC_RELAXED, __HIP_MEMORY_SCOPE_AGENT); } \
                const float oth = __shfl_xor(tot, 32); \
                const float mean = (lane < 32 ? tot : oth) * (1.0f / 64.0f), ex2 = (lane < 32 ? oth : tot) * (1.0f / 64.0f); \
                const float rstd = rsqrtf(fmaxf(ex2 - mean * mean, 0.f) + 64e-5f); \
                if (lane < 32) { STT[2 * lane] = mean; STT[2 * lane + 1] = rstd; } \
                const float mu = STT[2 * t], rsd = STT[2 * t + 1]; \
                const int ro = (tb & 3) * 1024 + t * 32 + 16 * hf; const float rk = RKP[(tb & 3) * 64 + 2 * t] + RKP[(tb & 3) * 64 + 2 * t + 1]; \
                unsigned ow[8]; \
                _Pragma("unroll") for (int qd = 0; qd < 4; ++qd) { const f32x4 lg = *(const LAS f32x4*)(CST + 320 + 32 * rh + 16 * hf + 4 * qd), lb = *(const LAS f32x4*)(CST + 384 + 32 * rh + 16 * hf + 4 * qd); \
                    const f32x4 o = ((*(const LAS f32x4*)(YY + ro + 4 * qd) - mu) * rsd * lg + lb + rk * *(const LAS f32x4*)(VV + ro + 4 * qd)) * *(const LAS f32x4*)(GG + ro + 4 * qd); \
                    ow[2 * qd] = pk2(o.x, o.y); ow[2 * qd + 1] = pk2(o.z, o.w); } \
                bf16_t* dst = (bf16_t*)(WSP + WS_A2) + ((size_t)pass * PROWS + rowb + tb * 32 + t) * 2048 + vgo; \
                *(u32x4*)(dst) = (u32x4){ow[0], ow[1], ow[2], ow[3]}; *(u32x4*)(dst + 8) = (u32x4){ow[4], ow[5], ow[6], ow[7]}; } \
            } \
            SCAN_BAR; } while (0)
        for (int it2 = -1; it2 < 65; it2 += 2) { PROD_ITER(it2, 0); PROD_ITER(it2 + 1, 1); }
        PROD_ITER(65, 0);
#undef PROD_ITER
#undef ISSUE
    }
}
__device__ __forceinline__ void p10_final(const Params& p, int G, int bid) {
    OPQ_TID; const int gw = bid * 8 + wave, ngw = G * 8;
    for (int m = gw; m < T; m += ngw) { float* xr = ((float*)p.out) + (size_t)m * D; f32x4 v[4]; float s = 0.f;
#pragma unroll
        for (int j = 0; j < 4; ++j) { v[j] = *((const f32x4*)xr + lane + 64 * j); s += (v[j].x * v[j].x + v[j].y * v[j].y) + (v[j].z * v[j].z + v[j].w * v[j].w); }
        const float rs = rsqrtf(wave_sum(s) * (1.0f / 1024.0f) + 1e-6f);
#pragma unroll
        for (int j = 0; j < 4; ++j) { const f32x4 gg = *((const f32x4*)((const float*)p.in[I_FG]) + lane + 64 * j); *((f32x4*)xr + lane + 64 * j) = v[j] * rs * gg; } }
}

#define XB_TMO      128
#define XB_XCNT(j)  (256  + 64 * (j))
#define XB_XSUB(j)  (1280 + 64 * (j))
#define XB_XGEN(j)  (2304 + 64 * (j))
#define XB_TOP      3328
#define XB_TOPGEN   3392
#define XCD_BAR_WORDS 3456
#define XB_SPIN_CAP (1u << 18)

__device__ __forceinline__ unsigned xb_ld(unsigned* p)              { return __hip_atomic_load(p, __ATOMIC_RELAXED, __HIP_MEMORY_SCOPE_AGENT); }
__device__ __forceinline__ unsigned xb_add(unsigned* p, unsigned v) { return __hip_atomic_fetch_add(p, v, __ATOMIC_RELAXED, __HIP_MEMORY_SCOPE_AGENT); }
__device__ __forceinline__ unsigned xb_xcc_id() { return (unsigned)__builtin_amdgcn_s_getreg((3 << 11) | 20) & 0xFu; }
#define XB_SPIN(cond, bar) do { unsigned _sp = 0; while (cond) { __builtin_amdgcn_s_sleep(1); \
    if ((++_sp & 255u) == 0u) { if (xb_ld(&(bar)[XB_TMO])) break; if (_sp > XB_SPIN_CAP) { atomicAdd(&(bar)[XB_TMO], 1u); break; } } } } while (0)

struct XcdBarrier {
    unsigned* bar; unsigned x;
    volatile LAS unsigned* st;
};

__device__ __forceinline__ XcdBarrier xcd_barrier_post(unsigned* bar, volatile LAS unsigned* st) {
    XcdBarrier b; b.bar = bar; b.x = xb_xcc_id(); b.st = st;
    if (threadIdx.x == 0) (void)xb_add(&bar[XB_XCNT(b.x)], 1u);
    return b;
}
__device__ __forceinline__ void xcd_barrier_complete(unsigned* bar, unsigned x, unsigned& nloc, unsigned& nx) {
    const unsigned G = gridDim.x * gridDim.y * gridDim.z;
    unsigned sum, cnt, mine, sp = 0u;
    for (;;) {
        sum = 0u; cnt = 0u; mine = 0u;
#pragma unroll
        for (unsigned j = 0; j < 16; ++j) { const unsigned c = xb_ld(&bar[XB_XCNT(j)]); sum += c; cnt += (c > 0u) ? 1u : 0u; mine = (j == x) ? c : mine; }
        if (sum == G) break;
        __builtin_amdgcn_s_sleep(1);
        if ((++sp & 255u) == 0u) { if (xb_ld(&bar[XB_TMO])) break; if (sp > XB_SPIN_CAP) { atomicAdd(&bar[XB_TMO], 1u); break; } }
    }
    nloc = mine > 0u ? mine : 1u; nx = cnt > 0u ? cnt : 1u;
}

__device__ __forceinline__ void xcd_barrier(const XcdBarrier& b) {
    asm volatile("s_waitcnt vmcnt(0)" ::: "memory");
    __syncthreads();
    if (threadIdx.x == 0) {
        unsigned* bar = (unsigned*)(*(volatile LAS unsigned long long*)(b.st + 4)); const unsigned bx_ = xb_xcc_id();
        __builtin_amdgcn_s_waitcnt(0);
        unsigned nloc = b.st[0], nx = b.st[1];
        if (nloc == 0u) { xcd_barrier_complete(bar, bx_, nloc, nx); b.st[0] = nloc; b.st[1] = nx; }
        const unsigned old = xb_add(&bar[XB_XSUB(bx_)], 1u);
        const unsigned gen = old / nloc;
        if (old + 1u == (gen + 1u) * nloc) {
            __builtin_amdgcn_fence(__ATOMIC_RELEASE, "agent");
            asm volatile("s_waitcnt vmcnt(0)" ::: "memory");
            const unsigned og = xb_add(&bar[XB_TOP], 1u);
            const unsigned tg = og / nx;
            if (og + 1u == (tg + 1u) * nx) xb_add(&bar[XB_TOPGEN], 1u);
            else XB_SPIN(xb_ld(&bar[XB_TOPGEN]) == tg, bar);
            __builtin_amdgcn_fence(__ATOMIC_ACQUIRE, "agent");
            xb_add(&bar[XB_XGEN(bx_)], 1u);
            asm volatile("s_waitcnt vmcnt(0)" ::: "memory");
        } else {
            XB_SPIN(xb_ld(&bar[XB_XGEN(bx_)]) == gen, bar);
            __builtin_amdgcn_fence(__ATOMIC_ACQUIRE, "agent");
            asm volatile("s_waitcnt vmcnt(0)" ::: "memory");
        }
    }
    __syncthreads();
}

__global__ void __launch_bounds__(NT, 2) mk_fwd(Params p) {
    auto wsl = [&]() { return launder_ws(((unsigned char*)p.ws)); };
    extern __shared__ __attribute__((aligned(16))) unsigned char lds_raw[];
    LAS unsigned char* lds = (LAS unsigned char*)lds_raw;
    cg::grid_group grid = cg::this_grid();
    const int G = gridDim.x, bid = blockIdx.x;
    if (threadIdx.x < 16) ((LAS unsigned*)(lds + LDS_MISC))[threadIdx.x] = 0u;
    __syncthreads();
    if (threadIdx.x == 0) *(LAS unsigned long long*)(lds + LDS_MISC + 16) = (unsigned long long)(((unsigned char*)p.ws) + WS_BAR);
    __syncthreads();
    (void)xcd_barrier_post((unsigned*)(((unsigned char*)p.ws) + WS_BAR), (volatile LAS unsigned*)(lds + LDS_MISC));
#define XBAR() do { XcdBarrier xb_; xb_.bar = nullptr; xb_.x = 0u; xb_.st = (volatile LAS unsigned*)(lds + LDS_MISC); xcd_barrier(xb_); } while (0)
#if PROBE == 7
    p0_prologue(p, lds, G, bid);
#endif
    p0_prologue(p, lds, G, bid);
    grid.sync();
    { pg8::Gemm g{(const bf16_t*)((float*)p.out), (const bf16_t*)(wsl() + WS_WIN), T, ZW, D, D}; pg8::StaticOrder S; S.init(T, ZW, G, bid); pg8::EpiBf16 E{(bf16_t*)(wsl() + WS_Z), ZW};
      pg8::gemm_phase<pg8::EpiBf16, pg8::StaticOrder, true, true>(lds, g, S, E); }
    XBAR();
#if PROBE == 3
    { u32x4 pre[3]; if (bid < 2048) rg_a_prefetch((const bf16_t*)(wsl() + WS_Z), bid, threadIdx.x, pre); for (int u = bid; u < 2048; u += G) rg_a_unit(p, lds, u, u + G, pre); }
    { u32x4 pre[6]; if (bid < 2048) hg_a_prefetch((const bf16_t*)(wsl() + WS_Z), bid, threadIdx.x, pre); for (int u = bid; u < 2048; u += G) hg_a_unit(p, lds, u, u + G, pre); }
    XBAR();
#endif
    { u32x4 pre[3]; if (bid < 2048) rg_a_prefetch((const bf16_t*)(wsl() + WS_Z), bid, threadIdx.x, pre); for (int u = bid; u < 2048; u += G) rg_a_unit(p, lds, u, u + G, pre); }
    { u32x4 pre[6]; if (bid < 2048) hg_a_prefetch((const bf16_t*)(wsl() + WS_Z), bid, threadIdx.x, pre); for (int u = bid; u < 2048; u += G) hg_a_unit(p, lds, u, u + G, pre); }
    XBAR();
#if PROBE == 2
    for (int u = bid; u < 256; u += G) hg_b_item(p, lds, u, p.dry != 0);
    XBAR();
#endif
#if PROBE == 6
    for (int u = bid; u < 512; u += G) rg_b_unit(p, u);
    XBAR();
#endif
#if PROBE == 4
    for (int q = 0; q < 16; ++q) XBAR();
#endif
    for (int u = bid; u < 256; u += G) { const int it_ = (G == 256) ? ((((u & 7) + 8 * (u >> 6)) << 3) | ((u >> 3) & 7)) : u; hg_b_item(p, lds, it_); }
    for (int u = bid; u < 512; u += G) rg_b_unit(p, u);
    XBAR();
#if PROBE == 8
    p4_finalize(p, G, bid);
#endif
    p4_finalize(p, G, bid);
    XBAR();
    { pg8::Gemm g{(const bf16_t*)(wsl() + WS_Z), (const bf16_t*)(wsl() + WS_WOUT), T, D, 2048, ZW}; pg8::StaticOrder S; S.init(T, D, G, bid); pg8::EpiResF32 E{((const float*)p.in[I_X]), ((float*)p.out), D, 0, 0};
      pg8::gemm_phase<pg8::EpiResF32, pg8::StaticOrder, true, true>(lds, g, S, E); }
    XBAR();
#if PROBE == 9
    p6_prologue(p, lds, G, bid);
#endif
    p6_prologue(p, lds, G, bid);
    XBAR();
#pragma unroll 1
    for (int pass = 0; pass < 2; ++pass) {
        { pg8::Gemm g{(const bf16_t*)(wsl() + WS_A2) + (size_t)pass * 8192 * 2048, (const bf16_t*)(wsl() + WS_WC), 8192, 8192, 2048, 2048}; pg8::StaticOrder S; S.init(8192, 8192, G, bid);
          pg8::EpiL1 E{(bf16_t*)(wsl() + WS_R), (bf16_t*)(wsl() + WS_LW), (bf16_t*)(wsl() + WS_LA)};
          pg8::gemm_phase<pg8::EpiL1, pg8::StaticOrder, true, true>(lds, g, S, E); }
        XBAR();
        for (int u0 = 0; u0 < 256; u0 += G) { const int u = u0 + bid; if (u < 256) { int pi, rh; if (G == 256) { pi = (u & 7) + 8 * (u >> 4); rh = (u >> 3) & 1; } else { pi = u >> 1; rh = u & 1; } scan_half(p, lds, pi, rh, pass); } }
        XBAR();
    }
    if (G == 256) {
        pg8::Gemm g{(const bf16_t*)(wsl() + WS_A2), (const bf16_t*)(wsl() + WS_WO), T, D, 2048, 2048}; pg8::StaticOrder S; S.init(T, D, G, bid); pg8::EpiFinalNorm E{((float*)p.out), ((const float*)p.in[I_FG]), (unsigned long long*)(wsl() + WS_XG), D};
        pg8::gemm_phase<pg8::EpiFinalNorm, pg8::StaticOrder, false, true>(lds, g, S, E);
    } else {
        { pg8::Gemm g{(const bf16_t*)(wsl() + WS_A2), (const bf16_t*)(wsl() + WS_WO), T, D, 2048, 2048}; pg8::StaticOrder S; S.init(T, D, G, bid); pg8::EpiResF32 E{((float*)p.out), ((float*)p.out), D, 1, 0};
          pg8::gemm_phase<pg8::EpiResF32, pg8::StaticOrder, true, true>(lds, g, S, E); }
        XBAR();
        p10_final(p, G, bid);
    }
}

extern "C" void kernel_launch(void* const* d_in, const int* in_sizes, int n_in, void* d_out, int out_size, void* d_ws, size_t ws_size, hipStream_t stream) {
    static int grid = 0;
    if (grid == 0) {
        int dev = 0, cus = 0, per_cu = 0;
        if (n_in != 32 || out_size != T * D || ws_size < 256 * MiB) { fprintf(stderr, "kernel_launch: unexpected shapes (n_in %d out %d ws %zu)\n", n_in, out_size, ws_size); grid = -1; return; }
        if (hipGetDevice(&dev) != hipSuccess || hipDeviceGetAttribute(&cus, hipDeviceAttributeMultiprocessorCount, dev) != hipSuccess) { grid = -1; return; }
        if (hipFuncSetAttribute((const void*)mk_fwd, hipFuncAttributeMaxDynamicSharedMemorySize, LDS_BYTES) != hipSuccess) { fprintf(stderr, "hipFuncSetAttribute failed\n"); grid = -1; return; }
        if (hipOccupancyMaxActiveBlocksPerMultiprocessor(&per_cu, (const void*)mk_fwd, NT, LDS_BYTES) != hipSuccess || per_cu < 1) fprintf(stderr, "occupancy query: %d\n", per_cu);
        (void)hipGetLastError();
        grid = cus;
    }
    if (grid < 0) return;
    if (hipMemsetAsync((char*)d_ws + WS_BAR, 0, 16384, stream) != hipSuccess) { fprintf(stderr, "memset failed\n"); return; }
    Params p{};
    p.dry = 1;
    for (int i = 0; i < 32; ++i) memcpy(&p.in[i], &d_in[i], sizeof(void*));
    memcpy(&p.out, &d_out, sizeof(void*)); memcpy(&p.ws, &d_ws, sizeof(void*));
    void* args[] = {&p};
    hipError_t e = hipLaunchCooperativeKernel((const void*)mk_fwd, dim3(grid), dim3(NT), args, LDS_BYTES, stream);
    if (e != hipSuccess) fprintf(stderr, "cooperative launch failed: %s (grid %d)\n", hipGetErrorString(e), grid);
}
```

```cpp
#define PROBE 0
#include <hip/hip_runtime.h>
#include <hip/hip_cooperative_groups.h>
#include <cstdio>
#include <cstring>
#include <cstdint>
namespace cg = cooperative_groups;
namespace pg8 {
#define PG8_LAS __attribute__((address_space(3)))
typedef unsigned short bf16_t;
typedef short bf16x8 __attribute__((ext_vector_type(8)));
typedef float f32x4 __attribute__((ext_vector_type(4)));
typedef unsigned u32x4 __attribute__((ext_vector_type(4)));
constexpr int BM = 256, BK = 64, HALF = 128, HTB = HALF * BK * 2  , STAGE_BYTES = 8 * HTB, NXCD = 8, WGM = 8;

__host__ __device__ __forceinline__ int lds_byte(int r, int c) { const int st = (r >> 4) * 2 + (c >> 5), rr = r & 15, cc = c & 31, ob = rr * 64 + cc * 2; return st * 1024 + (ob ^ (((ob >> 9) & 1) << 5)); }
__host__ __device__ __forceinline__ void stage_rc(int b, int& R, int& C) { const int st = b / 1024, sb = b % 1024, swz = sb ^ (((sb >> 9) & 1) << 5); R = (st >> 1) * 16 + swz / 64; C = (st & 1) * 32 + (swz % 64) / 2; }
__host__ __device__ __forceinline__ int perm32(int rho) { const int n = rho >> 4, i = rho & 15; return 8 * (i >> 2) + 4 * n + (i & 3); }

struct Unit { int pm, pn; };
struct Gemm { const bf16_t* A; const bf16_t* Bt; int M, N, K, lda; };

struct StaticOrder {
    int nM, nN, nwg, G, c;
    __host__ __device__ void init(int M, int N, int G_, int c_) { nM = M / BM; nN = N / BM; nwg = nM * nN; G = G_; c = c_; }
    __host__ __device__ bool next(int i, Unit& u) const {
        const long L = (long)i * G + c; if (L >= nwg) return false;
        int wgid = (int)L; { const int q = nwg / NXCD, r = nwg % NXCD, xcd = wgid % NXCD, off = wgid / NXCD; wgid = (xcd < r ? xcd * (q + 1) : r * (q + 1) + (xcd - r) * q) + off; }
        const int nig = WGM * nN, gid = wgid / nig, fm = gid * WGM, gsz = (nM - fm) < WGM ? (nM - fm) : WGM;
        u.pm = fm + ((wgid % nig) % gsz); u.pn = (wgid % nig) / gsz; return true;
    }
    __device__ __forceinline__ void a_ready(const Unit&) const {}
    __device__ __forceinline__ void done(const Unit&) const {}
};


struct LoraOrder {
    StaticOrder so; int extra;
    __host__ __device__ void init(int M, int N, int G_, int c_, int extra_) { so.init(M, N, G_, c_); extra = extra_; }
    __host__ __device__ bool next(int i, Unit& u) const { const long L = (long)i * so.G + so.c; if (L < so.nwg) return so.next(i, u); if (L >= so.nwg + extra) return false; u.pm = so.nM + (int)(L - so.nwg); u.pn = so.nN - 1; return true; }
    __device__ __forceinline__ void a_ready(const Unit&) const {}
    __device__ __forceinline__ void done(const Unit&) const {}
};
__device__ __forceinline__ unsigned cvt_pk_bf16(float lo, float hi) { unsigned r; asm volatile("v_cvt_pk_bf16_f32 %0, %1, %2" : "=v"(r) : "v"(lo), "v"(hi)); return r; }
__device__ __forceinline__ float sigm(float x) { return __builtin_amdgcn_rcpf(1.0f + __expf(-x)); }
struct EpiBf16 {
    static constexpr bool PERM = true, AFTER_DRAIN = false;
    bf16_t* O; int ldc;
    __device__ __forceinline__ void operator()(const f32x4 (&acc)[2][2][4][2], const Unit& u, int wr, int wc, int fr, int fq) const {
        const int row0 = u.pm * BM + wr * 64 + fr; const int col0 = u.pn * BM + wc * 32 + 8 * fq;
#pragma unroll
        for (int ai = 0; ai < 2; ++ai)
#pragma unroll
            for (int m = 0; m < 4; ++m) { bf16_t* rowp = O + (size_t)(row0 + ai * HALF + m * 16) * ldc + col0;
#pragma unroll
                for (int bj = 0; bj < 2; ++bj) { const f32x4 v0 = acc[ai][bj][m][0], v1 = acc[ai][bj][m][1];
                    u32x4 w; w.x = cvt_pk_bf16(v0[0], v0[1]); w.y = cvt_pk_bf16(v0[2], v0[3]); w.z = cvt_pk_bf16(v1[0], v1[1]); w.w = cvt_pk_bf16(v1[2], v1[3]);
                    *(u32x4*)(rowp + bj * HALF) = w; } }
    }
};
struct EpiResF32 {
    static constexpr bool PERM = false, AFTER_DRAIN = false;
    const float* base; float* out; int ldc; int remap; int pass;
    __device__ __forceinline__ void operator()(const f32x4 (&acc)[2][2][4][2], const Unit& u, int wr, int wc, int fr, int fq) const {
        const int col0 = u.pn * BM + wc * 32 + 4 * fq; const int rbase = remap ? ((((u.pm >> 3) & 3) << 12) + (u.pm >> 5) * 2048 + (u.pm & 7) * BM) : u.pm * BM;
#pragma unroll
        for (int ai = 0; ai < 2; ++ai)
#pragma unroll
            for (int m = 0; m < 4; ++m) { const size_t off = (size_t)(rbase + ai * HALF + wr * 64 + m * 16 + fr) * ldc + col0;
#pragma unroll
                for (int bj = 0; bj < 2; ++bj)
#pragma unroll
                    for (int n = 0; n < 2; ++n) { const f32x4 bs = *(const f32x4*)(base + off + bj * HALF + n * 16); *(f32x4*)(out + off + bj * HALF + n * 16) = bs + acc[ai][bj][m][n]; } }
    }
};
struct EpiL1 {
    static constexpr bool PERM = true, AFTER_DRAIN = false;
    bf16_t* R; bf16_t* LW; bf16_t* LA;
    __device__ __forceinline__ void operator()(const f32x4 (&acc)[2][2][4][2], const Unit& u, int wr, int wc, int fr, int fq) const {
        const int row0 = u.pm * BM + wr * 64 + fr;
        if (u.pn < 32) {
            const int buf = u.pn >> 3; bf16_t* base = R + (size_t)buf * (8192u * 2048u); const int col0 = (u.pn & 7) * BM + wc * 32 + 8 * fq;
#pragma unroll
            for (int ai = 0; ai < 2; ++ai)
#pragma unroll
                for (int m = 0; m < 4; ++m) { bf16_t* rowp = base + (size_t)(row0 + ai * HALF + m * 16) * 2048 + col0;
#pragma unroll
                    for (int bj = 0; bj < 2; ++bj) { f32x4 v0 = acc[ai][bj][m][0], v1 = acc[ai][bj][m][1];
                        if (buf == 3) {
#pragma unroll
                            for (int q = 0; q < 4; ++q) { v0[q] = v0[q] * sigm(v0[q]); v1[q] = v1[q] * sigm(v1[q]); } }
                        u32x4 w; w.x = cvt_pk_bf16(v0[0], v0[1]); w.y = cvt_pk_bf16(v0[2], v0[3]); w.z = cvt_pk_bf16(v1[0], v1[1]); w.w = cvt_pk_bf16(v1[2], v1[3]);
                        *(u32x4*)(rowp + bj * HALF) = w; } }
        } else {
            const int c0 = wc * 32 + 8 * fq;
#pragma unroll
            for (int ai = 0; ai < 2; ++ai)
#pragma unroll
                for (int m = 0; m < 4; ++m) { const size_t row = (size_t)(row0 + ai * HALF + m * 16); f32x4 v0 = acc[ai][0][m][0], v1 = acc[ai][0][m][1];
                    if (c0 < 64) {
#pragma unroll
                        for (int q = 0; q < 4; ++q) { v0[q] = tanhf(v0[q]); v1[q] = tanhf(v1[q]); } }
                    u32x4 w; w.x = cvt_pk_bf16(v0[0], v0[1]); w.y = cvt_pk_bf16(v0[2], v0[3]); w.z = cvt_pk_bf16(v1[0], v1[1]); w.w = cvt_pk_bf16(v1[2], v1[3]);
                    if (c0 < 64) *(u32x4*)(LW + row * 64 + c0) = w; else *(u32x4*)(LA + row * 64 + c0 - 64) = w; }
        }
    }
};

struct EpiFinalNorm {
    static constexpr bool PERM = false, AFTER_DRAIN = true;
    float* out; const float* g; unsigned long long* xg; int ldc;
    __device__ __forceinline__ void fused(f32x4 (&acc)[2][2][4][2], const Unit& u, int wr, int wc, int fr, int fq, PG8_LAS unsigned char* lds, int wid, int lane) const {
        PG8_LAS float* P = (PG8_LAS float*)lds; PG8_LAS float* S = (PG8_LAS float*)(lds + 4096);
        const int col0 = u.pn * BM + wc * 32 + 4 * fq; const int rbase = (((u.pm >> 3) & 3) << 12) + (u.pm >> 5) * 2048 + (u.pm & 7) * BM;
#pragma unroll
        for (int ai = 0; ai < 2; ++ai)
#pragma unroll
            for (int m = 0; m < 4; ++m) { const size_t off = (size_t)(rbase + ai * HALF + wr * 64 + m * 16 + fr) * ldc + col0; float s = 0.f;
#pragma unroll
                for (int bj = 0; bj < 2; ++bj)
#pragma unroll
                    for (int n = 0; n < 2; ++n) { const f32x4 v = acc[ai][bj][m][n] + *(const f32x4*)(out + off + bj * HALF + n * 16); acc[ai][bj][m][n] = v; s += (v[0] * v[0] + v[1] * v[1]) + (v[2] * v[2] + v[3] * v[3]); }
                s += __shfl_xor(s, 16); s += __shfl_xor(s, 32);
                if (fq == 0) P[(ai * HALF + wr * 64 + m * 16 + fr) * 4 + wc] = s; }
        asm volatile("s_waitcnt lgkmcnt(0)" ::: "memory"); __builtin_amdgcn_s_barrier(); asm volatile("" ::: "memory");
        const int row = wid * 32 + (lane & 31);
        if (lane < 32) { const float tot = (P[row * 4] + P[row * 4 + 1]) + (P[row * 4 + 2] + P[row * 4 + 3]);
            __hip_atomic_store(xg + ((size_t)(u.pm * 4 + u.pn) * 256 + row), (1ull << 32) | (unsigned long long)__float_as_uint(tot), __ATOMIC_RELAXED, __HIP_MEMORY_SCOPE_AGENT); }
        {
            float tot = 0.f;
            for (unsigned spins = 0;; ++spins) { bool ok = true; tot = 0.f;
                if (lane < 32) {
#pragma unroll
                    for (int q = 0; q < 4; ++q) { const unsigned long long x = __hip_atomic_load(xg + ((size_t)(u.pm * 4 + q) * 256 + row), __ATOMIC_RELAXED, __HIP_MEMORY_SCOPE_AGENT); ok &= (unsigned)(x >> 32) == 1u; tot += __uint_as_float((unsigned)x); } }
                if (__all(ok) || spins > (1u << 22)) break;
                __builtin_amdgcn_s_sleep(1); }
            if (lane < 32) S[row] = rsqrtf(tot * (1.0f / 1024.0f) + 1e-6f);
        }
        asm volatile("s_waitcnt lgkmcnt(0)" ::: "memory"); __builtin_amdgcn_s_barrier(); asm volatile("" ::: "memory");
#pragma unroll
        for (int ai = 0; ai < 2; ++ai)
#pragma unroll
            for (int m = 0; m < 4; ++m) { const int r = ai * HALF + wr * 64 + m * 16 + fr; const float rs = S[r]; const size_t off = (size_t)(rbase + r) * ldc + col0;
#pragma unroll
                for (int bj = 0; bj < 2; ++bj)
#pragma unroll
                    for (int n = 0; n < 2; ++n) { const f32x4 gg = *(const f32x4*)(g + col0 + bj * HALF + n * 16); *(f32x4*)(out + off + bj * HALF + n * 16) = acc[ai][bj][m][n] * rs * gg; } }
    }
};
template <class Epi, class Sched, bool ALIGN_EPI = false, bool SP2 = false>
__device__ __forceinline__ void gemm_phase(PG8_LAS unsigned char* lds, const Gemm g, const Sched& S, const Epi& E) {
    int tid_o = threadIdx.x; asm volatile("" : "+v"(tid_o)); const int tid = tid_o, wid = __builtin_amdgcn_readfirstlane(tid >> 6), lane = tid & 63, wr = wid >> 2, wc = wid & 3, fr = lane & 15, fq = lane >> 4;
    const int K = g.K, nt = K / BK;
    unsigned voffA[2], voffB[2];
#pragma unroll
    for (int i = 0; i < 2; ++i) { int R, C; stage_rc(tid * 16 + i * 8192, R, C); const int Rb = Epi::PERM ? ((R & ~31) + perm32(R & 31)) : R;
        voffA[i] = (unsigned)(R * g.lda + C) * 2u; voffB[i] = (unsigned)(Rb * K + C) * 2u; }
    const size_t kstep = (size_t)(BK * 2);
    const size_t hstep = (size_t)HALF * K * 2;
    const size_t tstep = 2 * hstep; const size_t hstepA = (size_t)HALF * g.lda * 2, tstepA = 2 * hstepA;
    const unsigned ldsw = (unsigned)wid * 1024u;
    const int aoff = lds_byte(wr * 64 + fr, fq * 8), boff = lds_byte(wc * 32 + fr, fq * 8);
#define PG8_SA(b, h) (((b) * 2 + (h)) * HTB)
#define PG8_SB(b, h) ((4 + (b) * 2 + (h)) * HTB)
#define PG8_STAGE(bufoff, gbase, voff) do { _Pragma("unroll") for (int _i = 0; _i < 2; ++_i) \
        __builtin_amdgcn_global_load_lds((const unsigned*)((const char*)(gbase) + (voff)[_i]), (PG8_LAS unsigned*)(lds + (bufoff) + ldsw + _i * 8192), 16, 0, 0); } while (0)
#define PG8_LDA(dst, b, h) do { _Pragma("unroll") for (int m = 0; m < 4; ++m) _Pragma("unroll") for (int k = 0; k < 2; ++k) dst[m][k] = *(const PG8_LAS bf16x8*)(lds + PG8_SA(b, h) + aoff + m * 2048 + k * 1024); } while (0)
#define PG8_LDB(dst, b, h) do { _Pragma("unroll") for (int n = 0; n < 2; ++n) _Pragma("unroll") for (int k = 0; k < 2; ++k) dst[n][k] = *(const PG8_LAS bf16x8*)(lds + PG8_SB(b, h) + boff + n * 2048 + k * 1024); } while (0)
#define PG8_MMA(ai, bj, At, Bt) do { __builtin_amdgcn_s_setprio(1); _Pragma("unroll") for (int m = 0; m < 4; ++m) _Pragma("unroll") for (int n = 0; n < 2; ++n) _Pragma("unroll") for (int k = 0; k < 2; ++k) \
        acc[ai][bj][m][n] = __builtin_amdgcn_mfma_f32_16x16x32_bf16(Bt[n][k], At[m][k], acc[ai][bj][m][n], 0, 0, 0); __builtin_amdgcn_s_setprio(0); } while (0)
#define PG8_WAIT_V(n) asm volatile("s_waitcnt vmcnt(" #n ")" ::: "memory")
#define PG8_WAIT_L(n) asm volatile("s_waitcnt lgkmcnt(" #n ")" ::: "memory")
#define PG8_BAR __builtin_amdgcn_s_barrier()
#define PG8_SCHED __builtin_amdgcn_sched_barrier(0)
    Unit cur, nxt; int ui = 0;
    if (!S.next(0, cur)) return;
    f32x4 acc[2][2][4][2];
#pragma unroll
    for (int a = 0; a < 2; ++a)
#pragma unroll
        for (int b = 0; b < 2; ++b)
#pragma unroll
            for (int m = 0; m < 4; ++m)
#pragma unroll
                for (int n = 0; n < 2; ++n) acc[a][b][m][n] = (f32x4){0.f, 0.f, 0.f, 0.f};
    bf16x8 At[4][2], B0[2][2], B1[2][2];
    const char* cA = (const char*)g.A + (size_t)cur.pm * tstepA; const char* cB = (const char*)g.Bt + (size_t)cur.pn * tstep;
    S.a_ready(cur);
    if constexpr (SP2) {
        PG8_STAGE(PG8_SB(0, 0), cB, voffB); PG8_STAGE(PG8_SB(0, 1), cB + hstep, voffB); PG8_STAGE(PG8_SA(0, 0), cA, voffA); PG8_STAGE(PG8_SA(0, 1), cA + hstepA, voffA);
        if (wr == 1) PG8_BAR;
        PG8_WAIT_V(2); PG8_BAR;
        PG8_STAGE(PG8_SB(1, 0), cB + kstep, voffB); PG8_STAGE(PG8_SA(1, 0), cA + kstep, voffA); PG8_STAGE(PG8_SB(1, 1), cB + hstep + kstep, voffB);
        PG8_WAIT_V(6); PG8_BAR;
    } else {
        PG8_STAGE(PG8_SB(0, 0), cB, voffB); PG8_STAGE(PG8_SA(0, 0), cA, voffA); PG8_STAGE(PG8_SB(0, 1), cB + hstep, voffB); PG8_STAGE(PG8_SA(0, 1), cA + hstepA, voffA);
        if (wr == 1) PG8_BAR;
        PG8_WAIT_V(4); PG8_BAR;
        PG8_STAGE(PG8_SB(1, 0), cB + kstep, voffB); PG8_STAGE(PG8_SA(1, 0), cA + kstep, voffA); PG8_STAGE(PG8_SB(1, 1), cB + hstep + kstep, voffB);
        PG8_WAIT_V(6); PG8_BAR;
    }
    for (;;) {
        const bool has_next = S.next(ui + 1, nxt);
        const char* nA = has_next ? (const char*)g.A + (size_t)nxt.pm * tstepA : cA; const char* nB = has_next ? (const char*)g.Bt + (size_t)nxt.pn * tstep : cB;
        for (int t = 0; t < nt; t += 2) {
            const bool last = (t == nt - 2);
            const char* a1 = cA + (size_t)(t + 1) * kstep;
            const char* a2 = last ? nA : cA + (size_t)(t + 2) * kstep; const char* b2 = last ? nB : cB + (size_t)(t + 2) * kstep;
            const char* a3 = a2 + kstep; const char* b3 = b2 + kstep;
            if (last && has_next) S.a_ready(nxt);
            if constexpr (SP2) {
            PG8_LDB(B0, 0, 0); PG8_LDB(B1, 0, 1); PG8_SCHED; PG8_LDA(At, 0, 0); PG8_STAGE(PG8_SA(1, 1), a1 + hstepA, voffA);
            PG8_WAIT_V(8); PG8_WAIT_L(0); PG8_BAR; PG8_MMA(0, 0, At, B0); PG8_MMA(0, 1, At, B1); PG8_BAR; PG8_SCHED;
            PG8_LDA(At, 0, 1); PG8_STAGE(PG8_SB(0, 0), b2, voffB); PG8_STAGE(PG8_SB(0, 1), b2 + hstep, voffB); PG8_STAGE(PG8_SA(0, 0), a2, voffA);
            PG8_WAIT_V(8); PG8_WAIT_L(0); PG8_BAR; PG8_MMA(1, 0, At, B0); PG8_MMA(1, 1, At, B1); PG8_BAR; PG8_SCHED;
            PG8_LDB(B0, 1, 0); PG8_LDB(B1, 1, 1); PG8_SCHED; PG8_LDA(At, 1, 0); PG8_STAGE(PG8_SA(0, 1), a2 + hstepA, voffA);
            PG8_WAIT_V(8); PG8_WAIT_L(0); PG8_BAR; PG8_MMA(0, 0, At, B0); PG8_MMA(0, 1, At, B1); PG8_BAR; PG8_SCHED;
            PG8_LDA(At, 1, 1); PG8_STAGE(PG8_SB(1, 0), b3, voffB); PG8_STAGE(PG8_SB(1, 1), b3 + hstep, voffB); PG8_STAGE(PG8_SA(1, 0), a3, voffA);
            PG8_WAIT_V(8); PG8_WAIT_L(0); PG8_BAR; PG8_MMA(1, 0, At, B0); PG8_MMA(1, 1, At, B1); PG8_BAR; PG8_SCHED;
            } else {
            PG8_LDB(B0, 0, 0); PG8_SCHED; PG8_LDA(At, 0, 0); PG8_STAGE(PG8_SA(1, 1), a1 + hstepA, voffA);
            PG8_WAIT_L(8); PG8_BAR; PG8_WAIT_L(0); PG8_MMA(0, 0, At, B0); PG8_BAR; PG8_SCHED;
            PG8_LDB(B1, 0, 1); PG8_STAGE(PG8_SB(0, 0), b2, voffB);
            PG8_BAR; PG8_WAIT_L(0); PG8_MMA(0, 1, At, B1); PG8_BAR;
            PG8_LDA(At, 0, 1); PG8_STAGE(PG8_SA(0, 0), a2, voffA);
            PG8_BAR; PG8_WAIT_L(0); PG8_MMA(1, 0, At, B0); PG8_BAR; PG8_SCHED;
            PG8_STAGE(PG8_SB(0, 1), b2 + hstep, voffB);
            PG8_WAIT_V(6); PG8_BAR; PG8_MMA(1, 1, At, B1); PG8_BAR;
            PG8_LDB(B0, 1, 0); PG8_SCHED; PG8_LDA(At, 1, 0); PG8_STAGE(PG8_SA(0, 1), a2 + hstepA, voffA);
            PG8_WAIT_L(8); PG8_BAR; PG8_WAIT_L(0); PG8_MMA(0, 0, At, B0); PG8_BAR; PG8_SCHED;
            PG8_LDB(B1, 1, 1); PG8_STAGE(PG8_SB(1, 0), b3, voffB);
            PG8_BAR; PG8_WAIT_L(0); PG8_MMA(0, 1, At, B1); PG8_BAR;
            PG8_LDA(At, 1, 1); PG8_STAGE(PG8_SA(1, 0), a3, voffA);
            PG8_BAR; PG8_WAIT_L(0); PG8_MMA(1, 0, At, B0); PG8_BAR; PG8_SCHED;
            PG8_STAGE(PG8_SB(1, 1), b3 + hstep, voffB);
            PG8_WAIT_V(6); PG8_BAR; PG8_MMA(1, 1, At, B1); PG8_BAR;
            }
        }
        if constexpr (ALIGN_EPI) { if (wr == 0) PG8_BAR; }
        if constexpr (!Epi::AFTER_DRAIN) { E(acc, cur, wr, wc, fr, fq); S.done(cur); }
        if (!has_next) break;
#pragma unroll
        for (int a = 0; a < 2; ++a)
#pragma unroll
            for (int b = 0; b < 2; ++b)
#pragma unroll
                for (int m = 0; m < 4; ++m)
#pragma unroll
                    for (int n = 0; n < 2; ++n) acc[a][b][m][n] = (f32x4){0.f, 0.f, 0.f, 0.f};
        cur = nxt; cA = nA; cB = nB; ++ui;
        if constexpr (ALIGN_EPI) { if (wr == 1) PG8_BAR; }
    }
    PG8_WAIT_V(0);
    if constexpr (!ALIGN_EPI) { if (wr == 0) PG8_BAR; }
    PG8_BAR;
    if constexpr (Epi::AFTER_DRAIN) { E.fused(acc, cur, wr, wc, fr, fq, lds, wid, lane); S.done(cur); }
#undef PG8_SA
#undef PG8_SB
#undef PG8_STAGE
#undef PG8_LDA
#undef PG8_LDB
#undef PG8_MMA
#undef PG8_WAIT_V
#undef PG8_WAIT_L
#undef PG8_BAR
#undef PG8_SCHED
}
}
#define GAS __attribute__((address_space(1)))
#define LAS __attribute__((address_space(3)))
typedef unsigned short bf16_t;
typedef short bf16x8 __attribute__((ext_vector_type(8)));
typedef float f32x4 __attribute__((ext_vector_type(4)));
typedef unsigned u32x4 __attribute__((ext_vector_type(4)));
typedef unsigned u32x2 __attribute__((ext_vector_type(2)));
typedef float f32x2 __attribute__((ext_vector_type(2)));
constexpr int NT = 512, PROWS6 = 8192;
constexpr int T = 16384, SEQ = 4096, D = 1024, ZW = 6144;
constexpr size_t MiB = 1u << 20;
constexpr size_t WS_DEC = 0;
constexpr size_t WS_Z = 4 * MiB;
constexpr size_t WS_WIN = 196 * MiB, WS_WOUT = 208 * MiB, WS_RGA = 212 * MiB, WS_RGX = 212 * MiB + 256 * 1024;
constexpr size_t WS_OI = 213 * MiB;
constexpr size_t WS_A2 = 4 * MiB;
constexpr size_t WS_R = 68 * MiB;
constexpr size_t WS_V = 132 * MiB;
constexpr size_t WS_WC = 196 * MiB, WS_WO = 229 * MiB, WS_LW = 233 * MiB, WS_LA = 235 * MiB;
constexpr size_t WS_W2T = 237 * MiB, WS_A2T = 237 * MiB + 256 * 1024, WS_GR = 238 * MiB, WS_ST = 239 * MiB, WS_XG = 241 * MiB;
constexpr size_t WS_WL = 246 * MiB;
constexpr size_t WS_BAR = 2 * MiB;
constexpr int LDS_BYTES = 147456, LDS_MISC = 147456 - 64;

struct Params { const GAS float* in[32]; GAS float* out; GAS unsigned char* ws; long long dry; };
#ifndef PROBE
#define PROBE 0
#endif
enum { I_X = 0, I_ABG, I_WIN, I_CONVW, I_CONVB, I_RGWA, I_RGBA, I_RGWX, I_RGBX, I_LAM, I_LB, I_HGG, I_WOUT, I_CNG, I_MU, I_WR, I_WK, I_WV, I_WG, I_W0, I_W1, I_W2, I_A0, I_A1, I_A2, I_KK, I_KA, I_RK, I_LNG, I_LNB, I_WO, I_FG };

__device__ __forceinline__ unsigned f2bf(float f) { unsigned u = __float_as_uint(f); return (u + 0x7fffu + ((u >> 16) & 1u)) >> 16; }
__device__ __forceinline__ float bf2f(unsigned h) { return __uint_as_float(h << 16); }
__device__ __forceinline__ unsigned pk2(float lo, float hi) { return f2bf(lo) | (f2bf(hi) << 16); }
__device__ __forceinline__ float sigmf(float x) { return __builtin_amdgcn_rcpf(1.0f + __expf(-x)); }
__device__ __forceinline__ float wave_sum(float v) {
#pragma unroll
    for (int o = 1; o < 64; o <<= 1) v += __shfl_xor(v, o);
    return v;
}
#define OPQ_TID unsigned char* WSP = launder_ws(((unsigned char*)p.ws)); int tid = threadIdx.x; asm volatile("" : "+v"(tid)); const int lane = tid & 63, wave = __builtin_amdgcn_readfirstlane(tid >> 6); (void)lane; (void)wave
__device__ __forceinline__ unsigned char* launder_ws(unsigned char* w) { const unsigned long long v = (unsigned long long)w; unsigned lo = __builtin_amdgcn_readfirstlane((unsigned)v), hi = __builtin_amdgcn_readfirstlane((unsigned)(v >> 32)); asm volatile("" : "+s"(lo), "+s"(hi)); return (unsigned char*)(GAS unsigned char*)(((unsigned long long)hi << 32) | lo); }
#define MFMA16(a, b, c) __builtin_amdgcn_mfma_f32_16x16x32_bf16((a), (b), (c), 0, 0, 0)

__device__ __forceinline__ void tr_item(const float* src, int ld_src, bf16_t* dst, int ld_dst, const float* sc, int scmode, LAS float* scr, int kb, int nb, int lane) {
    const int k0 = 64 * kb, n0 = 32 * nb;
#pragma unroll
    for (int i = 0; i < 8; ++i) { const int kk = 8 * i + (lane >> 3), c4 = (lane & 7) * 4; f32x4 v = *(const f32x4*)(src + (size_t)(k0 + kk) * ld_src + n0 + c4);
        if (sc) { const float m_ = sc[k0 + kk]; v = v * (scmode ? m_ : (1.0f - m_)); }
        scr[kk * 33 + c4] = v.x; scr[kk * 33 + c4 + 1] = v.y; scr[kk * 33 + c4 + 2] = v.z; scr[kk * 33 + c4 + 3] = v.w; }
    asm volatile("s_waitcnt lgkmcnt(0)" ::: "memory");
    const int c = lane & 7;
#pragma unroll
    for (int j = 0; j < 4; ++j) { const int n = (lane >> 3) + 8 * j; const LAS float* s = scr + (8 * c) * 33 + n;
        u32x4 o; o.x = pk2(s[0 * 33], s[1 * 33]); o.y = pk2(s[2 * 33], s[3 * 33]); o.z = pk2(s[4 * 33], s[5 * 33]); o.w = pk2(s[6 * 33], s[7 * 33]);
        *(u32x4*)(dst + (size_t)(n0 + n) * ld_dst + k0 + 8 * c) = o; }
    asm volatile("s_waitcnt lgkmcnt(0)" ::: "memory");
}
__device__ __forceinline__ void tr_item2(const float* src, int ld_src, bf16_t* dst0, bf16_t* dst1, int ld_dst, const float* mu, LAS float* scr, int kb, int nb, int lane) {
    const int k0 = 64 * kb, n0 = 32 * nb;
#pragma unroll
    for (int i = 0; i < 8; ++i) { const int kk = 8 * i + (lane >> 3), c4 = (lane & 7) * 4; const f32x4 v = *(const f32x4*)(src + (size_t)(k0 + kk) * ld_src + n0 + c4);
        scr[kk * 33 + c4] = v.x; scr[kk * 33 + c4 + 1] = v.y; scr[kk * 33 + c4 + 2] = v.z; scr[kk * 33 + c4 + 3] = v.w; }
    asm volatile("s_waitcnt lgkmcnt(0)" ::: "memory");
    const int c = lane & 7;
    const f32x4 m0 = *(const f32x4*)(mu + k0 + 8 * c), m1 = *(const f32x4*)(mu + k0 + 8 * c + 4);
#pragma unroll
    for (int j = 0; j < 4; ++j) { const int n = (lane >> 3) + 8 * j; const LAS float* s = scr + (8 * c) * 33 + n;
        const float s0 = s[0], s1 = s[33], s2 = s[66], s3 = s[99], s4 = s[132], s5 = s[165], s6 = s[198], s7 = s[231];
        u32x4 o; o.x = pk2(s0 * m0.x, s1 * m0.y); o.y = pk2(s2 * m0.z, s3 * m0.w); o.z = pk2(s4 * m1.x, s5 * m1.y); o.w = pk2(s6 * m1.z, s7 * m1.w);
        *(u32x4*)(dst1 + (size_t)(n0 + n) * ld_dst + k0 + 8 * c) = o;
        o.x = pk2(s0 * (1.0f - m0.x), s1 * (1.0f - m0.y)); o.y = pk2(s2 * (1.0f - m0.z), s3 * (1.0f - m0.w)); o.z = pk2(s4 * (1.0f - m1.x), s5 * (1.0f - m1.y)); o.w = pk2(s6 * (1.0f - m1.z), s7 * (1.0f - m1.w));
        *(u32x4*)(dst0 + (size_t)(n0 + n) * ld_dst + k0 + 8 * c) = o; }
    asm volatile("s_waitcnt lgkmcnt(0)" ::: "memory");
}
__device__ __forceinline__ void rms_row(const float* xrow, const float* g, int lane, u32x2 (&o)[4]) {
    f32x4 v[4]; float s = 0.f;
#pragma unroll
    for (int j = 0; j < 4; ++j) { v[j] = *((const f32x4*)xrow + lane + 64 * j); s += (v[j].x * v[j].x + v[j].y * v[j].y) + (v[j].z * v[j].z + v[j].w * v[j].w); }
    const float rs = rsqrtf(wave_sum(s) * (1.0f / 1024.0f) + 1e-6f);
#pragma unroll
    for (int j = 0; j < 4; ++j) { const f32x4 gg = *((const f32x4*)g + lane + 64 * j); o[j].x = pk2(v[j].x * rs * gg.x, v[j].y * rs * gg.y); o[j].y = pk2(v[j].z * rs * gg.z, v[j].w * rs * gg.w); }
}

__device__ __forceinline__ void p0_prologue(const Params& p, LAS unsigned char* lds, int G, int bid) {
    OPQ_TID; const int gw = bid * 8 + wave, ngw = G * 8;
    LAS float* scr = (LAS float*)(lds + wave * 16384);
    bf16_t* WinT = (bf16_t*)(WSP + WS_WIN); bf16_t* WoutT = (bf16_t*)(WSP + WS_WOUT); bf16_t* RGA = (bf16_t*)(WSP + WS_RGA); bf16_t* RGX = (bf16_t*)(WSP + WS_RGX);
    constexpr int IA = 16 * 192, IB = 32 * 32, IC = 64, IL0 = 64;
    for (int it = gw; it < IA + IB + 2 * IC + IL0; it += ngw) {
        int r = it;
        if (r >= IA + IB + 2 * IC) { r -= IA + IB + 2 * IC; const int wh = r >> 5, q = r & 31;
            bf16_t* dst = (bf16_t*)(WSP + WS_WL) + (size_t)(wh * 64) * 2048;
            tr_item2(wh ? ((const float*)p.in[I_A1]) : ((const float*)p.in[I_W1]), 64, dst, dst + 1024, 2048, ((const float*)p.in[I_MU]) + (wh ? 4 : 1) * 1024, scr, q >> 1, q & 1, lane); continue; }
        if (r < IA) { tr_item(((const float*)p.in[I_WIN]), ZW, WinT, 1024, nullptr, 0, scr, r / 192, r % 192, lane); continue; } r -= IA;
        if (r < IB) { tr_item(((const float*)p.in[I_WOUT]), 1024, WoutT, 2048, nullptr, 0, scr, r / 32, r % 32, lane); continue; } r -= IB;
        const float* src = (r < IC) ? ((const float*)p.in[I_RGWA]) : ((const float*)p.in[I_RGWX]); bf16_t* dst = (r < IC) ? RGA : RGX; if (r >= IC) r -= IC;
        const int blk = r >> 3, q = r & 7;
        tr_item(src + blk * 16384, 128, dst + blk * 16384, 128, nullptr, 0, scr, q >> 2, q & 3, lane);
    }
    bf16_t* U0 = (bf16_t*)((float*)p.out);
    for (int m = gw; m < T; m += ngw) { u32x2 o[4]; rms_row(((const float*)p.in[I_X]) + (size_t)m * D, ((const float*)p.in[I_ABG]), lane, o);
#pragma unroll
        for (int j = 0; j < 4; ++j) *((u32x2*)(U0 + (size_t)m * D) + lane + 64 * j) = o[j]; }
}

__device__ __forceinline__ void rg_a_prefetch(const bf16_t* Z, int unit, int tid, u32x4 (&pre)[3]) {
    const int b = unit >> 9, n = (unit >> 3) & 63, j = unit & 7; const int tok0 = b * SEQ + n * 64, ch0 = j * 128;
#pragma unroll
    for (int q = 0; q < 3; ++q) { const int i = tid + q * NT; const int row = i >> 4, cc = i & 15; pre[q] = (u32x4){0u, 0u, 0u, 0u};
        if (i < 67 * 16 && (n > 0 || row >= 3)) pre[q] = *(const u32x4*)(Z + (size_t)(tok0 - 3 + row) * ZW + ch0 + 8 * cc); }
}
__device__ __forceinline__ void rg_a_unit(const Params& p, LAS unsigned char* lds, int unit, int next_unit, u32x4 (&pre)[3]) {
    OPQ_TID;
    LAS float* XC = (LAS float*)lds; LAS float* AA = (LAS float*)(lds + 32768); LAS bf16_t* XB = (LAS bf16_t*)(lds + 65536); LAS bf16_t* XR = (LAS bf16_t*)(lds + 82944);
    LAS float* SUMP = (LAS float*)(lds + 82944); LAS float* SUMH = SUMP + 512; LAS bf16_t* HT = XB; LAS bf16_t* PT = (LAS bf16_t*)(lds + 87040);
    const int b = unit >> 9, n = (unit >> 3) & 63, j = unit & 7;
    const int tok0 = b * SEQ + n * 64, ch0 = j * 128;
    const bf16_t* Z = (const bf16_t*)(WSP + WS_Z);
#pragma unroll
    for (int q = 0; q < 3; ++q) { const int i = tid + q * NT; if (i < 67 * 16) *(LAS u32x4*)(XR + (i >> 4) * 136 + 8 * (i & 15)) = pre[q]; }
    __syncthreads();
    if (next_unit < 2048) rg_a_prefetch(Z, next_unit, tid, pre);
    const int c = tid & 127, sub = tid >> 7;
    {
        const int ch = ch0 + c;
        const float w0 = ((const float*)p.in[I_CONVW])[ch], w1 = ((const float*)p.in[I_CONVW])[1024 + ch], w2 = ((const float*)p.in[I_CONVW])[2048 + ch], w3 = ((const float*)p.in[I_CONVW])[3072 + ch], cb = ((const float*)p.in[I_CONVB])[ch];
        const LAS bf16_t* xr = XR + (sub * 16) * 136 + c;
        float xm3 = bf2f(xr[0]), xm2 = bf2f(xr[136]), xm1 = bf2f(xr[272]);
#pragma unroll
        for (int i = 0; i < 16; ++i) { const float x = bf2f(xr[(i + 3) * 136]); const float y = w0 * xm3 + w1 * xm2 + w2 * xm1 + w3 * x + cb;
            XC[(sub * 16 + i) * 128 + c] = y; XB[(sub * 16 + i) * 136 + c] = (bf16_t)f2bf(y); xm3 = xm2; xm2 = xm1; xm1 = x; }
    }
    __syncthreads();
    {
        const int fr = lane & 15, fq = lane >> 4;
        const bf16_t* WA = (const bf16_t*)(WSP + WS_RGA) + j * 16384 + (16 * wave + fr) * 128 + 8 * fq;
        const bf16_t* WX = (const bf16_t*)(WSP + WS_RGX) + j * 16384 + (16 * wave + fr) * 128 + 8 * fq;
        f32x4 accA[4], accX[4];
#pragma unroll
        for (int m = 0; m < 4; ++m) { accA[m] = (f32x4){0.f, 0.f, 0.f, 0.f}; accX[m] = (f32x4){0.f, 0.f, 0.f, 0.f}; }
#pragma unroll
        for (int k = 0; k < 4; ++k) { const bf16x8 bA = *(const bf16x8*)(WA + 32 * k), bX = *(const bf16x8*)(WX + 32 * k);
#pragma unroll
            for (int m = 0; m < 4; ++m) { const bf16x8 a = *(const LAS bf16x8*)(XB + (16 * m + fr) * 136 + 32 * k + 8 * fq); accA[m] = MFMA16(a, bA, accA[m]); accX[m] = MFMA16(a, bX, accX[m]); } }
        const int cl = 16 * wave + fr, ch = ch0 + cl;
        const float ba = ((const float*)p.in[I_RGBA])[ch], bx = ((const float*)p.in[I_RGBX])[ch], lam = ((const float*)p.in[I_LAM])[ch];
        const float sp = log1pf(expf(-lam));
#pragma unroll
        for (int m = 0; m < 4; ++m)
#pragma unroll
            for (int r = 0; r < 4; ++r) { const int tk = 16 * m + 4 * fq + r; const float gr = sigmf(accA[m][r] + ba), gi = sigmf(accX[m][r] + bx);
                const float la = -8.0f * gr * sp; const float a = __expf(la); const float mult = __builtin_amdgcn_sqrtf(fmaxf(1.0f - a * a, 0.f));
                const float xc = XC[tk * 128 + cl]; AA[tk * 128 + cl] = a; XC[tk * 128 + cl] = mult * gi * xc; }
    }
    __syncthreads();
    {
        float hl[16], pl[16]; float h = 0.f, P = 1.f;
#pragma unroll
        for (int i = 0; i < 16; ++i) { const float a = AA[(sub * 16 + i) * 128 + c], u = XC[(sub * 16 + i) * 128 + c]; h = a * h + u; P *= a; hl[i] = h; pl[i] = P; }
        SUMP[sub * 128 + c] = P; SUMH[sub * 128 + c] = h;
        __syncthreads();
        float chh = 0.f, cp = 1.f;
#pragma unroll
        for (int s = 0; s < 3; ++s) if (s < sub) { const float sp_ = SUMP[s * 128 + c]; chh = chh * sp_ + SUMH[s * 128 + c]; cp *= sp_; }
#pragma unroll
        for (int i = 0; i < 16; ++i) { HT[(sub * 16 + i) * 136 + c] = (bf16_t)f2bf(hl[i] + pl[i] * chh); PT[(sub * 16 + i) * 136 + c] = (bf16_t)f2bf(pl[i] * cp); }
    }
    __syncthreads();
    {
        bf16_t* HL = (bf16_t*)((float*)p.out) + (size_t)tok0 * D + ch0; bf16_t* PC = HL + (size_t)T * D;
        for (int i = tid; i < 1024; i += NT) { const int row = i >> 4, cc = i & 15;
            *(u32x4*)(HL + (size_t)row * D + 8 * cc) = *(const LAS u32x4*)(HT + row * 136 + 8 * cc); *(u32x4*)(PC + (size_t)row * D + 8 * cc) = *(const LAS u32x4*)(PT + row * 136 + 8 * cc); }
    }
    __syncthreads();
}

__device__ __forceinline__ void hg_a_prefetch(const bf16_t* Z, int unit, int tid, u32x4 (&pre)[6]) {
    const int b = unit >> 9, h = (unit >> 6) & 7, n = unit & 63; const int tok0 = b * SEQ + n * 64;
#pragma unroll
    for (int q = 0; q < 6; ++q) { const int i = tid + q * NT; const int arr = i >> 10, row = (i >> 4) & 63, cc = i & 15; pre[q] = *(const u32x4*)(Z + (size_t)(tok0 + row) * ZW + 2048 + 1024 * arr + h * 128 + 8 * cc); }
}
__device__ __forceinline__ void hg_a_unit(const Params& p, LAS unsigned char* lds, int unit, int next_unit, u32x4 (&pre)[6]) {
    OPQ_TID;
    LAS bf16_t* QD = (LAS bf16_t*)lds; LAS bf16_t* KI = (LAS bf16_t*)(lds + 17408); LAS bf16_t* VR = (LAS bf16_t*)(lds + 34816); LAS bf16_t* VT = (LAS bf16_t*)(lds + 52224);
    LAS bf16_t* SC = (LAS bf16_t*)(lds + 70656); LAS float* ST = (LAS float*)(lds + 79872); LAS bf16_t* OT = VR;
    const int b = unit >> 9, h = (unit >> 6) & 7, n = unit & 63;
    const int tok0 = b * SEQ + n * 64;
    bf16_t* Z = (bf16_t*)(WSP + WS_Z);
    const int fr = lane & 15, fq = lane >> 4;
#pragma unroll
    for (int q = 0; q < 6; ++q) { const int i = tid + q * NT; const int arr = i >> 10, row = (i >> 4) & 63, cc = i & 15;
        *(LAS u32x4*)((arr == 0 ? QD : (arr == 1 ? KI : VR)) + row * 136 + 8 * cc) = pre[q]; }
    __syncthreads();
    {
        const int d = tid & 127, sub = tid >> 7, hd = h * 128 + d;
        const float lb = sigmf(((const float*)p.in[I_LB])[hd] - ((const float*)p.in[I_LB])[1024 + hd]), omlb = 1.0f - lb;
        float q[16], kq[16], cl[16]; unsigned short vv[16]; float run = 0.f;
#pragma unroll
        for (int i = 0; i < 16; ++i) { const int t = sub * 16 + i; const float f = bf2f(KI[t * 136 + d]); const float sg = sigmf(f);
            run += __logf(lb + omlb * sg); cl[i] = run; kq[i] = omlb * (1.0f - sg); q[i] = bf2f(QD[t * 136 + d]); vv[i] = VR[t * 136 + d]; }
        ST[sub * 128 + d] = run;
        __syncthreads();
        float off = 0.f, total = 0.f;
#pragma unroll
        for (int s = 0; s < 4; ++s) { const float x = ST[s * 128 + d]; total += x; if (s < sub) off += x; }
        unsigned ke[8], vp[8];
#pragma unroll
        for (int i = 0; i < 16; ++i) { const float cum = off + cl[i]; const unsigned qd = f2bf(q[i] * __expf(cum)), ki = f2bf(kq[i] * __expf(-cum)), kE = f2bf(kq[i] * __expf(total - cum));
            QD[(sub * 16 + i) * 136 + d] = (bf16_t)qd; KI[(sub * 16 + i) * 136 + d] = (bf16_t)ki;
            if (i & 1) { ke[i >> 1] |= kE << 16; vp[i >> 1] |= (unsigned)vv[i] << 16; } else { ke[i >> 1] = kE; vp[i >> 1] = vv[i]; } }
        *(LAS u32x4*)(VT + d * 72 + sub * 16) = (u32x4){vp[0], vp[1], vp[2], vp[3]}; *(LAS u32x4*)(VT + d * 72 + sub * 16 + 8) = (u32x4){vp[4], vp[5], vp[6], vp[7]};
        bf16_t* tb = Z + (size_t)(tok0 + (d >> 1)) * ZW + h * 128 + (d & 1) * 64 + sub * 16;
        *(u32x4*)(tb + 3072) = (u32x4){ke[0], ke[1], ke[2], ke[3]}; *(u32x4*)(tb + 3072 + 8) = (u32x4){ke[4], ke[5], ke[6], ke[7]};
        *(u32x4*)(tb + 4096) = (u32x4){vp[0], vp[1], vp[2], vp[3]}; *(u32x4*)(tb + 4096 + 8) = (u32x4){vp[4], vp[5], vp[6], vp[7]};
        if (sub == 0) ((float*)(WSP + WS_DEC))[unit * 128 + d] = __expf(total);
    }
    __syncthreads();
    if (next_unit < 2048) hg_a_prefetch(Z, next_unit, tid, pre);
    for (int i = tid; i < 1024; i += NT) { const int row = i >> 4, cc = i & 15; *(u32x4*)(Z + (size_t)(tok0 + row) * ZW + 2048 + h * 128 + 8 * cc) = *(const LAS u32x4*)(QD + row * 136 + 8 * cc); }
    {
        const int lt = wave >> 1;
#pragma unroll
        for (int x = 0; x < 2; ++x) { const int mt = (wave & 1) * 2 + x; f32x4 acc = (f32x4){0.f, 0.f, 0.f, 0.f};
            if (mt <= lt) {
#pragma unroll
                for (int k = 0; k < 4; ++k) { const bf16x8 a = *(const LAS bf16x8*)(QD + (16 * lt + fr) * 136 + 32 * k + 8 * fq), bb = *(const LAS bf16x8*)(KI + (16 * mt + fr) * 136 + 32 * k + 8 * fq); acc = MFMA16(a, bb, acc); } }
#pragma unroll
            for (int r = 0; r < 4; ++r) { const int l = 16 * lt + 4 * fq + r, mm = 16 * mt + fr; SC[l * 72 + mm] = (bf16_t)f2bf(mm <= l ? acc[r] : 0.f); } }
    }
    __syncthreads();
    {
#pragma unroll
        for (int lt = 0; lt < 4; ++lt) { f32x4 acc = (f32x4){0.f, 0.f, 0.f, 0.f};
#pragma unroll
            for (int k = 0; k < 2; ++k) { const bf16x8 a = *(const LAS bf16x8*)(SC + (16 * lt + fr) * 72 + 32 * k + 8 * fq), bb = *(const LAS bf16x8*)(VT + (16 * wave + fr) * 72 + 32 * k + 8 * fq); acc = MFMA16(a, bb, acc); }
#pragma unroll
            for (int r = 0; r < 4; ++r) OT[(16 * lt + 4 * fq + r) * 136 + 16 * wave + fr] = (bf16_t)f2bf(acc[r]); }
    }
    __syncthreads();
    { bf16_t* OI = (bf16_t*)(WSP + WS_OI) + (size_t)tok0 * D + h * 128;
      for (int i = tid; i < 1024; i += NT) { const int row = i >> 4, cc = i & 15; *(u32x4*)(OI + (size_t)row * D + 8 * cc) = *(const LAS u32x4*)(OT + row * 136 + 8 * cc); } }
    __syncthreads();
}

__device__ __forceinline__ void hg_b_item(const Params& p, LAS unsigned char* lds, int item, bool dry = false) {
    OPQ_TID;
    LAS bf16_t* SB = (LAS bf16_t*)lds;
    const int b = item >> 6, h = (item >> 3) & 7, es = item & 7;
    const int fr = lane & 15, fq = lane >> 4;
    const bf16_t* Z = (const bf16_t*)(WSP + WS_Z); bf16_t* OI = (bf16_t*)(WSP + WS_OI); const float* DEC = (const float*)(WSP + WS_DEC);
    for (int i = tid; i < 2 * 16 * 136 / 2; i += NT) ((LAS unsigned*)SB)[i] = 0u;
    __syncthreads();
    f32x4 S = (f32x4){0.f, 0.f, 0.f, 0.f};
    const int eg = 16 * es + fr, dg = 16 * wave + fr;
    const bf16_t* pV = Z + (size_t)(b * SEQ + (eg >> 1)) * ZW + 4096 + h * 128 + (eg & 1) * 64 + 8 * fq;
    const bf16_t* pK = Z + (size_t)(b * SEQ + (dg >> 1)) * ZW + 3072 + h * 128 + (dg & 1) * 64 + 8 * fq;
    const bf16_t* pQ = Z + (size_t)(b * SEQ + 16 * (wave & 3) + fr) * ZW + 2048 + h * 128 + 8 * fq;
    bf16_t* pO = OI + (size_t)(b * SEQ + 16 * (wave & 3) + 4 * fq) * D + h * 128 + 16 * es + fr;
    const float* pD = DEC + (size_t)((b * 8 + h) * 64) * 128 + dg;
    bf16x8 nV[2][2], nK[2][2], nQ[2][4]; float ndec[2]; unsigned short nO[2][4];
#define HGB_LOAD(SET, n_) do { const size_t ro_ = (size_t)(n_) * 64 * ZW; ndec[SET] = pD[(n_) * 128]; \
        _Pragma("unroll") for (int k = 0; k < 2; ++k) { nV[SET][k] = *(const bf16x8*)(pV + ro_ + 32 * k); nK[SET][k] = *(const bf16x8*)(pK + ro_ + 32 * k); } \
        if (wave < 4) { _Pragma("unroll") for (int k = 0; k < 4; ++k) nQ[SET][k] = *(const bf16x8*)(pQ + ro_ + 32 * k); \
            _Pragma("unroll") for (int r = 0; r < 4; ++r) nO[SET][r] = pO[(size_t)((n_) * 64 + r) * D]; } } while (0)
#define HGB_STEP(SET, n) do { \
        const float dec = ndec[SET]; bf16x8 aV[2], bK[2]; \
        _Pragma("unroll") for (int k = 0; k < 2; ++k) { aV[k] = nV[SET][k]; bK[k] = nK[SET][k]; } \
        if (wave < 4) { \
            f32x4 acc = (f32x4){0.f, 0.f, 0.f, 0.f}; \
            _Pragma("unroll") for (int k = 0; k < 4; ++k) { const bf16x8 bb = *(const LAS bf16x8*)(SB + ((n) & 1) * 2176 + fr * 136 + 32 * k + 8 * fq); acc = MFMA16(nQ[SET][k], bb, acc); } \
            _Pragma("unroll") for (int r = 0; r < 4; ++r) { const float nv = bf2f(nO[SET][r]) + acc[r]; if (!dry) pO[(size_t)((n) * 64 + r) * D] = (bf16_t)f2bf(nv); else if (nv == 123456.0f) pO[0] = 0; } \
        } \
        if ((n) + 2 < 64) HGB_LOAD(SET, (n) + 2); \
        S = S * dec; \
        _Pragma("unroll") for (int k = 0; k < 2; ++k) S = MFMA16(aV[k], bK[k], S); \
        _Pragma("unroll") for (int r = 0; r < 4; ++r) SB[(((n) + 1) & 1) * 2176 + (4 * fq + r) * 136 + dg] = (bf16_t)f2bf(S[r]); \
        asm volatile("s_waitcnt lgkmcnt(0)" ::: "memory"); __builtin_amdgcn_s_barrier(); asm volatile("" ::: "memory"); } while (0)
    HGB_LOAD(0, 0); HGB_LOAD(1, 1);
#pragma unroll 1
    for (int n2 = 0; n2 < 64; n2 += 2) { HGB_STEP(0, n2); HGB_STEP(1, n2 + 1); }
#undef HGB_LOAD
#undef HGB_STEP
}
__device__ __forceinline__ void rg_b_unit(const Params& p, int unit) {
    OPQ_TID;
    const int b = unit >> 7, n = (unit >> 1) & 63, ch = (unit & 1) * 512 + 8 * (tid & 63), r8 = tid >> 6;
    const bf16_t* HL = (const bf16_t*)((float*)p.out) + (size_t)b * SEQ * D + ch; const bf16_t* PC = HL + (size_t)T * D;
    bf16_t* Z = (bf16_t*)(WSP + WS_Z) + (size_t)(b * SEQ + n * 64) * ZW + ch;
    float carry[8];
#pragma unroll
    for (int i = 0; i < 8; ++i) carry[i] = 0.f;
    int m0 = 0;
    for (; m0 + 4 <= n; m0 += 4) { u32x4 pp[4], hh4[4];
#pragma unroll
        for (int i = 0; i < 4; ++i) { const size_t o = (size_t)((m0 + i) * 64 + 63) * D; pp[i] = *(const u32x4*)(PC + o); hh4[i] = *(const u32x4*)(HL + o); }
#pragma unroll
        for (int i = 0; i < 4; ++i)
#pragma unroll
            for (int c = 0; c < 4; ++c) { carry[2 * c] = carry[2 * c] * bf2f(pp[i][c] & 0xffffu) + bf2f(hh4[i][c] & 0xffffu); carry[2 * c + 1] = carry[2 * c + 1] * bf2f(pp[i][c] >> 16) + bf2f(hh4[i][c] >> 16); } }
    for (; m0 < n; ++m0) { const size_t o = (size_t)(m0 * 64 + 63) * D; const u32x4 pp = *(const u32x4*)(PC + o), hh4 = *(const u32x4*)(HL + o);
#pragma unroll
        for (int c = 0; c < 4; ++c) { carry[2 * c] = carry[2 * c] * bf2f(pp[c] & 0xffffu) + bf2f(hh4[c] & 0xffffu); carry[2 * c + 1] = carry[2 * c + 1] * bf2f(pp[c] >> 16) + bf2f(hh4[c] >> 16); } }
#pragma unroll 4
    for (int tq = 0; tq < 8; ++tq) { const int t = 8 * tq + r8; const size_t o = (size_t)(n * 64 + t) * D;
        const u32x4 hv = *(const u32x4*)(HL + o), pv = *(const u32x4*)(PC + o), gv = *(const u32x4*)(Z + (size_t)t * ZW + 1024); u32x4 ov;
#pragma unroll
        for (int c = 0; c < 4; ++c) { const float h0 = bf2f(hv[c] & 0xffffu) + bf2f(pv[c] & 0xffffu) * carry[2 * c], h1 = bf2f(hv[c] >> 16) + bf2f(pv[c] >> 16) * carry[2 * c + 1];
            const float g0 = bf2f(gv[c] & 0xffffu), g1 = bf2f(gv[c] >> 16); ov[c] = pk2(h0 * g0 * sigmf(g0), h1 * g1 * sigmf(g1)); }
        *(u32x4*)(Z + (size_t)t * ZW) = ov; }
}
__device__ __forceinline__ float row16_sum_p4(float x) {
    x += __int_as_float(__builtin_amdgcn_update_dpp(0, __float_as_int(x), 0xB1, 0xf, 0xf, true)); x += __int_as_float(__builtin_amdgcn_update_dpp(0, __float_as_int(x), 0x4E, 0xf, 0xf, true));
    x += __int_as_float(__builtin_amdgcn_update_dpp(0, __float_as_int(x), 0x141, 0xf, 0xf, true)); x += __int_as_float(__builtin_amdgcn_update_dpp(0, __float_as_int(x), 0x140, 0xf, 0xf, true)); return x; }
__device__ __forceinline__ void p4_finalize(const Params& p, int G, int bid) {
    OPQ_TID; const int gw = bid * 8 + wave, ngw = G * 8;
    bf16_t* Z = (bf16_t*)(WSP + WS_Z); const bf16_t* OI = (const bf16_t*)(WSP + WS_OI);
    const int l16 = lane & 15, pr = lane >> 4;
    const f32x4 g0 = *(const f32x4*)(((const float*)p.in[I_HGG]) + 8 * l16), g1 = *(const f32x4*)(((const float*)p.in[I_HGG]) + 8 * l16 + 4);
    for (int it = gw; it < T * 2; it += ngw) { const int tok = it >> 1, h = (it & 1) * 4 + pr;
        const u32x4 ov = *(const u32x4*)(OI + (size_t)tok * D + h * 128 + 8 * l16); const u32x4 gv = *(const u32x4*)(Z + (size_t)tok * ZW + 5120 + h * 128 + 8 * l16);
        float o[8], gb[8]; float ss = 0.f;
#pragma unroll
        for (int c = 0; c < 4; ++c) { o[2 * c] = bf2f(ov[c] & 0xffffu); o[2 * c + 1] = bf2f(ov[c] >> 16); gb[2 * c] = bf2f(gv[c] & 0xffffu); gb[2 * c + 1] = bf2f(gv[c] >> 16); ss += o[2 * c] * o[2 * c] + o[2 * c + 1] * o[2 * c + 1]; }
        const float rs = rsqrtf(row16_sum_p4(ss) * (1.0f / 128.0f) + 1e-6f);
        u32x4 w;
#pragma unroll
        for (int c = 0; c < 4; ++c) { const float ga = c < 2 ? g0[2 * c] : g1[2 * c - 4], gbq = c < 2 ? g0[2 * c + 1] : g1[2 * c - 3];
            w[c] = pk2(o[2 * c] * rs * ga * gb[2 * c] * sigmf(gb[2 * c]), o[2 * c + 1] * rs * gbq * gb[2 * c + 1] * sigmf(gb[2 * c + 1])); }
        *(u32x4*)(Z + (size_t)tok * ZW + 1024 + h * 128 + 8 * l16) = w; }
}
__device__ __forceinline__ void p6_prologue(const Params& p, LAS unsigned char* lds, int G, int bid) {
    OPQ_TID; const int gw = bid * 8 + wave, ngw = G * 8;
    LAS float* scr = (LAS float*)(lds + wave * 16384);
    constexpr int IP = 4096, IL = 0, IO = 1024, I2 = 128;
    for (int i = gw * 64 + lane; i < (int)(MiB / 16); i += ngw * 64) ((u32x4*)(WSP + WS_GR))[i] = (u32x4){0u, 0u, 0u, 0u};
    for (int i = gw * 64 + lane; i < (int)(MiB / 32); i += ngw * 64) ((u32x4*)(WSP + WS_XG))[i] = (u32x4){0u, 0u, 0u, 0u};
    for (int it = gw; it < IP + IL + IO + I2; it += ngw) {
        int r = it;
        if (r < IP) { const int pj = r >> 10, q = r & 1023;
            const int muidx = pj == 0 ? 0 : (pj == 1 ? 2 : (pj == 2 ? 3 : 5));
            bf16_t* dst = (bf16_t*)(WSP + WS_WC) + (size_t)(pj * 2048) * 2048;
            tr_item2(((const float*)p.in[I_WR + pj]), 2048, dst, dst + 1024, 2048, ((const float*)p.in[I_MU]) + muidx * 1024, scr, q >> 6, q & 63, lane); continue; }
        r -= IP;
        if (r >= IO) { r -= IO; const int wh = r >> 6, nb = r & 63; tr_item(wh ? ((const float*)p.in[I_A2]) : ((const float*)p.in[I_W2]), 2048, (bf16_t*)(WSP + (wh ? WS_A2T : WS_W2T)), 64, nullptr, 0, scr, 0, nb, lane); continue; }
        tr_item(((const float*)p.in[I_WO]), 1024, (bf16_t*)(WSP + WS_WO), 2048, nullptr, 0, scr, r >> 5, r & 31, lane);
    }
    bf16_t* A2 = (bf16_t*)(WSP + WS_A2);
    const int fr = lane & 15, fq = lane >> 4;
    for (int tile = bid; tile < T / 64; tile += G) {
        const int m0 = tile * 64;
        for (int i = (wave == 0 && (m0 & (SEQ - 1)) != 0) ? -1 : 0; i < 8; ++i) { const int m = (i < 0) ? m0 - 1 : m0 + 8 * wave + i;
            u32x2 o[4]; rms_row(((float*)p.out) + (size_t)m * D, ((const float*)p.in[I_CNG]), lane, o); const int bb = m >> 12, t = m & (SEQ - 1);
            const size_t cr = (size_t)(t >> 11) * PROWS6 + bb * 2048 + (t & 2047);
            const size_t cn = (size_t)((t + 1) >> 11) * PROWS6 + bb * 2048 + ((t + 1) & 2047);
#pragma unroll
            for (int j = 0; j < 4; ++j) { if (i >= 0) *((u32x2*)(A2 + cr * 2048) + lane + 64 * j) = o[j];
                if (t + 1 < SEQ) *((u32x2*)(A2 + cn * 2048 + 1024) + lane + 64 * j) = o[j];
                if (t == 0) *((u32x2*)(A2 + cr * 2048 + 1024) + lane + 64 * j) = (u32x2){0u, 0u}; } }
        __syncthreads();
        { const int t0 = m0 & (SEQ - 1), bb = m0 >> 12; const size_t cr0 = (size_t)(t0 >> 11) * PROWS6 + bb * 2048 + (t0 & 2047);
          const int mt = wave & 3, nh = wave >> 2;
          LAS bf16_t* LA_ = (LAS bf16_t*)lds; LAS bf16_t* LB_ = (LAS bf16_t*)(lds + 64 * 264 * 2);
          const bf16_t* ga = A2 + cr0 * 2048; const bf16_t* gb = (const bf16_t*)(WSP + WS_WL);
          u32x4 pa_[4], pb_[8];
#define LORA_LOAD(kc) do { _Pragma("unroll") for (int q = 0; q < 4; ++q) { const int i = tid + q * NT; pa_[q] = *(const u32x4*)(ga + (size_t)(i >> 5) * 2048 + (kc) * 256 + 8 * (i & 31)); } \
              _Pragma("unroll") for (int q = 0; q < 8; ++q) { const int i = tid + q * NT; pb_[q] = *(const u32x4*)(gb + (size_t)(i >> 5) * 2048 + (kc) * 256 + 8 * (i & 31)); } } while (0)
          LORA_LOAD(0);
          f32x4 acc[4];
#pragma unroll
          for (int nt = 0; nt < 4; ++nt) acc[nt] = (f32x4){0.f, 0.f, 0.f, 0.f};
#pragma unroll 1
          for (int kc = 0; kc < 8; ++kc) {
#pragma unroll
              for (int q = 0; q < 4; ++q) { const int i = tid + q * NT; *(LAS u32x4*)(LA_ + (i >> 5) * 264 + 8 * (i & 31)) = pa_[q]; }
#pragma unroll
              for (int q = 0; q < 8; ++q) { const int i = tid + q * NT; *(LAS u32x4*)(LB_ + (i >> 5) * 264 + 8 * (i & 31)) = pb_[q]; }
              __syncthreads();
              if (kc + 1 < 8) LORA_LOAD(kc + 1);
#pragma unroll
              for (int ks = 0; ks < 8; ++ks) { const bf16x8 a = *(const LAS bf16x8*)(LA_ + (16 * mt + fr) * 264 + 32 * ks + 8 * fq);
#pragma unroll
                  for (int nt = 0; nt < 4; ++nt) { const bf16x8 bfr = *(const LAS bf16x8*)(LB_ + (64 * nh + 16 * nt + fr) * 264 + 32 * ks + 8 * fq); acc[nt] = MFMA16(a, bfr, acc[nt]); } }
              __syncthreads();
          }
#undef LORA_LOAD
          bf16_t* dstb = (bf16_t*)(WSP + (nh ? WS_LA : WS_LW));
#pragma unroll
          for (int nt = 0; nt < 4; ++nt)
#pragma unroll
              for (int r = 0; r < 4; ++r) { const float v = acc[nt][r]; dstb[(cr0 + 16 * mt + 4 * fq + r) * 64 + 16 * nt + fr] = (bf16_t)f2bf(nh ? v : tanhf(v)); } }
        __syncthreads();
    }
}
template <int CTRL> __device__ __forceinline__ float dpp_add(float x) { const int y = __builtin_amdgcn_update_dpp(0, __float_as_int(x), CTRL, 0xf, 0xf, true); return x + __int_as_float(y); }
__device__ __forceinline__ f32x4 bf4(u32x2 v) { return (f32x4){bf2f(v.x & 0xffffu), bf2f(v.x >> 16), bf2f(v.y & 0xffffu), bf2f(v.y >> 16)}; }
__device__ __forceinline__ float afma(float a, float b, float c) { float d; asm("v_fma_f32 %0, %1, %2, %3" : "=v"(d) : "v"(a), "v"(b), "v"(c)); return d; }
__device__ __forceinline__ float anfma(float a, float b, float c) { float d; asm("v_fma_f32 %0, -%1, %2, %3" : "=v"(d) : "v"(a), "v"(b), "v"(c)); return d; }
__device__ __forceinline__ float amul(float a, float b) { float d; asm("v_mul_f32 %0, %1, %2" : "=v"(d) : "v"(a), "v"(b)); return d; }
__device__ __forceinline__ f32x2 pkmul(f32x2 a, f32x2 b) { f32x2 d; asm("v_pk_mul_f32 %0, %1, %2" : "=v"(d) : "v"(a), "v"(b)); return d; }
__device__ __forceinline__ f32x2 pkfma(f32x2 a, f32x2 b, f32x2 c) { f32x2 d; asm("v_pk_fma_f32 %0, %1, %2, %3" : "=v"(d) : "v"(a), "v"(b), "v"(c)); return d; }
__device__ __forceinline__ f32x2 pkmul_bl(f32x2 s, f32x2 b) { f32x2 d; asm("v_pk_mul_f32 %0, %1, %2 op_sel_hi:[0,1]" : "=v"(d) : "v"(s), "v"(b)); return d; }
__device__ __forceinline__ f32x2 pknfma_bl(f32x2 s, f32x2 b, f32x2 c) { f32x2 d; asm("v_pk_fma_f32 %0, %1, %2, %3 op_sel_hi:[0,1,1] neg_lo:[1,0,0] neg_hi:[1,0,0]" : "=v"(d) : "v"(s), "v"(b), "v"(c)); return d; }
#define VPKMUL(d, a, b) asm volatile("v_pk_mul_f32 %0, %1, %2" : "=v"(d) : "v"(a), "v"(b))
#define VPKFMA(d, a, b, c) asm volatile("v_pk_fma_f32 %0, %1, %2, %3" : "=v"(d) : "v"(a), "v"(b), "v"(c))
#define VPKMULBL(d, s, b) asm volatile("v_pk_mul_f32 %0, %1, %2 op_sel_hi:[0,1]" : "=v"(d) : "v"(s), "v"(b))
#define VPKNFMABL(d, s, b, c) asm volatile("v_pk_fma_f32 %0, %1, %2, %3 op_sel_hi:[0,1,1] neg_lo:[1,0,0] neg_hi:[1,0,0]" : "=v"(d) : "v"(s), "v"(b), "v"(c))
#define VADD(d, a, b) asm volatile("v_add_f32 %0, %1, %2" : "=v"(d) : "v"(a), "v"(b))
#define VDPP1(x) asm volatile("v_add_f32_dpp %0, %0, %0 quad_perm:[1,0,3,2] row_mask:0xf bank_mask:0xf bound_ctrl:1" : "+v"(x))
#define VDPP2(x) asm volatile("v_add_f32_dpp %0, %0, %0 quad_perm:[2,3,0,1] row_mask:0xf bank_mask:0xf bound_ctrl:1" : "+v"(x))
#define VDPP3(x) asm volatile("v_add_f32_dpp %0, %0, %0 row_half_mirror row_mask:0xf bank_mask:0xf bound_ctrl:1" : "+v"(x))
constexpr int RSTR = 68;
constexpr int REC_ARR = 32 * RSTR;
constexpr int REC_BUF = 5 * REC_ARR;
constexpr int L_REC = 0, L_YY = 87040, L_VV = 103424, L_GG = 119808, L_RKP = 136192, L_SSP = 137216, L_STT = 137728, L_CST = 137984;
constexpr int PROWS = 8192;
#define SCAN_BAR do { asm volatile("s_waitcnt lgkmcnt(0)" ::: "memory"); __builtin_amdgcn_s_barrier(); asm volatile("" ::: "memory"); } while (0)
__device__ __forceinline__ void scan_half(const Params& p, LAS unsigned char* lds, int pi, int rh, int pass) {
    OPQ_TID;
    LAS float* REC = (LAS float*)(lds + L_REC); LAS float* YY = (LAS float*)(lds + L_YY); LAS float* VV = (LAS float*)(lds + L_VV); LAS float* GG = (LAS float*)(lds + L_GG);
    LAS float* RKP = (LAS float*)(lds + L_RKP); LAS float* SSP = (LAS float*)(lds + L_SSP); LAS float* STT = (LAS float*)(lds + L_STT); LAS float* CST = (LAS float*)(lds + L_CST);
    const int b = pi >> 5, hg = pi & 31, colg = hg * 64;
    const bf16_t* Rb = (const bf16_t*)(WSP + WS_R); const bf16_t* Kb = Rb + (size_t)PROWS * 2048; bf16_t* Vb = (bf16_t*)(WSP + WS_V); const bf16_t* Gb = Vb + (size_t)PROWS * 2048;
    const bf16_t* LWb = (const bf16_t*)(WSP + WS_LW) + (size_t)pass * PROWS * 64; const bf16_t* LAb = (const bf16_t*)(WSP + WS_LA) + (size_t)pass * PROWS * 64;
    unsigned long long* GR = (unsigned long long*)(WSP + WS_GR);
    const size_t rowb = (size_t)b * 2048;
    __syncthreads();
    if (tid < 64) { CST[tid] = ((const float*)p.in[I_W0])[colg + tid]; CST[64 + tid] = ((const float*)p.in[I_A0])[colg + tid]; CST[128 + tid] = ((const float*)p.in[I_KK])[colg + tid]; CST[192 + tid] = ((const float*)p.in[I_KA])[colg + tid]; CST[256 + tid] = ((const float*)p.in[I_RK])[colg + tid];
                    CST[320 + tid] = ((const float*)p.in[I_LNG])[colg + tid]; CST[384 + tid] = ((const float*)p.in[I_LNB])[colg + tid]; }
    __syncthreads();
    const int fr = lane & 15, fq = lane >> 4;
    if (wave < 4) {
        const int j = lane & 7, rowl = 8 * wave + (lane >> 3);
        float* stp = (float*)(WSP + WS_ST) + ((size_t)(pi * 64 + 32 * rh + rowl)) * 64 + 8 * j;
        f32x2 P01 = (f32x2){0.f, 0.f}, P23 = P01, P45 = P01, P67 = P01;
        if (pass == 1) { const f32x4 a = *(const f32x4*)stp, c = *(const f32x4*)(stp + 4); P01 = a.xy; P23 = a.zw; P45 = c.xy; P67 = c.zw; }
        const bool first = (lane & 7) == 0;
        SCAN_BAR;
        for (int it = 0; it < 66; ++it) {
            if (it < 64) {
                const LAS float* rec = REC + (it & 1) * REC_BUF + 8 * j; const LAS float* vvp = VV + (it & 3) * 1024 + rowl; LAS float* yyp = YY + (it & 3) * 1024 + rowl;
                const LAS float* ssp = SSP + (it & 1) * 64 + 2 * (lane & 31);
                const float inv2 = __builtin_amdgcn_rcpf(fmaxf(ssp[0] + ssp[1], 1e-24f));
                f32x4 Rkk[2][2], Rw[2][2], Rka[2][2], Rkm[2][2], Rr[2][2]; float Rv[2];
#define LOADREC(slot, s) do { const LAS float* rs_ = rec + (s) * RSTR; \
                    Rkk[slot][0] = *(const LAS f32x4*)(rs_); Rkk[slot][1] = *(const LAS f32x4*)(rs_ + 4); Rw[slot][0] = *(const LAS f32x4*)(rs_ + REC_ARR); Rw[slot][1] = *(const LAS f32x4*)(rs_ + REC_ARR + 4); \
                    Rka[slot][0] = *(const LAS f32x4*)(rs_ + 2 * REC_ARR); Rka[slot][1] = *(const LAS f32x4*)(rs_ + 2 * REC_ARR + 4); Rkm[slot][0] = *(const LAS f32x4*)(rs_ + 3 * REC_ARR); Rkm[slot][1] = *(const LAS f32x4*)(rs_ + 3 * REC_ARR + 4); \
                    Rr[slot][0] = *(const LAS f32x4*)(rs_ + 4 * REC_ARR); Rr[slot][1] = *(const LAS f32x4*)(rs_ + 4 * REC_ARR + 4); Rv[slot] = vvp[(s) * 32]; } while (0)
                LOADREC(0, 0);
                float yp = 0.f, yk0 = 0.f, yk1 = 0.f, yk2 = 0.f, yk3 = 0.f;
#define YSHIFT(YK) do { YK = __int_as_float(__builtin_amdgcn_update_dpp(__float_as_int(yp), __float_as_int(YK), 0x111, 0xf, 0xf, false)); YK = first ? yp : YK; } while (0)
#pragma unroll
                for (int s = 0; s < 32; ++s) {
                    const int c = s & 1, pc = c ^ 1;
                    const float si = __int_as_float(__builtin_amdgcn_readlane(__float_as_int(inv2), s));
                    f32x2 px, py, t01, t23, t45, t67; float x;
                    f32x2 vv2; vv2.x = Rv[c]; asm volatile("" : "+v"(vv2));
                    if (s >= 1) {
                        VPKMUL(px, P01, Rkk[c][0].xy); VPKMUL(py, P01, Rr[pc][0].xy); VPKFMA(px, P23, Rkk[c][0].zw, px); VPKFMA(py, P23, Rr[pc][0].zw, py);
                        VPKFMA(px, P45, Rkk[c][1].xy, px); VPKFMA(py, P45, Rr[pc][1].xy, py); VPKFMA(px, P67, Rkk[c][1].zw, px); VPKFMA(py, P67, Rr[pc][1].zw, py);
                        VADD(x, px.x, px.y); VADD(yp, py.x, py.y);
                    } else {
                        VPKMUL(px, P01, Rkk[c][0].xy); VPKFMA(px, P23, Rkk[c][0].zw, px); VPKFMA(px, P45, Rkk[c][1].xy, px); VPKFMA(px, P67, Rkk[c][1].zw, px);
                        VADD(x, px.x, px.y);
                    }
                    asm volatile("" ::: "memory");
                    if (s + 1 < 32) LOADREC((s + 1) & 1, s + 1);
                    asm volatile("" ::: "memory");
                    VPKMULBL(t01, vv2, Rkm[c][0].xy); VPKMULBL(t23, vv2, Rkm[c][0].zw);
                    VDPP1(x); if (s >= 1) VDPP1(yp);
                    VPKMULBL(t45, vv2, Rkm[c][1].xy); VPKMULBL(t67, vv2, Rkm[c][1].zw);
                    VDPP2(x); if (s >= 1) VDPP2(yp);
                    VPKFMA(P01, P01, Rw[c][0].xy, t01); VPKFMA(P23, P23, Rw[c][0].zw, t23);
                    VDPP3(x); if (s >= 1) VDPP3(yp);
                    VPKFMA(P45, P45, Rw[c][1].xy, t45); VPKFMA(P67, P67, Rw[c][1].zw, t67);
                    if (s >= 1) { if (s - 1 < 8) YSHIFT(yk0); else if (s - 1 < 16) YSHIFT(yk1); else if (s - 1 < 24) YSHIFT(yk2); else YSHIFT(yk3); }
                    x = x * si;
                    f32x2 x2; x2.x = x; asm volatile("" : "+v"(x2));
                    VPKNFMABL(P01, x2, Rka[c][0].xy, P01); VPKNFMABL(P23, x2, Rka[c][0].zw, P23); VPKNFMABL(P45, x2, Rka[c][1].xy, P45); VPKNFMABL(P67, x2, Rka[c][1].zw, P67);
                }
                { f32x2 py; VPKMUL(py, P01, Rr[1][0].xy); VPKFMA(py, P23, Rr[1][0].zw, py); VPKFMA(py, P45, Rr[1][1].xy, py); VPKFMA(py, P67, Rr[1][1].zw, py); VADD(yp, py.x, py.y); }
                yp = dpp_add<0xB1>(yp); yp = dpp_add<0x4E>(yp); yp = dpp_add<0x141>(yp); YSHIFT(yk3);
                yyp[(7 - j) * 32] = yk0; yyp[(15 - j) * 32] = yk1; yyp[(23 - j) * 32] = yk2; yyp[(31 - j) * 32] = yk3;
#undef LOADREC
#undef YSHIFT
            }
            SCAN_BAR;
        }
        if (pass == 0) { *(f32x4*)stp = (f32x4){P01.x, P01.y, P23.x, P23.y}; *(f32x4*)(stp + 4) = (f32x4){P45.x, P45.y, P67.x, P67.y}; }
    } else {
        const int pw = wave - 4, tt = pw >> 1, kh = pw & 1;
        bf16x8 aWc[2][2], aAc[2][2];
#pragma unroll
        for (int kt = 0; kt < 2; ++kt)
#pragma unroll
            for (int ks = 0; ks < 2; ++ks) { const size_t o = (size_t)(colg + 32 * kh + 16 * kt + fr) * 64 + 32 * ks + 8 * fq; aWc[kt][ks] = *(const bf16x8*)((const bf16_t*)(WSP + WS_W2T) + o); aAc[kt][ks] = *(const bf16x8*)((const bf16_t*)(WSP + WS_A2T) + o); }
        bf16x8 lwf[2][2], laf[2][2]; u32x2 r2[2][2], k2[2][2];
#define ISSUE(SET, tbx) do { const size_t tok_ = rowb + (tbx) * 32 + 16 * tt + fr; \
            _Pragma("unroll") for (int ks = 0; ks < 2; ++ks) { lwf[SET][ks] = *(const bf16x8*)(LWb + tok_ * 64 + 32 * ks + 8 * fq); laf[SET][ks] = *(const bf16x8*)(LAb + tok_ * 64 + 32 * ks + 8 * fq); } \
            _Pragma("unroll") for (int kt = 0; kt < 2; ++kt) { r2[SET][kt] = *(const u32x2*)(Rb + tok_ * 2048 + colg + 32 * kh + 16 * kt + 4 * fq); k2[SET][kt] = *(const u32x2*)(Kb + tok_ * 2048 + colg + 32 * kh + 16 * kt + 4 * fq); } } while (0)
        ISSUE(0, 0); ISSUE(1, 1);
        const int t = lane >> 1, hf = lane & 1;
        const size_t vgo = (size_t)colg + 32 * rh + 16 * hf;
        u32x4 v8a = (u32x4){0u, 0u, 0u, 0u}, v8b = v8a, g8a = v8a, g8b = v8a;
        if (pw == 2) { const size_t eo = (rowb + t) * 2048 + vgo; v8a = *(const u32x4*)(Vb + eo); v8b = *(const u32x4*)(Vb + eo + 8); g8a = *(const u32x4*)(Gb + eo); g8b = *(const u32x4*)(Gb + eo + 8); }
        unsigned long long gx[2] = {0ull, 0ull};
#define PROD_ITER(it, PS) do { \
            { const int tb = (it) + 1; \
              if (tb < 64) { \
                LAS float* rec = REC + (tb & 1) * REC_BUF + (16 * tt + fr) * RSTR + 32 * kh + 4 * fq; \
                float ss = 0.f, rkp = 0.f; \
                _Pragma("unroll") for (int kt = 0; kt < 2; ++kt) { \
                    f32x4 accW = (f32x4){0.f, 0.f, 0.f, 0.f}, accA = (f32x4){0.f, 0.f, 0.f, 0.f}; \
                    _Pragma("unroll") for (int ks = 0; ks < 2; ++ks) { accW = MFMA16(aWc[kt][ks], lwf[PS][ks], accW); accA = MFMA16(aAc[kt][ks], laf[PS][ks], accA); } \
                    const int kc = 32 * kh + 16 * kt + 4 * fq; \
                    const f32x4 w0v = *(const LAS f32x4*)(CST + kc), a0v = *(const LAS f32x4*)(CST + 64 + kc), kkc = *(const LAS f32x4*)(CST + 128 + kc), kac = *(const LAS f32x4*)(CST + 192 + kc), rkc = *(const LAS f32x4*)(CST + 256 + kc); \
                    const f32x4 r4 = bf4(r2[PS][kt]), k4 = bf4(k2[PS][kt]); \
                    f32x4 w4, a4; \
                    _Pragma("unroll") for (int e = 0; e < 4; ++e) { w4[e] = __expf(-0.60653066f * sigmf(accW[e] + w0v[e])); a4[e] = sigmf(accA[e] + a0v[e]); } \
                    const f32x4 kkr = k4 * kkc; ss += (kkr.x * kkr.x + kkr.y * kkr.y) + (kkr.z * kkr.z + kkr.w * kkr.w); \
                    const f32x4 km = k4 * (1.0f + (a4 - 1.0f) * kac); const f32x4 rr = r4 * km * rkc; rkp += (rr.x + rr.y) + (rr.z + rr.w); \
                    *(LAS f32x4*)(rec + 16 * kt) = kkr; *(LAS f32x4*)(rec + REC_ARR + 16 * kt) = w4; *(LAS f32x4*)(rec + 2 * REC_ARR + 16 * kt) = kkr * a4; *(LAS f32x4*)(rec + 3 * REC_ARR + 16 * kt) = km; *(LAS f32x4*)(rec + 4 * REC_ARR + 16 * kt) = r4; \
                } \
                if (tb + 2 < 64) ISSUE(PS, tb + 2); \
                ss += __shfl_xor(ss, 16); ss += __shfl_xor(ss, 32); rkp += __shfl_xor(rkp, 16); rkp += __shfl_xor(rkp, 32); \
                if (fq == 0) { SSP[(tb & 1) * 64 + 2 * (16 * tt + fr) + kh] = ss; RKP[(tb & 3) * 64 + 2 * (16 * tt + fr) + kh] = rkp; } \
              } \
              if (pw == 2 && tb < 64) { \
                LAS float* vp = VV + (tb & 3) * 1024 + t * 32 + 16 * hf; LAS float* gp = GG + (tb & 3) * 1024 + t * 32 + 16 * hf; \
                *(LAS f32x4*)(vp) = bf4((u32x2){v8a.x, v8a.y}); *(LAS f32x4*)(vp + 4) = bf4((u32x2){v8a.z, v8a.w}); *(LAS f32x4*)(vp + 8) = bf4((u32x2){v8b.x, v8b.y}); *(LAS f32x4*)(vp + 12) = bf4((u32x2){v8b.z, v8b.w}); \
                *(LAS f32x4*)(gp) = bf4((u32x2){g8a.x, g8a.y}); *(LAS f32x4*)(gp + 4) = bf4((u32x2){g8a.z, g8a.w}); *(LAS f32x4*)(gp + 8) = bf4((u32x2){g8b.x, g8b.y}); *(LAS f32x4*)(gp + 12) = bf4((u32x2){g8b.z, g8b.w}); \
                if (tb + 1 < 64) { const size_t eo = (rowb + (tb + 1) * 32 + t) * 2048 + vgo; v8a = *(const u32x4*)(Vb + eo); v8b = *(const u32x4*)(Vb + eo + 8); g8a = *(const u32x4*)(Gb + eo); g8b = *(const u32x4*)(Gb + eo + 8); } \
              } \
            } \
            if (pw == 3) { \
              if ((it) >= 2 && (it) <= 65) { const int tb = (it) - 2; const unsigned long long* g = GR + ((size_t)(pi * 8 + (tb & 7)) * 2) * 64 + lane; \
                gx[0] = __hip_atomic_load(g, __ATOMIC_RELAXED, __HIP_MEMORY_SCOPE_AGENT); gx[1] = __hip_atomic_load(g + 64, __ATOMIC_RELAXED, __HIP_MEMORY_SCOPE_AGENT); } \
              if ((it) >= 1 && (it) <= 64) { const int tb = (it) - 1; const LAS float* yp_ = YY + (tb & 3) * 1024 + t * 32 + 16 * hf; float s1 = 0.f, s2 = 0.f; \
                _Pragma("unroll") for (int qd = 0; qd < 4; ++qd) { const f32x4 a = *(const LAS f32x4*)(yp_ + 4 * qd); s1 += (a.x + a.y) + (a.z + a.w); s2 += (a.x * a.x + a.y * a.y) + (a.z * a.z + a.w * a.w); } \
                s1 = dpp_add<0xB1>(s1); s2 = dpp_add<0xB1>(s2); \
                const unsigned epoch = (unsigned)(pass * 64 + tb + 1); \
                __hip_atomic_store(GR + ((size_t)((pi * 8 + (tb & 7)) * 2 + rh) * 64 + hf * 32 + t), ((unsigned long long)epoch << 32) | (unsigned long long)__float_as_uint(hf ? s2 : s1), __ATOMIC_RELAXED, __HIP_MEMORY_SCOPE_AGENT); } \
              if ((it) >= 2 && (it) <= 65) { const int tb = (it) - 2; const unsigned epoch = (unsigned)(pass * 64 + tb + 1); \
                const unsigned long long* g = GR + ((size_t)(pi * 8 + (tb & 7)) * 2) * 64 + lane; float tot; \
                for (unsigned spins = 0;; ++spins) { const bool ok = ((unsigned)(gx[0] >> 32) == epoch) && ((unsigned)(gx[1] >> 32) == epoch); tot = __uint_as_float((unsigned)gx[0]) + __uint_as_float((unsigned)gx[1]); \
                    if (__all(ok) || spins > (1u << 22)) break; \
                    __builtin_amdgcn_s_sleep(1); \
                    gx[0] = __hip_atomic_load(g, __ATOMIC_RELAXED, __HIP_MEMORY_SCOPE_AGENT); gx[1] = __hip_atomic_load(g + 64, __ATOMIC_RELAXED, __HIP_MEMORY_SCOPE_AGENT); } \
                const float oth = __shfl_xor(tot, 32); \
                const float mean = (lane < 32 ? tot : oth) * (1.0f / 64.0f), ex2 = (lane < 32 ? oth : tot) * (1.0f / 64.0f); \
                const float rstd = rsqrtf(fmaxf(ex2 - mean * mean, 0.f) + 64e-5f); \
                if (lane < 32) { STT[2 * lane] = mean; STT[2 * lane + 1] = rstd; } \
                const float mu = STT[2 * t], rsd = STT[2 * t + 1]; \
                const int ro = (tb & 3) * 1024 + t * 32 + 16 * hf; const float rk = RKP[(tb & 3) * 64 + 2 * t] + RKP[(tb & 3) * 64 + 2 * t + 1]; \
                unsigned ow[8]; \
                _Pragma("unroll") for (int qd = 0; qd < 4; ++qd) { const f32x4 lg = *(const LAS f32x4*)(CST + 320 + 32 * rh + 16 * hf + 4 * qd), lb = *(const LAS f32x4*)(CST + 384 + 32 * rh + 16 * hf + 4 * qd); \
                    const f32x4 o = ((*(const LAS f32x4*)(YY + ro + 4 * qd) - mu) * rsd * lg + lb + rk * *(const LAS f32x4*)(VV + ro + 4 * qd)) * *(const LAS f32x4*)(GG + ro + 4 * qd); \
                    ow[2 * qd] = pk2(o.x, o.y); ow[2 * qd + 1] = pk2(o.z, o.w); } \
                bf16_t* dst = (bf16_t*)(WSP + WS_A2) + ((size_t)pass * PROWS + rowb + tb * 32 + t) * 2048 + vgo; \
                *(u32x4*)(dst) = (u32x4){ow[0], ow[1], ow[2], ow[3]}; *(u32x4*)(dst + 8) = (u32x4){ow[4], ow[5], ow[6], ow[7]}; } \
            } \
            SCAN_BAR; } while (0)
        for (int it2 = -1; it2 < 65; it2 += 2) { PROD_ITER(it2, 0); PROD_ITER(it2 + 1, 1); }
        PROD_ITER(65, 0);
#undef PROD_ITER
#undef ISSUE
    }
}
__device__ __forceinline__ void p10_final(const Params& p, int G, int bid) {
    OPQ_TID; const int gw = bid * 8 + wave, ngw = G * 8;
    for (int m = gw; m < T; m += ngw) { float* xr = ((float*)p.out) + (size_t)m * D; f32x4 v[4]; float s = 0.f;
#pragma unroll
        for (int j = 0; j < 4; ++j) { v[j] = *((const f32x4*)xr + lane + 64 * j); s += (v[j].x * v[j].x + v[j].y * v[j].y) + (v[j].z * v[j].z + v[j].w * v[j].w); }
        const float rs = rsqrtf(wave_sum(s) * (1.0f / 1024.0f) + 1e-6f);
#pragma unroll
        for (int j = 0; j < 4; ++j) { const f32x4 gg = *((const f32x4*)((const float*)p.in[I_FG]) + lane + 64 * j); *((f32x4*)xr + lane + 64 * j) = v[j] * rs * gg; } }
}

#define XB_TMO      128
#define XB_XCNT(j)  (256  + 64 * (j))
#define XB_XSUB(j)  (1280 + 64 * (j))
#define XB_XGEN(j)  (2304 + 64 * (j))
#define XB_TOP      3328
#define XB_TOPGEN   3392
#define XCD_BAR_WORDS 3456
#define XB_SPIN_CAP (1u << 18)

__device__ __forceinline__ unsigned xb_ld(unsigned* p)              { return __hip_atomic_load(p, __ATOMIC_RELAXED, __HIP_MEMORY_SCOPE_AGENT); }
__device__ __forceinline__ unsigned xb_add(unsigned* p, unsigned v) { return __hip_atomic_fetch_add(p, v, __ATOMIC_RELAXED, __HIP_MEMORY_SCOPE_AGENT); }
__device__ __forceinline__ unsigned xb_xcc_id() { return (unsigned)__builtin_amdgcn_s_getreg((3 << 11) | 20) & 0xFu; }
#define XB_SPIN(cond, bar) do { unsigned _sp = 0; while (cond) { __builtin_amdgcn_s_sleep(1); \
    if ((++_sp & 255u) == 0u) { if (xb_ld(&(bar)[XB_TMO])) break; if (_sp > XB_SPIN_CAP) { atomicAdd(&(bar)[XB_TMO], 1u); break; } } } } while (0)

struct XcdBarrier {
    unsigned* bar; unsigned x;
    volatile LAS unsigned* st;
};

__device__ __forceinline__ XcdBarrier xcd_barrier_post(unsigned* bar, volatile LAS unsigned* st) {
    XcdBarrier b; b.bar = bar; b.x = xb_xcc_id(); b.st = st;
    if (threadIdx.x == 0) (void)xb_add(&bar[XB_XCNT(b.x)], 1u);
    return b;
}
__device__ __forceinline__ void xcd_barrier_complete(unsigned* bar, unsigned x, unsigned& nloc, unsigned& nx) {
    const unsigned G = gridDim.x * gridDim.y * gridDim.z;
    unsigned sum, cnt, mine, sp = 0u;
    for (;;) {
        sum = 0u; cnt = 0u; mine = 0u;
#pragma unroll
        for (unsigned j = 0; j < 16; ++j) { const unsigned c = xb_ld(&bar[XB_XCNT(j)]); sum += c; cnt += (c > 0u) ? 1u : 0u; mine = (j == x) ? c : mine; }
        if (sum == G) break;
        __builtin_amdgcn_s_sleep(1);
        if ((++sp & 255u) == 0u) { if (xb_ld(&bar[XB_TMO])) break; if (sp > XB_SPIN_CAP) { atomicAdd(&bar[XB_TMO], 1u); break; } }
    }
    nloc = mine > 0u ? mine : 1u; nx = cnt > 0u ? cnt : 1u;
}

__device__ __forceinline__ void xcd_barrier(const XcdBarrier& b) {
    asm volatile("s_waitcnt vmcnt(0)" ::: "memory");
    __syncthreads();
    if (threadIdx.x == 0) {
        unsigned* bar = (unsigned*)(*(volatile LAS unsigned long long*)(b.st + 4)); const unsigned bx_ = xb_xcc_id();
        __builtin_amdgcn_s_waitcnt(0);
        unsigned nloc = b.st[0], nx = b.st[1];
        if (nloc == 0u) { xcd_barrier_complete(bar, bx_, nloc, nx); b.st[0] = nloc; b.st[1] = nx; }
        const unsigned old = xb_add(&bar[XB_XSUB(bx_)], 1u);
        const unsigned gen = old / nloc;
        if (old + 1u == (gen + 1u) * nloc) {
            __builtin_amdgcn_fence(__ATOMIC_RELEASE, "agent");
            asm volatile("s_waitcnt vmcnt(0)" ::: "memory");
            const unsigned og = xb_add(&bar[XB_TOP], 1u);
            const unsigned tg = og / nx;
            if (og + 1u == (tg + 1u) * nx) xb_add(&bar[XB_TOPGEN], 1u);
            else XB_SPIN(xb_ld(&bar[XB_TOPGEN]) == tg, bar);
            __builtin_amdgcn_fence(__ATOMIC_ACQUIRE, "agent");
            xb_add(&bar[XB_XGEN(bx_)], 1u);
            asm volatile("s_waitcnt vmcnt(0)" ::: "memory");
        } else {
            XB_SPIN(xb_ld(&bar[XB_XGEN(bx_)]) == gen, bar);
            __builtin_amdgcn_fence(__ATOMIC_ACQUIRE, "agent");
            asm volatile("s_waitcnt vmcnt(0)" ::: "memory");
        }
    }
    __syncthreads();
}

__global__ void __launch_bounds__(NT, 2) mk_fwd(Params p) {
    auto wsl = [&]() { return launder_ws(((unsigned char*)p.ws)); };
    extern __shared__ __attribute__((aligned(16))) unsigned char lds_raw[];
    LAS unsigned char* lds = (LAS unsigned char*)lds_raw;
    cg::grid_group grid = cg::this_grid();
    const int G = gridDim.x, bid = blockIdx.x;
    if (threadIdx.x < 16) ((LAS unsigned*)(lds + LDS_MISC))[threadIdx.x] = 0u;
    __syncthreads();
    if (threadIdx.x == 0) *(LAS unsigned long long*)(lds + LDS_MISC + 16) = (unsigned long long)(((unsigned char*)p.ws) + WS_BAR);
    __syncthreads();
    (void)xcd_barrier_post((unsigned*)(((unsigned char*)p.ws) + WS_BAR), (volatile LAS unsigned*)(lds + LDS_MISC));
#define XBAR() do { XcdBarrier xb_; xb_.bar = nullptr; xb_.x = 0u; xb_.st = (volatile LAS unsigned*)(lds + LDS_MISC); xcd_barrier(xb_); } while (0)
#if PROBE == 7
    p0_prologue(p, lds, G, bid);
#endif
    p0_prologue(p, lds, G, bid);
    grid.sync();
    { pg8::Gemm g{(const bf16_t*)((float*)p.out), (const bf16_t*)(wsl() + WS_WIN), T, ZW, D, D}; pg8::StaticOrder S; S.init(T, ZW, G, bid); pg8::EpiBf16 E{(bf16_t*)(wsl() + WS_Z), ZW};
      pg8::gemm_phase<pg8::EpiBf16, pg8::StaticOrder, true, true>(lds, g, S, E); }
    XBAR();
#if PROBE == 3
    { u32x4 pre[3]; if (bid < 2048) rg_a_prefetch((const bf16_t*)(wsl() + WS_Z), bid, threadIdx.x, pre); for (int u = bid; u < 2048; u += G) rg_a_unit(p, lds, u, u + G, pre); }
    { u32x4 pre[6]; if (bid < 2048) hg_a_prefetch((const bf16_t*)(wsl() + WS_Z), bid, threadIdx.x, pre); for (int u = bid; u < 2048; u += G) hg_a_unit(p, lds, u, u + G, pre); }
    XBAR();
#endif
    { u32x4 pre[3]; if (bid < 2048) rg_a_prefetch((const bf16_t*)(wsl() + WS_Z), bid, threadIdx.x, pre); for (int u = bid; u < 2048; u += G) rg_a_unit(p, lds, u, u + G, pre); }
    { u32x4 pre[6]; if (bid < 2048) hg_a_prefetch((const bf16_t*)(wsl() + WS_Z), bid, threadIdx.x, pre); for (int u = bid; u < 2048; u += G) hg_a_unit(p, lds, u, u + G, pre); }
    XBAR();
#if PROBE == 2
    for (int u = bid; u < 256; u += G) hg_b_item(p, lds, u, p.dry != 0);
    XBAR();
#endif
#if PROBE == 6
    for (int u = bid; u < 512; u += G) rg_b_unit(p, u);
    XBAR();
#endif
#if PROBE == 4
    for (int q = 0; q < 16; ++q) XBAR();
#endif
    for (int u = bid; u < 256; u += G) { const int it_ = (G == 256) ? ((((u & 7) + 8 * (u >> 6)) << 3) | ((u >> 3) & 7)) : u; hg_b_item(p, lds, it_); }
    for (int u = bid; u < 512; u += G) rg_b_unit(p, u);
    XBAR();
#if PROBE == 8
    p4_finalize(p, G, bid);
#endif
    p4_finalize(p, G, bid);
    XBAR();
    { pg8::Gemm g{(const bf16_t*)(wsl() + WS_Z), (const bf16_t*)(wsl() + WS_WOUT), T, D, 2048, ZW}; pg8::StaticOrder S; S.init(T, D, G, bid); pg8::EpiResF32 E{((const float*)p.in[I_X]), ((float*)p.out), D, 0, 0};
      pg8::gemm_phase<pg8::EpiResF32, pg8::StaticOrder, true, true>(lds, g, S, E); }
    XBAR();
#if PROBE == 9
    p6_prologue(p, lds, G, bid);
#endif
    p6_prologue(p, lds, G, bid);
    XBAR();
#pragma unroll 1
    for (int pass = 0; pass < 2; ++pass) {
        { pg8::Gemm g{(const bf16_t*)(wsl() + WS_A2) + (size_t)pass * 8192 * 2048, (const bf16_t*)(wsl() + WS_WC), 8192, 8192, 2048, 2048}; pg8::StaticOrder S; S.init(8192, 8192, G, bid);
          pg8::EpiL1 E{(bf16_t*)(wsl() + WS_R), (bf16_t*)(wsl() + WS_LW), (bf16_t*)(wsl() + WS_LA)};
          pg8::gemm_phase<pg8::EpiL1, pg8::StaticOrder, true, true>(lds, g, S, E); }
        XBAR();
        for (int u0 = 0; u0 < 256; u0 += G) { const int u = u0 + bid; if (u < 256) { int pi, rh; if (G == 256) { pi = (u & 7) + 8 * (u >> 4); rh = (u >> 3) & 1; } else { pi = u >> 1; rh = u & 1; } scan_half(p, lds, pi, rh, pass); } }
        XBAR();
    }
    if (G == 256) {
        pg8::Gemm g{(const bf16_t*)(wsl() + WS_A2), (const bf16_t*)(wsl() + WS_WO), T, D, 2048, 2048}; pg8::StaticOrder S; S.init(T, D, G, bid); pg8::EpiFinalNorm E{((float*)p.out), ((const float*)p.in[I_FG]), (unsigned long long*)(wsl() + WS_XG), D};
        pg8::gemm_phase<pg8::EpiFinalNorm, pg8::StaticOrder, false, true>(lds, g, S, E);
    } else {
        { pg8::Gemm g{(const bf16_t*)(wsl() + WS_A2), (const bf16_t*)(wsl() + WS_WO), T, D, 2048, 2048}; pg8::StaticOrder S; S.init(T, D, G, bid); pg8::EpiResF32 E{((float*)p.out), ((float*)p.out), D, 1, 0};
          pg8::gemm_phase<pg8::EpiResF32, pg8::StaticOrder, true, true>(lds, g, S, E); }
        XBAR();
        p10_final(p, G, bid);
    }
}

extern "C" void kernel_launch(void* const* d_in, const int* in_sizes, int n_in, void* d_out, int out_size, void* d_ws, size_t ws_size, hipStream_t stream) {
    static int grid = 0;
    if (grid == 0) {
        int dev = 0, cus = 0, per_cu = 0;
        if (n_in != 32 || out_size != T * D || ws_size < 256 * MiB) { fprintf(stderr, "kernel_launch: unexpected shapes (n_in %d out %d ws %zu)\n", n_in, out_size, ws_size); grid = -1; return; }
        if (hipGetDevice(&dev) != hipSuccess || hipDeviceGetAttribute(&cus, hipDeviceAttributeMultiprocessorCount, dev) != hipSuccess) { grid = -1; return; }
        if (hipFuncSetAttribute((const void*)mk_fwd, hipFuncAttributeMaxDynamicSharedMemorySize, LDS_BYTES) != hipSuccess) { fprintf(stderr, "hipFuncSetAttribute failed\n"); grid = -1; return; }
        if (hipOccupancyMaxActiveBlocksPerMultiprocessor(&per_cu, (const void*)mk_fwd, NT, LDS_BYTES) != hipSuccess || per_cu < 1) fprintf(stderr, "occupancy query: %d\n", per_cu);
        (void)hipGetLastError();
        grid = cus;
    }
    if (grid < 0) return;
    if (hipMemsetAsync((char*)d_ws + WS_BAR, 0, 16384, stream) != hipSuccess) { fprintf(stderr, "memset failed\n"); return; }
    Params p{};
    p.dry = 1;
    for (int i = 0; i < 32; ++i) memcpy(&p.in[i], &d_in[i], sizeof(void*));
    memcpy(&p.out, &d_out, sizeof(void*)); memcpy(&p.ws, &d_ws, sizeof(void*));
    void* args[] = {&p};
    hipError_t e = hipLaunchCooperativeKernel((const void*)mk_fwd, dim3(grid), dim3(NT), args, LDS_BYTES, stream);
    if (e != hipSuccess) fprintf(stderr, "cooperative launch failed: %s (grid %d)\n", hipGetErrorString(e), grid);
}
```

```cpp
#define PROBE 0
#include <hip/hip_runtime.h>
#include <hip/hip_cooperative_groups.h>
#include <cstdio>
#include <cstring>
#include <cstdint>
namespace cg = cooperative_groups;
namespace pg8 {
#define PG8_LAS __attribute__((address_space(3)))
typedef unsigned short bf16_t;
typedef short bf16x8 __attribute__((ext_vector_type(8)));
typedef float f32x4 __attribute__((ext_vector_type(4)));
typedef unsigned u32x4 __attribute__((ext_vector_type(4)));
constexpr int BM = 256, BK = 64, HALF = 128, HTB = HALF * BK * 2  , STAGE_BYTES = 8 * HTB, NXCD = 8, WGM = 8;

__host__ __device__ __forceinline__ int lds_byte(int r, int c) { const int st = (r >> 4) * 2 + (c >> 5), rr = r & 15, cc = c & 31, ob = rr * 64 + cc * 2; return st * 1024 + (ob ^ (((ob >> 9) & 1) << 5)); }
__host__ __device__ __forceinline__ void stage_rc(int b, int& R, int& C) { const int st = b / 1024, sb = b % 1024, swz = sb ^ (((sb >> 9) & 1) << 5); R = (st >> 1) * 16 + swz / 64; C = (st & 1) * 32 + (swz % 64) / 2; }
__host__ __device__ __forceinline__ int perm32(int rho) { const int n = rho >> 4, i = rho & 15; return 8 * (i >> 2) + 4 * n + (i & 3); }

struct Unit { int pm, pn; };
struct Gemm { const bf16_t* A; const bf16_t* Bt; int M, N, K, lda; };

struct StaticOrder {
    int nM, nN, nwg, G, c;
    __host__ __device__ void init(int M, int N, int G_, int c_) { nM = M / BM; nN = N / BM; nwg = nM * nN; G = G_; c = c_; }
    __host__ __device__ bool next(int i, Unit& u) const {
        const long L = (long)i * G + c; if (L >= nwg) return false;
        int wgid = (int)L; { const int q = nwg / NXCD, r = nwg % NXCD, xcd = wgid % NXCD, off = wgid / NXCD; wgid = (xcd < r ? xcd * (q + 1) : r * (q + 1) + (xcd - r) * q) + off; }
        const int nig = WGM * nN, gid = wgid / nig, fm = gid * WGM, gsz = (nM - fm) < WGM ? (nM - fm) : WGM;
        u.pm = fm + ((wgid % nig) % gsz); u.pn = (wgid % nig) / gsz; return true;
    }
    __device__ __forceinline__ void a_ready(const Unit&) const {}
    __device__ __forceinline__ void done(const Unit&) const {}
};


struct LoraOrder {
    StaticOrder so; int extra;
    __host__ __device__ void init(int M, int N, int G_, int c_, int extra_) { so.init(M, N, G_, c_); extra = extra_; }
    __host__ __device__ bool next(int i, Unit& u) const { const long L = (long)i * so.G + so.c; if (L < so.nwg) return so.next(i, u); if (L >= so.nwg + extra) return false; u.pm = so.nM + (int)(L - so.nwg); u.pn = so.nN - 1; return true; }
    __device__ __forceinline__ void a_ready(const Unit&) const {}
    __device__ __forceinline__ void done(const Unit&) const {}
};
__device__ __forceinline__ unsigned cvt_pk_bf16(float lo, float hi) { unsigned r; asm volatile("v_cvt_pk_bf16_f32 %0, %1, %2" : "=v"(r) : "v"(lo), "v"(hi)); return r; }
__device__ __forceinline__ float sigm(float x) { return __builtin_amdgcn_rcpf(1.0f + __expf(-x)); }
struct EpiBf16 {
    static constexpr bool PERM = true, AFTER_DRAIN = false;
    bf16_t* O; int ldc;
    __device__ __forceinline__ void operator()(const f32x4 (&acc)[2][2][4][2], const Unit& u, int wr, int wc, int fr, int fq) const {
        const int row0 = u.pm * BM + wr * 64 + fr; const int col0 = u.pn * BM + wc * 32 + 8 * fq;
#pragma unroll
        for (int ai = 0; ai < 2; ++ai)
#pragma unroll
            for (int m = 0; m < 4; ++m) { bf16_t* rowp = O + (size_t)(row0 + ai * HALF + m * 16) * ldc + col0;
#pragma unroll
                for (int bj = 0; bj < 2; ++bj) { const f32x4 v0 = acc[ai][bj][m][0], v1 = acc[ai][bj][m][1];
                    u32x4 w; w.x = cvt_pk_bf16(v0[0], v0[1]); w.y = cvt_pk_bf16(v0[2], v0[3]); w.z = cvt_pk_bf16(v1[0], v1[1]); w.w = cvt_pk_bf16(v1[2], v1[3]);
                    *(u32x4*)(rowp + bj * HALF) = w; } }
    }
};
struct EpiResF32 {
    static constexpr bool PERM = false, AFTER_DRAIN = false;
    const float* base; float* out; int ldc; int remap; int pass;
    __device__ __forceinline__ void operator()(const f32x4 (&acc)[2][2][4][2], const Unit& u, int wr, int wc, int fr, int fq) const {
        const int col0 = u.pn * BM + wc * 32 + 4 * fq; const int rbase = remap ? ((((u.pm >> 3) & 3) << 12) + (u.pm >> 5) * 2048 + (u.pm & 7) * BM) : u.pm * BM;
#pragma unroll
        for (int ai = 0; ai < 2; ++ai)
#pragma unroll
            for (int m = 0; m < 4; ++m) { const size_t off = (size_t)(rbase + ai * HALF + wr * 64 + m * 16 + fr) * ldc + col0;
#pragma unroll
                for (int bj = 0; bj < 2; ++bj)
#pragma unroll
                    for (int n = 0; n < 2; ++n) { const f32x4 bs = *(const f32x4*)(base + off + bj * HALF + n * 16); *(f32x4*)(out + off + bj * HALF + n * 16) = bs + acc[ai][bj][m][n]; } }
    }
};
struct EpiL1 {
    static constexpr bool PERM = true, AFTER_DRAIN = false;
    bf16_t* R; bf16_t* LW; bf16_t* LA;
    __device__ __forceinline__ void operator()(const f32x4 (&acc)[2][2][4][2], const Unit& u, int wr, int wc, int fr, int fq) const {
        const int row0 = u.pm * BM + wr * 64 + fr;
        if (u.pn < 32) {
            const int buf = u.pn >> 3; bf16_t* base = R + (size_t)buf * (8192u * 2048u); const int col0 = (u.pn & 7) * BM + wc * 32 + 8 * fq;
#pragma unroll
            for (int ai = 0; ai < 2; ++ai)
#pragma unroll
                for (int m = 0; m < 4; ++m) { bf16_t* rowp = base + (size_t)(row0 + ai * HALF + m * 16) * 2048 + col0;
#pragma unroll
                    for (int bj = 0; bj < 2; ++bj) { f32x4 v0 = acc[ai][bj][m][0], v1 = acc[ai][bj][m][1];
                        if (buf == 3) {
#pragma unroll
                            for (int q = 0; q < 4; ++q) { v0[q] = v0[q] * sigm(v0[q]); v1[q] = v1[q] * sigm(v1[q]); } }
                        u32x4 w; w.x = cvt_pk_bf16(v0[0], v0[1]); w.y = cvt_pk_bf16(v0[2], v0[3]); w.z = cvt_pk_bf16(v1[0], v1[1]); w.w = cvt_pk_bf16(v1[2], v1[3]);
                        *(u32x4*)(rowp + bj * HALF) = w; } }
        } else {
            const int c0 = wc * 32 + 8 * fq;
#pragma unroll
            for (int ai = 0; ai < 2; ++ai)
#pragma unroll
                for (int m = 0; m < 4; ++m) { const size_t row = (size_t)(row0 + ai * HALF + m * 16); f32x4 v0 = acc[ai][0][m][0], v1 = acc[ai][0][m][1];
                    if (c0 < 64) {
#pragma unroll
                        for (int q = 0; q < 4; ++q) { v0[q] = tanhf(v0[q]); v1[q] = tanhf(v1[q]); } }
                    u32x4 w; w.x = cvt_pk_bf16(v0[0], v0[1]); w.y = cvt_pk_bf16(v0[2], v0[3]); w.z = cvt_pk_bf16(v1[0], v1[1]); w.w = cvt_pk_bf16(v1[2], v1[3]);
                    if (c0 < 64) *(u32x4*)(LW + row * 64 + c0) = w; else *(u32x4*)(LA + row * 64 + c0 - 64) = w; }
        }
    }
};

struct EpiFinalNorm {
    static constexpr bool PERM = false, AFTER_DRAIN = true;
    float* out; const float* g; unsigned long long* xg; int ldc;
    __device__ __forceinline__ void fused(f32x4 (&acc)[2][2][4][2], const Unit& u, int wr, int wc, int fr, int fq, PG8_LAS unsigned char* lds, int wid, int lane) const {
        PG8_LAS float* P = (PG8_LAS float*)lds; PG8_LAS float* S = (PG8_LAS float*)(lds + 4096);
        const int col0 = u.pn * BM + wc * 32 + 4 * fq; const int rbase = (((u.pm >> 3) & 3) << 12) + (u.pm >> 5) * 2048 + (u.pm & 7) * BM;
#pragma unroll
        for (int ai = 0; ai < 2; ++ai)
#pragma unroll
            for (int m = 0; m < 4; ++m) { const size_t off = (size_t)(rbase + ai * HALF + wr * 64 + m * 16 + fr) * ldc + col0; float s = 0.f;
#pragma unroll
                for (int bj = 0; bj < 2; ++bj)
#pragma unroll
                    for (int n = 0; n < 2; ++n) { const f32x4 v = acc[ai][bj][m][n] + *(const f32x4*)(out + off + bj * HALF + n * 16); acc[ai][bj][m][n] = v; s += (v[0] * v[0] + v[1] * v[1]) + (v[2] * v[2] + v[3] * v[3]); }
                s += __shfl_xor(s, 16); s += __shfl_xor(s, 32);
                if (fq == 0) P[(ai * HALF + wr * 64 + m * 16 + fr) * 4 + wc] = s; }
        asm volatile("s_waitcnt lgkmcnt(0)" ::: "memory"); __builtin_amdgcn_s_barrier(); asm volatile("" ::: "memory");
        const int row = wid * 32 + (lane & 31);
        if (lane < 32) { const float tot = (P[row * 4] + P[row * 4 + 1]) + (P[row * 4 + 2] + P[row * 4 + 3]);
            __hip_atomic_store(xg + ((size_t)(u.pm * 4 + u.pn) * 256 + row), (1ull << 32) | (unsigned long long)__float_as_uint(tot), __ATOMIC_RELAXED, __HIP_MEMORY_SCOPE_AGENT); }
        {
            float tot = 0.f;
            for (unsigned spins = 0;; ++spins) { bool ok = true; tot = 0.f;
                if (lane < 32) {
#pragma unroll
                    for (int q = 0; q < 4; ++q) { const unsigned long long x = __hip_atomic_load(xg + ((size_t)(u.pm * 4 + q) * 256 + row), __ATOMIC_RELAXED, __HIP_MEMORY_SCOPE_AGENT); ok &= (unsigned)(x >> 32) == 1u; tot += __uint_as_float((unsigned)x); } }
                if (__all(ok) || spins > (1u << 22)) break;
                __builtin_amdgcn_s_sleep(1); }
            if (lane < 32) S[row] = rsqrtf(tot * (1.0f / 1024.0f) + 1e-6f);
        }
        asm volatile("s_waitcnt lgkmcnt(0)" ::: "memory"); __builtin_amdgcn_s_barrier(); asm volatile("" ::: "memory");
#pragma unroll
        for (int ai = 0; ai < 2; ++ai)
#pragma unroll
            for (int m = 0; m < 4; ++m) { const int r = ai * HALF + wr * 64 + m * 16 + fr; const float rs = S[r]; const size_t off = (size_t)(rbase + r) * ldc + col0;
#pragma unroll
                for (int bj = 0; bj < 2; ++bj)
#pragma unroll
                    for (int n = 0; n < 2; ++n) { const f32x4 gg = *(const f32x4*)(g + col0 + bj * HALF + n * 16); *(f32x4*)(out + off + bj * HALF + n * 16) = acc[ai][bj][m][n] * rs * gg; } }
    }
};
template <class Epi, class Sched, bool ALIGN_EPI = false, bool SP2 = false>
__device__ __forceinline__ void gemm_phase(PG8_LAS unsigned char* lds, const Gemm g, const Sched& S, const Epi& E) {
    int tid_o = threadIdx.x; asm volatile("" : "+v"(tid_o)); const int tid = tid_o, wid = __builtin_amdgcn_readfirstlane(tid >> 6), lane = tid & 63, wr = wid >> 2, wc = wid & 3, fr = lane & 15, fq = lane >> 4;
    const int K = g.K, nt = K / BK;
    unsigned voffA[2], voffB[2];
#pragma unroll
    for (int i = 0; i < 2; ++i) { int R, C; stage_rc(tid * 16 + i * 8192, R, C); const int Rb = Epi::PERM ? ((R & ~31) + perm32(R & 31)) : R;
        voffA[i] = (unsigned)(R * g.lda + C) * 2u; voffB[i] = (unsigned)(Rb * K + C) * 2u; }
    const size_t kstep = (size_t)(BK * 2);
    const size_t hstep = (size_t)HALF * K * 2;
    const size_t tstep = 2 * hstep; const size_t hstepA = (size_t)HALF * g.lda * 2, tstepA = 2 * hstepA;
    const unsigned ldsw = (unsigned)wid * 1024u;
    const int aoff = lds_byte(wr * 64 + fr, fq * 8), boff = lds_byte(wc * 32 + fr, fq * 8);
#define PG8_SA(b, h) (((b) * 2 + (h)) * HTB)
#define PG8_SB(b, h) ((4 + (b) * 2 + (h)) * HTB)
#define PG8_STAGE(bufoff, gbase, voff) do { _Pragma("unroll") for (int _i = 0; _i < 2; ++_i) \
        __builtin_amdgcn_global_load_lds((const unsigned*)((const char*)(gbase) + (voff)[_i]), (PG8_LAS unsigned*)(lds + (bufoff) + ldsw + _i * 8192), 16, 0, 0); } while (0)
#define PG8_LDA(dst, b, h) do { _Pragma("unroll") for (int m = 0; m < 4; ++m) _Pragma("unroll") for (int k = 0; k < 2; ++k) dst[m][k] = *(const PG8_LAS bf16x8*)(lds + PG8_SA(b, h) + aoff + m * 2048 + k * 1024); } while (0)
#define PG8_LDB(dst, b, h) do { _Pragma("unroll") for (int n = 0; n < 2; ++n) _Pragma("unroll") for (int k = 0; k < 2; ++k) dst[n][k] = *(const PG8_LAS bf16x8*)(lds + PG8_SB(b, h) + boff + n * 2048 + k * 1024); } while (0)
#define PG8_MMA(ai, bj, At, Bt) do { __builtin_amdgcn_s_setprio(1); _Pragma("unroll") for (int m = 0; m < 4; ++m) _Pragma("unroll") for (int n = 0; n < 2; ++n) _Pragma("unroll") for (int k = 0; k < 2; ++k) \
        acc[ai][bj][m][n] = __builtin_amdgcn_mfma_f32_16x16x32_bf16(Bt[n][k], At[m][k], acc[ai][bj][m][n], 0, 0, 0); __builtin_amdgcn_s_setprio(0); } while (0)
#define PG8_WAIT_V(n) asm volatile("s_waitcnt vmcnt(" #n ")" ::: "memory")
#define PG8_WAIT_L(n) asm volatile("s_waitcnt lgkmcnt(" #n ")" ::: "memory")
#define PG8_BAR __builtin_amdgcn_s_barrier()
#define PG8_SCHED __builtin_amdgcn_sched_barrier(0)
    Unit cur, nxt; int ui = 0;
    if (!S.next(0, cur)) return;
    f32x4 acc[2][2][4][2];
#pragma unroll
    for (int a = 0; a < 2; ++a)
#pragma unroll
        for (int b = 0; b < 2; ++b)
#pragma unroll
            for (int m = 0; m < 4; ++m)
#pragma unroll
                for (int n = 0; n < 2; ++n) acc[a][b][m][n] = (f32x4){0.f, 0.f, 0.f, 0.f};
    bf16x8 At[4][2], B0[2][2], B1[2][2];
    const char* cA = (const char*)g.A + (size_t)cur.pm * tstepA; const char* cB = (const char*)g.Bt + (size_t)cur.pn * tstep;
    S.a_ready(cur);
    if constexpr (SP2) {
        PG8_STAGE(PG8_SB(0, 0), cB, voffB); PG8_STAGE(PG8_SB(0, 1), cB + hstep, voffB); PG8_STAGE(PG8_SA(0, 0), cA, voffA); PG8_STAGE(PG8_SA(0, 1), cA + hstepA, voffA);
        if (wr == 1) PG8_BAR;
        PG8_WAIT_V(2); PG8_BAR;
        PG8_STAGE(PG8_SB(1, 0), cB + kstep, voffB); PG8_STAGE(PG8_SA(1, 0), cA + kstep, voffA); PG8_STAGE(PG8_SB(1, 1), cB + hstep + kstep, voffB);
        PG8_WAIT_V(6); PG8_BAR;
    } else {
        PG8_STAGE(PG8_SB(0, 0), cB, voffB); PG8_STAGE(PG8_SA(0, 0), cA, voffA); PG8_STAGE(PG8_SB(0, 1), cB + hstep, voffB); PG8_STAGE(PG8_SA(0, 1), cA + hstepA, voffA);
        if (wr == 1) PG8_BAR;
        PG8_WAIT_V(4); PG8_BAR;
        PG8_STAGE(PG8_SB(1, 0), cB + kstep, voffB); PG8_STAGE(PG8_SA(1, 0), cA + kstep, voffA); PG8_STAGE(PG8_SB(1, 1), cB + hstep + kstep, voffB);
        PG8_WAIT_V(6); PG8_BAR;
    }
    for (;;) {
        const bool has_next = S.next(ui + 1, nxt);
        const char* nA = has_next ? (const char*)g.A + (size_t)nxt.pm * tstepA : cA; const char* nB = has_next ? (const char*)g.Bt + (size_t)nxt.pn * tstep : cB;
        for (int t = 0; t < nt; t += 2) {
            const bool last = (t == nt - 2);
            const char* a1 = cA + (size_t)(t + 1) * kstep;
            const char* a2 = last ? nA : cA + (size_t)(t + 2) * kstep; const char* b2 = last ? nB : cB + (size_t)(t + 2) * kstep;
            const char* a3 = a2 + kstep; const char* b3 = b2 + kstep;
            if (last && has_next) S.a_ready(nxt);
            if constexpr (SP2) {
            PG8_LDB(B0, 0, 0); PG8_LDB(B1, 0, 1); PG8_SCHED; PG8_LDA(At, 0, 0); PG8_STAGE(PG8_SA(1, 1), a1 + hstepA, voffA);
            PG8_WAIT_V(8); PG8_WAIT_L(0); PG8_BAR; PG8_MMA(0, 0, At, B0); PG8_MMA(0, 1, At, B1); PG8_BAR; PG8_SCHED;
            PG8_LDA(At, 0, 1); PG8_STAGE(PG8_SB(0, 0), b2, voffB); PG8_STAGE(PG8_SB(0, 1), b2 + hstep, voffB); PG8_STAGE(PG8_SA(0, 0), a2, voffA);
            PG8_WAIT_V(8); PG8_WAIT_L(0); PG8_BAR; PG8_MMA(1, 0, At, B0); PG8_MMA(1, 1, At, B1); PG8_BAR; PG8_SCHED;
            PG8_LDB(B0, 1, 0); PG8_LDB(B1, 1, 1); PG8_SCHED; PG8_LDA(At, 1, 0); PG8_STAGE(PG8_SA(0, 1), a2 + hstepA, voffA);
            PG8_WAIT_V(8); PG8_WAIT_L(0); PG8_BAR; PG8_MMA(0, 0, At, B0); PG8_MMA(0, 1, At, B1); PG8_BAR; PG8_SCHED;
            PG8_LDA(At, 1, 1); PG8_STAGE(PG8_SB(1, 0), b3, voffB); PG8_STAGE(PG8_SB(1, 1), b3 + hstep, voffB); PG8_STAGE(PG8_SA(1, 0), a3, voffA);
            PG8_WAIT_V(8); PG8_WAIT_L(0); PG8_BAR; PG8_MMA(1, 0, At, B0); PG8_MMA(1, 1, At, B1); PG8_BAR; PG8_SCHED;
            } else {
            PG8_LDB(B0, 0, 0); PG8_SCHED; PG8_LDA(At, 0, 0); PG8_STAGE(PG8_SA(1, 1), a1 + hstepA, voffA);
            PG8_WAIT_L(8); PG8_BAR; PG8_WAIT_L(0); PG8_MMA(0, 0, At, B0); PG8_BAR; PG8_SCHED;
            PG8_LDB(B1, 0, 1); PG8_STAGE(PG8_SB(0, 0), b2, voffB);
            PG8_BAR; PG8_WAIT_L(0); PG8_MMA(0, 1, At, B1); PG8_BAR;
            PG8_LDA(At, 0, 1); PG8_STAGE(PG8_SA(0, 0), a2, voffA);
            PG8_BAR; PG8_WAIT_L(0); PG8_MMA(1, 0, At, B0); PG8_BAR; PG8_SCHED;
            PG8_STAGE(PG8_SB(0, 1), b2 + hstep, voffB);
            PG8_WAIT_V(6); PG8_BAR; PG8_MMA(1, 1, At, B1); PG8_BAR;
            PG8_LDB(B0, 1, 0); PG8_SCHED; PG8_LDA(At, 1, 0); PG8_STAGE(PG8_SA(0, 1), a2 + hstepA, voffA);
            PG8_WAIT_L(8); PG8_BAR; PG8_WAIT_L(0); PG8_MMA(0, 0, At, B0); PG8_BAR; PG8_SCHED;
            PG8_LDB(B1, 1, 1); PG8_STAGE(PG8_SB(1, 0), b3, voffB);
            PG8_BAR; PG8_WAIT_L(0); PG8_MMA(0, 1, At, B1); PG8_BAR;
            PG8_LDA(At, 1, 1); PG8_STAGE(PG8_SA(1, 0), a3, voffA);
            PG8_BAR; PG8_WAIT_L(0); PG8_MMA(1, 0, At, B0); PG8_BAR; PG8_SCHED;
            PG8_STAGE(PG8_SB(1, 1), b3 + hstep, voffB);
            PG8_WAIT_V(6); PG8_BAR; PG8_MMA(1, 1, At, B1); PG8_BAR;
            }
        }
        if constexpr (ALIGN_EPI) { if (wr == 0) PG8_BAR; }
        if constexpr (!Epi::AFTER_DRAIN) { E(acc, cur, wr, wc, fr, fq); S.done(cur); }
        if (!has_next) break;
#pragma unroll
        for (int a = 0; a < 2; ++a)
#pragma unroll
            for (int b = 0; b < 2; ++b)
#pragma unroll
                for (int m = 0; m < 4; ++m)
#pragma unroll
                    for (int n = 0; n < 2; ++n) acc[a][b][m][n] = (f32x4){0.f, 0.f, 0.f, 0.f};
        cur = nxt; cA = nA; cB = nB; ++ui;
        if constexpr (ALIGN_EPI) { if (wr == 1) PG8_BAR; }
    }
    PG8_WAIT_V(0);
    if constexpr (!ALIGN_EPI) { if (wr == 0) PG8_BAR; }
    PG8_BAR;
    if constexpr (Epi::AFTER_DRAIN) { E.fused(acc, cur, wr, wc, fr, fq, lds, wid, lane); S.done(cur); }
#undef PG8_SA
#undef PG8_SB
#undef PG8_STAGE
#undef PG8_LDA
#undef PG8_LDB
#undef PG8_MMA
#undef PG8_WAIT_V
#undef PG8_WAIT_L
#undef PG8_BAR
#undef PG8_SCHED
}
}
#define GAS __attribute__((address_space(1)))
#define LAS __attribute__((address_space(3)))
typedef unsigned short bf16_t;
typedef short bf16x8 __attribute__((ext_vector_type(8)));
typedef float f32x4 __attribute__((ext_vector_type(4)));
typedef unsigned u32x4 __attribute__((ext_vector_type(4)));
typedef unsigned u32x2 __attribute__((ext_vector_type(2)));
typedef float f32x2 __attribute__((ext_vector_type(2)));
constexpr int NT = 512, PROWS6 = 8192;
constexpr int T = 16384, SEQ = 4096, D = 1024, ZW = 6144;
constexpr size_t MiB = 1u << 20;
constexpr size_t WS_DEC = 0;
constexpr size_t WS_Z = 4 * MiB;
constexpr size_t WS_WIN = 196 * MiB, WS_WOUT = 208 * MiB, WS_RGA = 212 * MiB, WS_RGX = 212 * MiB + 256 * 1024;
constexpr size_t WS_OI = 213 * MiB;
constexpr size_t WS_A2 = 4 * MiB;
constexpr size_t WS_R = 68 * MiB;
constexpr size_t WS_V = 132 * MiB;
constexpr size_t WS_WC = 196 * MiB, WS_WO = 229 * MiB, WS_LW = 233 * MiB, WS_LA = 235 * MiB;
constexpr size_t WS_W2T = 237 * MiB, WS_A2T = 237 * MiB + 256 * 1024, WS_GR = 238 * MiB, WS_ST = 239 * MiB, WS_XG = 241 * MiB;
constexpr size_t WS_WL = 246 * MiB;
constexpr size_t WS_BAR = 2 * MiB;
constexpr int LDS_BYTES = 147456, LDS_MISC = 147456 - 64;

struct Params { const GAS float* in[32]; GAS float* out; GAS unsigned char* ws; long long dry; };
#ifndef PROBE
#define PROBE 0
#endif
enum { I_X = 0, I_ABG, I_WIN, I_CONVW, I_CONVB, I_RGWA, I_RGBA, I_RGWX, I_RGBX, I_LAM, I_LB, I_HGG, I_WOUT, I_CNG, I_MU, I_WR, I_WK, I_WV, I_WG, I_W0, I_W1, I_W2, I_A0, I_A1, I_A2, I_KK, I_KA, I_RK, I_LNG, I_LNB, I_WO, I_FG };

__device__ __forceinline__ unsigned f2bf(float f) { unsigned u = __float_as_uint(f); return (u + 0x7fffu + ((u >> 16) & 1u)) >> 16; }
__device__ __forceinline__ float bf2f(unsigned h) { return __uint_as_float(h << 16); }
__device__ __forceinline__ unsigned pk2(float lo, float hi) { return f2bf(lo) | (f2bf(hi) << 16); }
__device__ __forceinline__ float sigmf(float x) { return __builtin_amdgcn_rcpf(1.0f + __expf(-x)); }
__device__ __forceinline__ float wave_sum(float v) {
#pragma unroll
    for (int o = 1; o < 64; o <<= 1) v += __shfl_xor(v, o);
    return v;
}
#define OPQ_TID unsigned char* WSP = launder_ws(((unsigned char*)p.ws)); int tid = threadIdx.x; asm volatile("" : "+v"(tid)); const int lane = tid & 63, wave = __builtin_amdgcn_readfirstlane(tid >> 6); (void)lane; (void)wave
__device__ __forceinline__ unsigned char* launder_ws(unsigned char* w) { const unsigned long long v = (unsigned long long)w; unsigned lo = __builtin_amdgcn_readfirstlane((unsigned)v), hi = __builtin_amdgcn_readfirstlane((unsigned)(v >> 32)); asm volatile("" : "+s"(lo), "+s"(hi)); return (unsigned char*)(GAS unsigned char*)(((unsigned long long)hi << 32) | lo); }
#define MFMA16(a, b, c) __builtin_amdgcn_mfma_f32_16x16x32_bf16((a), (b), (c), 0, 0, 0)

__device__ __forceinline__ void tr_item(const float* src, int ld_src, bf16_t* dst, int ld_dst, const float* sc, int scmode, LAS float* scr, int kb, int nb, int lane) {
    const int k0 = 64 * kb, n0 = 32 * nb;
#pragma unroll
    for (int i = 0; i < 8; ++i) { const int kk = 8 * i + (lane >> 3), c4 = (lane & 7) * 4; f32x4 v = *(const f32x4*)(src + (size_t)(k0 + kk) * ld_src + n0 + c4);
        if (sc) { const float m_ = sc[k0 + kk]; v = v * (scmode ? m_ : (1.0f - m_)); }
        scr[kk * 33 + c4] = v.x; scr[kk * 33 + c4 + 1] = v.y; scr[kk * 33 + c4 + 2] = v.z; scr[kk * 33 + c4 + 3] = v.w; }
    asm volatile("s_waitcnt lgkmcnt(0)" ::: "memory");
    const int c = lane & 7;
#pragma unroll
    for (int j = 0; j < 4; ++j) { const int n = (lane >> 3) + 8 * j; const LAS float* s = scr + (8 * c) * 33 + n;
        u32x4 o; o.x = pk2(s[0 * 33], s[1 * 33]); o.y = pk2(s[2 * 33], s[3 * 33]); o.z = pk2(s[4 * 33], s[5 * 33]); o.w = pk2(s[6 * 33], s[7 * 33]);
        *(u32x4*)(dst + (size_t)(n0 + n) * ld_dst + k0 + 8 * c) = o; }
    asm volatile("s_waitcnt lgkmcnt(0)" ::: "memory");
}
__device__ __forceinline__ void tr_item2(const float* src, int ld_src, bf16_t* dst0, bf16_t* dst1, int ld_dst, const float* mu, LAS float* scr, int kb, int nb, int lane) {
    const int k0 = 64 * kb, n0 = 32 * nb;
#pragma unroll
    for (int i = 0; i < 8; ++i) { const int kk = 8 * i + (lane >> 3), c4 = (lane & 7) * 4; const f32x4 v = *(const f32x4*)(src + (size_t)(k0 + kk) * ld_src + n0 + c4);
        scr[kk * 33 + c4] = v.x; scr[kk * 33 + c4 + 1] = v.y; scr[kk * 33 + c4 + 2] = v.z; scr[kk * 33 + c4 + 3] = v.w; }
    asm volatile("s_waitcnt lgkmcnt(0)" ::: "memory");
    const int c = lane & 7;
    const f32x4 m0 = *(const f32x4*)(mu + k0 + 8 * c), m1 = *(const f32x4*)(mu + k0 + 8 * c + 4);
#pragma unroll
    for (int j = 0; j < 4; ++j) { const int n = (lane >> 3) + 8 * j; const LAS float* s = scr + (8 * c) * 33 + n;
        const float s0 = s[0], s1 = s[33], s2 = s[66], s3 = s[99], s4 = s[132], s5 = s[165], s6 = s[198], s7 = s[231];
        u32x4 o; o.x = pk2(s0 * m0.x, s1 * m0.y); o.y = pk2(s2 * m0.z, s3 * m0.w); o.z = pk2(s4 * m1.x, s5 * m1.y); o.w = pk2(s6 * m1.z, s7 * m1.w);
        *(u32x4*)(dst1 + (size_t)(n0 + n) * ld_dst + k0 + 8 * c) = o;
        o.x = pk2(s0 * (1.0f - m0.x), s1 * (1.0f - m0.y)); o.y = pk2(s2 * (1.0f - m0.z), s3 * (1.0f - m0.w)); o.z = pk2(s4 * (1.0f - m1.x), s5 * (1.0f - m1.y)); o.w = pk2(s6 * (1.0f - m1.z), s7 * (1.0f - m1.w));
        *(u32x4*)(dst0 + (size_t)(n0 + n) * ld_dst + k0 + 8 * c) = o; }
    asm volatile("s_waitcnt lgkmcnt(0)" ::: "memory");
}
__device__ __forceinline__ void rms_row(const float* xrow, const float* g, int lane, u32x2 (&o)[4]) {
    f32x4 v[4]; float s = 0.f;
#pragma unroll
    for (int j = 0; j < 4; ++j) { v[j] = *((const f32x4*)xrow + lane + 64 * j); s += (v[j].x * v[j].x + v[j].y * v[j].y) + (v[j].z * v[j].z + v[j].w * v[j].w); }
    const float rs = rsqrtf(wave_sum(s) * (1.0f / 1024.0f) + 1e-6f);
#pragma unroll
    for (int j = 0; j < 4; ++j) { const f32x4 gg = *((const f32x4*)g + lane + 64 * j); o[j].x = pk2(v[j].x * rs * gg.x, v[j].y * rs * gg.y); o[j].y = pk2(v[j].z * rs * gg.z, v[j].w * rs * gg.w); }
}

__device__ __forceinline__ void p0_prologue(const Params& p, LAS unsigned char* lds, int G, int bid) {
    OPQ_TID; const int gw = bid * 8 + wave, ngw = G * 8;
    LAS float* scr = (LAS float*)(lds + wave * 16384);
    bf16_t* WinT = (bf16_t*)(WSP + WS_WIN); bf16_t* WoutT = (bf16_t*)(WSP + WS_WOUT); bf16_t* RGA = (bf16_t*)(WSP + WS_RGA); bf16_t* RGX = (bf16_t*)(WSP + WS_RGX);
    constexpr int IA = 16 * 192, IB = 32 * 32, IC = 64, IL0 = 64;
    for (int it = gw; it < IA + IB + 2 * IC + IL0; it += ngw) {
        int r = it;
        if (r >= IA + IB + 2 * IC) { r -= IA + IB + 2 * IC; const int wh = r >> 5, q = r & 31;
            bf16_t* dst = (bf16_t*)(WSP + WS_WL) + (size_t)(wh * 64) * 2048;
            tr_item2(wh ? ((const float*)p.in[I_A1]) : ((const float*)p.in[I_W1]), 64, dst, dst + 1024, 2048, ((const float*)p.in[I_MU]) + (wh ? 4 : 1) * 1024, scr, q >> 1, q & 1, lane); continue; }
        if (r < IA) { tr_item(((const float*)p.in[I_WIN]), ZW, WinT, 1024, nullptr, 0, scr, r / 192, r % 192, lane); continue; } r -= IA;
        if (r < IB) { tr_item(((const float*)p.in[I_WOUT]), 1024, WoutT, 2048, nullptr, 0, scr, r / 32, r % 32, lane); continue; } r -= IB;
        const float* src = (r < IC) ? ((const float*)p.in[I_RGWA]) : ((const float*)p.in[I_RGWX]); bf16_t* dst = (r < IC) ? RGA : RGX; if (r >= IC) r -= IC;
        const int blk = r >> 3, q = r & 7;
        tr_item(src + blk * 16384, 128, dst + blk * 16384, 128, nullptr, 0, scr, q >> 2, q & 3, lane);
    }
    bf16_t* U0 = (bf16_t*)((float*)p.out);
    for (int m = gw; m < T; m += ngw) { u32x2 o[4]; rms_row(((const float*)p.in[I_X]) + (size_t)m * D, ((const float*)p.in[I_ABG]), lane, o);
#pragma unroll
        for (int j = 0; j < 4; ++j) *((u32x2*)(U0 + (size_t)m * D) + lane + 64 * j) = o[j]; }
}

__device__ __forceinline__ void rg_a_prefetch(const bf16_t* Z, int unit, int tid, u32x4 (&pre)[3]) {
    const int b = unit >> 9, n = (unit >> 3) & 63, j = unit & 7; const int tok0 = b * SEQ + n * 64, ch0 = j * 128;
#pragma unroll
    for (int q = 0; q < 3; ++q) { const int i = tid + q * NT; const int row = i >> 4, cc = i & 15; pre[q] = (u32x4){0u, 0u, 0u, 0u};
        if (i < 67 * 16 && (n > 0 || row >= 3)) pre[q] = *(const u32x4*)(Z + (size_t)(tok0 - 3 + row) * ZW + ch0 + 8 * cc); }
}
__device__ __forceinline__ void rg_a_unit(const Params& p, LAS unsigned char* lds, int unit, int next_unit, u32x4 (&pre)[3]) {
    OPQ_TID;
    LAS float* XC = (LAS float*)lds; LAS float* AA = (LAS float*)(lds + 32768); LAS bf16_t* XB = (LAS bf16_t*)(lds + 65536); LAS bf16_t* XR = (LAS bf16_t*)(lds + 82944);
    LAS float* SUMP = (LAS float*)(lds + 82944); LAS float* SUMH = SUMP + 512; LAS bf16_t* HT = XB; LAS bf16_t* PT = (LAS bf16_t*)(lds + 87040);
    const int b = unit >> 9, n = (unit >> 3) & 63, j = unit & 7;
    const int tok0 = b * SEQ + n * 64, ch0 = j * 128;
    const bf16_t* Z = (const bf16_t*)(WSP + WS_Z);
#pragma unroll
    for (int q = 0; q < 3; ++q) { const int i = tid + q * NT; if (i < 67 * 16) *(LAS u32x4*)(XR + (i >> 4) * 136 + 8 * (i & 15)) = pre[q]; }
    __syncthreads();
    if (next_unit < 2048) rg_a_prefetch(Z, next_unit, tid, pre);
    const int c = tid & 127, sub = tid >> 7;
    {
        const int ch = ch0 + c;
        const float w0 = ((const float*)p.in[I_CONVW])[ch], w1 = ((const float*)p.in[I_CONVW])[1024 + ch], w2 = ((const float*)p.in[I_CONVW])[2048 + ch], w3 = ((const float*)p.in[I_CONVW])[3072 + ch], cb = ((const float*)p.in[I_CONVB])[ch];
        const LAS bf16_t* xr = XR + (sub * 16) * 136 + c;
        float xm3 = bf2f(xr[0]), xm2 = bf2f(xr[136]), xm1 = bf2f(xr[272]);
#pragma unroll
        for (int i = 0; i < 16; ++i) { const float x = bf2f(xr[(i + 3) * 136]); const float y = w0 * xm3 + w1 * xm2 + w2 * xm1 + w3 * x + cb;
            XC[(sub * 16 + i) * 128 + c] = y; XB[(sub * 16 + i) * 136 + c] = (bf16_t)f2bf(y); xm3 = xm2; xm2 = xm1; xm1 = x; }
    }
    __syncthreads();
    {
        const int fr = lane & 15, fq = lane >> 4;
        const bf16_t* WA = (const bf16_t*)(WSP + WS_RGA) + j * 16384 + (16 * wave + fr) * 128 + 8 * fq;
        const bf16_t* WX = (const bf16_t*)(WSP + WS_RGX) + j * 16384 + (16 * wave + fr) * 128 + 8 * fq;
        f32x4 accA[4], accX[4];
#pragma unroll
        for (int m = 0; m < 4; ++m) { accA[m] = (f32x4){0.f, 0.f, 0.f, 0.f}; accX[m] = (f32x4){0.f, 0.f, 0.f, 0.f}; }
#pragma unroll
        for (int k = 0; k < 4; ++k) { const bf16x8 bA = *(const bf16x8*)(WA + 32 * k), bX = *(const bf16x8*)(WX + 32 * k);
#pragma unroll
            for (int m = 0; m < 4; ++m) { const bf16x8 a = *(const LAS bf16x8*)(XB + (16 * m + fr) * 136 + 32 * k + 8 * fq); accA[m] = MFMA16(a, bA, accA[m]); accX[m] = MFMA16(a, bX, accX[m]); } }
        const int cl = 16 * wave + fr, ch = ch0 + cl;
        const float ba = ((const float*)p.in[I_RGBA])[ch], bx = ((const float*)p.in[I_RGBX])[ch], lam = ((const float*)p.in[I_LAM])[ch];
        const float sp = log1pf(expf(-lam));
#pragma unroll
        for (int m = 0; m < 4; ++m)
#pragma unroll
            for (int r = 0; r < 4; ++r) { const int tk = 16 * m + 4 * fq + r; const float gr = sigmf(accA[m][r] + ba), gi = sigmf(accX[m][r] + bx);
                const float la = -8.0f * gr * sp; const float a = __expf(la); const float mult = __builtin_amdgcn_sqrtf(fmaxf(1.0f - a * a, 0.f));
                const float xc = XC[tk * 128 + cl]; AA[tk * 128 + cl] = a; XC[tk * 128 + cl] = mult * gi * xc; }
    }
    __syncthreads();
    {
        float hl[16], pl[16]; float h = 0.f, P = 1.f;
#pragma unroll
        for (int i = 0; i < 16; ++i) { const float a = AA[(sub * 16 + i) * 128 + c], u = XC[(sub * 16 + i) * 128 + c]; h = a * h + u; P *= a; hl[i] = h; pl[i] = P; }
        SUMP[sub * 128 + c] = P; SUMH[sub * 128 + c] = h;
        __syncthreads();
        float chh = 0.f, cp = 1.f;
#pragma unroll
        for (int s = 0; s < 3; ++s) if (s < sub) { const float sp_ = SUMP[s * 128 + c]; chh = chh * sp_ + SUMH[s * 128 + c]; cp *= sp_; }
#pragma unroll
        for (int i = 0; i < 16; ++i) { HT[(sub * 16 + i) * 136 + c] = (bf16_t)f2bf(hl[i] + pl[i] * chh); PT[(sub * 16 + i) * 136 + c] = (bf16_t)f2bf(pl[i] * cp); }
    }
    __syncthreads();
    {
        bf16_t* HL = (bf16_t*)((float*)p.out) + (size_t)tok0 * D + ch0; bf16_t* PC = HL + (size_t)T * D;
        for (int i = tid; i < 1024; i += NT) { const int row = i >> 4, cc = i & 15;
            *(u32x4*)(HL + (size_t)row * D + 8 * cc) = *(const LAS u32x4*)(HT + row * 136 + 8 * cc); *(u32x4*)(PC + (size_t)row * D + 8 * cc) = *(const LAS u32x4*)(PT + row * 136 + 8 * cc); }
    }
    __syncthreads();
}

__device__ __forceinline__ void hg_a_prefetch(const bf16_t* Z, int unit, int tid, u32x4 (&pre)[6]) {
    const int b = unit >> 9, h = (unit >> 6) & 7, n = unit & 63; const int tok0 = b * SEQ + n * 64;
#pragma unroll
    for (int q = 0; q < 6; ++q) { const int i = tid + q * NT; const int arr = i >> 10, row = (i >> 4) & 63, cc = i & 15; pre[q] = *(const u32x4*)(Z + (size_t)(tok0 + row) * ZW + 2048 + 1024 * arr + h * 128 + 8 * cc); }
}
__device__ __forceinline__ void hg_a_unit(const Params& p, LAS unsigned char* lds, int unit, int next_unit, u32x4 (&pre)[6]) {
    OPQ_TID;
    LAS bf16_t* QD = (LAS bf16_t*)lds; LAS bf16_t* KI = (LAS bf16_t*)(lds + 17408); LAS bf16_t* VR = (LAS bf16_t*)(lds + 34816); LAS bf16_t* VT = (LAS bf16_t*)(lds + 52224);
    LAS bf16_t* SC = (LAS bf16_t*)(lds + 70656); LAS float* ST = (LAS float*)(lds + 79872); LAS bf16_t* OT = VR;
    const int b = unit >> 9, h = (unit >> 6) & 7, n = unit & 63;
    const int tok0 = b * SEQ + n * 64;
    bf16_t* Z = (bf16_t*)(WSP + WS_Z);
    const int fr = lane & 15, fq = lane >> 4;
#pragma unroll
    for (int q = 0; q < 6; ++q) { const int i = tid + q * NT; const int arr = i >> 10, row = (i >> 4) & 63, cc = i & 15;
        *(LAS u32x4*)((arr == 0 ? QD : (arr == 1 ? KI : VR)) + row * 136 + 8 * cc) = pre[q]; }
    __syncthreads();
    {
        const int d = tid & 127, sub = tid >> 7, hd = h * 128 + d;
        const float lb = sigmf(((const float*)p.in[I_LB])[hd] - ((const float*)p.in[I_LB])[1024 + hd]), omlb = 1.0f - lb;
        float q[16], kq[16], cl[16]; unsigned short vv[16]; float run = 0.f;
#pragma unroll
        for (int i = 0; i < 16; ++i) { const int t = sub * 16 + i; const float f = bf2f(KI[t * 136 + d]); const float sg = sigmf(f);
            run += __logf(lb + omlb * sg); cl[i] = run; kq[i] = omlb * (1.0f - sg); q[i] = bf2f(QD[t * 136 + d]); vv[i] = VR[t * 136 + d]; }
        ST[sub * 128 + d] = run;
        __syncthreads();
        float off = 0.f, total = 0.f;
#pragma unroll
        for (int s = 0; s < 4; ++s) { const float x = ST[s * 128 + d]; total += x; if (s < sub) off += x; }
        unsigned ke[8], vp[8];
#pragma unroll
        for (int i = 0; i < 16; ++i) { const float cum = off + cl[i]; const unsigned qd = f2bf(q[i] * __expf(cum)), ki = f2bf(kq[i] * __expf(-cum)), kE = f2bf(kq[i] * __expf(total - cum));
            QD[(sub * 16 + i) * 136 + d] = (bf16_t)qd; KI[(sub * 16 + i) * 136 + d] = (bf16_t)ki;
            if (i & 1) { ke[i >> 1] |= kE << 16; vp[i >> 1] |= (unsigned)vv[i] << 16; } else { ke[i >> 1] = kE; vp[i >> 1] = vv[i]; } }
        *(LAS u32x4*)(VT + d * 72 + sub * 16) = (u32x4){vp[0], vp[1], vp[2], vp[3]}; *(LAS u32x4*)(VT + d * 72 + sub * 16 + 8) = (u32x4){vp[4], vp[5], vp[6], vp[7]};
        bf16_t* tb = Z + (size_t)(tok0 + (d >> 1)) * ZW + h * 128 + (d & 1) * 64 + sub * 16;
        *(u32x4*)(tb + 3072) = (u32x4){ke[0], ke[1], ke[2], ke[3]}; *(u32x4*)(tb + 3072 + 8) = (u32x4){ke[4], ke[5], ke[6], ke[7]};
        *(u32x4*)(tb + 4096) = (u32x4){vp[0], vp[1], vp[2], vp[3]}; *(u32x4*)(tb + 4096 + 8) = (u32x4){vp[4], vp[5], vp[6], vp[7]};
        if (sub == 0) ((float*)(WSP + WS_DEC))[unit * 128 + d] = __expf(total);
    }
    __syncthreads();
    if (next_unit < 2048) hg_a_prefetch(Z, next_unit, tid, pre);
    for (int i = tid; i < 1024; i += NT) { const int row = i >> 4, cc = i & 15; *(u32x4*)(Z + (size_t)(tok0 + row) * ZW + 2048 + h * 128 + 8 * cc) = *(const LAS u32x4*)(QD + row * 136 + 8 * cc); }
    {
        const int lt = wave >> 1;
#pragma unroll
        for (int x = 0; x < 2; ++x) { const int mt = (wave & 1) * 2 + x; f32x4 acc = (f32x4){0.f, 0.f, 0.f, 0.f};
            if (mt <= lt) {
#pragma unroll
                for (int k = 0; k < 4; ++k) { const bf16x8 a = *(const LAS bf16x8*)(QD + (16 * lt + fr) * 136 + 32 * k + 8 * fq), bb = *(const LAS bf16x8*)(KI + (16 * mt + fr) * 136 + 32 * k + 8 * fq); acc = MFMA16(a, bb, acc); } }
#pragma unroll
            for (int r = 0; r < 4; ++r) { const int l = 16 * lt + 4 * fq + r, mm = 16 * mt + fr; SC[l * 72 + mm] = (bf16_t)f2bf(mm <= l ? acc[r] : 0.f); } }
    }
    __syncthreads();
    {
#pragma unroll
        for (int lt = 0; lt < 4; ++lt) { f32x4 acc = (f32x4){0.f, 0.f, 0.f, 0.f};
#pragma unroll
            for (int k = 0; k < 2; ++k) { const bf16x8 a = *(const LAS bf16x8*)(SC + (16 * lt + fr) * 72 + 32 * k + 8 * fq), bb = *(const LAS bf16x8*)(VT + (16 * wave + fr) * 72 + 32 * k + 8 * fq); acc = MFMA16(a, bb, acc); }
#pragma unroll
            for (int r = 0; r < 4; ++r) OT[(16 * lt + 4 * fq + r) * 136 + 16 * wave + fr] = (bf16_t)f2bf(acc[r]); }
    }
    __syncthreads();
    { bf16_t* OI = (bf16_t*)(WSP + WS_OI) + (size_t)tok0 * D + h * 128;
      for (int i = tid; i < 1024; i += NT) { const int row = i >> 4, cc = i & 15; *(u32x4*)(OI + (size_t)row * D + 8 * cc) = *(const LAS u32x4*)(OT + row * 136 + 8 * cc); } }
    __syncthreads();
}

__device__ __forceinline__ void hg_b_item(const Params& p, LAS unsigned char* lds, int item, bool dry = false) {
    OPQ_TID;
    LAS bf16_t* SB = (LAS bf16_t*)lds;
    const int b = item >> 6, h = (item >> 3) & 7, es = item & 7;
    const int fr = lane & 15, fq = lane >> 4;
    const bf16_t* Z = (const bf16_t*)(WSP + WS_Z); bf16_t* OI = (bf16_t*)(WSP + WS_OI); const float* DEC = (const float*)(WSP + WS_DEC);
    for (int i = tid; i < 2 * 16 * 136 / 2; i += NT) ((LAS unsigned*)SB)[i] = 0u;
    __syncthreads();
    f32x4 S = (f32x4){0.f, 0.f, 0.f, 0.f};
    const int eg = 16 * es + fr, dg = 16 * wave + fr;
    const bf16_t* pV = Z + (size_t)(b * SEQ + (eg >> 1)) * ZW + 4096 + h * 128 + (eg & 1) * 64 + 8 * fq;
    const bf16_t* pK = Z + (size_t)(b * SEQ + (dg >> 1)) * ZW + 3072 + h * 128 + (dg & 1) * 64 + 8 * fq;
    const bf16_t* pQ = Z + (size_t)(b * SEQ + 16 * (wave & 3) + fr) * ZW + 2048 + h * 128 + 8 * fq;
    bf16_t* pO = OI + (size_t)(b * SEQ + 16 * (wave & 3) + 4 * fq) * D + h * 128 + 16 * es + fr;
    const float* pD = DEC + (size_t)((b * 8 + h) * 64) * 128 + dg;
    bf16x8 nV[2][2], nK[2][2], nQ[2][4]; float ndec[2]; unsigned short nO[2][4];
#define HGB_LOAD(SET, n_) do { const size_t ro_ = (size_t)(n_) * 64 * ZW; ndec[SET] = pD[(n_) * 128]; \
        _Pragma("unroll") for (int k = 0; k < 2; ++k) { nV[SET][k] = *(const bf16x8*)(pV + ro_ + 32 * k); nK[SET][k] = *(const bf16x8*)(pK + ro_ + 32 * k); } \
        if (wave < 4) { _Pragma("unroll") for (int k = 0; k < 4; ++k) nQ[SET][k] = *(const bf16x8*)(pQ + ro_ + 32 * k); \
            _Pragma("unroll") for (int r = 0; r < 4; ++r) nO[SET][r] = pO[(size_t)((n_) * 64 + r) * D]; } } while (0)
#define HGB_STEP(SET, n) do { \
        const float dec = ndec[SET]; bf16x8 aV[2], bK[2]; \
        _Pragma("unroll") for (int k = 0; k < 2; ++k) { aV[k] = nV[SET][k]; bK[k] = nK[SET][k]; } \
        if (wave < 4) { \
            f32x4 acc = (f32x4){0.f, 0.f, 0.f, 0.f}; \
            _Pragma("unroll") for (int k = 0; k < 4; ++k) { const bf16x8 bb = *(const LAS bf16x8*)(SB + ((n) & 1) * 2176 + fr * 136 + 32 * k + 8 * fq); acc = MFMA16(nQ[SET][k], bb, acc); } \
            _Pragma("unroll") for (int r = 0; r < 4; ++r) { const float nv = bf2f(nO[SET][r]) + acc[r]; if (!dry) pO[(size_t)((n) * 64 + r) * D] = (bf16_t)f2bf(nv); else if (nv == 123456.0f) pO[0] = 0; } \
        } \
        if ((n) + 2 < 64) HGB_LOAD(SET, (n) + 2); \
        S = S * dec; \
        _Pragma("unroll") for (int k = 0; k < 2; ++k) S = MFMA16(aV[k], bK[k], S); \
        _Pragma("unroll") for (int r = 0; r < 4; ++r) SB[(((n) + 1) & 1) * 2176 + (4 * fq + r) * 136 + dg] = (bf16_t)f2bf(S[r]); \
        asm volatile("s_waitcnt lgkmcnt(0)" ::: "memory"); __builtin_amdgcn_s_barrier(); asm volatile("" ::: "memory"); } while (0)
    HGB_LOAD(0, 0); HGB_LOAD(1, 1);
#pragma unroll 1
    for (int n2 = 0; n2 < 64; n2 += 2) { HGB_STEP(0, n2); HGB_STEP(1, n2 + 1); }
#undef HGB_LOAD
#undef HGB_STEP
}
__device__ __forceinline__ void rg_b_unit(const Params& p, int unit) {
    OPQ_TID;
    const int b = unit >> 7, n = (unit >> 1) & 63, ch = (unit & 1) * 512 + 8 * (tid & 63), r8 = tid >> 6;
    const bf16_t* HL = (const bf16_t*)((float*)p.out) + (size_t)b * SEQ * D + ch; const bf16_t* PC = HL + (size_t)T * D;
    bf16_t* Z = (bf16_t*)(WSP + WS_Z) + (size_t)(b * SEQ + n * 64) * ZW + ch;
    float carry[8];
#pragma unroll
    for (int i = 0; i < 8; ++i) carry[i] = 0.f;
    int m0 = 0;
    for (; m0 + 4 <= n; m0 += 4) { u32x4 pp[4], hh4[4];
#pragma unroll
        for (int i = 0; i < 4; ++i) { const size_t o = (size_t)((m0 + i) * 64 + 63) * D; pp[i] = *(const u32x4*)(PC + o); hh4[i] = *(const u32x4*)(HL + o); }
#pragma unroll
        for (int i = 0; i < 4; ++i)
#pragma unroll
            for (int c = 0; c < 4; ++c) { carry[2 * c] = carry[2 * c] * bf2f(pp[i][c] & 0xffffu) + bf2f(hh4[i][c] & 0xffffu); carry[2 * c + 1] = carry[2 * c + 1] * bf2f(pp[i][c] >> 16) + bf2f(hh4[i][c] >> 16); } }
    for (; m0 < n; ++m0) { const size_t o = (size_t)(m0 * 64 + 63) * D; const u32x4 pp = *(const u32x4*)(PC + o), hh4 = *(const u32x4*)(HL + o);
#pragma unroll
        for (int c = 0; c < 4; ++c) { carry[2 * c] = carry[2 * c] * bf2f(pp[c] & 0xffffu) + bf2f(hh4[c] & 0xffffu); carry[2 * c + 1] = carry[2 * c + 1] * bf2f(pp[c] >> 16) + bf2f(hh4[c] >> 16); } }
#pragma unroll 4
    for (int tq = 0; tq < 8; ++tq) { const int t = 8 * tq + r8; const size_t o = (size_t)(n * 64 + t) * D;
        const u32x4 hv = *(const u32x4*)(HL + o), pv = *(const u32x4*)(PC + o), gv = *(const u32x4*)(Z + (size_t)t * ZW + 1024); u32x4 ov;
#pragma unroll
        for (int c = 0; c < 4; ++c) { const float h0 = bf2f(hv[c] & 0xffffu) + bf2f(pv[c] & 0xffffu) * carry[2 * c], h1 = bf2f(hv[c] >> 16) + bf2f(pv[c] >> 16) * carry[2 * c + 1];
            const float g0 = bf2f(gv[c] & 0xffffu), g1 = bf2f(gv[c] >> 16); ov[c] = pk2(h0 * g0 * sigmf(g0), h1 * g1 * sigmf(g1)); }
        *(u32x4*)(Z + (size_t)t * ZW) = ov; }
}
__device__ __forceinline__ float row16_sum_p4(float x) {
    x += __int_as_float(__builtin_amdgcn_update_dpp(0, __float_as_int(x), 0xB1, 0xf, 0xf, true)); x += __int_as_float(__builtin_amdgcn_update_dpp(0, __float_as_int(x), 0x4E, 0xf, 0xf, true));
    x += __int_as_float(__builtin_amdgcn_update_dpp(0, __float_as_int(x), 0x141, 0xf, 0xf, true)); x += __int_as_float(__builtin_amdgcn_update_dpp(0, __float_as_int(x), 0x140, 0xf, 0xf, true)); return x; }
__device__ __forceinline__ void p4_finalize(const Params& p, int G, int bid) {
    OPQ_TID; const int gw = bid * 8 + wave, ngw = G * 8;
    bf16_t* Z = (bf16_t*)(WSP + WS_Z); const bf16_t* OI = (const bf16_t*)(WSP + WS_OI);
    const int l16 = lane & 15, pr = lane >> 4;
    const f32x4 g0 = *(const f32x4*)(((const float*)p.in[I_HGG]) + 8 * l16), g1 = *(const f32x4*)(((const float*)p.in[I_HGG]) + 8 * l16 + 4);
    for (int it = gw; it < T * 2; it += ngw) { const int tok = it >> 1, h = (it & 1) * 4 + pr;
        const u32x4 ov = *(const u32x4*)(OI + (size_t)tok * D + h * 128 + 8 * l16); const u32x4 gv = *(const u32x4*)(Z + (size_t)tok * ZW + 5120 + h * 128 + 8 * l16);
        float o[8], gb[8]; float ss = 0.f;
#pragma unroll
        for (int c = 0; c < 4; ++c) { o[2 * c] = bf2f(ov[c] & 0xffffu); o[2 * c + 1] = bf2f(ov[c] >> 16); gb[2 * c] = bf2f(gv[c] & 0xffffu); gb[2 * c + 1] = bf2f(gv[c] >> 16); ss += o[2 * c] * o[2 * c] + o[2 * c + 1] * o[2 * c + 1]; }
        const float rs = rsqrtf(row16_sum_p4(ss) * (1.0f / 128.0f) + 1e-6f);
        u32x4 w;
#pragma unroll
        for (int c = 0; c < 4; ++c) { const float ga = c < 2 ? g0[2 * c] : g1[2 * c - 4], gbq = c < 2 ? g0[2 * c + 1] : g1[2 * c - 3];
            w[c] = pk2(o[2 * c] * rs * ga * gb[2 * c] * sigmf(gb[2 * c]), o[2 * c + 1] * rs * gbq * gb[2 * c + 1] * sigmf(gb[2 * c + 1])); }
        *(u32x4*)(Z + (size_t)tok * ZW + 1024 + h * 128 + 8 * l16) = w; }
}
__device__ __forceinline__ void p6_prologue(const Params& p, LAS unsigned char* lds, int G, int bid) {
    OPQ_TID; const int gw = bid * 8 + wave, ngw = G * 8;
    LAS float* scr = (LAS float*)(lds + wave * 16384);
    constexpr int IP = 4096, IL = 0, IO = 1024, I2 = 128;
    for (int i = gw * 64 + lane; i < (int)(MiB / 16); i += ngw * 64) ((u32x4*)(WSP + WS_GR))[i] = (u32x4){0u, 0u, 0u, 0u};
    for (int i = gw * 64 + lane; i < (int)(MiB / 32); i += ngw * 64) ((u32x4*)(WSP + WS_XG))[i] = (u32x4){0u, 0u, 0u, 0u};
    for (int it = gw; it < IP + IL + IO + I2; it += ngw) {
        int r = it;
        if (r < IP) { const int pj = r >> 10, q = r & 1023;
            const int muidx = pj == 0 ? 0 : (pj == 1 ? 2 : (pj == 2 ? 3 : 5));
            bf16_t* dst = (bf16_t*)(WSP + WS_WC) + (size_t)(pj * 2048) * 2048;
            tr_item2(((const float*)p.in[I_WR + pj]), 2048, dst, dst + 1024, 2048, ((const float*)p.in[I_MU]) + muidx * 1024, scr, q >> 6, q & 63, lane); continue; }
        r -= IP;
        if (r >= IO) { r -= IO; const int wh = r >> 6, nb = r & 63; tr_item(wh ? ((const float*)p.in[I_A2]) : ((const float*)p.in[I_W2]), 2048, (bf16_t*)(WSP + (wh ? WS_A2T : WS_W2T)), 64, nullptr, 0, scr, 0, nb, lane); continue; }
        tr_item(((const float*)p.in[I_WO]), 1024, (bf16_t*)(WSP + WS_WO), 2048, nullptr, 0, scr, r >> 5, r & 31, lane);
    }
    bf16_t* A2 = (bf16_t*)(WSP + WS_A2);
    const int fr = lane & 15, fq = lane >> 4;
    for (int tile = bid; tile < T / 64; tile += G) {
        const int m0 = tile * 64;
        for (int i = (wave == 0 && (m0 & (SEQ - 1)) != 0) ? -1 : 0; i < 8; ++i) { const int m = (i < 0) ? m0 - 1 : m0 + 8 * wave + i;
            u32x2 o[4]; rms_row(((float*)p.out) + (size_t)m * D, ((const float*)p.in[I_CNG]), lane, o); const int bb = m >> 12, t = m & (SEQ - 1);
            const size_t cr = (size_t)(t >> 11) * PROWS6 + bb * 2048 + (t & 2047);
            const size_t cn = (size_t)((t + 1) >> 11) * PROWS6 + bb * 2048 + ((t + 1) & 2047);
#pragma unroll
            for (int j = 0; j < 4; ++j) { if (i >= 0) *((u32x2*)(A2 + cr * 2048) + lane + 64 * j) = o[j];
                if (t + 1 < SEQ) *((u32x2*)(A2 + cn * 2048 + 1024) + lane + 64 * j) = o[j];
                if (t == 0) *((u32x2*)(A2 + cr * 2048 + 1024) + lane + 64 * j) = (u32x2){0u, 0u}; } }
        __syncthreads();
        { const int t0 = m0 & (SEQ - 1), bb = m0 >> 12; const size_t cr0 = (size_t)(t0 >> 11) * PROWS6 + bb * 2048 + (t0 & 2047);
          const int mt = wave & 3, nh = wave >> 2;
          LAS bf16_t* LA_ = (LAS bf16_t*)lds; LAS bf16_t* LB_ = (LAS bf16_t*)(lds + 64 * 264 * 2);
          const bf16_t* ga = A2 + cr0 * 2048; const bf16_t* gb = (const bf16_t*)(WSP + WS_WL);
          u32x4 pa_[4], pb_[8];
#define LORA_LOAD(kc) do { _Pragma("unroll") for (int q = 0; q < 4; ++q) { const int i = tid + q * NT; pa_[q] = *(const u32x4*)(ga + (size_t)(i >> 5) * 2048 + (kc) * 256 + 8 * (i & 31)); } \
              _Pragma("unroll") for (int q = 0; q < 8; ++q) { const int i = tid + q * NT; pb_[q] = *(const u32x4*)(gb + (size_t)(i >> 5) * 2048 + (kc) * 256 + 8 * (i & 31)); } } while (0)
          LORA_LOAD(0);
          f32x4 acc[4];
#pragma unroll
          for (int nt = 0; nt < 4; ++nt) acc[nt] = (f32x4){0.f, 0.f, 0.f, 0.f};
#pragma unroll 1
          for (int kc = 0; kc < 8; ++kc) {
#pragma unroll
              for (int q = 0; q < 4; ++q) { const int i = tid + q * NT; *(LAS u32x4*)(LA_ + (i >> 5) * 264 + 8 * (i & 31)) = pa_[q]; }
#pragma unroll
              for (int q = 0; q < 8; ++q) { const int i = tid + q * NT; *(LAS u32x4*)(LB_ + (i >> 5) * 264 + 8 * (i & 31)) = pb_[q]; }
              __syncthreads();
              if (kc + 1 < 8) LORA_LOAD(kc + 1);
#pragma unroll
              for (int ks = 0; ks < 8; ++ks) { const bf16x8 a = *(const LAS bf16x8*)(LA_ + (16 * mt + fr) * 264 + 32 * ks + 8 * fq);
#pragma unroll
                  for (int nt = 0; nt < 4; ++nt) { const bf16x8 bfr = *(const LAS bf16x8*)(LB_ + (64 * nh + 16 * nt + fr) * 264 + 32 * ks + 8 * fq); acc[nt] = MFMA16(a, bfr, acc[nt]); } }
              __syncthreads();
          }
#undef LORA_LOAD
          bf16_t* dstb = (bf16_t*)(WSP + (nh ? WS_LA : WS_LW));
#pragma unroll
          for (int nt = 0; nt < 4; ++nt)
#pragma unroll
              for (int r = 0; r < 4; ++r) { const float v = acc[nt][r]; dstb[(cr0 + 16 * mt + 4 * fq + r) * 64 + 16 * nt + fr] = (bf16_t)f2bf(nh ? v : tanhf(v)); } }
        __syncthreads();
    }
}
template <int CTRL> __device__ __forceinline__ float dpp_add(float x) { const int y = __builtin_amdgcn_update_dpp(0, __float_as_int(x), CTRL, 0xf, 0xf, true); return x + __int_as_float(y); }
__device__ __forceinline__ f32x4 bf4(u32x2 v) { return (f32x4){bf2f(v.x & 0xffffu), bf2f(v.x >> 16), bf2f(v.y & 0xffffu), bf2f(v.y >> 16)}; }
__device__ __forceinline__ float afma(float a, float b, float c) { float d; asm("v_fma_f32 %0, %1, %2, %3" : "=v"(d) : "v"(a), "v"(b), "v"(c)); return d; }
__device__ __forceinline__ float anfma(float a, float b, float c) { float d; asm("v_fma_f32 %0, -%1, %2, %3" : "=v"(d) : "v"(a), "v"(b), "v"(c)); return d; }
__device__ __forceinline__ float amul(float a, float b) { float d; asm("v_mul_f32 %0, %1, %2" : "=v"(d) : "v"(a), "v"(b)); return d; }
__device__ __forceinline__ f32x2 pkmul(f32x2 a, f32x2 b) { f32x2 d; asm("v_pk_mul_f32 %0, %1, %2" : "=v"(d) : "v"(a), "v"(b)); return d; }
__device__ __forceinline__ f32x2 pkfma(f32x2 a, f32x2 b, f32x2 c) { f32x2 d; asm("v_pk_fma_f32 %0, %1, %2, %3" : "=v"(d) : "v"(a), "v"(b), "v"(c)); return d; }
__device__ __forceinline__ f32x2 pkmul_bl(f32x2 s, f32x2 b) { f32x2 d; asm("v_pk_mul_f32 %0, %1, %2 op_sel_hi:[0,1]" : "=v"(d) : "v"(s), "v"(b)); return d; }
__device__ __forceinline__ f32x2 pknfma_bl(f32x2 s, f32x2 b, f32x2 c) { f32x2 d; asm("v_pk_fma_f32 %0, %1, %2, %3 op_sel_hi:[0,1,1] neg_lo:[1,0,0] neg_hi:[1,0,0]" : "=v"(d) : "v"(s), "v"(b), "v"(c)); return d; }
#define VPKMUL(d, a, b) asm volatile("v_pk_mul_f32 %0, %1, %2" : "=v"(d) : "v"(a), "v"(b))
#define VPKFMA(d, a, b, c) asm volatile("v_pk_fma_f32 %0, %1, %2, %3" : "=v"(d) : "v"(a), "v"(b), "v"(c))
#define VPKMULBL(d, s, b) asm volatile("v_pk_mul_f32 %0, %1, %2 op_sel_hi:[0,1]" : "=v"(d) : "v"(s), "v"(b))
#define VPKNFMABL(d, s, b, c) asm volatile("v_pk_fma_f32 %0, %1, %2, %3 op_sel_hi:[0,1,1] neg_lo:[1,0,0] neg_hi:[1,0,0]" : "=v"(d) : "v"(s), "v"(b), "v"(c))
#define VADD(d, a, b) asm volatile("v_add_f32 %0, %1, %2" : "=v"(d) : "v"(a), "v"(b))
#define VDPP1(x) asm volatile("v_add_f32_dpp %0, %0, %0 quad_perm:[1,0,3,2] row_mask:0xf bank_mask:0xf bound_ctrl:1" : "+v"(x))
#define VDPP2(x) asm volatile("v_add_f32_dpp %0, %0, %0 quad_perm:[2,3,0,1] row_mask:0xf bank_mask:0xf bound_ctrl:1" : "+v"(x))
#define VDPP3(x) asm volatile("v_add_f32_dpp %0, %0, %0 row_half_mirror row_mask:0xf bank_mask:0xf bound_ctrl:1" : "+v"(x))
constexpr int RSTR = 68;
constexpr int REC_ARR = 32 * RSTR;
constexpr int REC_BUF = 5 * REC_ARR;
constexpr int L_REC = 0, L_YY = 87040, L_VV = 103424, L_GG = 119808, L_RKP = 136192, L_SSP = 137216, L_STT = 137728, L_CST = 137984;
constexpr int PROWS = 8192;
#define SCAN_BAR do { asm volatile("s_waitcnt lgkmcnt(0)" ::: "memory"); __builtin_amdgcn_s_barrier(); asm volatile("" ::: "memory"); } while (0)
__device__ __forceinline__ void scan_half(const Params& p, LAS unsigned char* lds, int pi, int rh, int pass) {
    OPQ_TID;
    LAS float* REC = (LAS float*)(lds + L_REC); LAS float* YY = (LAS float*)(lds + L_YY); LAS float* VV = (LAS float*)(lds + L_VV); LAS float* GG = (LAS float*)(lds + L_GG);
    LAS float* RKP = (LAS float*)(lds + L_RKP); LAS float* SSP = (LAS float*)(lds + L_SSP); LAS float* STT = (LAS float*)(lds + L_STT); LAS float* CST = (LAS float*)(lds + L_CST);
    const int b = pi >> 5, hg = pi & 31, colg = hg * 64;
    const bf16_t* Rb = (const bf16_t*)(WSP + WS_R); const bf16_t* Kb = Rb + (size_t)PROWS * 2048; bf16_t* Vb = (bf16_t*)(WSP + WS_V); const bf16_t* Gb = Vb + (size_t)PROWS * 2048;
    const bf16_t* LWb = (const bf16_t*)(WSP + WS_LW) + (size_t)pass * PROWS * 64; const bf16_t* LAb = (const bf16_t*)(WSP + WS_LA) + (size_t)pass * PROWS * 64;
    unsigned long long* GR = (unsigned long long*)(WSP + WS_GR);
    const size_t rowb = (size_t)b * 2048;
    __syncthreads();
    if (tid < 64) { CST[tid] = ((const float*)p.in[I_W0])[colg + tid]; CST[64 + tid] = ((const float*)p.in[I_A0])[colg + tid]; CST[128 + tid] = ((const float*)p.in[I_KK])[colg + tid]; CST[192 + tid] = ((const float*)p.in[I_KA])[colg + tid]; CST[256 + tid] = ((const float*)p.in[I_RK])[colg + tid];
                    CST[320 + tid] = ((const float*)p.in[I_LNG])[colg + tid]; CST[384 + tid] = ((const float*)p.in[I_LNB])[colg + tid]; }
    __syncthreads();
    const int fr = lane & 15, fq = lane >> 4;
    if (wave < 4) {
        const int j = lane & 7, rowl = 8 * wave + (lane >> 3);
        float* stp = (float*)(WSP + WS_ST) + ((size_t)(pi * 64 + 32 * rh + rowl)) * 64 + 8 * j;
        f32x2 P01 = (f32x2){0.f, 0.f}, P23 = P01, P45 = P01, P67 = P01;
        if (pass == 1) { const f32x4 a = *(const f32x4*)stp, c = *(const f32x4*)(stp + 4); P01 = a.xy; P23 = a.zw; P45 = c.xy; P67 = c.zw; }
        const bool first = (lane & 7) == 0;
        SCAN_BAR;
        for (int it = 0; it < 66; ++it) {
            if (it < 64) {
                const LAS float* rec = REC + (it & 1) * REC_BUF + 8 * j; const LAS float* vvp = VV + (it & 3) * 1024 + rowl; LAS float* yyp = YY + (it & 3) * 1024 + rowl;
                const LAS float* ssp = SSP + (it & 1) * 64 + 2 * (lane & 31);
                const float inv2 = __builtin_amdgcn_rcpf(fmaxf(ssp[0] + ssp[1], 1e-24f));
                f32x4 Rkk[2][2], Rw[2][2], Rka[2][2], Rkm[2][2], Rr[2][2]; float Rv[2];
#define LOADREC(slot, s) do { const LAS float* rs_ = rec + (s) * RSTR; \
                    Rkk[slot][0] = *(const LAS f32x4*)(rs_); Rkk[slot][1] = *(const LAS f32x4*)(rs_ + 4); Rw[slot][0] = *(const LAS f32x4*)(rs_ + REC_ARR); Rw[slot][1] = *(const LAS f32x4*)(rs_ + REC_ARR + 4); \
                    Rka[slot][0] = *(const LAS f32x4*)(rs_ + 2 * REC_ARR); Rka[slot][1] = *(const LAS f32x4*)(rs_ + 2 * REC_ARR + 4); Rkm[slot][0] = *(const LAS f32x4*)(rs_ + 3 * REC_ARR); Rkm[slot][1] = *(const LAS f32x4*)(rs_ + 3 * REC_ARR + 4); \
                    Rr[slot][0] = *(const LAS f32x4*)(rs_ + 4 * REC_ARR); Rr[slot][1] = *(const LAS f32x4*)(rs_ + 4 * REC_ARR + 4); Rv[slot] = vvp[(s) * 32]; } while (0)
                LOADREC(0, 0);
                float yp = 0.f, yk0 = 0.f, yk1 = 0.f, yk2 = 0.f, yk3 = 0.f;
#define YSHIFT(YK) do { YK = __int_as_float(__builtin_amdgcn_update_dpp(__float_as_int(yp), __float_as_int(YK), 0x111, 0xf, 0xf, false)); YK = first ? yp : YK; } while (0)
#pragma unroll
                for (int s = 0; s < 32; ++s) {
                    const int c = s & 1, pc = c ^ 1;
                    const float si = __int_as_float(__builtin_amdgcn_readlane(__float_as_int(inv2), s));
                    f32x2 px, py, t01, t23, t45, t67; float x;
                    f32x2 vv2; vv2.x = Rv[c]; asm volatile("" : "+v"(vv2));
                    if (s >= 1) {
                        VPKMUL(px, P01, Rkk[c][0].xy); VPKMUL(py, P01, Rr[pc][0].xy); VPKFMA(px, P23, Rkk[c][0].zw, px); VPKFMA(py, P23, Rr[pc][0].zw, py);
                        VPKFMA(px, P45, Rkk[c][1].xy, px); VPKFMA(py, P45, Rr[pc][1].xy, py); VPKFMA(px, P67, Rkk[c][1].zw, px); VPKFMA(py, P67, Rr[pc][1].zw, py);
                        VADD(x, px.x, px.y); VADD(yp, py.x, py.y);
                    } else {
                        VPKMUL(px, P01, Rkk[c][0].xy); VPKFMA(px, P23, Rkk[c][0].zw, px); VPKFMA(px, P45, Rkk[c][1].xy, px); VPKFMA(px, P67, Rkk[c][1].zw, px);
                        VADD(x, px.x, px.y);
                    }
                    asm volatile("" ::: "memory");
                    if (s + 1 < 32) LOADREC((s + 1) & 1, s + 1);
                    asm volatile("" ::: "memory");
                    VPKMULBL(t01, vv2, Rkm[c][0].xy); VPKMULBL(t23, vv2, Rkm[c][0].zw);
                    VDPP1(x); if (s >= 1) VDPP1(yp);
                    VPKMULBL(t45, vv2, Rkm[c][1].xy); VPKMULBL(t67, vv2, Rkm[c][1].zw);
                    VDPP2(x); if (s >= 1) VDPP2(yp);
                    VPKFMA(P01, P01, Rw[c][0].xy, t01); VPKFMA(P23, P23, Rw[c][0].zw, t23);
                    VDPP3(x); if (s >= 1) VDPP3(yp);
                    VPKFMA(P45, P45, Rw[c][1].xy, t45); VPKFMA(P67, P67, Rw[c][1].zw, t67);
                    if (s >= 1) { if (s - 1 < 8) YSHIFT(yk0); else if (s - 1 < 16) YSHIFT(yk1); else if (s - 1 < 24) YSHIFT(yk2); else YSHIFT(yk3); }
                    x = x * si;
                    f32x2 x2; x2.x = x; asm volatile("" : "+v"(x2));
                    VPKNFMABL(P01, x2, Rka[c][0].xy, P01); VPKNFMABL(P23, x2, Rka[c][0].zw, P23); VPKNFMABL(P45, x2, Rka[c][1].xy, P45); VPKNFMABL(P67, x2, Rka[c][1].zw, P67);
                }
                { f32x2 py; VPKMUL(py, P01, Rr[1][0].xy); VPKFMA(py, P23, Rr[1][0].zw, py); VPKFMA(py, P45, Rr[1][1].xy, py); VPKFMA(py, P67, Rr[1][1].zw, py); VADD(yp, py.x, py.y); }
                yp = dpp_add<0xB1>(yp); yp = dpp_add<0x4E>(yp); yp = dpp_add<0x141>(yp); YSHIFT(yk3);
                yyp[(7 - j) * 32] = yk0; yyp[(15 - j) * 32] = yk1; yyp[(23 - j) * 32] = yk2; yyp[(31 - j) * 32] = yk3;
#undef LOADREC
#undef YSHIFT
            }
            SCAN_BAR;
        }
        if (pass == 0) { *(f32x4*)stp = (f32x4){P01.x, P01.y, P23.x, P23.y}; *(f32x4*)(stp + 4) = (f32x4){P45.x, P45.y, P67.x, P67.y}; }
    } else {
        const int pw = wave - 4, tt = pw >> 1, kh = pw & 1;
        bf16x8 aWc[2][2], aAc[2][2];
#pragma unroll
        for (int kt = 0; kt < 2; ++kt)
#pragma unroll
            for (int ks = 0; ks < 2; ++ks) { const size_t o = (size_t)(colg + 32 * kh + 16 * kt + fr) * 64 + 32 * ks + 8 * fq; aWc[kt][ks] = *(const bf16x8*)((const bf16_t*)(WSP + WS_W2T) + o); aAc[kt][ks] = *(const bf16x8*)((const bf16_t*)(WSP + WS_A2T) + o); }
        bf16x8 lwf[2][2], laf[2][2]; u32x2 r2[2][2], k2[2][2];
#define ISSUE(SET, tbx) do { const size_t tok_ = rowb + (tbx) * 32 + 16 * tt + fr; \
            _Pragma("unroll") for (int ks = 0; ks < 2; ++ks) { lwf[SET][ks] = *(const bf16x8*)(LWb + tok_ * 64 + 32 * ks + 8 * fq); laf[SET][ks] = *(const bf16x8*)(LAb + tok_ * 64 + 32 * ks + 8 * fq); } \
            _Pragma("unroll") for (int kt = 0; kt < 2; ++kt) { r2[SET][kt] = *(const u32x2*)(Rb + tok_ * 2048 + colg + 32 * kh + 16 * kt + 4 * fq); k2[SET][kt] = *(const u32x2*)(Kb + tok_ * 2048 + colg + 32 * kh + 16 * kt + 4 * fq); } } while (0)
        ISSUE(0, 0); ISSUE(1, 1);
        const int t = lane >> 1, hf = lane & 1;
        const size_t vgo = (size_t)colg + 32 * rh + 16 * hf;
        u32x4 v8a = (u32x4){0u, 0u, 0u, 0u}, v8b = v8a, g8a = v8a, g8b = v8a;
        if (pw == 2) { const size_t eo = (rowb + t) * 2048 + vgo; v8a = *(const u32x4*)(Vb + eo); v8b = *(const u32x4*)(Vb + eo + 8); g8a = *(const u32x4*)(Gb + eo); g8b = *(const u32x4*)(Gb + eo + 8); }
        unsigned long long gx[2] = {0ull, 0ull};
#define PROD_ITER(it, PS) do { \
            { const int tb = (it) + 1; \
              if (tb < 64) { \
                LAS float* rec = REC + (tb & 1) * REC_BUF + (16 * tt + fr) * RSTR + 32 * kh + 4 * fq; \
                float ss = 0.f, rkp = 0.f; \
                _Pragma("unroll") for (int kt = 0; kt < 2; ++kt) { \
                    f32x4 accW = (f32x4){0.f, 0.f, 0.f, 0.f}, accA = (f32x4){0.f, 0.f, 0.f, 0.f}; \
                    _Pragma("unroll") for (int ks = 0; ks < 2; ++ks) { accW = MFMA16(aWc[kt][ks], lwf[PS][ks], accW); accA = MFMA16(aAc[kt][ks], laf[PS][ks], accA); } \
                    const int kc = 32 * kh + 16 * kt + 4 * fq; \
                    const f32x4 w0v = *(const LAS f32x4*)(CST + kc), a0v = *(const LAS f32x4*)(CST + 64 + kc), kkc = *(const LAS f32x4*)(CST + 128 + kc), kac = *(const LAS f32x4*)(CST + 192 + kc), rkc = *(const LAS f32x4*)(CST + 256 + kc); \
                    const f32x4 r4 = bf4(r2[PS][kt]), k4 = bf4(k2[PS][kt]); \
                    f32x4 w4, a4; \
                    _Pragma("unroll") for (int e = 0; e < 4; ++e) { w4[e] = __expf(-0.60653066f * sigmf(accW[e] + w0v[e])); a4[e] = sigmf(accA[e] + a0v[e]); } \
                    const f32x4 kkr = k4 * kkc; ss += (kkr.x * kkr.x + kkr.y * kkr.y) + (kkr.z * kkr.z + kkr.w * kkr.w); \
                    const f32x4 km = k4 * (1.0f + (a4 - 1.0f) * kac); const f32x4 rr = r4 * km * rkc; rkp += (rr.x + rr.y) + (rr.z + rr.w); \
                    *(LAS f32x4*)(rec + 16 * kt) = kkr; *(LAS f32x4*)(rec + REC_ARR + 16 * kt) = w4; *(LAS f32x4*)(rec + 2 * REC_ARR + 16 * kt) = kkr * a4; *(LAS f32x4*)(rec + 3 * REC_ARR + 16 * kt) = km; *(LAS f32x4*)(rec + 4 * REC_ARR + 16 * kt) = r4; \
                } \
                if (tb + 2 < 64) ISSUE(PS, tb + 2); \
                ss += __shfl_xor(ss, 16); ss += __shfl_xor(ss, 32); rkp += __shfl_xor(rkp, 16); rkp += __shfl_xor(rkp, 32); \
                if (fq == 0) { SSP[(tb & 1) * 64 + 2 * (16 * tt + fr) + kh] = ss; RKP[(tb & 3) * 64 + 2 * (16 * tt + fr) + kh] = rkp; } \
              } \
              if (pw == 2 && tb < 64) { \
                LAS float* vp = VV + (tb & 3) * 1024 + t * 32 + 16 * hf; LAS float* gp = GG + (tb & 3) * 1024 + t * 32 + 16 * hf; \
                *(LAS f32x4*)(vp) = bf4((u32x2){v8a.x, v8a.y}); *(LAS f32x4*)(vp + 4) = bf4((u32x2){v8a.z, v8a.w}); *(LAS f32x4*)(vp + 8) = bf4((u32x2){v8b.x, v8b.y}); *(LAS f32x4*)(vp + 12) = bf4((u32x2){v8b.z, v8b.w}); \
                *(LAS f32x4*)(gp) = bf4((u32x2){g8a.x, g8a.y}); *(LAS f32x4*)(gp + 4) = bf4((u32x2){g8a.z, g8a.w}); *(LAS f32x4*)(gp + 8) = bf4((u32x2){g8b.x, g8b.y}); *(LAS f32x4*)(gp + 12) = bf4((u32x2){g8b.z, g8b.w}); \
                if (tb + 1 < 64) { const size_t eo = (rowb + (tb + 1) * 32 + t) * 2048 + vgo; v8a = *(const u32x4*)(Vb + eo); v8b = *(const u32x4*)(Vb + eo + 8); g8a = *(const u32x4*)(Gb + eo); g8b = *(const u32x4*)(Gb + eo + 8); } \
              } \
            } \
            if (pw == 3) { \
              if ((it) >= 2 && (it) <= 65) { const int tb = (it) - 2; const unsigned long long* g = GR + ((size_t)(pi * 8 + (tb & 7)) * 2) * 64 + lane; \
                gx[0] = __hip_atomic_load(g, __ATOMIC_RELAXED, __HIP_MEMORY_SCOPE_AGENT); gx[1] = __hip_atomic_load(g + 64, __ATOMIC_RELAXED, __HIP_MEMORY_SCOPE_AGENT); } \
              if ((it) >= 1 && (it) <= 64) { const int tb = (it) - 1; const LAS float* yp_ = YY + (tb & 3) * 1024 + t * 32 + 16 * hf; float s1 = 0.f, s2 = 0.f; \
                _Pragma("unroll") for (int qd = 0; qd < 4; ++qd) { const f32x4 a = *(const LAS f32x4*)(yp_ + 4 * qd); s1 += (a.x + a.y) + (a.z + a.w); s2 += (a.x * a.x + a.y * a.y) + (a.z * a.z + a.w * a.w); } \
                s1 = dpp_add<0xB1>(s1); s2 = dpp_add<0xB1>(s2); \
                const unsigned epoch = (unsigned)(pass * 64 + tb + 1); \
                __hip_atomic_store(GR + ((size_t)((pi * 8 + (tb & 7)) * 2 + rh) * 64 + hf * 32 + t), ((unsigned long long)epoch << 32) | (unsigned long long)__float_as_uint(hf ? s2 : s1), __ATOMIC_RELAXED, __HIP_MEMORY_SCOPE_AGENT); } \
              if ((it) >= 2 && (it) <= 65) { const int tb = (it) - 2; const unsigned epoch = (unsigned)(pass * 64 + tb + 1); \
                const unsigned long long* g = GR + ((size_t)(pi * 8 + (tb & 7)) * 2) * 64 + lane; float tot; \
                for (unsigned spins = 0;; ++spins) { const bool ok = ((unsigned)(gx[0] >> 32) == epoch) && ((unsigned)(gx[1] >> 32) == epoch); tot = __uint_as_float((unsigned)gx[0]) + __uint_as_float((unsigned)gx[1]); \
                    if (__all(ok) || spins > (1u << 22)) break; \
                    __builtin_amdgcn_s_sleep(1); \
                    gx[0] = __hip_atomic_load(g, __ATOMIC_RELAXED, __HIP_MEMORY_SCOPE_AGENT); gx[1] = __hip_atomic_load(g + 64, __ATOMIC_RELAXED, __HIP_MEMORY_SCOPE_AGENT); } \
                const float oth = __shfl_xor(tot, 32); \
                const float mean = (lane < 32 ? tot : oth) * (1.0f / 64.0f), ex2 = (lane < 32 ? oth : tot) * (1.0f / 64.0f); \
                const float rstd = rsqrtf(fmaxf(ex2 - mean * mean, 0.f) + 64e-5f); \
                if (lane < 32) { STT[2 * lane] = mean; STT[2 * lane + 1] = rstd; } \
                const float mu = STT[2 * t], rsd = STT[2 * t + 1]; \
                const int ro = (tb & 3) * 1024 + t * 32 + 16 * hf; const float rk = RKP[(tb & 3) * 64 + 2 * t] + RKP[(tb & 3) * 64 + 2 * t + 1]; \
                unsigned ow[8]; \
                _Pragma("unroll") for (int qd = 0; qd < 4; ++qd) { const f32x4 lg = *(const LAS f32x4*)(CST + 320 + 32 * rh + 16 * hf + 4 * qd), lb = *(const LAS f32x4*)(CST + 384 + 32 * rh + 16 * hf + 4 * qd); \
                    const f32x4 o = ((*(const LAS f32x4*)(YY + ro + 4 * qd) - mu) * rsd * lg + lb + rk * *(const LAS f32x4*)(VV + ro + 4 * qd)) * *(const LAS f32x4*)(GG + ro + 4 * qd); \
                    ow[2 * qd] = pk2(o.x, o.y); ow[2 * qd + 1] = pk2(o.z, o.w); } \
                bf16_t* dst = (bf16_t*)(WSP + WS_A2) + ((size_t)pass * PROWS + rowb + tb * 32 + t) * 2048 + vgo; \
                *(u32x4*)(dst) = (u32x4){ow[0], ow[1], ow[2], ow[3]}; *(u32x4*)(dst + 8) = (u32x4){ow[4], ow[5], ow[6], ow[7]}; } \
            } \
            SCAN_BAR; } while (0)
        for (int it2 = -1; it2 < 65; it2 += 2) { PROD_ITER(it2, 0); PROD_ITER(it2 + 1, 1); }
        PROD_ITER(65, 0);
#undef PROD_ITER
#undef ISSUE
    }
}
__device__ __forceinline__ void p10_final(const Params& p, int G, int bid) {
    OPQ_TID; const int gw = bid * 8 + wave, ngw = G * 8;
    for (int m = gw; m < T; m += ngw) { float* xr = ((float*)p.out) + (size_t)m * D; f32x4 v[4]; float s = 0.f;
#pragma unroll
        for (int j = 0; j < 4; ++j) { v[j] = *((const f32x4*)xr + lane + 64 * j); s += (v[j].x * v[j].x + v[j].y * v[j].y) + (v[j].z * v[j].z + v[j].w * v[j].w); }
        const float rs = rsqrtf(wave_sum(s) * (1.0f / 1024.0f) + 1e-6f);
#pragma unroll
        for (int j = 0; j < 4; ++j) { const f32x4 gg = *((const f32x4*)((const float*)p.in[I_FG]) + lane + 64 * j); *((f32x4*)xr + lane + 64 * j) = v[j] * rs * gg; } }
}

#define XB_TMO      128
#define XB_XCNT(j)  (256  + 64 * (j))
#define XB_XSUB(j)  (1280 + 64 * (j))
#define XB_XGEN(j)  (2304 + 64 * (j))
#define XB_TOP      3328
#define XB_TOPGEN   3392
#define XCD_BAR_WORDS 3456
#define XB_SPIN_CAP (1u << 18)

__device__ __forceinline__ unsigned xb_ld(unsigned* p)              { return __hip_atomic_load(p, __ATOMIC_RELAXED, __HIP_MEMORY_SCOPE_AGENT); }
__device__ __forceinline__ unsigned xb_add(unsigned* p, unsigned v) { return __hip_atomic_fetch_add(p, v, __ATOMIC_RELAXED, __HIP_MEMORY_SCOPE_AGENT); }
__device__ __forceinline__ unsigned xb_xcc_id() { return (unsigned)__builtin_amdgcn_s_getreg((3 << 11) | 20) & 0xFu; }
#define XB_SPIN(cond, bar) do { unsigned _sp = 0; while (cond) { __builtin_amdgcn_s_sleep(1); \
    if ((++_sp & 255u) == 0u) { if (xb_ld(&(bar)[XB_TMO])) break; if (_sp > XB_SPIN_CAP) { atomicAdd(&(bar)[XB_TMO], 1u); break; } } } } while (0)

struct XcdBarrier {
    unsigned* bar; unsigned x;
    volatile LAS unsigned* st;
};

__device__ __forceinline__ XcdBarrier xcd_barrier_post(unsigned* bar, volatile LAS unsigned* st) {
    XcdBarrier b; b.bar = bar; b.x = xb_xcc_id(); b.st = st;
    if (threadIdx.x == 0) (void)xb_add(&bar[XB_XCNT(b.x)], 1u);
    return b;
}
__device__ __forceinline__ void xcd_barrier_complete(unsigned* bar, unsigned x, unsigned& nloc, unsigned& nx) {
    const unsigned G = gridDim.x * gridDim.y * gridDim.z;
    unsigned sum, cnt, mine, sp = 0u;
    for (;;) {
        sum = 0u; cnt = 0u; mine = 0u;
#pragma unroll
        for (unsigned j = 0; j < 16; ++j) { const unsigned c = xb_ld(&bar[XB_XCNT(j)]); sum += c; cnt += (c > 0u) ? 1u : 0u; mine = (j == x) ? c : mine; }
        if (sum == G) break;
        __builtin_amdgcn_s_sleep(1);
        if ((++sp & 255u) == 0u) { if (xb_ld(&bar[XB_TMO])) break; if (sp > XB_SPIN_CAP) { atomicAdd(&bar[XB_TMO], 1u); break; } }
    }
    nloc = mine > 0u ? mine : 1u; nx = cnt > 0u ? cnt : 1u;
}

__device__ __forceinline__ void xcd_barrier(const XcdBarrier& b) {
    asm volatile("s_waitcnt vmcnt(0)" ::: "memory");
    __syncthreads();
    if (threadIdx.x == 0) {
        unsigned* bar = (unsigned*)(*(volatile LAS unsigned long long*)(b.st + 4)); const unsigned bx_ = xb_xcc_id();
        __builtin_amdgcn_s_waitcnt(0);
        unsigned nloc = b.st[0], nx = b.st[1];
        if (nloc == 0u) { xcd_barrier_complete(bar, bx_, nloc, nx); b.st[0] = nloc; b.st[1] = nx; }
        const unsigned old = xb_add(&bar[XB_XSUB(bx_)], 1u);
        const unsigned gen = old / nloc;
        if (old + 1u == (gen + 1u) * nloc) {
            __builtin_amdgcn_fence(__ATOMIC_RELEASE, "agent");
            asm volatile("s_waitcnt vmcnt(0)" ::: "memory");
            const unsigned og = xb_add(&bar[XB_TOP], 1u);
            const unsigned tg = og / nx;
            if (og + 1u == (tg + 1u) * nx) xb_add(&bar[XB_TOPGEN], 1u);
            else XB_SPIN(xb_ld(&bar[XB_TOPGEN]) == tg, bar);
            __builtin_amdgcn_fence(__ATOMIC_ACQUIRE, "agent");
            xb_add(&bar[XB_XGEN(bx_)], 1u);
            asm volatile("s_waitcnt vmcnt(0)" ::: "memory");
        } else {
            XB_SPIN(xb_ld(&bar[XB_XGEN(bx_)]) == gen, bar);
            __builtin_amdgcn_fence(__ATOMIC_ACQUIRE, "agent");
            asm volatile("s_waitcnt vmcnt(0)" ::: "memory");
        }
    }
    __syncthreads();
}

__global__ void __launch_bounds__(NT, 2) mk_fwd(Params p) {
    auto wsl = [&]() { return launder_ws(((unsigned char*)p.ws)); };
    extern __shared__ __attribute__((aligned(16))) unsigned char lds_raw[];
    LAS unsigned char* lds = (LAS unsigned char*)lds_raw;
    cg::grid_group grid = cg::this_grid();
    const int G = gridDim.x, bid = blockIdx.x;
    if (threadIdx.x < 16) ((LAS unsigned*)(lds + LDS_MISC))[threadIdx.x] = 0u;
    __syncthreads();
    if (threadIdx.x == 0) *(LAS unsigned long long*)(lds + LDS_MISC + 16) = (unsigned long long)(((unsigned char*)p.ws) + WS_BAR);
    __syncthreads();
    if (bid == 0) for (int i = threadIdx.x; i < 4096; i += NT) ((unsigned*)(((unsigned char*)p.ws) + WS_BAR))[i] = 0u;
#define XBAR() do { XcdBarrier xb_; xb_.bar = nullptr; xb_.x = 0u; xb_.st = (volatile LAS unsigned*)(lds + LDS_MISC); xcd_barrier(xb_); } while (0)
#if PROBE == 7
    p0_prologue(p, lds, G, bid);
#endif
    p0_prologue(p, lds, G, bid);
    grid.sync();
    (void)xcd_barrier_post((unsigned*)(((unsigned char*)p.ws) + WS_BAR), (volatile LAS unsigned*)(lds + LDS_MISC));
    { pg8::Gemm g{(const bf16_t*)((float*)p.out), (const bf16_t*)(wsl() + WS_WIN), T, ZW, D, D}; pg8::StaticOrder S; S.init(T, ZW, G, bid); pg8::EpiBf16 E{(bf16_t*)(wsl() + WS_Z), ZW};
      pg8::gemm_phase<pg8::EpiBf16, pg8::StaticOrder, true, true>(lds, g, S, E); }
    XBAR();
#if PROBE == 3
    { u32x4 pre[3]; if (bid < 2048) rg_a_prefetch((const bf16_t*)(wsl() + WS_Z), bid, threadIdx.x, pre); for (int u = bid; u < 2048; u += G) rg_a_unit(p, lds, u, u + G, pre); }
    { u32x4 pre[6]; if (bid < 2048) hg_a_prefetch((const bf16_t*)(wsl() + WS_Z), bid, threadIdx.x, pre); for (int u = bid; u < 2048; u += G) hg_a_unit(p, lds, u, u + G, pre); }
    XBAR();
#endif
    { u32x4 pre[3]; if (bid < 2048) rg_a_prefetch((const bf16_t*)(wsl() + WS_Z), bid, threadIdx.x, pre); for (int u = bid; u < 2048; u += G) rg_a_unit(p, lds, u, u + G, pre); }
    { u32x4 pre[6]; if (bid < 2048) hg_a_prefetch((const bf16_t*)(wsl() + WS_Z), bid, threadIdx.x, pre); for (int u = bid; u < 2048; u += G) hg_a_unit(p, lds, u, u + G, pre); }
    XBAR();
#if PROBE == 2
    for (int u = bid; u < 256; u += G) hg_b_item(p, lds, u, p.dry != 0);
    XBAR();
#endif
#if PROBE == 6
    for (int u = bid; u < 512; u += G) rg_b_unit(p, u);
    XBAR();
#endif
#if PROBE == 4
    for (int q = 0; q < 16; ++q) XBAR();
#endif
    for (int u = bid; u < 256; u += G) { const int it_ = (G == 256) ? ((((u & 7) + 8 * (u >> 6)) << 3) | ((u >> 3) & 7)) : u; hg_b_item(p, lds, it_); }
    for (int u = bid; u < 512; u += G) rg_b_unit(p, u);
    XBAR();
#if PROBE == 8
    p4_finalize(p, G, bid);
#endif
    p4_finalize(p, G, bid);
    XBAR();
    { pg8::Gemm g{(const bf16_t*)(wsl() + WS_Z), (const bf16_t*)(wsl() + WS_WOUT), T, D, 2048, ZW}; pg8::StaticOrder S; S.init(T, D, G, bid); pg8::EpiResF32 E{((const float*)p.in[I_X]), ((float*)p.out), D, 0, 0};
      pg8::gemm_phase<pg8::EpiResF32, pg8::StaticOrder, true, true>(lds, g, S, E); }
    XBAR();
#if PROBE == 9
    p6_prologue(p, lds, G, bid);
#endif
    p6_prologue(p, lds, G, bid);
    XBAR();
#pragma unroll 1
    for (int pass = 0; pass < 2; ++pass) {
        { pg8::Gemm g{(const bf16_t*)(wsl() + WS_A2) + (size_t)pass * 8192 * 2048, (const bf16_t*)(wsl() + WS_WC), 8192, 8192, 2048, 2048}; pg8::StaticOrder S; S.init(8192, 8192, G, bid);
          pg8::EpiL1 E{(bf16_t*)(wsl() + WS_R), (bf16_t*)(wsl() + WS_LW), (bf16_t*)(wsl() + WS_LA)};
          pg8::gemm_phase<pg8::EpiL1, pg8::StaticOrder, true, true>(lds, g, S, E); }
        XBAR();
        for (int u0 = 0; u0 < 256; u0 += G) { const int u = u0 + bid; if (u < 256) { int pi, rh; if (G == 256) { pi = (u & 7) + 8 * (u >> 4); rh = (u >> 3) & 1; } else { pi = u >> 1; rh = u & 1; } scan_half(p, lds, pi, rh, pass); } }
        XBAR();
    }
    if (G == 256) {
        pg8::Gemm g{(const bf16_t*)(wsl() + WS_A2), (const bf16_t*)(wsl() + WS_WO), T, D, 2048, 2048}; pg8::StaticOrder S; S.init(T, D, G, bid); pg8::EpiFinalNorm E{((float*)p.out), ((const float*)p.in[I_FG]), (unsigned long long*)(wsl() + WS_XG), D};
        pg8::gemm_phase<pg8::EpiFinalNorm, pg8::StaticOrder, false, true>(lds, g, S, E);
    } else {
        { pg8::Gemm g{(const bf16_t*)(wsl() + WS_A2), (const bf16_t*)(wsl() + WS_WO), T, D, 2048, 2048}; pg8::StaticOrder S; S.init(T, D, G, bid); pg8::EpiResF32 E{((float*)p.out), ((float*)p.out), D, 1, 0};
          pg8::gemm_phase<pg8::EpiResF32, pg8::StaticOrder, true, true>(lds, g, S, E); }
        XBAR();
        p10_final(p, G, bid);
    }
}

extern "C" void kernel_launch(void* const* d_in, const int* in_sizes, int n_in, void* d_out, int out_size, void* d_ws, size_t ws_size, hipStream_t stream) {
    static int grid = 0;
    if (grid == 0) {
        int dev = 0, cus = 0, per_cu = 0;
        if (n_in != 32 || out_size != T * D || ws_size < 256 * MiB) { fprintf(stderr, "kernel_launch: unexpected shapes (n_in %d out %d ws %zu)\n", n_in, out_size, ws_size); grid = -1; return; }
        if (hipGetDevice(&dev) != hipSuccess || hipDeviceGetAttribute(&cus, hipDeviceAttributeMultiprocessorCount, dev) != hipSuccess) { grid = -1; return; }
        if (hipFuncSetAttribute((const void*)mk_fwd, hipFuncAttributeMaxDynamicSharedMemorySize, LDS_BYTES) != hipSuccess) { fprintf(stderr, "hipFuncSetAttribute failed\n"); grid = -1; return; }
        if (hipOccupancyMaxActiveBlocksPerMultiprocessor(&per_cu, (const void*)mk_fwd, NT, LDS_BYTES) != hipSuccess || per_cu < 1) fprintf(stderr, "occupancy query: %d\n", per_cu);
        (void)hipGetLastError();
        grid = cus;
    }
    if (grid < 0) return;
    Params p{};
    p.dry = 1;
    for (int i = 0; i < 32; ++i) memcpy(&p.in[i], &d_in[i], sizeof(void*));
    memcpy(&p.out, &d_out, sizeof(void*)); memcpy(&p.ws, &d_ws, sizeof(void*));
    void* args[] = {&p};
    hipError_t e = hipLaunchCooperativeKernel((const void*)mk_fwd, dim3(grid), dim3(NT), args, LDS_BYTES, stream);
    if (e != hipSuccess) fprintf(stderr, "cooperative launch failed: %s (grid %d)\n", hipGetErrorString(e), grid);
}
```

```cpp
#define PROBE 0
#include <hip/hip_runtime.h>
#include <hip/hip_cooperative_groups.h>
#include <cstdio>
#include <cstring>
#include <cstdint>
namespace cg = cooperative_groups;
namespace pg8 {
#define PG8_LAS __attribute__((address_space(3)))
typedef unsigned short bf16_t;
typedef short bf16x8 __attribute__((ext_vector_type(8)));
typedef float f32x4 __attribute__((ext_vector_type(4)));
typedef unsigned u32x4 __attribute__((ext_vector_type(4)));
constexpr int BM = 256, BK = 64, HALF = 128, HTB = HALF * BK * 2  , STAGE_BYTES = 8 * HTB, NXCD = 8, WGM = 8;

__host__ __device__ __forceinline__ int lds_byte(int r, int c) { const int st = (r >> 4) * 2 + (c >> 5), rr = r & 15, cc = c & 31, ob = rr * 64 + cc * 2; return st * 1024 + (ob ^ (((ob >> 9) & 1) << 5)); }
__host__ __device__ __forceinline__ void stage_rc(int b, int& R, int& C) { const int st = b / 1024, sb = b % 1024, swz = sb ^ (((sb >> 9) & 1) << 5); R = (st >> 1) * 16 + swz / 64; C = (st & 1) * 32 + (swz % 64) / 2; }
__host__ __device__ __forceinline__ int perm32(int rho) { const int n = rho >> 4, i = rho & 15; return 8 * (i >> 2) + 4 * n + (i & 3); }

struct Unit { int pm, pn; };
struct Gemm { const bf16_t* A; const bf16_t* Bt; int M, N, K, lda; };

struct StaticOrder {
    int nM, nN, nwg, G, c;
    __host__ __device__ void init(int M, int N, int G_, int c_) { nM = M / BM; nN = N / BM; nwg = nM * nN; G = G_; c = c_; }
    __host__ __device__ bool next(int i, Unit& u) const {
        const long L = (long)i * G + c; if (L >= nwg) return false;
        int wgid = (int)L; { const int q = nwg / NXCD, r = nwg % NXCD, xcd = wgid % NXCD, off = wgid / NXCD; wgid = (xcd < r ? xcd * (q + 1) : r * (q + 1) + (xcd - r) * q) + off; }
        const int nig = WGM * nN, gid = wgid / nig, fm = gid * WGM, gsz = (nM - fm) < WGM ? (nM - fm) : WGM;
        u.pm = fm + ((wgid % nig) % gsz); u.pn = (wgid % nig) / gsz; return true;
    }
    __device__ __forceinline__ void a_ready(const Unit&) const {}
    __device__ __forceinline__ void done(const Unit&) const {}
};


struct LoraOrder {
    StaticOrder so; int extra;
    __host__ __device__ void init(int M, int N, int G_, int c_, int extra_) { so.init(M, N, G_, c_); extra = extra_; }
    __host__ __device__ bool next(int i, Unit& u) const { const long L = (long)i * so.G + so.c; if (L < so.nwg) return so.next(i, u); if (L >= so.nwg + extra) return false; u.pm = so.nM + (int)(L - so.nwg); u.pn = so.nN - 1; return true; }
    __device__ __forceinline__ void a_ready(const Unit&) const {}
    __device__ __forceinline__ void done(const Unit&) const {}
};
__device__ __forceinline__ unsigned cvt_pk_bf16(float lo, float hi) { unsigned r; asm volatile("v_cvt_pk_bf16_f32 %0, %1, %2" : "=v"(r) : "v"(lo), "v"(hi)); return r; }
__device__ __forceinline__ float sigm(float x) { return __builtin_amdgcn_rcpf(1.0f + __expf(-x)); }
struct EpiBf16 {
    static constexpr bool PERM = true, AFTER_DRAIN = false;
    bf16_t* O; int ldc;
    __device__ __forceinline__ void operator()(const f32x4 (&acc)[2][2][4][2], const Unit& u, int wr, int wc, int fr, int fq) const {
        const int row0 = u.pm * BM + wr * 64 + fr; const int col0 = u.pn * BM + wc * 32 + 8 * fq;
#pragma unroll
        for (int ai = 0; ai < 2; ++ai)
#pragma unroll
            for (int m = 0; m < 4; ++m) { bf16_t* rowp = O + (size_t)(row0 + ai * HALF + m * 16) * ldc + col0;
#pragma unroll
                for (int bj = 0; bj < 2; ++bj) { const f32x4 v0 = acc[ai][bj][m][0], v1 = acc[ai][bj][m][1];
                    u32x4 w; w.x = cvt_pk_bf16(v0[0], v0[1]); w.y = cvt_pk_bf16(v0[2], v0[3]); w.z = cvt_pk_bf16(v1[0], v1[1]); w.w = cvt_pk_bf16(v1[2], v1[3]);
                    *(u32x4*)(rowp + bj * HALF) = w; } }
    }
};
struct EpiResF32 {
    static constexpr bool PERM = false, AFTER_DRAIN = false;
    const float* base; float* out; int ldc; int remap; int pass;
    __device__ __forceinline__ void operator()(const f32x4 (&acc)[2][2][4][2], const Unit& u, int wr, int wc, int fr, int fq) const {
        const int col0 = u.pn * BM + wc * 32 + 4 * fq; const int rbase = remap ? ((((u.pm >> 3) & 3) << 12) + (u.pm >> 5) * 2048 + (u.pm & 7) * BM) : u.pm * BM;
#pragma unroll
        for (int ai = 0; ai < 2; ++ai)
#pragma unroll
            for (int m = 0; m < 4; ++m) { const size_t off = (size_t)(rbase + ai * HALF + wr * 64 + m * 16 + fr) * ldc + col0;
#pragma unroll
                for (int bj = 0; bj < 2; ++bj)
#pragma unroll
                    for (int n = 0; n < 2; ++n) { const f32x4 bs = *(const f32x4*)(base + off + bj * HALF + n * 16); *(f32x4*)(out + off + bj * HALF + n * 16) = bs + acc[ai][bj][m][n]; } }
    }
};
struct EpiL1 {
    static constexpr bool PERM = true, AFTER_DRAIN = false;
    bf16_t* R; bf16_t* LW; bf16_t* LA;
    __device__ __forceinline__ void operator()(const f32x4 (&acc)[2][2][4][2], const Unit& u, int wr, int wc, int fr, int fq) const {
        const int row0 = u.pm * BM + wr * 64 + fr;
        if (u.pn < 32) {
            const int buf = u.pn >> 3; bf16_t* base = R + (size_t)buf * (8192u * 2048u); const int col0 = (u.pn & 7) * BM + wc * 32 + 8 * fq;
#pragma unroll
            for (int ai = 0; ai < 2; ++ai)
#pragma unroll
                for (int m = 0; m < 4; ++m) { bf16_t* rowp = base + (size_t)(row0 + ai * HALF + m * 16) * 2048 + col0;
#pragma unroll
                    for (int bj = 0; bj < 2; ++bj) { f32x4 v0 = acc[ai][bj][m][0], v1 = acc[ai][bj][m][1];
                        if (buf == 3) {
#pragma unroll
                            for (int q = 0; q < 4; ++q) { v0[q] = v0[q] * sigm(v0[q]); v1[q] = v1[q] * sigm(v1[q]); } }
                        u32x4 w; w.x = cvt_pk_bf16(v0[0], v0[1]); w.y = cvt_pk_bf16(v0[2], v0[3]); w.z = cvt_pk_bf16(v1[0], v1[1]); w.w = cvt_pk_bf16(v1[2], v1[3]);
                        *(u32x4*)(rowp + bj * HALF) = w; } }
        } else {
            const int c0 = wc * 32 + 8 * fq;
#pragma unroll
            for (int ai = 0; ai < 2; ++ai)
#pragma unroll
                for (int m = 0; m < 4; ++m) { const size_t row = (size_t)(row0 + ai * HALF + m * 16); f32x4 v0 = acc[ai][0][m][0], v1 = acc[ai][0][m][1];
                    if (c0 < 64) {
#pragma unroll
                        for (int q = 0; q < 4; ++q) { v0[q] = tanhf(v0[q]); v1[q] = tanhf(v1[q]); } }
                    u32x4 w; w.x = cvt_pk_bf16(v0[0], v0[1]); w.y = cvt_pk_bf16(v0[2], v0[3]); w.z = cvt_pk_bf16(v1[0], v1[1]); w.w = cvt_pk_bf16(v1[2], v1[3]);
                    if (c0 < 64) *(u32x4*)(LW + row * 64 + c0) = w; else *(u32x4*)(LA + row * 64 + c0 - 64) = w; }
        }
    }
};

struct EpiFinalNorm {
    static constexpr bool PERM = false, AFTER_DRAIN = true;
    float* out; const float* g; unsigned long long* xg; int ldc;
    __device__ __forceinline__ void fused(f32x4 (&acc)[2][2][4][2], const Unit& u, int wr, int wc, int fr, int fq, PG8_LAS unsigned char* lds, int wid, int lane) const {
        PG8_LAS float* P = (PG8_LAS float*)lds; PG8_LAS float* S = (PG8_LAS float*)(lds + 4096);
        const int col0 = u.pn * BM + wc * 32 + 4 * fq; const int rbase = (((u.pm >> 3) & 3) << 12) + (u.pm >> 5) * 2048 + (u.pm & 7) * BM;
#pragma unroll
        for (int ai = 0; ai < 2; ++ai)
#pragma unroll
            for (int m = 0; m < 4; ++m) { const size_t off = (size_t)(rbase + ai * HALF + wr * 64 + m * 16 + fr) * ldc + col0; float s = 0.f;
#pragma unroll
                for (int bj = 0; bj < 2; ++bj)
#pragma unroll
                    for (int n = 0; n < 2; ++n) { const f32x4 v = acc[ai][bj][m][n] + *(const f32x4*)(out + off + bj * HALF + n * 16); acc[ai][bj][m][n] = v; s += (v[0] * v[0] + v[1] * v[1]) + (v[2] * v[2] + v[3] * v[3]); }
                s += __shfl_xor(s, 16); s += __shfl_xor(s, 32);
                if (fq == 0) P[(ai * HALF + wr * 64 + m * 16 + fr) * 4 + wc] = s; }
        asm volatile("s_waitcnt lgkmcnt(0)" ::: "memory"); __builtin_amdgcn_s_barrier(); asm volatile("" ::: "memory");
        const int row = wid * 32 + (lane & 31);
        if (lane < 32) { const float tot = (P[row * 4] + P[row * 4 + 1]) + (P[row * 4 + 2] + P[row * 4 + 3]);
            __hip_atomic_store(xg + ((size_t)(u.pm * 4 + u.pn) * 256 + row), (1ull << 32) | (unsigned long long)__float_as_uint(tot), __ATOMIC_RELAXED, __HIP_MEMORY_SCOPE_AGENT); }
        {
            float tot = 0.f;
            for (unsigned spins = 0;; ++spins) { bool ok = true; tot = 0.f;
                if (lane < 32) {
#pragma unroll
                    for (int q = 0; q < 4; ++q) { const unsigned long long x = __hip_atomic_load(xg + ((size_t)(u.pm * 4 + q) * 256 + row), __ATOMIC_RELAXED, __HIP_MEMORY_SCOPE_AGENT); ok &= (unsigned)(x >> 32) == 1u; tot += __uint_as_float((unsigned)x); } }
                if (__all(ok) || spins > (1u << 22)) break;
                __builtin_amdgcn_s_sleep(1); }
            if (lane < 32) S[row] = rsqrtf(tot * (1.0f / 1024.0f) + 1e-6f);
        }
        asm volatile("s_waitcnt lgkmcnt(0)" ::: "memory"); __builtin_amdgcn_s_barrier(); asm volatile("" ::: "memory");
#pragma unroll
        for (int ai = 0; ai < 2; ++ai)
#pragma unroll
            for (int m = 0; m < 4; ++m) { const int r = ai * HALF + wr * 64 + m * 16 + fr; const float rs = S[r]; const size_t off = (size_t)(rbase + r) * ldc + col0;
#pragma unroll
                for (int bj = 0; bj < 2; ++bj)
#pragma unroll
                    for (int n = 0; n < 2; ++n) { const f32x4 gg = *(const f32x4*)(g + col0 + bj * HALF + n * 16); *(f32x4*)(out + off + bj * HALF + n * 16) = acc[ai][bj][m][n] * rs * gg; } }
    }
};
template <class Epi, class Sched, bool ALIGN_EPI = false, bool SP2 = false>
__device__ __forceinline__ void gemm_phase(PG8_LAS unsigned char* lds, const Gemm g, const Sched& S, const Epi& E) {
    int tid_o = threadIdx.x; asm volatile("" : "+v"(tid_o)); const int tid = tid_o, wid = __builtin_amdgcn_readfirstlane(tid >> 6), lane = tid & 63, wr = wid >> 2, wc = wid & 3, fr = lane & 15, fq = lane >> 4;
    const int K = g.K, nt = K / BK;
    unsigned voffA[2], voffB[2];
#pragma unroll
    for (int i = 0; i < 2; ++i) { int R, C; stage_rc(tid * 16 + i * 8192, R, C); const int Rb = Epi::PERM ? ((R & ~31) + perm32(R & 31)) : R;
        voffA[i] = (unsigned)(R * g.lda + C) * 2u; voffB[i] = (unsigned)(Rb * K + C) * 2u; }
    const size_t kstep = (size_t)(BK * 2);
    const size_t hstep = (size_t)HALF * K * 2;
    const size_t tstep = 2 * hstep; const size_t hstepA = (size_t)HALF * g.lda * 2, tstepA = 2 * hstepA;
    const unsigned ldsw = (unsigned)wid * 1024u;
    const int aoff = lds_byte(wr * 64 + fr, fq * 8), boff = lds_byte(wc * 32 + fr, fq * 8);
#define PG8_SA(b, h) (((b) * 2 + (h)) * HTB)
#define PG8_SB(b, h) ((4 + (b) * 2 + (h)) * HTB)
#define PG8_STAGE(bufoff, gbase, voff) do { _Pragma("unroll") for (int _i = 0; _i < 2; ++_i) \
        __builtin_amdgcn_global_load_lds((const unsigned*)((const char*)(gbase) + (voff)[_i]), (PG8_LAS unsigned*)(lds + (bufoff) + ldsw + _i * 8192), 16, 0, 0); } while (0)
#define PG8_LDA(dst, b, h) do { _Pragma("unroll") for (int m = 0; m < 4; ++m) _Pragma("unroll") for (int k = 0; k < 2; ++k) dst[m][k] = *(const PG8_LAS bf16x8*)(lds + PG8_SA(b, h) + aoff + m * 2048 + k * 1024); } while (0)
#define PG8_LDB(dst, b, h) do { _Pragma("unroll") for (int n = 0; n < 2; ++n) _Pragma("unroll") for (int k = 0; k < 2; ++k) dst[n][k] = *(const PG8_LAS bf16x8*)(lds + PG8_SB(b, h) + boff + n * 2048 + k * 1024); } while (0)
#define PG8_MMA(ai, bj, At, Bt) do { __builtin_amdgcn_s_setprio(1); _Pragma("unroll") for (int m = 0; m < 4; ++m) _Pragma("unroll") for (int n = 0; n < 2; ++n) _Pragma("unroll") for (int k = 0; k < 2; ++k) \
        acc[ai][bj][m][n] = __builtin_amdgcn_mfma_f32_16x16x32_bf16(Bt[n][k], At[m][k], acc[ai][bj][m][n], 0, 0, 0); __builtin_amdgcn_s_setprio(0); } while (0)
#define PG8_WAIT_V(n) asm volatile("s_waitcnt vmcnt(" #n ")" ::: "memory")
#define PG8_WAIT_L(n) asm volatile("s_waitcnt lgkmcnt(" #n ")" ::: "memory")
#define PG8_BAR __builtin_amdgcn_s_barrier()
#define PG8_SCHED __builtin_amdgcn_sched_barrier(0)
    Unit cur, nxt; int ui = 0;
    if (!S.next(0, cur)) return;
    f32x4 acc[2][2][4][2];
#pragma unroll
    for (int a = 0; a < 2; ++a)
#pragma unroll
        for (int b = 0; b < 2; ++b)
#pragma unroll
            for (int m = 0; m < 4; ++m)
#pragma unroll
                for (int n = 0; n < 2; ++n) acc[a][b][m][n] = (f32x4){0.f, 0.f, 0.f, 0.f};
    bf16x8 At[4][2], B0[2][2], B1[2][2];
    const char* cA = (const char*)g.A + (size_t)cur.pm * tstepA; const char* cB = (const char*)g.Bt + (size_t)cur.pn * tstep;
    S.a_ready(cur);
    if constexpr (SP2) {
        PG8_STAGE(PG8_SB(0, 0), cB, voffB); PG8_STAGE(PG8_SB(0, 1), cB + hstep, voffB); PG8_STAGE(PG8_SA(0, 0), cA, voffA); PG8_STAGE(PG8_SA(0, 1), cA + hstepA, voffA);
        if (wr == 1) PG8_BAR;
        PG8_WAIT_V(2); PG8_BAR;
        PG8_STAGE(PG8_SB(1, 0), cB + kstep, voffB); PG8_STAGE(PG8_SA(1, 0), cA + kstep, voffA); PG8_STAGE(PG8_SB(1, 1), cB + hstep + kstep, voffB);
        PG8_WAIT_V(6); PG8_BAR;
    } else {
        PG8_STAGE(PG8_SB(0, 0), cB, voffB); PG8_STAGE(PG8_SA(0, 0), cA, voffA); PG8_STAGE(PG8_SB(0, 1), cB + hstep, voffB); PG8_STAGE(PG8_SA(0, 1), cA + hstepA, voffA);
        if (wr == 1) PG8_BAR;
        PG8_WAIT_V(4); PG8_BAR;
        PG8_STAGE(PG8_SB(1, 0), cB + kstep, voffB); PG8_STAGE(PG8_SA(1, 0), cA + kstep, voffA); PG8_STAGE(PG8_SB(1, 1), cB + hstep + kstep, voffB);
        PG8_WAIT_V(6); PG8_BAR;
    }
    for (;;) {
        const bool has_next = S.next(ui + 1, nxt);
        const char* nA = has_next ? (const char*)g.A + (size_t)nxt.pm * tstepA : cA; const char* nB = has_next ? (const char*)g.Bt + (size_t)nxt.pn * tstep : cB;
        for (int t = 0; t < nt; t += 2) {
            const bool last = (t == nt - 2);
            const char* a1 = cA + (size_t)(t + 1) * kstep;
            const char* a2 = last ? nA : cA + (size_t)(t + 2) * kstep; const char* b2 = last ? nB : cB + (size_t)(t + 2) * kstep;
            const char* a3 = a2 + kstep; const char* b3 = b2 + kstep;
            if (last && has_next) S.a_ready(nxt);
            if constexpr (SP2) {
            PG8_LDB(B0, 0, 0); PG8_LDB(B1, 0, 1); PG8_SCHED; PG8_LDA(At, 0, 0); PG8_STAGE(PG8_SA(1, 1), a1 + hstepA, voffA);
            PG8_WAIT_V(8); PG8_WAIT_L(0); PG8_BAR; PG8_MMA(0, 0, At, B0); PG8_MMA(0, 1, At, B1); PG8_BAR; PG8_SCHED;
            PG8_LDA(At, 0, 1); PG8_STAGE(PG8_SB(0, 0), b2, voffB); PG8_STAGE(PG8_SB(0, 1), b2 + hstep, voffB); PG8_STAGE(PG8_SA(0, 0), a2, voffA);
            PG8_WAIT_V(8); PG8_WAIT_L(0); PG8_BAR; PG8_MMA(1, 0, At, B0); PG8_MMA(1, 1, At, B1); PG8_BAR; PG8_SCHED;
            PG8_LDB(B0, 1, 0); PG8_LDB(B1, 1, 1); PG8_SCHED; PG8_LDA(At, 1, 0); PG8_STAGE(PG8_SA(0, 1), a2 + hstepA, voffA);
            PG8_WAIT_V(8); PG8_WAIT_L(0); PG8_BAR; PG8_MMA(0, 0, At, B0); PG8_MMA(0, 1, At, B1); PG8_BAR; PG8_SCHED;
            PG8_LDA(At, 1, 1); PG8_STAGE(PG8_SB(1, 0), b3, voffB); PG8_STAGE(PG8_SB(1, 1), b3 + hstep, voffB); PG8_STAGE(PG8_SA(1, 0), a3, voffA);
            PG8_WAIT_V(8); PG8_WAIT_L(0); PG8_BAR; PG8_MMA(1, 0, At, B0); PG8_MMA(1, 1, At, B1); PG8_BAR; PG8_SCHED;
            } else {
            PG8_LDB(B0, 0, 0); PG8_SCHED; PG8_LDA(At, 0, 0); PG8_STAGE(PG8_SA(1, 1), a1 + hstepA, voffA);
            PG8_WAIT_L(8); PG8_BAR; PG8_WAIT_L(0); PG8_MMA(0, 0, At, B0); PG8_BAR; PG8_SCHED;
            PG8_LDB(B1, 0, 1); PG8_STAGE(PG8_SB(0, 0), b2, voffB);
            PG8_BAR; PG8_WAIT_L(0); PG8_MMA(0, 1, At, B1); PG8_BAR;
            PG8_LDA(At, 0, 1); PG8_STAGE(PG8_SA(0, 0), a2, voffA);
            PG8_BAR; PG8_WAIT_L(0); PG8_MMA(1, 0, At, B0); PG8_BAR; PG8_SCHED;
            PG8_STAGE(PG8_SB(0, 1), b2 + hstep, voffB);
            PG8_WAIT_V(6); PG8_BAR; PG8_MMA(1, 1, At, B1); PG8_BAR;
            PG8_LDB(B0, 1, 0); PG8_SCHED; PG8_LDA(At, 1, 0); PG8_STAGE(PG8_SA(0, 1), a2 + hstepA, voffA);
            PG8_WAIT_L(8); PG8_BAR; PG8_WAIT_L(0); PG8_MMA(0, 0, At, B0); PG8_BAR; PG8_SCHED;
            PG8_LDB(B1, 1, 1); PG8_STAGE(PG8_SB(1, 0), b3, voffB);
            PG8_BAR; PG8_WAIT_L(0); PG8_MMA(0, 1, At, B1); PG8_BAR;
            PG8_LDA(At, 1, 1); PG8_STAGE(PG8_SA(1, 0), a3, voffA);
            PG8_BAR; PG8_WAIT_L(0); PG8_MMA(1, 0, At, B0); PG8_BAR; PG8_SCHED;
            PG8_STAGE(PG8_SB(1, 1), b3 + hstep, voffB);
            PG8_WAIT_V(6); PG8_BAR; PG8_MMA(1, 1, At, B1); PG8_BAR;
            }
        }
        if constexpr (ALIGN_EPI) { if (wr == 0) PG8_BAR; }
        if constexpr (!Epi::AFTER_DRAIN) { E(acc, cur, wr, wc, fr, fq); S.done(cur); }
        if (!has_next) break;
#pragma unroll
        for (int a = 0; a < 2; ++a)
#pragma unroll
            for (int b = 0; b < 2; ++b)
#pragma unroll
                for (int m = 0; m < 4; ++m)
#pragma unroll
                    for (int n = 0; n < 2; ++n) acc[a][b][m][n] = (f32x4){0.f, 0.f, 0.f, 0.f};
        cur = nxt; cA = nA; cB = nB; ++ui;
        if constexpr (ALIGN_EPI) { if (wr == 1) PG8_BAR; }
    }
    PG8_WAIT_V(0);
    if constexpr (!ALIGN_EPI) { if (wr == 0) PG8_BAR; }
    PG8_BAR;
    if constexpr (Epi::AFTER_DRAIN) { E.fused(acc, cur, wr, wc, fr, fq, lds, wid, lane); S.done(cur); }
#undef PG8_SA
#undef PG8_SB
#undef PG8_STAGE
#undef PG8_LDA
#undef PG8_LDB
#undef PG8_MMA
#undef PG8_WAIT_V
#undef PG8_WAIT_L
#undef PG8_BAR
#undef PG8_SCHED
}
}
#define GAS __attribute__((address_space(1)))
#define LAS __attribute__((address_space(3)))
typedef unsigned short bf16_t;
typedef short bf16x8 __attribute__((ext_vector_type(8)));
typedef float f32x4 __attribute__((ext_vector_type(4)));
typedef unsigned u32x4 __attribute__((ext_vector_type(4)));
typedef unsigned u32x2 __attribute__((ext_vector_type(2)));
typedef float f32x2 __attribute__((ext_vector_type(2)));
constexpr int NT = 512, PROWS6 = 8192;
constexpr int T = 16384, SEQ = 4096, D = 1024, ZW = 6144;
constexpr size_t MiB = 1u << 20;
constexpr size_t WS_DEC = 0;
constexpr size_t WS_Z = 4 * MiB;
constexpr size_t WS_WIN = 196 * MiB, WS_WOUT = 208 * MiB, WS_RGA = 212 * MiB, WS_RGX = 212 * MiB + 256 * 1024;
constexpr size_t WS_OI = 213 * MiB;
constexpr size_t WS_A2 = 4 * MiB;
constexpr size_t WS_R = 68 * MiB;
constexpr size_t WS_V = 132 * MiB;
constexpr size_t WS_WC = 196 * MiB, WS_WO = 229 * MiB, WS_LW = 233 * MiB, WS_LA = 235 * MiB;
constexpr size_t WS_W2T = 237 * MiB, WS_A2T = 237 * MiB + 256 * 1024, WS_GR = 238 * MiB, WS_ST = 239 * MiB, WS_XG = 241 * MiB;
constexpr size_t WS_WL = 246 * MiB;
constexpr size_t WS_BAR = 2 * MiB;
constexpr int LDS_BYTES = 147456, LDS_MISC = 147456 - 64;

struct Params { const GAS float* in[32]; GAS float* out; GAS unsigned char* ws; long long dry; };
#ifndef PROBE
#define PROBE 0
#endif
enum { I_X = 0, I_ABG, I_WIN, I_CONVW, I_CONVB, I_RGWA, I_RGBA, I_RGWX, I_RGBX, I_LAM, I_LB, I_HGG, I_WOUT, I_CNG, I_MU, I_WR, I_WK, I_WV, I_WG, I_W0, I_W1, I_W2, I_A0, I_A1, I_A2, I_KK, I_KA, I_RK, I_LNG, I_LNB, I_WO, I_FG };

__device__ __forceinline__ unsigned f2bf(float f) { unsigned u = __float_as_uint(f); return (u + 0x7fffu + ((u >> 16) & 1u)) >> 16; }
__device__ __forceinline__ float bf2f(unsigned h) { return __uint_as_float(h << 16); }
__device__ __forceinline__ unsigned pk2(float lo, float hi) { return f2bf(lo) | (f2bf(hi) << 16); }
__device__ __forceinline__ float sigmf(float x) { return __builtin_amdgcn_rcpf(1.0f + __expf(-x)); }
__device__ __forceinline__ float wave_sum(float v) {
#pragma unroll
    for (int o = 1; o < 64; o <<= 1) v += __shfl_xor(v, o);
    return v;
}
#define OPQ_TID unsigned char* WSP = launder_ws(((unsigned char*)p.ws)); int tid = threadIdx.x; asm volatile("" : "+v"(tid)); const int lane = tid & 63, wave = __builtin_amdgcn_readfirstlane(tid >> 6); (void)lane; (void)wave
__device__ __forceinline__ unsigned char* launder_ws(unsigned char* w) { const unsigned long long v = (unsigned long long)w; unsigned lo = __builtin_amdgcn_readfirstlane((unsigned)v), hi = __builtin_amdgcn_readfirstlane((unsigned)(v >> 32)); asm volatile("" : "+s"(lo), "+s"(hi)); return (unsigned char*)(GAS unsigned char*)(((unsigned long long)hi << 32) | lo); }
#define MFMA16(a, b, c) __builtin_amdgcn_mfma_f32_16x16x32_bf16((a), (b), (c), 0, 0, 0)

__device__ __forceinline__ void tr_item(const float* src, int ld_src, bf16_t* dst, int ld_dst, const float* sc, int scmode, LAS float* scr, int kb, int nb, int lane) {
    const int k0 = 64 * kb, n0 = 32 * nb;
#pragma unroll
    for (int i = 0; i < 8; ++i) { const int kk = 8 * i + (lane >> 3), c4 = (lane & 7) * 4; f32x4 v = *(const f32x4*)(src + (size_t)(k0 + kk) * ld_src + n0 + c4);
        if (sc) { const float m_ = sc[k0 + kk]; v = v * (scmode ? m_ : (1.0f - m_)); }
        scr[kk * 33 + c4] = v.x; scr[kk * 33 + c4 + 1] = v.y; scr[kk * 33 + c4 + 2] = v.z; scr[kk * 33 + c4 + 3] = v.w; }
    asm volatile("s_waitcnt lgkmcnt(0)" ::: "memory");
    const int c = lane & 7;
#pragma unroll
    for (int j = 0; j < 4; ++j) { const int n = (lane >> 3) + 8 * j; const LAS float* s = scr + (8 * c) * 33 + n;
        u32x4 o; o.x = pk2(s[0 * 33], s[1 * 33]); o.y = pk2(s[2 * 33], s[3 * 33]); o.z = pk2(s[4 * 33], s[5 * 33]); o.w = pk2(s[6 * 33], s[7 * 33]);
        *(u32x4*)(dst + (size_t)(n0 + n) * ld_dst + k0 + 8 * c) = o; }
    asm volatile("s_waitcnt lgkmcnt(0)" ::: "memory");
}
__device__ __forceinline__ void tr_item2(const float* src, int ld_src, bf16_t* dst0, bf16_t* dst1, int ld_dst, const float* mu, LAS float* scr, int kb, int nb, int lane) {
    const int k0 = 64 * kb, n0 = 32 * nb;
#pragma unroll
    for (int i = 0; i < 8; ++i) { const int kk = 8 * i + (lane >> 3), c4 = (lane & 7) * 4; const f32x4 v = *(const f32x4*)(src + (size_t)(k0 + kk) * ld_src + n0 + c4);
        scr[kk * 33 + c4] = v.x; scr[kk * 33 + c4 + 1] = v.y; scr[kk * 33 + c4 + 2] = v.z; scr[kk * 33 + c4 + 3] = v.w; }
    asm volatile("s_waitcnt lgkmcnt(0)" ::: "memory");
    const int c = lane & 7;
    const f32x4 m0 = *(const f32x4*)(mu + k0 + 8 * c), m1 = *(const f32x4*)(mu + k0 + 8 * c + 4);
#pragma unroll
    for (int j = 0; j < 4; ++j) { const int n = (lane >> 3) + 8 * j; const LAS float* s = scr + (8 * c) * 33 + n;
        const float s0 = s[0], s1 = s[33], s2 = s[66], s3 = s[99], s4 = s[132], s5 = s[165], s6 = s[198], s7 = s[231];
        u32x4 o; o.x = pk2(s0 * m0.x, s1 * m0.y); o.y = pk2(s2 * m0.z, s3 * m0.w); o.z = pk2(s4 * m1.x, s5 * m1.y); o.w = pk2(s6 * m1.z, s7 * m1.w);
        *(u32x4*)(dst1 + (size_t)(n0 + n) * ld_dst + k0 + 8 * c) = o;
        o.x = pk2(s0 * (1.0f - m0.x), s1 * (1.0f - m0.y)); o.y = pk2(s2 * (1.0f - m0.z), s3 * (1.0f - m0.w)); o.z = pk2(s4 * (1.0f - m1.x), s5 * (1.0f - m1.y)); o.w = pk2(s6 * (1.0f - m1.z), s7 * (1.0f - m1.w));
        *(u32x4*)(dst0 + (size_t)(n0 + n) * ld_dst + k0 + 8 * c) = o; }
    asm volatile("s_waitcnt lgkmcnt(0)" ::: "memory");
}
__device__ __forceinline__ void rms_row(const float* xrow, const float* g, int lane, u32x2 (&o)[4]) {
    f32x4 v[4]; float s = 0.f;
#pragma unroll
    for (int j = 0; j < 4; ++j) { v[j] = *((const f32x4*)xrow + lane + 64 * j); s += (v[j].x * v[j].x + v[j].y * v[j].y) + (v[j].z * v[j].z + v[j].w * v[j].w); }
    const float rs = rsqrtf(wave_sum(s) * (1.0f / 1024.0f) + 1e-6f);
#pragma unroll
    for (int j = 0; j < 4; ++j) { const f32x4 gg = *((const f32x4*)g + lane + 64 * j); o[j].x = pk2(v[j].x * rs * gg.x, v[j].y * rs * gg.y); o[j].y = pk2(v[j].z * rs * gg.z, v[j].w * rs * gg.w); }
}

__device__ __forceinline__ void p0_prologue(const Params& p, LAS unsigned char* lds, int G, int bid) {
    OPQ_TID; const int gw = bid * 8 + wave, ngw = G * 8;
    LAS float* scr = (LAS float*)(lds + wave * 16384);
    bf16_t* WinT = (bf16_t*)(WSP + WS_WIN); bf16_t* WoutT = (bf16_t*)(WSP + WS_WOUT); bf16_t* RGA = (bf16_t*)(WSP + WS_RGA); bf16_t* RGX = (bf16_t*)(WSP + WS_RGX);
    constexpr int IA = 16 * 192, IB = 32 * 32, IC = 64, IL0 = 64;
    for (int it = gw; it < IA + IB + 2 * IC + IL0; it += ngw) {
        int r = it;
        if (r >= IA + IB + 2 * IC) { r -= IA + IB + 2 * IC; const int wh = r >> 5, q = r & 31;
            bf16_t* dst = (bf16_t*)(WSP + WS_WL) + (size_t)(wh * 64) * 2048;
            tr_item2(wh ? ((const float*)p.in[I_A1]) : ((const float*)p.in[I_W1]), 64, dst, dst + 1024, 2048, ((const float*)p.in[I_MU]) + (wh ? 4 : 1) * 1024, scr, q >> 1, q & 1, lane); continue; }
        if (r < IA) { tr_item(((const float*)p.in[I_WIN]), ZW, WinT, 1024, nullptr, 0, scr, r / 192, r % 192, lane); continue; } r -= IA;
        if (r < IB) { tr_item(((const float*)p.in[I_WOUT]), 1024, WoutT, 2048, nullptr, 0, scr, r / 32, r % 32, lane); continue; } r -= IB;
        const float* src = (r < IC) ? ((const float*)p.in[I_RGWA]) : ((const float*)p.in[I_RGWX]); bf16_t* dst = (r < IC) ? RGA : RGX; if (r >= IC) r -= IC;
        const int blk = r >> 3, q = r & 7;
        tr_item(src + blk * 16384, 128, dst + blk * 16384, 128, nullptr, 0, scr, q >> 2, q & 3, lane);
    }
    bf16_t* U0 = (bf16_t*)((float*)p.out);
    for (int m = gw; m < T; m += ngw) { u32x2 o[4]; rms_row(((const float*)p.in[I_X]) + (size_t)m * D, ((const float*)p.in[I_ABG]), lane, o);
#pragma unroll
        for (int j = 0; j < 4; ++j) *((u32x2*)(U0 + (size_t)m * D) + lane + 64 * j) = o[j]; }
}

__device__ __forceinline__ void rg_a_prefetch(const bf16_t* Z, int unit, int tid, u32x4 (&pre)[3]) {
    const int b = unit >> 9, n = (unit >> 3) & 63, j = unit & 7; const int tok0 = b * SEQ + n * 64, ch0 = j * 128;
#pragma unroll
    for (int q = 0; q < 3; ++q) { const int i = tid + q * NT; const int row = i >> 4, cc = i & 15; pre[q] = (u32x4){0u, 0u, 0u, 0u};
        if (i < 67 * 16 && (n > 0 || row >= 3)) pre[q] = *(const u32x4*)(Z + (size_t)(tok0 - 3 + row) * ZW + ch0 + 8 * cc); }
}
__device__ __forceinline__ void rg_a_unit(const Params& p, LAS unsigned char* lds, int unit, int next_unit, u32x4 (&pre)[3]) {
    OPQ_TID;
    LAS float* XC = (LAS float*)lds; LAS float* AA = (LAS float*)(lds + 32768); LAS bf16_t* XB = (LAS bf16_t*)(lds + 65536); LAS bf16_t* XR = (LAS bf16_t*)(lds + 82944);
    LAS float* SUMP = (LAS float*)(lds + 82944); LAS float* SUMH = SUMP + 512; LAS bf16_t* HT = XB; LAS bf16_t* PT = (LAS bf16_t*)(lds + 87040);
    const int b = unit >> 9, n = (unit >> 3) & 63, j = unit & 7;
    const int tok0 = b * SEQ + n * 64, ch0 = j * 128;
    const bf16_t* Z = (const bf16_t*)(WSP + WS_Z);
#pragma unroll
    for (int q = 0; q < 3; ++q) { const int i = tid + q * NT; if (i < 67 * 16) *(LAS u32x4*)(XR + (i >> 4) * 136 + 8 * (i & 15)) = pre[q]; }
    __syncthreads();
    if (next_unit < 2048) rg_a_prefetch(Z, next_unit, tid, pre);
    const int c = tid & 127, sub = tid >> 7;
    {
        const int ch = ch0 + c;
        const float w0 = ((const float*)p.in[I_CONVW])[ch], w1 = ((const float*)p.in[I_CONVW])[1024 + ch], w2 = ((const float*)p.in[I_CONVW])[2048 + ch], w3 = ((const float*)p.in[I_CONVW])[3072 + ch], cb = ((const float*)p.in[I_CONVB])[ch];
        const LAS bf16_t* xr = XR + (sub * 16) * 136 + c;
        float xm3 = bf2f(xr[0]), xm2 = bf2f(xr[136]), xm1 = bf2f(xr[272]);
#pragma unroll
        for (int i = 0; i < 16; ++i) { const float x = bf2f(xr[(i + 3) * 136]); const float y = w0 * xm3 + w1 * xm2 + w2 * xm1 + w3 * x + cb;
            XC[(sub * 16 + i) * 128 + c] = y; XB[(sub * 16 + i) * 136 + c] = (bf16_t)f2bf(y); xm3 = xm2; xm2 = xm1; xm1 = x; }
    }
    __syncthreads();
    {
        const int fr = lane & 15, fq = lane >> 4;
        const bf16_t* WA = (const bf16_t*)(WSP + WS_RGA) + j * 16384 + (16 * wave + fr) * 128 + 8 * fq;
        const bf16_t* WX = (const bf16_t*)(WSP + WS_RGX) + j * 16384 + (16 * wave + fr) * 128 + 8 * fq;
        f32x4 accA[4], accX[4];
#pragma unroll
        for (int m = 0; m < 4; ++m) { accA[m] = (f32x4){0.f, 0.f, 0.f, 0.f}; accX[m] = (f32x4){0.f, 0.f, 0.f, 0.f}; }
#pragma unroll
        for (int k = 0; k < 4; ++k) { const bf16x8 bA = *(const bf16x8*)(WA + 32 * k), bX = *(const bf16x8*)(WX + 32 * k);
#pragma unroll
            for (int m = 0; m < 4; ++m) { const bf16x8 a = *(const LAS bf16x8*)(XB + (16 * m + fr) * 136 + 32 * k + 8 * fq); accA[m] = MFMA16(a, bA, accA[m]); accX[m] = MFMA16(a, bX, accX[m]); } }
        const int cl = 16 * wave + fr, ch = ch0 + cl;
        const float ba = ((const float*)p.in[I_RGBA])[ch], bx = ((const float*)p.in[I_RGBX])[ch], lam = ((const float*)p.in[I_LAM])[ch];
        const float sp = log1pf(expf(-lam));
#pragma unroll
        for (int m = 0; m < 4; ++m)
#pragma unroll
            for (int r = 0; r < 4; ++r) { const int tk = 16 * m + 4 * fq + r; const float gr = sigmf(accA[m][r] + ba), gi = sigmf(accX[m][r] + bx);
                const float la = -8.0f * gr * sp; const float a = __expf(la); const float mult = __builtin_amdgcn_sqrtf(fmaxf(1.0f - a * a, 0.f));
                const float xc = XC[tk * 128 + cl]; AA[tk * 128 + cl] = a; XC[tk * 128 + cl] = mult * gi * xc; }
    }
    __syncthreads();
    {
        float hl[16], pl[16]; float h = 0.f, P = 1.f;
#pragma unroll
        for (int i = 0; i < 16; ++i) { const float a = AA[(sub * 16 + i) * 128 + c], u = XC[(sub * 16 + i) * 128 + c]; h = a * h + u; P *= a; hl[i] = h; pl[i] = P; }
        SUMP[sub * 128 + c] = P; SUMH[sub * 128 + c] = h;
        __syncthreads();
        float chh = 0.f, cp = 1.f;
#pragma unroll
        for (int s = 0; s < 3; ++s) if (s < sub) { const float sp_ = SUMP[s * 128 + c]; chh = chh * sp_ + SUMH[s * 128 + c]; cp *= sp_; }
#pragma unroll
        for (int i = 0; i < 16; ++i) { HT[(sub * 16 + i) * 136 + c] = (bf16_t)f2bf(hl[i] + pl[i] * chh); PT[(sub * 16 + i) * 136 + c] = (bf16_t)f2bf(pl[i] * cp); }
    }
    __syncthreads();
    {
        bf16_t* HL = (bf16_t*)((float*)p.out) + (size_t)tok0 * D + ch0; bf16_t* PC = HL + (size_t)T * D;
        for (int i = tid; i < 1024; i += NT) { const int row = i >> 4, cc = i & 15;
            *(u32x4*)(HL + (size_t)row * D + 8 * cc) = *(const LAS u32x4*)(HT + row * 136 + 8 * cc); *(u32x4*)(PC + (size_t)row * D + 8 * cc) = *(const LAS u32x4*)(PT + row * 136 + 8 * cc); }
    }
    __syncthreads();
}

__device__ __forceinline__ void hg_a_prefetch(const bf16_t* Z, int unit, int tid, u32x4 (&pre)[6]) {
    const int b = unit >> 9, h = (unit >> 6) & 7, n = unit & 63; const int tok0 = b * SEQ + n * 64;
#pragma unroll
    for (int q = 0; q < 6; ++q) { const int i = tid + q * NT; const int arr = i >> 10, row = (i >> 4) & 63, cc = i & 15; pre[q] = *(const u32x4*)(Z + (size_t)(tok0 + row) * ZW + 2048 + 1024 * arr + h * 128 + 8 * cc); }
}
__device__ __forceinline__ void hg_a_unit(const Params& p, LAS unsigned char* lds, int unit, int next_unit, u32x4 (&pre)[6]) {
    OPQ_TID;
    LAS bf16_t* QD = (LAS bf16_t*)lds; LAS bf16_t* KI = (LAS bf16_t*)(lds + 17408); LAS bf16_t* VR = (LAS bf16_t*)(lds + 34816); LAS bf16_t* VT = (LAS bf16_t*)(lds + 52224);
    LAS bf16_t* SC = (LAS bf16_t*)(lds + 70656); LAS float* ST = (LAS float*)(lds + 79872); LAS bf16_t* OT = VR;
    const int b = unit >> 9, h = (unit >> 6) & 7, n = unit & 63;
    const int tok0 = b * SEQ + n * 64;
    bf16_t* Z = (bf16_t*)(WSP + WS_Z);
    const int fr = lane & 15, fq = lane >> 4;
#pragma unroll
    for (int q = 0; q < 6; ++q) { const int i = tid + q * NT; const int arr = i >> 10, row = (i >> 4) & 63, cc = i & 15;
        *(LAS u32x4*)((arr == 0 ? QD : (arr == 1 ? KI : VR)) + row * 136 + 8 * cc) = pre[q]; }
    __syncthreads();
    {
        const int d = tid & 127, sub = tid >> 7, hd = h * 128 + d;
        const float lb = sigmf(((const float*)p.in[I_LB])[hd] - ((const float*)p.in[I_LB])[1024 + hd]), omlb = 1.0f - lb;
        float q[16], kq[16], cl[16]; unsigned short vv[16]; float run = 0.f;
#pragma unroll
        for (int i = 0; i < 16; ++i) { const int t = sub * 16 + i; const float f = bf2f(KI[t * 136 + d]); const float sg = sigmf(f);
            run += __logf(lb + omlb * sg); cl[i] = run; kq[i] = omlb * (1.0f - sg); q[i] = bf2f(QD[t * 136 + d]); vv[i] = VR[t * 136 + d]; }
        ST[sub * 128 + d] = run;
        __syncthreads();
        float off = 0.f, total = 0.f;
#pragma unroll
        for (int s = 0; s < 4; ++s) { const float x = ST[s * 128 + d]; total += x; if (s < sub) off += x; }
        unsigned ke[8], vp[8];
#pragma unroll
        for (int i = 0; i < 16; ++i) { const float cum = off + cl[i]; const unsigned qd = f2bf(q[i] * __expf(cum)), ki = f2bf(kq[i] * __expf(-cum)), kE = f2bf(kq[i] * __expf(total - cum));
            QD[(sub * 16 + i) * 136 + d] = (bf16_t)qd; KI[(sub * 16 + i) * 136 + d] = (bf16_t)ki;
            if (i & 1) { ke[i >> 1] |= kE << 16; vp[i >> 1] |= (unsigned)vv[i] << 16; } else { ke[i >> 1] = kE; vp[i >> 1] = vv[i]; } }
        *(LAS u32x4*)(VT + d * 72 + sub * 16) = (u32x4){vp[0], vp[1], vp[2], vp[3]}; *(LAS u32x4*)(VT + d * 72 + sub * 16 + 8) = (u32x4){vp[4], vp[5], vp[6], vp[7]};
        bf16_t* tb = Z + (size_t)(tok0 + (d >> 1)) * ZW + h * 128 + (d & 1) * 64 + sub * 16;
        *(u32x4*)(tb + 3072) = (u32x4){ke[0], ke[1], ke[2], ke[3]}; *(u32x4*)(tb + 3072 + 8) = (u32x4){ke[4], ke[5], ke[6], ke[7]};
        *(u32x4*)(tb + 4096) = (u32x4){vp[0], vp[1], vp[2], vp[3]}; *(u32x4*)(tb + 4096 + 8) = (u32x4){vp[4], vp[5], vp[6], vp[7]};
        if (sub == 0) ((float*)(WSP + WS_DEC))[unit * 128 + d] = __expf(total);
    }
    __syncthreads();
    if (next_unit < 2048) hg_a_prefetch(Z, next_unit, tid, pre);
    for (int i = tid; i < 1024; i += NT) { const int row = i >> 4, cc = i & 15; *(u32x4*)(Z + (size_t)(tok0 + row) * ZW + 2048 + h * 128 + 8 * cc) = *(const LAS u32x4*)(QD + row * 136 + 8 * cc); }
    {
        const int lt = wave >> 1;
#pragma unroll
        for (int x = 0; x < 2; ++x) { const int mt = (wave & 1) * 2 + x; f32x4 acc = (f32x4){0.f, 0.f, 0.f, 0.f};
            if (mt <= lt) {
#pragma unroll
                for (int k = 0; k < 4; ++k) { const bf16x8 a = *(const LAS bf16x8*)(QD + (16 * lt + fr) * 136 + 32 * k + 8 * fq), bb = *(const LAS bf16x8*)(KI + (16 * mt + fr) * 136 + 32 * k + 8 * fq); acc = MFMA16(a, bb, acc); } }
#pragma unroll
            for (int r = 0; r < 4; ++r) { const int l = 16 * lt + 4 * fq + r, mm = 16 * mt + fr; SC[l * 72 + mm] = (bf16_t)f2bf(mm <= l ? acc[r] : 0.f); } }
    }
    __syncthreads();
    {
#pragma unroll
        for (int lt = 0; lt < 4; ++lt) { f32x4 acc = (f32x4){0.f, 0.f, 0.f, 0.f};
#pragma unroll
            for (int k = 0; k < 2; ++k) { const bf16x8 a = *(const LAS bf16x8*)(SC + (16 * lt + fr) * 72 + 32 * k + 8 * fq), bb = *(const LAS bf16x8*)(VT + (16 * wave + fr) * 72 + 32 * k + 8 * fq); acc = MFMA16(a, bb, acc); }
#pragma unroll
            for (int r = 0; r < 4; ++r) OT[(16 * lt + 4 * fq + r) * 136 + 16 * wave + fr] = (bf16_t)f2bf(acc[r]); }
    }
    __syncthreads();
    { bf16_t* OI = (bf16_t*)(WSP + WS_OI) + (size_t)tok0 * D + h * 128;
      for (int i = tid; i < 1024; i += NT) { const int row = i >> 4, cc = i & 15; *(u32x4*)(OI + (size_t)row * D + 8 * cc) = *(const LAS u32x4*)(OT + row * 136 + 8 * cc); } }
    __syncthreads();
}

__device__ __forceinline__ void hg_b_item(const Params& p, LAS unsigned char* lds, int item, bool dry = false) {
    OPQ_TID;
    LAS bf16_t* SB = (LAS bf16_t*)lds;
    const int b = item >> 6, h = (item >> 3) & 7, es = item & 7;
    const int fr = lane & 15, fq = lane >> 4;
    const bf16_t* Z = (const bf16_t*)(WSP + WS_Z); bf16_t* OI = (bf16_t*)(WSP + WS_OI); const float* DEC = (const float*)(WSP + WS_DEC);
    f32x4 S = (f32x4){0.f, 0.f, 0.f, 0.f};
    const int eg = 16 * es + fr, dg = 16 * wave + fr;
    const bf16_t* pV = Z + (size_t)(b * SEQ + (eg >> 1)) * ZW + 4096 + h * 128 + (eg & 1) * 64 + 8 * fq;
    const bf16_t* pK = Z + (size_t)(b * SEQ + (dg >> 1)) * ZW + 3072 + h * 128 + (dg & 1) * 64 + 8 * fq;
    const bf16_t* pQ = Z + (size_t)(b * SEQ + fr) * ZW + 2048 + h * 128 + 8 * fq;
    bf16_t* pO = OI + (size_t)(b * SEQ + 4 * fq) * D + h * 128 + 16 * es + fr;
    const float* pD = DEC + (size_t)((b * 8 + h) * 64) * 128 + dg;
    __syncthreads();
#pragma unroll 1
    for (int G16 = 0; G16 < 4; ++G16) {
#pragma unroll 8
        for (int g = 0; g < 16; ++g) { const int n = 16 * G16 + g; const size_t ro = (size_t)n * 64 * ZW;
            const float dec = pD[n * 128];
            bf16x8 aV[2], bK[2];
#pragma unroll
            for (int k = 0; k < 2; ++k) { aV[k] = *(const bf16x8*)(pV + ro + 32 * k); bK[k] = *(const bf16x8*)(pK + ro + 32 * k); }
#pragma unroll
            for (int r = 0; r < 4; ++r) SB[g * 2176 + (4 * fq + r) * 136 + dg] = (bf16_t)f2bf(S[r]);
            S = S * dec;
#pragma unroll
            for (int k = 0; k < 2; ++k) S = MFMA16(aV[k], bK[k], S); }
        asm volatile("s_waitcnt lgkmcnt(0)" ::: "memory"); __builtin_amdgcn_s_barrier(); asm volatile("" ::: "memory");
#pragma unroll
        for (int c2 = 0; c2 < 2; ++c2) { const int g = wave + 8 * c2, nB = 16 * G16 + g; const size_t roB = (size_t)nB * 64 * ZW;
            bf16x8 bS[4];
#pragma unroll
            for (int k = 0; k < 4; ++k) bS[k] = *(const LAS bf16x8*)(SB + g * 2176 + fr * 136 + 32 * k + 8 * fq);
#pragma unroll
            for (int lt = 0; lt < 4; ++lt) { f32x4 acc = (f32x4){0.f, 0.f, 0.f, 0.f}; unsigned short oO[4];
#pragma unroll
                for (int r = 0; r < 4; ++r) oO[r] = pO[(size_t)(nB * 64 + 16 * lt + r) * D];
#pragma unroll
                for (int k = 0; k < 4; ++k) { const bf16x8 a = *(const bf16x8*)(pQ + roB + (size_t)(16 * lt) * ZW + 32 * k); acc = MFMA16(a, bS[k], acc); }
#pragma unroll
                for (int r = 0; r < 4; ++r) { const float nv = bf2f(oO[r]) + acc[r]; if (!dry) pO[(size_t)(nB * 64 + 16 * lt + r) * D] = (bf16_t)f2bf(nv); else if (nv == 123456.0f) pO[0] = 0; } } }
        asm volatile("s_waitcnt lgkmcnt(0)" ::: "memory"); __builtin_amdgcn_s_barrier(); asm volatile("" ::: "memory");
    }
}
__device__ __forceinline__ void rg_b_unit(const Params& p, int unit) {
    OPQ_TID;
    const int b = unit >> 7, n = (unit >> 1) & 63, ch = (unit & 1) * 512 + 8 * (tid & 63), r8 = tid >> 6;
    const bf16_t* HL = (const bf16_t*)((float*)p.out) + (size_t)b * SEQ * D + ch; const bf16_t* PC = HL + (size_t)T * D;
    bf16_t* Z = (bf16_t*)(WSP + WS_Z) + (size_t)(b * SEQ + n * 64) * ZW + ch;
    float carry[8];
#pragma unroll
    for (int i = 0; i < 8; ++i) carry[i] = 0.f;
    int m0 = 0;
    for (; m0 + 4 <= n; m0 += 4) { u32x4 pp[4], hh4[4];
#pragma unroll
        for (int i = 0; i < 4; ++i) { const size_t o = (size_t)((m0 + i) * 64 + 63) * D; pp[i] = *(const u32x4*)(PC + o); hh4[i] = *(const u32x4*)(HL + o); }
#pragma unroll
        for (int i = 0; i < 4; ++i)
#pragma unroll
            for (int c = 0; c < 4; ++c) { carry[2 * c] = carry[2 * c] * bf2f(pp[i][c] & 0xffffu) + bf2f(hh4[i][c] & 0xffffu); carry[2 * c + 1] = carry[2 * c + 1] * bf2f(pp[i][c] >> 16) + bf2f(hh4[i][c] >> 16); } }
    for (; m0 < n; ++m0) { const size_t o = (size_t)(m0 * 64 + 63) * D; const u32x4 pp = *(const u32x4*)(PC + o), hh4 = *(const u32x4*)(HL + o);
#pragma unroll
        for (int c = 0; c < 4; ++c) { carry[2 * c] = carry[2 * c] * bf2f(pp[c] & 0xffffu) + bf2f(hh4[c] & 0xffffu); carry[2 * c + 1] = carry[2 * c + 1] * bf2f(pp[c] >> 16) + bf2f(hh4[c] >> 16); } }
#pragma unroll 4
    for (int tq = 0; tq < 8; ++tq) { const int t = 8 * tq + r8; const size_t o = (size_t)(n * 64 + t) * D;
        const u32x4 hv = *(const u32x4*)(HL + o), pv = *(const u32x4*)(PC + o), gv = *(const u32x4*)(Z + (size_t)t * ZW + 1024); u32x4 ov;
#pragma unroll
        for (int c = 0; c < 4; ++c) { const float h0 = bf2f(hv[c] & 0xffffu) + bf2f(pv[c] & 0xffffu) * carry[2 * c], h1 = bf2f(hv[c] >> 16) + bf2f(pv[c] >> 16) * carry[2 * c + 1];
            const float g0 = bf2f(gv[c] & 0xffffu), g1 = bf2f(gv[c] >> 16); ov[c] = pk2(h0 * g0 * sigmf(g0), h1 * g1 * sigmf(g1)); }
        *(u32x4*)(Z + (size_t)t * ZW) = ov; }
}
__device__ __forceinline__ float row16_sum_p4(float x) {
    x += __int_as_float(__builtin_amdgcn_update_dpp(0, __float_as_int(x), 0xB1, 0xf, 0xf, true)); x += __int_as_float(__builtin_amdgcn_update_dpp(0, __float_as_int(x), 0x4E, 0xf, 0xf, true));
    x += __int_as_float(__builtin_amdgcn_update_dpp(0, __float_as_int(x), 0x141, 0xf, 0xf, true)); x += __int_as_float(__builtin_amdgcn_update_dpp(0, __float_as_int(x), 0x140, 0xf, 0xf, true)); return x; }
__device__ __forceinline__ void p4_finalize(const Params& p, int G, int bid) {
    OPQ_TID; const int gw = bid * 8 + wave, ngw = G * 8;
    bf16_t* Z = (bf16_t*)(WSP + WS_Z); const bf16_t* OI = (const bf16_t*)(WSP + WS_OI);
    const int l16 = lane & 15, pr = lane >> 4;
    const f32x4 g0 = *(const f32x4*)(((const float*)p.in[I_HGG]) + 8 * l16), g1 = *(const f32x4*)(((const float*)p.in[I_HGG]) + 8 * l16 + 4);
    for (int it = gw; it < T * 2; it += ngw) { const int tok = it >> 1, h = (it & 1) * 4 + pr;
        const u32x4 ov = *(const u32x4*)(OI + (size_t)tok * D + h * 128 + 8 * l16); const u32x4 gv = *(const u32x4*)(Z + (size_t)tok * ZW + 5120 + h * 128 + 8 * l16);
        float o[8], gb[8]; float ss = 0.f;
#pragma unroll
        for (int c = 0; c < 4; ++c) { o[2 * c] = bf2f(ov[c] & 0xffffu); o[2 * c + 1] = bf2f(ov[c] >> 16); gb[2 * c] = bf2f(gv[c] & 0xffffu); gb[2 * c + 1] = bf2f(gv[c] >> 16); ss += o[2 * c] * o[2 * c] + o[2 * c + 1] * o[2 * c + 1]; }
        const float rs = rsqrtf(row16_sum_p4(ss) * (1.0f / 128.0f) + 1e-6f);
        u32x4 w;
#pragma unroll
        for (int c = 0; c < 4; ++c) { const float ga = c < 2 ? g0[2 * c] : g1[2 * c - 4], gbq = c < 2 ? g0[2 * c + 1] : g1[2 * c - 3];
            w[c] = pk2(o[2 * c] * rs * ga * gb[2 * c] * sigmf(gb[2 * c]), o[2 * c + 1] * rs * gbq * gb[2 * c + 1] * sigmf(gb[2 * c + 1])); }
        *(u32x4*)(Z + (size_t)tok * ZW + 1024 + h * 128 + 8 * l16) = w; }
}
__device__ __forceinline__ void p6_prologue(const Params& p, LAS unsigned char* lds, int G, int bid) {
    OPQ_TID; const int gw = bid * 8 + wave, ngw = G * 8;
    LAS float* scr = (LAS float*)(lds + wave * 16384);
    constexpr int IP = 4096, IL = 0, IO = 1024, I2 = 128;
    for (int i = gw * 64 + lane; i < (int)(MiB / 16); i += ngw * 64) ((u32x4*)(WSP + WS_GR))[i] = (u32x4){0u, 0u, 0u, 0u};
    for (int i = gw * 64 + lane; i < (int)(MiB / 32); i += ngw * 64) ((u32x4*)(WSP + WS_XG))[i] = (u32x4){0u, 0u, 0u, 0u};
    for (int it = gw; it < IP + IL + IO + I2; it += ngw) {
        int r = it;
        if (r < IP) { const int pj = r >> 10, q = r & 1023;
            const int muidx = pj == 0 ? 0 : (pj == 1 ? 2 : (pj == 2 ? 3 : 5));
            bf16_t* dst = (bf16_t*)(WSP + WS_WC) + (size_t)(pj * 2048) * 2048;
            tr_item2(((const float*)p.in[I_WR + pj]), 2048, dst, dst + 1024, 2048, ((const float*)p.in[I_MU]) + muidx * 1024, scr, q >> 6, q & 63, lane); continue; }
        r -= IP;
        if (r >= IO) { r -= IO; const int wh = r >> 6, nb = r & 63; tr_item(wh ? ((const float*)p.in[I_A2]) : ((const float*)p.in[I_W2]), 2048, (bf16_t*)(WSP + (wh ? WS_A2T : WS_W2T)), 64, nullptr, 0, scr, 0, nb, lane); continue; }
        tr_item(((const float*)p.in[I_WO]), 1024, (bf16_t*)(WSP + WS_WO), 2048, nullptr, 0, scr, r >> 5, r & 31, lane);
    }
    bf16_t* A2 = (bf16_t*)(WSP + WS_A2);
    const int fr = lane & 15, fq = lane >> 4;
    for (int tile = bid; tile < T / 64; tile += G) {
        const int m0 = tile * 64;
        for (int i = (wave == 0 && (m0 & (SEQ - 1)) != 0) ? -1 : 0; i < 8; ++i) { const int m = (i < 0) ? m0 - 1 : m0 + 8 * wave + i;
            u32x2 o[4]; rms_row(((float*)p.out) + (size_t)m * D, ((const float*)p.in[I_CNG]), lane, o); const int bb = m >> 12, t = m & (SEQ - 1);
            const size_t cr = (size_t)(t >> 11) * PROWS6 + bb * 2048 + (t & 2047);
            const size_t cn = (size_t)((t + 1) >> 11) * PROWS6 + bb * 2048 + ((t + 1) & 2047);
#pragma unroll
            for (int j = 0; j < 4; ++j) { if (i >= 0) *((u32x2*)(A2 + cr * 2048) + lane + 64 * j) = o[j];
                if (t + 1 < SEQ) *((u32x2*)(A2 + cn * 2048 + 1024) + lane + 64 * j) = o[j];
                if (t == 0) *((u32x2*)(A2 + cr * 2048 + 1024) + lane + 64 * j) = (u32x2){0u, 0u}; } }
        __syncthreads();
        { const int t0 = m0 & (SEQ - 1), bb = m0 >> 12; const size_t cr0 = (size_t)(t0 >> 11) * PROWS6 + bb * 2048 + (t0 & 2047);
          const int mt = wave & 3, nh = wave >> 2;
          LAS bf16_t* LA_ = (LAS bf16_t*)lds; LAS bf16_t* LB_ = (LAS bf16_t*)(lds + 64 * 264 * 2);
          const bf16_t* ga = A2 + cr0 * 2048; const bf16_t* gb = (const bf16_t*)(WSP + WS_WL);
          u32x4 pa_[4], pb_[8];
#define LORA_LOAD(kc) do { _Pragma("unroll") for (int q = 0; q < 4; ++q) { const int i = tid + q * NT; pa_[q] = *(const u32x4*)(ga + (size_t)(i >> 5) * 2048 + (kc) * 256 + 8 * (i & 31)); } \
              _Pragma("unroll") for (int q = 0; q < 8; ++q) { const int i = tid + q * NT; pb_[q] = *(const u32x4*)(gb + (size_t)(i >> 5) * 2048 + (kc) * 256 + 8 * (i & 31)); } } while (0)
          LORA_LOAD(0);
          f32x4 acc[4];
#pragma unroll
          for (int nt = 0; nt < 4; ++nt) acc[nt] = (f32x4){0.f, 0.f, 0.f, 0.f};
#pragma unroll 1
          for (int kc = 0; kc < 8; ++kc) {
#pragma unroll
              for (int q = 0; q < 4; ++q) { const int i = tid + q * NT; *(LAS u32x4*)(LA_ + (i >> 5) * 264 + 8 * (i & 31)) = pa_[q]; }
#pragma unroll
              for (int q = 0; q < 8; ++q) { const int i = tid + q * NT; *(LAS u32x4*)(LB_ + (i >> 5) * 264 + 8 * (i & 31)) = pb_[q]; }
              __syncthreads();
              if (kc + 1 < 8) LORA_LOAD(kc + 1);
#pragma unroll
              for (int ks = 0; ks < 8; ++ks) { const bf16x8 a = *(const LAS bf16x8*)(LA_ + (16 * mt + fr) * 264 + 32 * ks + 8 * fq);
#pragma unroll
                  for (int nt = 0; nt < 4; ++nt) { const bf16x8 bfr = *(const LAS bf16x8*)(LB_ + (64 * nh + 16 * nt + fr) * 264 + 32 * ks + 8 * fq); acc[nt] = MFMA16(a, bfr, acc[nt]); } }
              __syncthreads();
          }
#undef LORA_LOAD
          bf16_t* dstb = (bf16_t*)(WSP + (nh ? WS_LA : WS_LW));
#pragma unroll
          for (int nt = 0; nt < 4; ++nt)
#pragma unroll
              for (int r = 0; r < 4; ++r) { const float v = acc[nt][r]; dstb[(cr0 + 16 * mt + 4 * fq + r) * 64 + 16 * nt + fr] = (bf16_t)f2bf(nh ? v : tanhf(v)); } }
        __syncthreads();
    }
}
template <int CTRL> __device__ __forceinline__ float dpp_add(float x) { const int y = __builtin_amdgcn_update_dpp(0, __float_as_int(x), CTRL, 0xf, 0xf, true); return x + __int_as_float(y); }
__device__ __forceinline__ f32x4 bf4(u32x2 v) { return (f32x4){bf2f(v.x & 0xffffu), bf2f(v.x >> 16), bf2f(v.y & 0xffffu), bf2f(v.y >> 16)}; }
__device__ __forceinline__ float afma(float a, float b, float c) { float d; asm("v_fma_f32 %0, %1, %2, %3" : "=v"(d) : "v"(a), "v"(b), "v"(c)); return d; }
__device__ __forceinline__ float anfma(float a, float b, float c) { float d; asm("v_fma_f32 %0, -%1, %2, %3" : "=v"(d) : "v"(a), "v"(b), "v"(c)); return d; }
__device__ __forceinline__ float amul(float a, float b) { float d; asm("v_mul_f32 %0, %1, %2" : "=v"(d) : "v"(a), "v"(b)); return d; }
__device__ __forceinline__ f32x2 pkmul(f32x2 a, f32x2 b) { f32x2 d; asm("v_pk_mul_f32 %0, %1, %2" : "=v"(d) : "v"(a), "v"(b)); return d; }
__device__ __forceinline__ f32x2 pkfma(f32x2 a, f32x2 b, f32x2 c) { f32x2 d; asm("v_pk_fma_f32 %0, %1, %2, %3" : "=v"(d) : "v"(a), "v"(b), "v"(c)); return d; }
__device__ __forceinline__ f32x2 pkmul_bl(f32x2 s, f32x2 b) { f32x2 d; asm("v_pk_mul_f32 %0, %1, %2 op_sel_hi:[0,1]" : "=v"(d) : "v"(s), "v"(b)); return d; }
__device__ __forceinline__ f32x2 pknfma_bl(f32x2 s, f32x2 b, f32x2 c) { f32x2 d; asm("v_pk_fma_f32 %0, %1, %2, %3 op_sel_hi:[0,1,1] neg_lo:[1,0,0] neg_hi:[1,0,0]" : "=v"(d) : "v"(s), "v"(b), "v"(c)); return d; }
#define VPKMUL(d, a, b) asm volatile("v_pk_mul_f32 %0, %1, %2" : "=v"(d) : "v"(a), "v"(b))
#define VPKFMA(d, a, b, c) asm volatile("v_pk_fma_f32 %0, %1, %2, %3" : "=v"(d) : "v"(a), "v"(b), "v"(c))
#define VPKMULBL(d, s, b) asm volatile("v_pk_mul_f32 %0, %1, %2 op_sel_hi:[0,1]" : "=v"(d) : "v"(s), "v"(b))
#define VPKNFMABL(d, s, b, c) asm volatile("v_pk_fma_f32 %0, %1, %2, %3 op_sel_hi:[0,1,1] neg_lo:[1,0,0] neg_hi:[1,0,0]" : "=v"(d) : "v"(s), "v"(b), "v"(c))
#define VADD(d, a, b) asm volatile("v_add_f32 %0, %1, %2" : "=v"(d) : "v"(a), "v"(b))
#define VDPP1(x) asm volatile("v_add_f32_dpp %0, %0, %0 quad_perm:[1,0,3,2] row_mask:0xf bank_mask:0xf bound_ctrl:1" : "+v"(x))
#define VDPP2(x) asm volatile("v_add_f32_dpp %0, %0, %0 quad_perm:[2,3,0,1] row_mask:0xf bank_mask:0xf bound_ctrl:1" : "+v"(x))
#define VDPP3(x) asm volatile("v_add_f32_dpp %0, %0, %0 row_half_mirror row_mask:0xf bank_mask:0xf bound_ctrl:1" : "+v"(x))
constexpr int RSTR = 68;
constexpr int REC_ARR = 32 * RSTR;
constexpr int REC_BUF = 5 * REC_ARR;
constexpr int L_REC = 0, L_YY = 87040, L_VV = 103424, L_GG = 119808, L_RKP = 136192, L_SSP = 137216, L_STT = 137728, L_CST = 137984;
constexpr int PROWS = 8192;
#define SCAN_BAR do { asm volatile("s_waitcnt lgkmcnt(0)" ::: "memory"); __builtin_amdgcn_s_barrier(); asm volatile("" ::: "memory"); } while (0)
__device__ __forceinline__ void scan_half(const Params& p, LAS unsigned char* lds, int pi, int rh, int pass) {
    OPQ_TID;
    LAS float* REC = (LAS float*)(lds + L_REC); LAS float* YY = (LAS float*)(lds + L_YY); LAS float* VV = (LAS float*)(lds + L_VV); LAS float* GG = (LAS float*)(lds + L_GG);
    LAS float* RKP = (LAS float*)(lds + L_RKP); LAS float* SSP = (LAS float*)(lds + L_SSP); LAS float* STT = (LAS float*)(lds + L_STT); LAS float* CST = (LAS float*)(lds + L_CST);
    const int b = pi >> 5, hg = pi & 31, colg = hg * 64;
    const bf16_t* Rb = (const bf16_t*)(WSP + WS_R); const bf16_t* Kb = Rb + (size_t)PROWS * 2048; bf16_t* Vb = (bf16_t*)(WSP + WS_V); const bf16_t* Gb = Vb + (size_t)PROWS * 2048;
    const bf16_t* LWb = (const bf16_t*)(WSP + WS_LW) + (size_t)pass * PROWS * 64; const bf16_t* LAb = (const bf16_t*)(WSP + WS_LA) + (size_t)pass * PROWS * 64;
    unsigned long long* GR = (unsigned long long*)(WSP + WS_GR);
    const size_t rowb = (size_t)b * 2048;
    __syncthreads();
    if (tid < 64) { CST[tid] = ((const float*)p.in[I_W0])[colg + tid]; CST[64 + tid] = ((const float*)p.in[I_A0])[colg + tid]; CST[128 + tid] = ((const float*)p.in[I_KK])[colg + tid]; CST[192 + tid] = ((const float*)p.in[I_KA])[colg + tid]; CST[256 + tid] = ((const float*)p.in[I_RK])[colg + tid];
                    CST[320 + tid] = ((const float*)p.in[I_LNG])[colg + tid]; CST[384 + tid] = ((const float*)p.in[I_LNB])[colg + tid]; }
    __syncthreads();
    const int fr = lane & 15, fq = lane >> 4;
    if (wave < 4) {
        const int j = lane & 7, rowl = 8 * wave + (lane >> 3);
        float* stp = (float*)(WSP + WS_ST) + ((size_t)(pi * 64 + 32 * rh + rowl)) * 64 + 8 * j;
        f32x2 P01 = (f32x2){0.f, 0.f}, P23 = P01, P45 = P01, P67 = P01;
        if (pass == 1) { const f32x4 a = *(const f32x4*)stp, c = *(const f32x4*)(stp + 4); P01 = a.xy; P23 = a.zw; P45 = c.xy; P67 = c.zw; }
        const bool first = (lane & 7) == 0;
        SCAN_BAR;
        for (int it = 0; it < 66; ++it) {
            if (it < 64) {
                const LAS float* rec = REC + (it & 1) * REC_BUF + 8 * j; const LAS float* vvp = VV + (it & 3) * 1024 + rowl; LAS float* yyp = YY + (it & 3) * 1024 + rowl;
                const LAS float* ssp = SSP + (it & 1) * 64 + 2 * (lane & 31);
                const float inv2 = __builtin_amdgcn_rcpf(fmaxf(ssp[0] + ssp[1], 1e-24f));
                f32x4 Rkk[2][2], Rw[2][2], Rka[2][2], Rkm[2][2], Rr[2][2]; float Rv[2];
#define LOADREC(slot, s) do { const LAS float* rs_ = rec + (s) * RSTR; \
                    Rkk[slot][0] = *(const LAS f32x4*)(rs_); Rkk[slot][1] = *(const LAS f32x4*)(rs_ + 4); Rw[slot][0] = *(const LAS f32x4*)(rs_ + REC_ARR); Rw[slot][1] = *(const LAS f32x4*)(rs_ + REC_ARR + 4); \
                    Rka[slot][0] = *(const LAS f32x4*)(rs_ + 2 * REC_ARR); Rka[slot][1] = *(const LAS f32x4*)(rs_ + 2 * REC_ARR + 4); Rkm[slot][0] = *(const LAS f32x4*)(rs_ + 3 * REC_ARR); Rkm[slot][1] = *(const LAS f32x4*)(rs_ + 3 * REC_ARR + 4); \
                    Rr[slot][0] = *(const LAS f32x4*)(rs_ + 4 * REC_ARR); Rr[slot][1] = *(const LAS f32x4*)(rs_ + 4 * REC_ARR + 4); Rv[slot] = vvp[(s) * 32]; } while (0)
                LOADREC(0, 0);
                float yp = 0.f, yk0 = 0.f, yk1 = 0.f, yk2 = 0.f, yk3 = 0.f;
#define YSHIFT(YK) do { YK = __int_as_float(__builtin_amdgcn_update_dpp(__float_as_int(yp), __float_as_int(YK), 0x111, 0xf, 0xf, false)); YK = first ? yp : YK; } while (0)
#pragma unroll
                for (int s = 0; s < 32; ++s) {
                    const int c = s & 1, pc = c ^ 1;
                    const float si = __int_as_float(__builtin_amdgcn_readlane(__float_as_int(inv2), s));
                    f32x2 px, py, t01, t23, t45, t67; float x;
                    f32x2 vv2; vv2.x = Rv[c]; asm volatile("" : "+v"(vv2));
                    if (s >= 1) {
                        VPKMUL(px, P01, Rkk[c][0].xy); VPKMUL(py, P01, Rr[pc][0].xy); VPKFMA(px, P23, Rkk[c][0].zw, px); VPKFMA(py, P23, Rr[pc][0].zw, py);
                        VPKFMA(px, P45, Rkk[c][1].xy, px); VPKFMA(py, P45, Rr[pc][1].xy, py); VPKFMA(px, P67, Rkk[c][1].zw, px); VPKFMA(py, P67, Rr[pc][1].zw, py);
                        VADD(x, px.x, px.y); VADD(yp, py.x, py.y);
                    } else {
                        VPKMUL(px, P01, Rkk[c][0].xy); VPKFMA(px, P23, Rkk[c][0].zw, px); VPKFMA(px, P45, Rkk[c][1].xy, px); VPKFMA(px, P67, Rkk[c][1].zw, px);
                        VADD(x, px.x, px.y);
                    }
                    asm volatile("" ::: "memory");
                    if (s + 1 < 32) LOADREC((s + 1) & 1, s + 1);
                    asm volatile("" ::: "memory");
                    VPKMULBL(t01, vv2, Rkm[c][0].xy); VPKMULBL(t23, vv2, Rkm[c][0].zw);
                    VDPP1(x); if (s >= 1) VDPP1(yp);
                    VPKMULBL(t45, vv2, Rkm[c][1].xy); VPKMULBL(t67, vv2, Rkm[c][1].zw);
                    VDPP2(x); if (s >= 1) VDPP2(yp);
                    VPKFMA(P01, P01, Rw[c][0].xy, t01); VPKFMA(P23, P23, Rw[c][0].zw, t23);
                    VDPP3(x); if (s >= 1) VDPP3(yp);
                    VPKFMA(P45, P45, Rw[c][1].xy, t45); VPKFMA(P67, P67, Rw[c][1].zw, t67);
                    if (s >= 1) { if (s - 1 < 8) YSHIFT(yk0); else if (s - 1 < 16) YSHIFT(yk1); else if (s - 1 < 24) YSHIFT(yk2); else YSHIFT(yk3); }
                    x = x * si;
                    f32x2 x2; x2.x = x; asm volatile("" : "+v"(x2));
                    VPKNFMABL(P01, x2, Rka[c][0].xy, P01); VPKNFMABL(P23, x2, Rka[c][0].zw, P23); VPKNFMABL(P45, x2, Rka[c][1].xy, P45); VPKNFMABL(P67, x2, Rka[c][1].zw, P67);
                }
                { f32x2 py; VPKMUL(py, P01, Rr[1][0].xy); VPKFMA(py, P23, Rr[1][0].zw, py); VPKFMA(py, P45, Rr[1][1].xy, py); VPKFMA(py, P67, Rr[1][1].zw, py); VADD(yp, py.x, py.y); }
                yp = dpp_add<0xB1>(yp); yp = dpp_add<0x4E>(yp); yp = dpp_add<0x141>(yp); YSHIFT(yk3);
                yyp[(7 - j) * 32] = yk0; yyp[(15 - j) * 32] = yk1; yyp[(23 - j) * 32] = yk2; yyp[(31 - j) * 32] = yk3;
#undef LOADREC
#undef YSHIFT
            }
            SCAN_BAR;
        }
        if (pass == 0) { *(f32x4*)stp = (f32x4){P01.x, P01.y, P23.x, P23.y}; *(f32x4*)(stp + 4) = (f32x4){P45.x, P45.y, P67.x, P67.y}; }
    } else {
        const int pw = wave - 4, tt = pw >> 1, kh = pw & 1;
        bf16x8 aWc[2][2], aAc[2][2];
#pragma unroll
        for (int kt = 0; kt < 2; ++kt)
#pragma unroll
            for (int ks = 0; ks < 2; ++ks) { const size_t o = (size_t)(colg + 32 * kh + 16 * kt + fr) * 64 + 32 * ks + 8 * fq; aWc[kt][ks] = *(const bf16x8*)((const bf16_t*)(WSP + WS_W2T) + o); aAc[kt][ks] = *(const bf16x8*)((const bf16_t*)(WSP + WS_A2T) + o); }
        bf16x8 lwf[2][2], laf[2][2]; u32x2 r2[2][2], k2[2][2];
#define ISSUE(SET, tbx) do { const size_t tok_ = rowb + (tbx) * 32 + 16 * tt + fr; \
            _Pragma("unroll") for (int ks = 0; ks < 2; ++ks) { lwf[SET][ks] = *(const bf16x8*)(LWb + tok_ * 64 + 32 * ks + 8 * fq); laf[SET][ks] = *(const bf16x8*)(LAb + tok_ * 64 + 32 * ks + 8 * fq); } \
            _Pragma("unroll") for (int kt = 0; kt < 2; ++kt) { r2[SET][kt] = *(const u32x2*)(Rb + tok_ * 2048 + colg + 32 * kh + 16 * kt + 4 * fq); k2[SET][kt] = *(const u32x2*)(Kb + tok_ * 2048 + colg + 32 * kh + 16 * kt + 4 * fq); } } while (0)
        ISSUE(0, 0); ISSUE(1, 1);
        const int t = lane >> 1, hf = lane & 1;
        const size_t vgo = (size_t)colg + 32 * rh + 16 * hf;
        u32x4 v8a = (u32x4){0u, 0u, 0u, 0u}, v8b = v8a, g8a = v8a, g8b = v8a;
        if (pw == 2) { const size_t eo = (rowb + t) * 2048 + vgo; v8a = *(const u32x4*)(Vb + eo); v8b = *(const u32x4*)(Vb + eo + 8); g8a = *(const u32x4*)(Gb + eo); g8b = *(const u32x4*)(Gb + eo + 8); }
        unsigned long long gx[2] = {0ull, 0ull};
#define PROD_ITER(it, PS) do { \
            { const int tb = (it) + 1; \
              if (tb < 64) { \
                LAS float* rec = REC + (tb & 1) * REC_BUF + (16 * tt + fr) * RSTR + 32 * kh + 4 * fq; \
                float ss = 0.f, rkp = 0.f; \
                _Pragma("unroll") for (int kt = 0; kt < 2; ++kt) { \
                    f32x4 accW = (f32x4){0.f, 0.f, 0.f, 0.f}, accA = (f32x4){0.f, 0.f, 0.f, 0.f}; \
                    _Pragma("unroll") for (int ks = 0; ks < 2; ++ks) { accW = MFMA16(aWc[kt][ks], lwf[PS][ks], accW); accA = MFMA16(aAc[kt][ks], laf[PS][ks], accA); } \
                    const int kc = 32 * kh + 16 * kt + 4 * fq; \
                    const f32x4 w0v = *(const LAS f32x4*)(CST + kc), a0v = *(const LAS f32x4*)(CST + 64 + kc), kkc = *(const LAS f32x4*)(CST + 128 + kc), kac = *(const LAS f32x4*)(CST + 192 + kc), rkc = *(const LAS f32x4*)(CST + 256 + kc); \
                    const f32x4 r4 = bf4(r2[PS][kt]), k4 = bf4(k2[PS][kt]); \
                    f32x4 w4, a4; \
                    _Pragma("unroll") for (int e = 0; e < 4; ++e) { w4[e] = __expf(-0.60653066f * sigmf(accW[e] + w0v[e])); a4[e] = sigmf(accA[e] + a0v[e]); } \
                    const f32x4 kkr = k4 * kkc; ss += (kkr.x * kkr.x + kkr.y * kkr.y) + (kkr.z * kkr.z + kkr.w * kkr.w); \
                    const f32x4 km = k4 * (1.0f + (a4 - 1.0f) * kac); const f32x4 rr = r4 * km * rkc; rkp += (rr.x + rr.y) + (rr.z + rr.w); \
                    *(LAS f32x4*)(rec + 16 * kt) = kkr; *(LAS f32x4*)(rec + REC_ARR + 16 * kt) = w4; *(LAS f32x4*)(rec + 2 * REC_ARR + 16 * kt) = kkr * a4; *(LAS f32x4*)(rec + 3 * REC_ARR + 16 * kt) = km; *(LAS f32x4*)(rec + 4 * REC_ARR + 16 * kt) = r4; \
                } \
                if (tb + 2 < 64) ISSUE(PS, tb + 2); \
                ss += __shfl_xor(ss, 16); ss += __shfl_xor(ss, 32); rkp += __shfl_xor(rkp, 16); rkp += __shfl_xor(rkp, 32); \
                if (fq == 0) { SSP[(tb & 1) * 64 + 2 * (16 * tt + fr) + kh] = ss; RKP[(tb & 3) * 64 + 2 * (16 * tt + fr) + kh] = rkp; } \
              } \
              if (pw == 2 && tb < 64) { \
                LAS float* vp = VV + (tb & 3) * 1024 + t * 32 + 16 * hf; LAS float* gp = GG + (tb & 3) * 1024 + t * 32 + 16 * hf; \
                *(LAS f32x4*)(vp) = bf4((u32x2){v8a.x, v8a.y}); *(LAS f32x4*)(vp + 4) = bf4((u32x2){v8a.z, v8a.w}); *(LAS f32x4*)(vp + 8) = bf4((u32x2){v8b.x, v8b.y}); *(LAS f32x4*)(vp + 12) = bf4((u32x2){v8b.z, v8b.w}); \
                *(LAS f32x4*)(gp) = bf4((u32x2){g8a.x, g8a.y}); *(LAS f32x4*)(gp + 4) = bf4((u32x2){g8a.z, g8a.w}); *(LAS f32x4*)(gp + 8) = bf4((u32x2){g8b.x, g8b.y}); *(LAS f32x4*)(gp + 12) = bf4((u32x2){g8b.z, g8b.w}); \
                if (tb + 1 < 64) { const size_t eo = (rowb + (tb + 1) * 32 + t) * 2048 + vgo; v8a = *(const u32x4*)(Vb + eo); v8b = *(const u32x4*)(Vb + eo + 8); g8a = *(const u32x4*)(Gb + eo); g8b = *(const u32x4*)(Gb + eo + 8); } \
              } \
            } \
            if (pw == 3) { \
              if ((it) >= 2 && (it) <= 65) { const int tb = (it) - 2; const unsigned long long* g = GR + ((size_t)(pi * 8 + (tb & 7)) * 2) * 64 + lane; \
                gx[0] = __hip_atomic_load(g, __ATOMIC_RELAXED, __HIP_MEMORY_SCOPE_AGENT); gx[1] = __hip_atomic_load(g + 64, __ATOMIC_RELAXED, __HIP_MEMORY_SCOPE_AGENT); } \
              if ((it) >= 1 && (it) <= 64) { const int tb = (it) - 1; const LAS float* yp_ = YY + (tb & 3) * 1024 + t * 32 + 16 * hf; float s1 = 0.f, s2 = 0.f; \
                _Pragma("unroll") for (int qd = 0; qd < 4; ++qd) { const f32x4 a = *(const LAS f32x4*)(yp_ + 4 * qd); s1 += (a.x + a.y) + (a.z + a.w); s2 += (a.x * a.x + a.y * a.y) + (a.z * a.z + a.w * a.w); } \
                s1 = dpp_add<0xB1>(s1); s2 = dpp_add<0xB1>(s2); \
                const unsigned epoch = (unsigned)(pass * 64 + tb + 1); \
                __hip_atomic_store(GR + ((size_t)((pi * 8 + (tb & 7)) * 2 + rh) * 64 + hf * 32 + t), ((unsigned long long)epoch << 32) | (unsigned long long)__float_as_uint(hf ? s2 : s1), __ATOMIC_RELAXED, __HIP_MEMORY_SCOPE_AGENT); } \
              if ((it) >= 2 && (it) <= 65) { const int tb = (it) - 2; const unsigned epoch = (unsigned)(pass * 64 + tb + 1); \
                const unsigned long long* g = GR + ((size_t)(pi * 8 + (tb & 7)) * 2) * 64 + lane; float tot; \
                for (unsigned spins = 0;; ++spins) { const bool ok = ((unsigned)(gx[0] >> 32) == epoch) && ((unsigned)(gx[1] >> 32) == epoch); tot = __uint_as_float((unsigned)gx[0]) + __uint_as_float((unsigned)gx[1]); \
                    if (__all(ok) || spins > (1u << 22)) break; \
                    __builtin_amdgcn_s_sleep(1); \
                    gx[0] = __hip_atomic_load(g, __ATOMIC_RELAXED, __HIP_MEMORY_SCOPE_AGENT); gx[1] = __hip_atomic_load(g + 64, __ATOMIC_RELAXED, __HIP_MEMORY_SCOPE_AGENT); } \
                const float oth = __shfl_xor(tot, 32); \
                const float mean = (lane < 32 ? tot : oth) * (1.0f / 64.0f), ex2 = (lane < 32 ? oth : tot) * (1.0f / 64.0f); \
                const float rstd = rsqrtf(fmaxf(ex2 - mean * mean, 0.f) + 64e-5f); \
                if (lane < 32) { STT[2 * lane] = mean; STT[2 * lane + 1] = rstd; } \
                const float mu = STT[2 * t], rsd = STT[2 * t + 1]; \
                const int ro = (tb & 3) * 1024 + t * 32 + 16 * hf; const float rk = RKP[(tb & 3) * 64 + 2 * t] + RKP[(tb & 3) * 64 + 2 * t + 1]; \
                unsigned ow[8]; \
                _Pragma("unroll") for (int qd = 0; qd < 4; ++qd) { const f32x4 lg = *(const LAS f32x4*)(CST + 320 + 32 * rh + 16 * hf + 4 * qd), lb = *(const LAS f32x4*)(CST + 384 + 32 * rh + 16 * hf + 4 * qd); \
                    const f32x4 o = ((*(const LAS f32x4*)(YY + ro + 4 * qd) - mu) * rsd * lg + lb + rk * *(const LAS f32x4*)(VV + ro + 4 * qd)) * *(const LAS f32x4*)(GG + ro + 4 * qd); \
                    ow[2 * qd] = pk2(o.x, o.y); ow[2 * qd + 1] = pk2(o.z, o.w); } \
                bf16_t* dst = (bf16_t*)(WSP + WS_A2) + ((size_t)pass * PROWS + rowb + tb * 32 + t) * 2048 + vgo; \
                *(u32x4*)(dst) = (u32x4){ow[0], ow[1], ow[2], ow[3]}; *(u32x4*)(dst + 8) = (u32x4){ow[4], ow[5], ow[6], ow[7]}; } \
            } \
            SCAN_BAR; } while (0)
        for (int it2 = -1; it2 < 65; it2 += 2) { PROD_ITER(it2, 0); PROD_ITER(it2 + 1, 1); }
        PROD_ITER(65, 0);
#undef PROD_ITER
#undef ISSUE
    }
}
__device__ __forceinline__ void p10_final(const Params& p, int G, int bid) {
    OPQ_TID; const int gw = bid * 8 + wave, ngw = G * 8;
    for (int m = gw; m < T; m += ngw) { float* xr = ((float*)p.out) + (size_t)m * D; f32x4 v[4]; float s = 0.f;
#pragma unroll
        for (int j = 0; j < 4; ++j) { v[j] = *((const f32x4*)xr + lane + 64 * j); s += (v[j].x * v[j].x + v[j].y * v[j].y) + (v[j].z * v[j].z + v[j].w * v[j].w); }
        const float rs = rsqrtf(wave_sum(s) * (1.0f / 1024.0f) + 1e-6f);
#pragma unroll
        for (int j = 0; j < 4; ++j) { const f32x4 gg = *((const f32x4*)((const float*)p.in[I_FG]) + lane + 64 * j); *((f32x4*)xr + lane + 64 * j) = v[j] * rs * gg; } }
}

#define XB_TMO      128
#define XB_XCNT(j)  (256  + 64 * (j))
#define XB_XSUB(j)  (1280 + 64 * (j))
#define XB_XGEN(j)  (2304 + 64 * (j))
#define XB_TOP      3328
#define XB_TOPGEN   3392
#define XCD_BAR_WORDS 3456
#define XB_SPIN_CAP (1u << 18)

__device__ __forceinline__ unsigned xb_ld(unsigned* p)              { return __hip_atomic_load(p, __ATOMIC_RELAXED, __HIP_MEMORY_SCOPE_AGENT); }
__device__ __forceinline__ unsigned xb_add(unsigned* p, unsigned v) { return __hip_atomic_fetch_add(p, v, __ATOMIC_RELAXED, __HIP_MEMORY_SCOPE_AGENT); }
__device__ __forceinline__ unsigned xb_xcc_id() { return (unsigned)__builtin_amdgcn_s_getreg((3 << 11) | 20) & 0xFu; }
#define XB_SPIN(cond, bar) do { unsigned _sp = 0; while (cond) { __builtin_amdgcn_s_sleep(1); \
    if ((++_sp & 255u) == 0u) { if (xb_ld(&(bar)[XB_TMO])) break; if (_sp > XB_SPIN_CAP) { atomicAdd(&(bar)[XB_TMO], 1u); break; } } } } while (0)

struct XcdBarrier {
    unsigned* bar; unsigned x;
    volatile LAS unsigned* st;
};

__device__ __forceinline__ XcdBarrier xcd_barrier_post(unsigned* bar, volatile LAS unsigned* st) {
    XcdBarrier b; b.bar = bar; b.x = xb_xcc_id(); b.st = st;
    if (threadIdx.x == 0) (void)xb_add(&bar[XB_XCNT(b.x)], 1u);
    return b;
}
__device__ __forceinline__ void xcd_barrier_complete(unsigned* bar, unsigned x, unsigned& nloc, unsigned& nx) {
    const unsigned G = gridDim.x * gridDim.y * gridDim.z;
    unsigned sum, cnt, mine, sp = 0u;
    for (;;) {
        sum = 0u; cnt = 0u; mine = 0u;
#pragma unroll
        for (unsigned j = 0; j < 16; ++j) { const unsigned c = xb_ld(&bar[XB_XCNT(j)]); sum += c; cnt += (c > 0u) ? 1u : 0u; mine = (j == x) ? c : mine; }
        if (sum == G) break;
        __builtin_amdgcn_s_sleep(1);
        if ((++sp & 255u) == 0u) { if (xb_ld(&bar[XB_TMO])) break; if (sp > XB_SPIN_CAP) { atomicAdd(&bar[XB_TMO], 1u); break; } }
    }
    nloc = mine > 0u ? mine : 1u; nx = cnt > 0u ? cnt : 1u;
}

__device__ __forceinline__ void xcd_barrier(const XcdBarrier& b) {
    asm volatile("s_waitcnt vmcnt(0)" ::: "memory");
    __syncthreads();
    if (threadIdx.x == 0) {
        unsigned* bar = (unsigned*)(*(volatile LAS unsigned long long*)(b.st + 4)); const unsigned bx_ = xb_xcc_id();
        __builtin_amdgcn_s_waitcnt(0);
        unsigned nloc = b.st[0], nx = b.st[1];
        if (nloc == 0u) { xcd_barrier_complete(bar, bx_, nloc, nx); b.st[0] = nloc; b.st[1] = nx; }
        const unsigned old = xb_add(&bar[XB_XSUB(bx_)], 1u);
        const unsigned gen = old / nloc;
        if (old + 1u == (gen + 1u) * nloc) {
            __builtin_amdgcn_fence(__ATOMIC_RELEASE, "agent");
            asm volatile("s_waitcnt vmcnt(0)" ::: "memory");
            const unsigned og = xb_add(&bar[XB_TOP], 1u);
            const unsigned tg = og / nx;
            if (og + 1u == (tg + 1u) * nx) xb_add(&bar[XB_TOPGEN], 1u);
            else XB_SPIN(xb_ld(&bar[XB_TOPGEN]) == tg, bar);
            __builtin_amdgcn_fence(__ATOMIC_ACQUIRE, "agent");
            xb_add(&bar[XB_XGEN(bx_)], 1u);
            asm volatile("s_waitcnt vmcnt(0)" ::: "memory");
        } else {
            XB_SPIN(xb_ld(&bar[XB_XGEN(bx_)]) == gen, bar);
            __builtin_amdgcn_fence(__ATOMIC_ACQUIRE, "agent");
            asm volatile("s_waitcnt vmcnt(0)" ::: "memory");
        }
    }
    __syncthreads();
}

__global__ void __launch_bounds__(NT, 2) mk_fwd(Params p) {
    auto wsl = [&]() { return launder_ws(((unsigned char*)p.ws)); };
    extern __shared__ __attribute__((aligned(16))) unsigned char lds_raw[];
    LAS unsigned char* lds = (LAS unsigned char*)lds_raw;
    cg::grid_group grid = cg::this_grid();
    const int G = gridDim.x, bid = blockIdx.x;
    if (threadIdx.x < 16) ((LAS unsigned*)(lds + LDS_MISC))[threadIdx.x] = 0u;
    __syncthreads();
    if (threadIdx.x == 0) *(LAS unsigned long long*)(lds + LDS_MISC + 16) = (unsigned long long)(((unsigned char*)p.ws) + WS_BAR);
    __syncthreads();
    if (bid == 0) for (int i = threadIdx.x; i < 4096; i += NT) ((unsigned*)(((unsigned char*)p.ws) + WS_BAR))[i] = 0u;
#define XBAR() do { XcdBarrier xb_; xb_.bar = nullptr; xb_.x = 0u; xb_.st = (volatile LAS unsigned*)(lds + LDS_MISC); xcd_barrier(xb_); } while (0)
#if PROBE == 7
    p0_prologue(p, lds, G, bid);
#endif
    p0_prologue(p, lds, G, bid);
    grid.sync();
    (void)xcd_barrier_post((unsigned*)(((unsigned char*)p.ws) + WS_BAR), (volatile LAS unsigned*)(lds + LDS_MISC));
    { pg8::Gemm g{(const bf16_t*)((float*)p.out), (const bf16_t*)(wsl() + WS_WIN), T, ZW, D, D}; pg8::StaticOrder S; S.init(T, ZW, G, bid); pg8::EpiBf16 E{(bf16_t*)(wsl() + WS_Z), ZW};
      pg8::gemm_phase<pg8::EpiBf16, pg8::StaticOrder, true, true>(lds, g, S, E); }
    XBAR();
#if PROBE == 3
    { u32x4 pre[3]; if (bid < 2048) rg_a_prefetch((const bf16_t*)(wsl() + WS_Z), bid, threadIdx.x, pre); for (int u = bid; u < 2048; u += G) rg_a_unit(p, lds, u, u + G, pre); }
    { u32x4 pre[6]; if (bid < 2048) hg_a_prefetch((const bf16_t*)(wsl() + WS_Z), bid, threadIdx.x, pre); for (int u = bid; u < 2048; u += G) hg_a_unit(p, lds, u, u + G, pre); }
    XBAR();
#endif
    { u32x4 pre[3]; if (bid < 2048) rg_a_prefetch((const bf16_t*)(wsl() + WS_Z), bid, threadIdx.x, pre); for (int u = bid; u < 2048; u += G) rg_a_unit(p, lds, u, u + G, pre); }
    { u32x4 pre[6]; if (bid < 2048) hg_a_prefetch((const bf16_t*)(wsl() + WS_Z), bid, threadIdx.x, pre); for (int u = bid; u < 2048; u += G) hg_a_unit(p, lds, u, u + G, pre); }
    XBAR();
#if PROBE == 2
    for (int u = bid; u < 256; u += G) hg_b_item(p, lds, u, p.dry != 0);
    XBAR();
#endif
#if PROBE == 6
    for (int u = bid; u < 512; u += G) rg_b_unit(p, u);
    XBAR();
#endif
#if PROBE == 4
    for (int q = 0; q < 16; ++q) XBAR();
#endif
    for (int u = bid; u < 256; u += G) { const int it_ = (G == 256) ? ((((u & 7) + 8 * (u >> 6)) << 3) | ((u >> 3) & 7)) : u; hg_b_item(p, lds, it_); }
    for (int u = bid; u < 512; u += G) rg_b_unit(p, u);
    XBAR();
#if PROBE == 8
    p4_finalize(p, G, bid);
#endif
    p4_finalize(p, G, bid);
    XBAR();
    { pg8::Gemm g{(const bf16_t*)(wsl() + WS_Z), (const bf16_t*)(wsl() + WS_WOUT), T, D, 2048, ZW}; pg8::StaticOrder S; S.init(T, D, G, bid); pg8::EpiResF32 E{((const float*)p.in[I_X]), ((float*)p.out), D, 0, 0};
      pg8::gemm_phase<pg8::EpiResF32, pg8::StaticOrder, true, true>(lds, g, S, E); }
    XBAR();
#if PROBE == 9
    p6_prologue(p, lds, G, bid);
#endif
    p6_prologue(p, lds, G, bid);
    XBAR();
#pragma unroll 1
    for (int pass = 0; pass < 2; ++pass) {
        { pg8::Gemm g{(const bf16_t*)(wsl() + WS_A2) + (size_t)pass * 8192 * 2048, (const bf16_t*)(wsl() + WS_WC), 8192, 8192, 2048, 2048}; pg8::StaticOrder S; S.init(8192, 8192, G, bid);
          pg8::EpiL1 E{(bf16_t*)(wsl() + WS_R), (bf16_t*)(wsl() + WS_LW), (bf16_t*)(wsl() + WS_LA)};
          pg8::gemm_phase<pg8::EpiL1, pg8::StaticOrder, true, true>(lds, g, S, E); }
        XBAR();
        for (int u0 = 0; u0 < 256; u0 += G) { const int u = u0 + bid; if (u < 256) { int pi, rh; if (G == 256) { pi = (u & 7) + 8 * (u >> 4); rh = (u >> 3) & 1; } else { pi = u >> 1; rh = u & 1; } scan_half(p, lds, pi, rh, pass); } }
        XBAR();
    }
    if (G == 256) {
        pg8::Gemm g{(const bf16_t*)(wsl() + WS_A2), (const bf16_t*)(wsl() + WS_WO), T, D, 2048, 2048}; pg8::StaticOrder S; S.init(T, D, G, bid); pg8::EpiFinalNorm E{((float*)p.out), ((const float*)p.in[I_FG]), (unsigned long long*)(wsl() + WS_XG), D};
        pg8::gemm_phase<pg8::EpiFinalNorm, pg8::StaticOrder, false, true>(lds, g, S, E);
    } else {
        { pg8::Gemm g{(const bf16_t*)(wsl() + WS_A2), (const bf16_t*)(wsl() + WS_WO), T, D, 2048, 2048}; pg8::StaticOrder S; S.init(T, D, G, bid); pg8::EpiResF32 E{((float*)p.out), ((float*)p.out), D, 1, 0};
          pg8::gemm_phase<pg8::EpiResF32, pg8::StaticOrder, true, true>(lds, g, S, E); }
        XBAR();
        p10_final(p, G, bid);
    }
}

extern "C" void kernel_launch(void* const* d_in, const int* in_sizes, int n_in, void* d_out, int out_size, void* d_ws, size_t ws_size, hipStream_t stream) {
    static int grid = 0;
    if (grid == 0) {
        int dev = 0, cus = 0, per_cu = 0;
        if (n_in != 32 || out_size != T * D || ws_size < 256 * MiB) { fprintf(stderr, "kernel_launch: unexpected shapes (n_in %d out %d ws %zu)\n", n_in, out_size, ws_size); grid = -1; return; }
        if (hipGetDevice(&dev) != hipSuccess || hipDeviceGetAttribute(&cus, hipDeviceAttributeMultiprocessorCount, dev) != hipSuccess) { grid = -1; return; }
        if (hipFuncSetAttribute((const void*)mk_fwd, hipFuncAttributeMaxDynamicSharedMemorySize, LDS_BYTES) != hipSuccess) { fprintf(stderr, "hipFuncSetAttribute failed\n"); grid = -1; return; }
        if (hipOccupancyMaxActiveBlocksPerMultiprocessor(&per_cu, (const void*)mk_fwd, NT, LDS_BYTES) != hipSuccess || per_cu < 1) fprintf(stderr, "occupancy query: %d\n", per_cu);
        (void)hipGetLastError();
        grid = cus;
    }
    if (grid < 0) return;
    Params p{};
    p.dry = 1;
    for (int i = 0; i < 32; ++i) memcpy(&p.in[i], &d_in[i], sizeof(void*));
    memcpy(&p.out, &d_out, sizeof(void*)); memcpy(&p.ws, &d_ws, sizeof(void*));
    void* args[] = {&p};
    hipError_t e = hipLaunchCooperativeKernel((const void*)mk_fwd, dim3(grid), dim3(NT), args, LDS_BYTES, stream);
    if (e != hipSuccess) fprintf(stderr, "cooperative launch failed: %s (grid %d)\n", hipGetErrorString(e), grid);
}
```

```cpp
#define PROBE 0
#include <hip/hip_runtime.h>
#include <hip/hip_cooperative_groups.h>
#include <cstdio>
#include <cstring>
#include <cstdint>
namespace cg = cooperative_groups;
namespace pg8 {
#define PG8_LAS __attribute__((address_space(3)))
typedef unsigned short bf16_t;
typedef short bf16x8 __attribute__((ext_vector_type(8)));
typedef float f32x4 __attribute__((ext_vector_type(4)));
typedef unsigned u32x4 __attribute__((ext_vector_type(4)));
constexpr int BM = 256, BK = 64, HALF = 128, HTB = HALF * BK * 2  , STAGE_BYTES = 8 * HTB, NXCD = 8, WGM = 8;

__host__ __device__ __forceinline__ int lds_byte(int r, int c) { const int st = (r >> 4) * 2 + (c >> 5), rr = r & 15, cc = c & 31, ob = rr * 64 + cc * 2; return st * 1024 + (ob ^ (((ob >> 9) & 1) << 5)); }
__host__ __device__ __forceinline__ void stage_rc(int b, int& R, int& C) { const int st = b / 1024, sb = b % 1024, swz = sb ^ (((sb >> 9) & 1) << 5); R = (st >> 1) * 16 + swz / 64; C = (st & 1) * 32 + (swz % 64) / 2; }
__host__ __device__ __forceinline__ int perm32(int rho) { const int n = rho >> 4, i = rho & 15; return 8 * (i >> 2) + 4 * n + (i & 3); }

struct Unit { int pm, pn; };
struct Gemm { const bf16_t* A; const bf16_t* Bt; int M, N, K, lda; };

struct StaticOrder {
    int nM, nN, nwg, G, c;
    __host__ __device__ void init(int M, int N, int G_, int c_) { nM = M / BM; nN = N / BM; nwg = nM * nN; G = G_; c = c_; }
    __host__ __device__ bool next(int i, Unit& u) const {
        const long L = (long)i * G + c; if (L >= nwg) return false;
        int wgid = (int)L; { const int q = nwg / NXCD, r = nwg % NXCD, xcd = wgid % NXCD, off = wgid / NXCD; wgid = (xcd < r ? xcd * (q + 1) : r * (q + 1) + (xcd - r) * q) + off; }
        const int nig = WGM * nN, gid = wgid / nig, fm = gid * WGM, gsz = (nM - fm) < WGM ? (nM - fm) : WGM;
        u.pm = fm + ((wgid % nig) % gsz); u.pn = (wgid % nig) / gsz; return true;
    }
    __device__ __forceinline__ void a_ready(const Unit&) const {}
    __device__ __forceinline__ void done(const Unit&) const {}
};


struct LoraOrder {
    StaticOrder so; int extra;
    __host__ __device__ void init(int M, int N, int G_, int c_, int extra_) { so.init(M, N, G_, c_); extra = extra_; }
    __host__ __device__ bool next(int i, Unit& u) const { const long L = (long)i * so.G + so.c; if (L < so.nwg) return so.next(i, u); if (L >= so.nwg + extra) return false; u.pm = so.nM + (int)(L - so.nwg); u.pn = so.nN - 1; return true; }
    __device__ __forceinline__ void a_ready(const Unit&) const {}
    __device__ __forceinline__ void done(const Unit&) const {}
};
__device__ __forceinline__ unsigned cvt_pk_bf16(float lo, float hi) { unsigned r; asm volatile("v_cvt_pk_bf16_f32 %0, %1, %2" : "=v"(r) : "v"(lo), "v"(hi)); return r; }
__device__ __forceinline__ float sigm(float x) { return __builtin_amdgcn_rcpf(1.0f + __expf(-x)); }
struct EpiBf16 {
    static constexpr bool PERM = true, AFTER_DRAIN = false;
    bf16_t* O; int ldc;
    __device__ __forceinline__ void operator()(const f32x4 (&acc)[2][2][4][2], const Unit& u, int wr, int wc, int fr, int fq) const {
        const int row0 = u.pm * BM + wr * 64 + fr; const int col0 = u.pn * BM + wc * 32 + 8 * fq;
#pragma unroll
        for (int ai = 0; ai < 2; ++ai)
#pragma unroll
            for (int m = 0; m < 4; ++m) { bf16_t* rowp = O + (size_t)(row0 + ai * HALF + m * 16) * ldc + col0;
#pragma unroll
                for (int bj = 0; bj < 2; ++bj) { const f32x4 v0 = acc[ai][bj][m][0], v1 = acc[ai][bj][m][1];
                    u32x4 w; w.x = cvt_pk_bf16(v0[0], v0[1]); w.y = cvt_pk_bf16(v0[2], v0[3]); w.z = cvt_pk_bf16(v1[0], v1[1]); w.w = cvt_pk_bf16(v1[2], v1[3]);
                    *(u32x4*)(rowp + bj * HALF) = w; } }
    }
};
struct EpiResF32 {
    static constexpr bool PERM = false, AFTER_DRAIN = false;
    const float* base; float* out; int ldc; int remap; int pass;
    __device__ __forceinline__ void operator()(const f32x4 (&acc)[2][2][4][2], const Unit& u, int wr, int wc, int fr, int fq) const {
        const int col0 = u.pn * BM + wc * 32 + 4 * fq; const int rbase = remap ? ((((u.pm >> 3) & 3) << 12) + (u.pm >> 5) * 2048 + (u.pm & 7) * BM) : u.pm * BM;
#pragma unroll
        for (int ai = 0; ai < 2; ++ai)
#pragma unroll
            for (int m = 0; m < 4; ++m) { const size_t off = (size_t)(rbase + ai * HALF + wr * 64 + m * 16 + fr) * ldc + col0;
#pragma unroll
                for (int bj = 0; bj < 2; ++bj)
#pragma unroll
                    for (int n = 0; n < 2; ++n) { const f32x4 bs = __builtin_nontemporal_load((const f32x4*)(base + off + bj * HALF + n * 16)); *(f32x4*)(out + off + bj * HALF + n * 16) = bs + acc[ai][bj][m][n]; } }
    }
};
struct EpiL1 {
    static constexpr bool PERM = true, AFTER_DRAIN = false;
    bf16_t* R; bf16_t* LW; bf16_t* LA;
    __device__ __forceinline__ void operator()(const f32x4 (&acc)[2][2][4][2], const Unit& u, int wr, int wc, int fr, int fq) const {
        const int row0 = u.pm * BM + wr * 64 + fr;
        if (u.pn < 32) {
            const int buf = u.pn >> 3; bf16_t* base = R + (size_t)buf * (8192u * 2048u); const int col0 = (u.pn & 7) * BM + wc * 32 + 8 * fq;
#pragma unroll
            for (int ai = 0; ai < 2; ++ai)
#pragma unroll
                for (int m = 0; m < 4; ++m) { bf16_t* rowp = base + (size_t)(row0 + ai * HALF + m * 16) * 2048 + col0;
#pragma unroll
                    for (int bj = 0; bj < 2; ++bj) { f32x4 v0 = acc[ai][bj][m][0], v1 = acc[ai][bj][m][1];
                        if (buf == 3) {
#pragma unroll
                            for (int q = 0; q < 4; ++q) { v0[q] = v0[q] * sigm(v0[q]); v1[q] = v1[q] * sigm(v1[q]); } }
                        u32x4 w; w.x = cvt_pk_bf16(v0[0], v0[1]); w.y = cvt_pk_bf16(v0[2], v0[3]); w.z = cvt_pk_bf16(v1[0], v1[1]); w.w = cvt_pk_bf16(v1[2], v1[3]);
                        *(u32x4*)(rowp + bj * HALF) = w; } }
        } else {
            const int c0 = wc * 32 + 8 * fq;
#pragma unroll
            for (int ai = 0; ai < 2; ++ai)
#pragma unroll
                for (int m = 0; m < 4; ++m) { const size_t row = (size_t)(row0 + ai * HALF + m * 16); f32x4 v0 = acc[ai][0][m][0], v1 = acc[ai][0][m][1];
                    if (c0 < 64) {
#pragma unroll
                        for (int q = 0; q < 4; ++q) { v0[q] = tanhf(v0[q]); v1[q] = tanhf(v1[q]); } }
                    u32x4 w; w.x = cvt_pk_bf16(v0[0], v0[1]); w.y = cvt_pk_bf16(v0[2], v0[3]); w.z = cvt_pk_bf16(v1[0], v1[1]); w.w = cvt_pk_bf16(v1[2], v1[3]);
                    if (c0 < 64) *(u32x4*)(LW + row * 64 + c0) = w; else *(u32x4*)(LA + row * 64 + c0 - 64) = w; }
        }
    }
};

struct EpiFinalNorm {
    static constexpr bool PERM = false, AFTER_DRAIN = true;
    float* out; const float* g; unsigned long long* xg; int ldc;
    __device__ __forceinline__ void fused(f32x4 (&acc)[2][2][4][2], const Unit& u, int wr, int wc, int fr, int fq, PG8_LAS unsigned char* lds, int wid, int lane) const {
        PG8_LAS float* P = (PG8_LAS float*)lds; PG8_LAS float* S = (PG8_LAS float*)(lds + 4096);
        const int col0 = u.pn * BM + wc * 32 + 4 * fq; const int rbase = (((u.pm >> 3) & 3) << 12) + (u.pm >> 5) * 2048 + (u.pm & 7) * BM;
#pragma unroll
        for (int ai = 0; ai < 2; ++ai)
#pragma unroll
            for (int m = 0; m < 4; ++m) { const size_t off = (size_t)(rbase + ai * HALF + wr * 64 + m * 16 + fr) * ldc + col0; float s = 0.f;
#pragma unroll
                for (int bj = 0; bj < 2; ++bj)
#pragma unroll
                    for (int n = 0; n < 2; ++n) { const f32x4 v = acc[ai][bj][m][n] + __builtin_nontemporal_load((const f32x4*)(out + off + bj * HALF + n * 16)); acc[ai][bj][m][n] = v; s += (v[0] * v[0] + v[1] * v[1]) + (v[2] * v[2] + v[3] * v[3]); }
                s += __shfl_xor(s, 16); s += __shfl_xor(s, 32);
                if (fq == 0) P[(ai * HALF + wr * 64 + m * 16 + fr) * 4 + wc] = s; }
        asm volatile("s_waitcnt lgkmcnt(0)" ::: "memory"); __builtin_amdgcn_s_barrier(); asm volatile("" ::: "memory");
        const int row = wid * 32 + (lane & 31);
        if (lane < 32) { const float tot = (P[row * 4] + P[row * 4 + 1]) + (P[row * 4 + 2] + P[row * 4 + 3]);
            __hip_atomic_store(xg + ((size_t)(u.pm * 4 + u.pn) * 256 + row), (1ull << 32) | (unsigned long long)__float_as_uint(tot), __ATOMIC_RELAXED, __HIP_MEMORY_SCOPE_AGENT); }
        {
            float tot = 0.f;
            for (unsigned spins = 0;; ++spins) { bool ok = true; tot = 0.f;
                if (lane < 32) {
#pragma unroll
                    for (int q = 0; q < 4; ++q) { const unsigned long long x = __hip_atomic_load(xg + ((size_t)(u.pm * 4 + q) * 256 + row), __ATOMIC_RELAXED, __HIP_MEMORY_SCOPE_AGENT); ok &= (unsigned)(x >> 32) == 1u; tot += __uint_as_float((unsigned)x); } }
                if (__all(ok) || spins > (1u << 22)) break;
                __builtin_amdgcn_s_sleep(1); }
            if (lane < 32) S[row] = rsqrtf(tot * (1.0f / 1024.0f) + 1e-6f);
        }
        asm volatile("s_waitcnt lgkmcnt(0)" ::: "memory"); __builtin_amdgcn_s_barrier(); asm volatile("" ::: "memory");
#pragma unroll
        for (int ai = 0; ai < 2; ++ai)
#pragma unroll
            for (int m = 0; m < 4; ++m) { const int r = ai * HALF + wr * 64 + m * 16 + fr; const float rs = S[r]; const size_t off = (size_t)(rbase + r) * ldc + col0;
#pragma unroll
                for (int bj = 0; bj < 2; ++bj)
#pragma unroll
                    for (int n = 0; n < 2; ++n) { const f32x4 gg = *(const f32x4*)(g + col0 + bj * HALF + n * 16); __builtin_nontemporal_store(acc[ai][bj][m][n] * rs * gg, (f32x4*)(out + off + bj * HALF + n * 16)); } }
    }
};
template <class Epi, class Sched, bool ALIGN_EPI = false, bool SP2 = false>
__device__ __forceinline__ void gemm_phase(PG8_LAS unsigned char* lds, const Gemm g, const Sched& S, const Epi& E) {
    int tid_o = threadIdx.x; asm volatile("" : "+v"(tid_o)); const int tid = tid_o, wid = __builtin_amdgcn_readfirstlane(tid >> 6), lane = tid & 63, wr = wid >> 2, wc = wid & 3, fr = lane & 15, fq = lane >> 4;
    const int K = g.K, nt = K / BK;
    unsigned voffA[2], voffB[2];
#pragma unroll
    for (int i = 0; i < 2; ++i) { int R, C; stage_rc(tid * 16 + i * 8192, R, C); const int Rb = Epi::PERM ? ((R & ~31) + perm32(R & 31)) : R;
        voffA[i] = (unsigned)(R * g.lda + C) * 2u; voffB[i] = (unsigned)(Rb * K + C) * 2u; }
    const size_t kstep = (size_t)(BK * 2);
    const size_t hstep = (size_t)HALF * K * 2;
    const size_t tstep = 2 * hstep; const size_t hstepA = (size_t)HALF * g.lda * 2, tstepA = 2 * hstepA;
    const unsigned ldsw = (unsigned)wid * 1024u;
    const int aoff = lds_byte(wr * 64 + fr, fq * 8), boff = lds_byte(wc * 32 + fr, fq * 8);
#define PG8_SA(b, h) (((b) * 2 + (h)) * HTB)
#define PG8_SB(b, h) ((4 + (b) * 2 + (h)) * HTB)
#define PG8_STAGE(bufoff, gbase, voff) do { _Pragma("unroll") for (int _i = 0; _i < 2; ++_i) \
        __builtin_amdgcn_global_load_lds((const unsigned*)((const char*)(gbase) + (voff)[_i]), (PG8_LAS unsigned*)(lds + (bufoff) + ldsw + _i * 8192), 16, 0, 0); } while (0)
#define PG8_LDA(dst, b, h) do { _Pragma("unroll") for (int m = 0; m < 4; ++m) _Pragma("unroll") for (int k = 0; k < 2; ++k) dst[m][k] = *(const PG8_LAS bf16x8*)(lds + PG8_SA(b, h) + aoff + m * 2048 + k * 1024); } while (0)
#define PG8_LDB(dst, b, h) do { _Pragma("unroll") for (int n = 0; n < 2; ++n) _Pragma("unroll") for (int k = 0; k < 2; ++k) dst[n][k] = *(const PG8_LAS bf16x8*)(lds + PG8_SB(b, h) + boff + n * 2048 + k * 1024); } while (0)
#define PG8_MMA(ai, bj, At, Bt) do { __builtin_amdgcn_s_setprio(1); _Pragma("unroll") for (int m = 0; m < 4; ++m) _Pragma("unroll") for (int n = 0; n < 2; ++n) _Pragma("unroll") for (int k = 0; k < 2; ++k) \
        acc[ai][bj][m][n] = __builtin_amdgcn_mfma_f32_16x16x32_bf16(Bt[n][k], At[m][k], acc[ai][bj][m][n], 0, 0, 0); __builtin_amdgcn_s_setprio(0); } while (0)
#define PG8_WAIT_V(n) asm volatile("s_waitcnt vmcnt(" #n ")" ::: "memory")
#define PG8_WAIT_L(n) asm volatile("s_waitcnt lgkmcnt(" #n ")" ::: "memory")
#define PG8_BAR __builtin_amdgcn_s_barrier()
#define PG8_SCHED __builtin_amdgcn_sched_barrier(0)
    Unit cur, nxt; int ui = 0;
    if (!S.next(0, cur)) return;
    f32x4 acc[2][2][4][2];
#pragma unroll
    for (int a = 0; a < 2; ++a)
#pragma unroll
        for (int b = 0; b < 2; ++b)
#pragma unroll
            for (int m = 0; m < 4; ++m)
#pragma unroll
                for (int n = 0; n < 2; ++n) acc[a][b][m][n] = (f32x4){0.f, 0.f, 0.f, 0.f};
    bf16x8 At[4][2], B0[2][2], B1[2][2];
    const char* cA = (const char*)g.A + (size_t)cur.pm * tstepA; const char* cB = (const char*)g.Bt + (size_t)cur.pn * tstep;
    S.a_ready(cur);
    if constexpr (SP2) {
        PG8_STAGE(PG8_SB(0, 0), cB, voffB); PG8_STAGE(PG8_SB(0, 1), cB + hstep, voffB); PG8_STAGE(PG8_SA(0, 0), cA, voffA); PG8_STAGE(PG8_SA(0, 1), cA + hstepA, voffA);
        if (wr == 1) PG8_BAR;
        PG8_WAIT_V(2); PG8_BAR;
        PG8_STAGE(PG8_SB(1, 0), cB + kstep, voffB); PG8_STAGE(PG8_SA(1, 0), cA + kstep, voffA); PG8_STAGE(PG8_SB(1, 1), cB + hstep + kstep, voffB);
        PG8_WAIT_V(6); PG8_BAR;
    } else {
        PG8_STAGE(PG8_SB(0, 0), cB, voffB); PG8_STAGE(PG8_SA(0, 0), cA, voffA); PG8_STAGE(PG8_SB(0, 1), cB + hstep, voffB); PG8_STAGE(PG8_SA(0, 1), cA + hstepA, voffA);
        if (wr == 1) PG8_BAR;
        PG8_WAIT_V(4); PG8_BAR;
        PG8_STAGE(PG8_SB(1, 0), cB + kstep, voffB); PG8_STAGE(PG8_SA(1, 0), cA + kstep, voffA); PG8_STAGE(PG8_SB(1, 1), cB + hstep + kstep, voffB);
        PG8_WAIT_V(6); PG8_BAR;
    }
    for (;;) {
        const bool has_next = S.next(ui + 1, nxt);
        const char* nA = has_next ? (const char*)g.A + (size_t)nxt.pm * tstepA : cA; const char* nB = has_next ? (const char*)g.Bt + (size_t)nxt.pn * tstep : cB;
        for (int t = 0; t < nt; t += 2) {
            const bool last = (t == nt - 2);
            const char* a1 = cA + (size_t)(t + 1) * kstep;
            const char* a2 = last ? nA : cA + (size_t)(t + 2) * kstep; const char* b2 = last ? nB : cB + (size_t)(t + 2) * kstep;
            const char* a3 = a2 + kstep; const char* b3 = b2 + kstep;
            if (last && has_next) S.a_ready(nxt);
            if constexpr (SP2) {
            PG8_LDB(B0, 0, 0); PG8_LDB(B1, 0, 1); PG8_SCHED; PG8_LDA(At, 0, 0); PG8_STAGE(PG8_SA(1, 1), a1 + hstepA, voffA);
            PG8_WAIT_V(8); PG8_WAIT_L(0); PG8_BAR; PG8_MMA(0, 0, At, B0); PG8_MMA(0, 1, At, B1); PG8_BAR; PG8_SCHED;
            PG8_LDA(At, 0, 1); PG8_STAGE(PG8_SB(0, 0), b2, voffB); PG8_STAGE(PG8_SB(0, 1), b2 + hstep, voffB); PG8_STAGE(PG8_SA(0, 0), a2, voffA);
            PG8_WAIT_V(8); PG8_WAIT_L(0); PG8_BAR; PG8_MMA(1, 0, At, B0); PG8_MMA(1, 1, At, B1); PG8_BAR; PG8_SCHED;
            PG8_LDB(B0, 1, 0); PG8_LDB(B1, 1, 1); PG8_SCHED; PG8_LDA(At, 1, 0); PG8_STAGE(PG8_SA(0, 1), a2 + hstepA, voffA);
            PG8_WAIT_V(8); PG8_WAIT_L(0); PG8_BAR; PG8_MMA(0, 0, At, B0); PG8_MMA(0, 1, At, B1); PG8_BAR; PG8_SCHED;
            PG8_LDA(At, 1, 1); PG8_STAGE(PG8_SB(1, 0), b3, voffB); PG8_STAGE(PG8_SB(1, 1), b3 + hstep, voffB); PG8_STAGE(PG8_SA(1, 0), a3, voffA);
            PG8_WAIT_V(8); PG8_WAIT_L(0); PG8_BAR; PG8_MMA(1, 0, At, B0); PG8_MMA(1, 1, At, B1); PG8_BAR; PG8_SCHED;
            } else {
            PG8_LDB(B0, 0, 0); PG8_SCHED; PG8_LDA(At, 0, 0); PG8_STAGE(PG8_SA(1, 1), a1 + hstepA, voffA);
            PG8_WAIT_L(8); PG8_BAR; PG8_WAIT_L(0); PG8_MMA(0, 0, At, B0); PG8_BAR; PG8_SCHED;
            PG8_LDB(B1, 0, 1); PG8_STAGE(PG8_SB(0, 0), b2, voffB);
            PG8_BAR; PG8_WAIT_L(0); PG8_MMA(0, 1, At, B1); PG8_BAR;
            PG8_LDA(At, 0, 1); PG8_STAGE(PG8_SA(0, 0), a2, voffA);
            PG8_BAR; PG8_WAIT_L(0); PG8_MMA(1, 0, At, B0); PG8_BAR; PG8_SCHED;
            PG8_STAGE(PG8_SB(0, 1), b2 + hstep, voffB);
            PG8_WAIT_V(6); PG8_BAR; PG8_MMA(1, 1, At, B1); PG8_BAR;
            PG8_LDB(B0, 1, 0); PG8_SCHED; PG8_LDA(At, 1, 0); PG8_STAGE(PG8_SA(0, 1), a2 + hstepA, voffA);
            PG8_WAIT_L(8); PG8_BAR; PG8_WAIT_L(0); PG8_MMA(0, 0, At, B0); PG8_BAR; PG8_SCHED;
            PG8_LDB(B1, 1, 1); PG8_STAGE(PG8_SB(1, 0), b3, voffB);
            PG8_BAR; PG8_WAIT_L(0); PG8_MMA(0, 1, At, B1); PG8_BAR;
            PG8_LDA(At, 1, 1); PG8_STAGE(PG8_SA(1, 0), a3, voffA);
            PG8_BAR; PG8_WAIT_L(0); PG8_MMA(1, 0, At, B0); PG8_BAR; PG8_SCHED;
            PG8_STAGE(PG8_SB(1, 1), b3 + hstep, voffB);
            PG8_WAIT_V(6); PG8_BAR; PG8_MMA(1, 1, At, B1); PG8_BAR;
            }
        }
        if constexpr (ALIGN_EPI) { if (wr == 0) PG8_BAR; }
        if constexpr (!Epi::AFTER_DRAIN) { E(acc, cur, wr, wc, fr, fq); S.done(cur); }
        if (!has_next) break;
#pragma unroll
        for (int a = 0; a < 2; ++a)
#pragma unroll
            for (int b = 0; b < 2; ++b)
#pragma unroll
                for (int m = 0; m < 4; ++m)
#pragma unroll
                    for (int n = 0; n < 2; ++n) acc[a][b][m][n] = (f32x4){0.f, 0.f, 0.f, 0.f};
        cur = nxt; cA = nA; cB = nB; ++ui;
        if constexpr (ALIGN_EPI) { if (wr == 1) PG8_BAR; }
    }
    PG8_WAIT_V(0);
    if constexpr (!ALIGN_EPI) { if (wr == 0) PG8_BAR; }
    PG8_BAR;
    if constexpr (Epi::AFTER_DRAIN) { E.fused(acc, cur, wr, wc, fr, fq, lds, wid, lane); S.done(cur); }
#undef PG8_SA
#undef PG8_SB
#undef PG8_STAGE
#undef PG8_LDA
#undef PG8_LDB
#undef PG8_MMA
#undef PG8_WAIT_V
#undef PG8_WAIT_L
#undef PG8_BAR
#undef PG8_SCHED
}
}
#define GAS __attribute__((address_space(1)))
#define LAS __attribute__((address_space(3)))
typedef unsigned short bf16_t;
typedef short bf16x8 __attribute__((ext_vector_type(8)));
typedef float f32x4 __attribute__((ext_vector_type(4)));
typedef unsigned u32x4 __attribute__((ext_vector_type(4)));
typedef unsigned u32x2 __attribute__((ext_vector_type(2)));
typedef float f32x2 __attribute__((ext_vector_type(2)));
constexpr int NT = 512, PROWS6 = 8192;
constexpr int T = 16384, SEQ = 4096, D = 1024, ZW = 6144;
constexpr size_t MiB = 1u << 20;
constexpr size_t WS_DEC = 0;
constexpr size_t WS_Z = 4 * MiB;
constexpr size_t WS_WIN = 196 * MiB, WS_WOUT = 208 * MiB, WS_RGA = 212 * MiB, WS_RGX = 212 * MiB + 256 * 1024;
constexpr size_t WS_OI = 213 * MiB;
constexpr size_t WS_A2 = 4 * MiB;
constexpr size_t WS_R = 68 * MiB;
constexpr size_t WS_V = 132 * MiB;
constexpr size_t WS_WC = 196 * MiB, WS_WO = 229 * MiB, WS_LW = 233 * MiB, WS_LA = 235 * MiB;
constexpr size_t WS_W2T = 237 * MiB, WS_A2T = 237 * MiB + 256 * 1024, WS_GR = 238 * MiB, WS_ST = 239 * MiB, WS_XG = 241 * MiB;
constexpr size_t WS_WL = 246 * MiB;
constexpr size_t WS_BAR = 2 * MiB;
constexpr int LDS_BYTES = 147456, LDS_MISC = 147456 - 64;

struct Params { const GAS float* in[32]; GAS float* out; GAS unsigned char* ws; long long dry; };
#ifndef PROBE
#define PROBE 0
#endif
enum { I_X = 0, I_ABG, I_WIN, I_CONVW, I_CONVB, I_RGWA, I_RGBA, I_RGWX, I_RGBX, I_LAM, I_LB, I_HGG, I_WOUT, I_CNG, I_MU, I_WR, I_WK, I_WV, I_WG, I_W0, I_W1, I_W2, I_A0, I_A1, I_A2, I_KK, I_KA, I_RK, I_LNG, I_LNB, I_WO, I_FG };

__device__ __forceinline__ unsigned f2bf(float f) { unsigned u = __float_as_uint(f); return (u + 0x7fffu + ((u >> 16) & 1u)) >> 16; }
__device__ __forceinline__ float bf2f(unsigned h) { return __uint_as_float(h << 16); }
__device__ __forceinline__ unsigned pk2(float lo, float hi) { return f2bf(lo) | (f2bf(hi) << 16); }
__device__ __forceinline__ float sigmf(float x) { return __builtin_amdgcn_rcpf(1.0f + __expf(-x)); }
__device__ __forceinline__ float wave_sum(float v) {
#pragma unroll
    for (int o = 1; o < 64; o <<= 1) v += __shfl_xor(v, o);
    return v;
}
#define OPQ_TID unsigned char* WSP = launder_ws(((unsigned char*)p.ws)); int tid = threadIdx.x; asm volatile("" : "+v"(tid)); const int lane = tid & 63, wave = __builtin_amdgcn_readfirstlane(tid >> 6); (void)lane; (void)wave
__device__ __forceinline__ unsigned char* launder_ws(unsigned char* w) { const unsigned long long v = (unsigned long long)w; unsigned lo = __builtin_amdgcn_readfirstlane((unsigned)v), hi = __builtin_amdgcn_readfirstlane((unsigned)(v >> 32)); asm volatile("" : "+s"(lo), "+s"(hi)); return (unsigned char*)(GAS unsigned char*)(((unsigned long long)hi << 32) | lo); }
#define MFMA16(a, b, c) __builtin_amdgcn_mfma_f32_16x16x32_bf16((a), (b), (c), 0, 0, 0)

__device__ __forceinline__ void tr_item(const float* src, int ld_src, bf16_t* dst, int ld_dst, const float* sc, int scmode, LAS float* scr, int kb, int nb, int lane) {
    const int k0 = 64 * kb, n0 = 32 * nb;
#pragma unroll
    for (int i = 0; i < 8; ++i) { const int kk = 8 * i + (lane >> 3), c4 = (lane & 7) * 4; f32x4 v = __builtin_nontemporal_load((const f32x4*)(src + (size_t)(k0 + kk) * ld_src + n0 + c4));
        if (sc) { const float m_ = sc[k0 + kk]; v = v * (scmode ? m_ : (1.0f - m_)); }
        scr[kk * 33 + c4] = v.x; scr[kk * 33 + c4 + 1] = v.y; scr[kk * 33 + c4 + 2] = v.z; scr[kk * 33 + c4 + 3] = v.w; }
    asm volatile("s_waitcnt lgkmcnt(0)" ::: "memory");
    const int c = lane & 7;
#pragma unroll
    for (int j = 0; j < 4; ++j) { const int n = (lane >> 3) + 8 * j; const LAS float* s = scr + (8 * c) * 33 + n;
        u32x4 o; o.x = pk2(s[0 * 33], s[1 * 33]); o.y = pk2(s[2 * 33], s[3 * 33]); o.z = pk2(s[4 * 33], s[5 * 33]); o.w = pk2(s[6 * 33], s[7 * 33]);
        *(u32x4*)(dst + (size_t)(n0 + n) * ld_dst + k0 + 8 * c) = o; }
    asm volatile("s_waitcnt lgkmcnt(0)" ::: "memory");
}
__device__ __forceinline__ void tr_item2(const float* src, int ld_src, bf16_t* dst0, bf16_t* dst1, int ld_dst, const float* mu, LAS float* scr, int kb, int nb, int lane) {
    const int k0 = 64 * kb, n0 = 32 * nb;
#pragma unroll
    for (int i = 0; i < 8; ++i) { const int kk = 8 * i + (lane >> 3), c4 = (lane & 7) * 4; const f32x4 v = __builtin_nontemporal_load((const f32x4*)(src + (size_t)(k0 + kk) * ld_src + n0 + c4));
        scr[kk * 33 + c4] = v.x; scr[kk * 33 + c4 + 1] = v.y; scr[kk * 33 + c4 + 2] = v.z; scr[kk * 33 + c4 + 3] = v.w; }
    asm volatile("s_waitcnt lgkmcnt(0)" ::: "memory");
    const int c = lane & 7;
    const f32x4 m0 = *(const f32x4*)(mu + k0 + 8 * c), m1 = *(const f32x4*)(mu + k0 + 8 * c + 4);
#pragma unroll
    for (int j = 0; j < 4; ++j) { const int n = (lane >> 3) + 8 * j; const LAS float* s = scr + (8 * c) * 33 + n;
        const float s0 = s[0], s1 = s[33], s2 = s[66], s3 = s[99], s4 = s[132], s5 = s[165], s6 = s[198], s7 = s[231];
        u32x4 o; o.x = pk2(s0 * m0.x, s1 * m0.y); o.y = pk2(s2 * m0.z, s3 * m0.w); o.z = pk2(s4 * m1.x, s5 * m1.y); o.w = pk2(s6 * m1.z, s7 * m1.w);
        *(u32x4*)(dst1 + (size_t)(n0 + n) * ld_dst + k0 + 8 * c) = o;
        o.x = pk2(s0 * (1.0f - m0.x), s1 * (1.0f - m0.y)); o.y = pk2(s2 * (1.0f - m0.z), s3 * (1.0f - m0.w)); o.z = pk2(s4 * (1.0f - m1.x), s5 * (1.0f - m1.y)); o.w = pk2(s6 * (1.0f - m1.z), s7 * (1.0f - m1.w));
        *(u32x4*)(dst0 + (size_t)(n0 + n) * ld_dst + k0 + 8 * c) = o; }
    asm volatile("s_waitcnt lgkmcnt(0)" ::: "memory");
}
__device__ __forceinline__ void rms_row(const float* xrow, const float* g, int lane, u32x2 (&o)[4]) {
    f32x4 v[4]; float s = 0.f;
#pragma unroll
    for (int j = 0; j < 4; ++j) { v[j] = __builtin_nontemporal_load((const f32x4*)xrow + lane + 64 * j); s += (v[j].x * v[j].x + v[j].y * v[j].y) + (v[j].z * v[j].z + v[j].w * v[j].w); }
    const float rs = rsqrtf(wave_sum(s) * (1.0f / 1024.0f) + 1e-6f);
#pragma unroll
    for (int j = 0; j < 4; ++j) { const f32x4 gg = *((const f32x4*)g + lane + 64 * j); o[j].x = pk2(v[j].x * rs * gg.x, v[j].y * rs * gg.y); o[j].y = pk2(v[j].z * rs * gg.z, v[j].w * rs * gg.w); }
}

__device__ __forceinline__ void p0_prologue(const Params& p, LAS unsigned char* lds, int G, int bid) {
    OPQ_TID; const int gw = bid * 8 + wave, ngw = G * 8;
    LAS float* scr = (LAS float*)(lds + wave * 16384);
    bf16_t* WinT = (bf16_t*)(WSP + WS_WIN); bf16_t* WoutT = (bf16_t*)(WSP + WS_WOUT); bf16_t* RGA = (bf16_t*)(WSP + WS_RGA); bf16_t* RGX = (bf16_t*)(WSP + WS_RGX);
    constexpr int IA = 16 * 192, IB = 32 * 32, IC = 64, IL0 = 64;
    for (int it = gw; it < IA + IB + 2 * IC + IL0; it += ngw) {
        int r = it;
        if (r >= IA + IB + 2 * IC) { r -= IA + IB + 2 * IC; const int wh = r >> 5, q = r & 31;
            bf16_t* dst = (bf16_t*)(WSP + WS_WL) + (size_t)(wh * 64) * 2048;
            tr_item2(wh ? ((const float*)p.in[I_A1]) : ((const float*)p.in[I_W1]), 64, dst, dst + 1024, 2048, ((const float*)p.in[I_MU]) + (wh ? 4 : 1) * 1024, scr, q >> 1, q & 1, lane); continue; }
        if (r < IA) { tr_item(((const float*)p.in[I_WIN]), ZW, WinT, 1024, nullptr, 0, scr, r / 192, r % 192, lane); continue; } r -= IA;
        if (r < IB) { tr_item(((const float*)p.in[I_WOUT]), 1024, WoutT, 2048, nullptr, 0, scr, r / 32, r % 32, lane); continue; } r -= IB;
        const float* src = (r < IC) ? ((const float*)p.in[I_RGWA]) : ((const float*)p.in[I_RGWX]); bf16_t* dst = (r < IC) ? RGA : RGX; if (r >= IC) r -= IC;
        const int blk = r >> 3, q = r & 7;
        tr_item(src + blk * 16384, 128, dst + blk * 16384, 128, nullptr, 0, scr, q >> 2, q & 3, lane);
    }
    bf16_t* U0 = (bf16_t*)((float*)p.out);
    for (int m = gw; m < T; m += ngw) { u32x2 o[4]; rms_row(((const float*)p.in[I_X]) + (size_t)m * D, ((const float*)p.in[I_ABG]), lane, o);
#pragma unroll
        for (int j = 0; j < 4; ++j) *((u32x2*)(U0 + (size_t)m * D) + lane + 64 * j) = o[j]; }
}

__device__ __forceinline__ void rg_a_prefetch(const bf16_t* Z, int unit, int tid, u32x4 (&pre)[3]) {
    const int b = unit >> 9, n = (unit >> 3) & 63, j = unit & 7; const int tok0 = b * SEQ + n * 64, ch0 = j * 128;
#pragma unroll
    for (int q = 0; q < 3; ++q) { const int i = tid + q * NT; const int row = i >> 4, cc = i & 15; pre[q] = (u32x4){0u, 0u, 0u, 0u};
        if (i < 67 * 16 && (n > 0 || row >= 3)) pre[q] = __builtin_nontemporal_load((const u32x4*)(Z + (size_t)(tok0 - 3 + row) * ZW + ch0 + 8 * cc)); }
}
__device__ __forceinline__ void rg_a_unit(const Params& p, LAS unsigned char* lds, int unit, int next_unit, u32x4 (&pre)[3]) {
    OPQ_TID;
    LAS float* XC = (LAS float*)lds; LAS float* AA = (LAS float*)(lds + 32768); LAS bf16_t* XB = (LAS bf16_t*)(lds + 65536); LAS bf16_t* XR = (LAS bf16_t*)(lds + 82944);
    LAS float* SUMP = (LAS float*)(lds + 82944); LAS float* SUMH = SUMP + 512; LAS bf16_t* HT = XB; LAS bf16_t* PT = (LAS bf16_t*)(lds + 87040);
    const int b = unit >> 9, n = (unit >> 3) & 63, j = unit & 7;
    const int tok0 = b * SEQ + n * 64, ch0 = j * 128;
    const bf16_t* Z = (const bf16_t*)(WSP + WS_Z);
#pragma unroll
    for (int q = 0; q < 3; ++q) { const int i = tid + q * NT; if (i < 67 * 16) *(LAS u32x4*)(XR + (i >> 4) * 136 + 8 * (i & 15)) = pre[q]; }
    __syncthreads();
    if (next_unit < 2048) rg_a_prefetch(Z, next_unit, tid, pre);
    const int c = tid & 127, sub = tid >> 7;
    {
        const int ch = ch0 + c;
        const float w0 = ((const float*)p.in[I_CONVW])[ch], w1 = ((const float*)p.in[I_CONVW])[1024 + ch], w2 = ((const float*)p.in[I_CONVW])[2048 + ch], w3 = ((const float*)p.in[I_CONVW])[3072 + ch], cb = ((const float*)p.in[I_CONVB])[ch];
        const LAS bf16_t* xr = XR + (sub * 16) * 136 + c;
        float xm3 = bf2f(xr[0]), xm2 = bf2f(xr[136]), xm1 = bf2f(xr[272]);
#pragma unroll
        for (int i = 0; i < 16; ++i) { const float x = bf2f(xr[(i + 3) * 136]); const float y = w0 * xm3 + w1 * xm2 + w2 * xm1 + w3 * x + cb;
            XC[(sub * 16 + i) * 128 + c] = y; XB[(sub * 16 + i) * 136 + c] = (bf16_t)f2bf(y); xm3 = xm2; xm2 = xm1; xm1 = x; }
    }
    __syncthreads();
    {
        const int fr = lane & 15, fq = lane >> 4;
        const bf16_t* WA = (const bf16_t*)(WSP + WS_RGA) + j * 16384 + (16 * wave + fr) * 128 + 8 * fq;
        const bf16_t* WX = (const bf16_t*)(WSP + WS_RGX) + j * 16384 + (16 * wave + fr) * 128 + 8 * fq;
        f32x4 accA[4], accX[4];
#pragma unroll
        for (int m = 0; m < 4; ++m) { accA[m] = (f32x4){0.f, 0.f, 0.f, 0.f}; accX[m] = (f32x4){0.f, 0.f, 0.f, 0.f}; }
#pragma unroll
        for (int k = 0; k < 4; ++k) { const bf16x8 bA = *(const bf16x8*)(WA + 32 * k), bX = *(const bf16x8*)(WX + 32 * k);
#pragma unroll
            for (int m = 0; m < 4; ++m) { const bf16x8 a = *(const LAS bf16x8*)(XB + (16 * m + fr) * 136 + 32 * k + 8 * fq); accA[m] = MFMA16(a, bA, accA[m]); accX[m] = MFMA16(a, bX, accX[m]); } }
        const int cl = 16 * wave + fr, ch = ch0 + cl;
        const float ba = ((const float*)p.in[I_RGBA])[ch], bx = ((const float*)p.in[I_RGBX])[ch], lam = ((const float*)p.in[I_LAM])[ch];
        const float sp = log1pf(expf(-lam));
#pragma unroll
        for (int m = 0; m < 4; ++m)
#pragma unroll
            for (int r = 0; r < 4; ++r) { const int tk = 16 * m + 4 * fq + r; const float gr = sigmf(accA[m][r] + ba), gi = sigmf(accX[m][r] + bx);
                const float la = -8.0f * gr * sp; const float a = __expf(la); const float mult = __builtin_amdgcn_sqrtf(fmaxf(1.0f - a * a, 0.f));
                const float xc = XC[tk * 128 + cl]; AA[tk * 128 + cl] = a; XC[tk * 128 + cl] = mult * gi * xc; }
    }
    __syncthreads();
    {
        float hl[16], pl[16]; float h = 0.f, P = 1.f;
#pragma unroll
        for (int i = 0; i < 16; ++i) { const float a = AA[(sub * 16 + i) * 128 + c], u = XC[(sub * 16 + i) * 128 + c]; h = a * h + u; P *= a; hl[i] = h; pl[i] = P; }
        SUMP[sub * 128 + c] = P; SUMH[sub * 128 + c] = h;
        __syncthreads();
        float chh = 0.f, cp = 1.f;
#pragma unroll
        for (int s = 0; s < 3; ++s) if (s < sub) { const float sp_ = SUMP[s * 128 + c]; chh = chh * sp_ + SUMH[s * 128 + c]; cp *= sp_; }
#pragma unroll
        for (int i = 0; i < 16; ++i) { HT[(sub * 16 + i) * 136 + c] = (bf16_t)f2bf(hl[i] + pl[i] * chh); PT[(sub * 16 + i) * 136 + c] = (bf16_t)f2bf(pl[i] * cp); }
    }
    __syncthreads();
    {
        bf16_t* HL = (bf16_t*)((float*)p.out) + (size_t)tok0 * D + ch0; bf16_t* PC = HL + (size_t)T * D;
        for (int i = tid; i < 1024; i += NT) { const int row = i >> 4, cc = i & 15;
            *(u32x4*)(HL + (size_t)row * D + 8 * cc) = *(const LAS u32x4*)(HT + row * 136 + 8 * cc); *(u32x4*)(PC + (size_t)row * D + 8 * cc) = *(const LAS u32x4*)(PT + row * 136 + 8 * cc); }
    }
    __syncthreads();
}

__device__ __forceinline__ void hg_a_prefetch(const bf16_t* Z, int unit, int tid, u32x4 (&pre)[6]) {
    const int b = unit >> 9, h = (unit >> 6) & 7, n = unit & 63; const int tok0 = b * SEQ + n * 64;
#pragma unroll
    for (int q = 0; q < 6; ++q) { const int i = tid + q * NT; const int arr = i >> 10, row = (i >> 4) & 63, cc = i & 15; pre[q] = __builtin_nontemporal_load((const u32x4*)(Z + (size_t)(tok0 + row) * ZW + 2048 + 1024 * arr + h * 128 + 8 * cc)); }
}
__device__ __forceinline__ void hg_a_unit(const Params& p, LAS unsigned char* lds, int unit, int next_unit, u32x4 (&pre)[6]) {
    OPQ_TID;
    LAS bf16_t* QD = (LAS bf16_t*)lds; LAS bf16_t* KI = (LAS bf16_t*)(lds + 17408); LAS bf16_t* VR = (LAS bf16_t*)(lds + 34816); LAS bf16_t* VT = (LAS bf16_t*)(lds + 52224);
    LAS bf16_t* SC = (LAS bf16_t*)(lds + 70656); LAS float* ST = (LAS float*)(lds + 79872); LAS bf16_t* OT = VR;
    const int b = unit >> 9, h = (unit >> 6) & 7, n = unit & 63;
    const int tok0 = b * SEQ + n * 64;
    bf16_t* Z = (bf16_t*)(WSP + WS_Z);
    const int fr = lane & 15, fq = lane >> 4;
#pragma unroll
    for (int q = 0; q < 6; ++q) { const int i = tid + q * NT; const int arr = i >> 10, row = (i >> 4) & 63, cc = i & 15;
        *(LAS u32x4*)((arr == 0 ? QD : (arr == 1 ? KI : VR)) + row * 136 + 8 * cc) = pre[q]; }
    __syncthreads();
    {
        const int d = tid & 127, sub = tid >> 7, hd = h * 128 + d;
        const float lb = sigmf(((const float*)p.in[I_LB])[hd] - ((const float*)p.in[I_LB])[1024 + hd]), omlb = 1.0f - lb;
        float q[16], kq[16], cl[16]; unsigned short vv[16]; float run = 0.f;
#pragma unroll
        for (int i = 0; i < 16; ++i) { const int t = sub * 16 + i; const float f = bf2f(KI[t * 136 + d]); const float sg = sigmf(f);
            run += __logf(lb + omlb * sg); cl[i] = run; kq[i] = omlb * (1.0f - sg); q[i] = bf2f(QD[t * 136 + d]); vv[i] = VR[t * 136 + d]; }
        ST[sub * 128 + d] = run;
        __syncthreads();
        float off = 0.f, total = 0.f;
#pragma unroll
        for (int s = 0; s < 4; ++s) { const float x = ST[s * 128 + d]; total += x; if (s < sub) off += x; }
        unsigned ke[8], vp[8];
#pragma unroll
        for (int i = 0; i < 16; ++i) { const float cum = off + cl[i]; const unsigned qd = f2bf(q[i] * __expf(cum)), ki = f2bf(kq[i] * __expf(-cum)), kE = f2bf(kq[i] * __expf(total - cum));
            QD[(sub * 16 + i) * 136 + d] = (bf16_t)qd; KI[(sub * 16 + i) * 136 + d] = (bf16_t)ki;
            if (i & 1) { ke[i >> 1] |= kE << 16; vp[i >> 1] |= (unsigned)vv[i] << 16; } else { ke[i >> 1] = kE; vp[i >> 1] = vv[i]; } }
        *(LAS u32x4*)(VT + d * 72 + sub * 16) = (u32x4){vp[0], vp[1], vp[2], vp[3]}; *(LAS u32x4*)(VT + d * 72 + sub * 16 + 8) = (u32x4){vp[4], vp[5], vp[6], vp[7]};
        bf16_t* tb = Z + (size_t)(tok0 + (d >> 1)) * ZW + h * 128 + (d & 1) * 64 + sub * 16;
        *(u32x4*)(tb + 3072) = (u32x4){ke[0], ke[1], ke[2], ke[3]}; *(u32x4*)(tb + 3072 + 8) = (u32x4){ke[4], ke[5], ke[6], ke[7]};
        *(u32x4*)(tb + 4096) = (u32x4){vp[0], vp[1], vp[2], vp[3]}; *(u32x4*)(tb + 4096 + 8) = (u32x4){vp[4], vp[5], vp[6], vp[7]};
        if (sub == 0) ((float*)(WSP + WS_DEC))[unit * 128 + d] = __expf(total);
    }
    __syncthreads();
    if (next_unit < 2048) hg_a_prefetch(Z, next_unit, tid, pre);
    for (int i = tid; i < 1024; i += NT) { const int row = i >> 4, cc = i & 15; *(u32x4*)(Z + (size_t)(tok0 + row) * ZW + 2048 + h * 128 + 8 * cc) = *(const LAS u32x4*)(QD + row * 136 + 8 * cc); }
    {
        const int lt = wave >> 1;
#pragma unroll
        for (int x = 0; x < 2; ++x) { const int mt = (wave & 1) * 2 + x; f32x4 acc = (f32x4){0.f, 0.f, 0.f, 0.f};
            if (mt <= lt) {
#pragma unroll
                for (int k = 0; k < 4; ++k) { const bf16x8 a = *(const LAS bf16x8*)(QD + (16 * lt + fr) * 136 + 32 * k + 8 * fq), bb = *(const LAS bf16x8*)(KI + (16 * mt + fr) * 136 + 32 * k + 8 * fq); acc = MFMA16(a, bb, acc); } }
#pragma unroll
            for (int r = 0; r < 4; ++r) { const int l = 16 * lt + 4 * fq + r, mm = 16 * mt + fr; SC[l * 72 + mm] = (bf16_t)f2bf(mm <= l ? acc[r] : 0.f); } }
    }
    __syncthreads();
    {
#pragma unroll
        for (int lt = 0; lt < 4; ++lt) { f32x4 acc = (f32x4){0.f, 0.f, 0.f, 0.f};
#pragma unroll
            for (int k = 0; k < 2; ++k) { const bf16x8 a = *(const LAS bf16x8*)(SC + (16 * lt + fr) * 72 + 32 * k + 8 * fq), bb = *(const LAS bf16x8*)(VT + (16 * wave + fr) * 72 + 32 * k + 8 * fq); acc = MFMA16(a, bb, acc); }
#pragma unroll
            for (int r = 0; r < 4; ++r) OT[(16 * lt + 4 * fq + r) * 136 + 16 * wave + fr] = (bf16_t)f2bf(acc[r]); }
    }
    __syncthreads();
    { bf16_t* OI = (bf16_t*)(WSP + WS_OI) + (size_t)tok0 * D + h * 128;
      for (int i = tid; i < 1024; i += NT) { const int row = i >> 4, cc = i & 15; *(u32x4*)(OI + (size_t)row * D + 8 * cc) = *(const LAS u32x4*)(OT + row * 136 + 8 * cc); } }
    __syncthreads();
}

__device__ __forceinline__ void hg_b_item(const Params& p, LAS unsigned char* lds, int item, bool dry = false) {
    OPQ_TID;
    LAS bf16_t* SB = (LAS bf16_t*)lds;
    const int b = item >> 6, h = (item >> 3) & 7, es = item & 7;
    const int fr = lane & 15, fq = lane >> 4;
    const bf16_t* Z = (const bf16_t*)(WSP + WS_Z); bf16_t* OI = (bf16_t*)(WSP + WS_OI); const float* DEC = (const float*)(WSP + WS_DEC);
    f32x4 S = (f32x4){0.f, 0.f, 0.f, 0.f};
    const int eg = 16 * es + fr, dg = 16 * wave + fr;
    const bf16_t* pV = Z + (size_t)(b * SEQ + (eg >> 1)) * ZW + 4096 + h * 128 + (eg & 1) * 64 + 8 * fq;
    const bf16_t* pK = Z + (size_t)(b * SEQ + (dg >> 1)) * ZW + 3072 + h * 128 + (dg & 1) * 64 + 8 * fq;
    const bf16_t* pQ = Z + (size_t)(b * SEQ + fr) * ZW + 2048 + h * 128 + 8 * fq;
    bf16_t* pO = OI + (size_t)(b * SEQ + 4 * fq) * D + h * 128 + 16 * es + fr;
    const float* pD = DEC + (size_t)((b * 8 + h) * 64) * 128 + dg;
    __syncthreads();
#pragma unroll 1
    for (int G16 = 0; G16 < 4; ++G16) {
#pragma unroll 8
        for (int g = 0; g < 16; ++g) { const int n = 16 * G16 + g; const size_t ro = (size_t)n * 64 * ZW;
            const float dec = pD[n * 128];
            bf16x8 aV[2], bK[2];
#pragma unroll
            for (int k = 0; k < 2; ++k) { aV[k] = *(const bf16x8*)(pV + ro + 32 * k); bK[k] = *(const bf16x8*)(pK + ro + 32 * k); }
#pragma unroll
            for (int r = 0; r < 4; ++r) SB[g * 2176 + (4 * fq + r) * 136 + dg] = (bf16_t)f2bf(S[r]);
            S = S * dec;
#pragma unroll
            for (int k = 0; k < 2; ++k) S = MFMA16(aV[k], bK[k], S); }
        asm volatile("s_waitcnt lgkmcnt(0)" ::: "memory"); __builtin_amdgcn_s_barrier(); asm volatile("" ::: "memory");
#pragma unroll
        for (int c2 = 0; c2 < 2; ++c2) { const int g = wave + 8 * c2, nB = 16 * G16 + g; const size_t roB = (size_t)nB * 64 * ZW;
            bf16x8 bS[4];
#pragma unroll
            for (int k = 0; k < 4; ++k) bS[k] = *(const LAS bf16x8*)(SB + g * 2176 + fr * 136 + 32 * k + 8 * fq);
#pragma unroll
            for (int lt = 0; lt < 4; ++lt) { f32x4 acc = (f32x4){0.f, 0.f, 0.f, 0.f}; unsigned short oO[4];
#pragma unroll
                for (int r = 0; r < 4; ++r) oO[r] = pO[(size_t)(nB * 64 + 16 * lt + r) * D];
#pragma unroll
                for (int k = 0; k < 4; ++k) { const bf16x8 a = *(const bf16x8*)(pQ + roB + (size_t)(16 * lt) * ZW + 32 * k); acc = MFMA16(a, bS[k], acc); }
#pragma unroll
                for (int r = 0; r < 4; ++r) { const float nv = bf2f(oO[r]) + acc[r]; if (!dry) pO[(size_t)(nB * 64 + 16 * lt + r) * D] = (bf16_t)f2bf(nv); else if (nv == 123456.0f) pO[0] = 0; } } }
        asm volatile("s_waitcnt lgkmcnt(0)" ::: "memory"); __builtin_amdgcn_s_barrier(); asm volatile("" ::: "memory");
    }
}
__device__ __forceinline__ void rg_b_unit(const Params& p, int unit) {
    OPQ_TID;
    const int b = unit >> 7, n = (unit >> 1) & 63, ch = (unit & 1) * 512 + 8 * (tid & 63), r8 = tid >> 6;
    const bf16_t* HL = (const bf16_t*)((float*)p.out) + (size_t)b * SEQ * D + ch; const bf16_t* PC = HL + (size_t)T * D;
    bf16_t* Z = (bf16_t*)(WSP + WS_Z) + (size_t)(b * SEQ + n * 64) * ZW + ch;
    float carry[8];
#pragma unroll
    for (int i = 0; i < 8; ++i) carry[i] = 0.f;
    int m0 = 0;
    for (; m0 + 4 <= n; m0 += 4) { u32x4 pp[4], hh4[4];
#pragma unroll
        for (int i = 0; i < 4; ++i) { const size_t o = (size_t)((m0 + i) * 64 + 63) * D; pp[i] = *(const u32x4*)(PC + o); hh4[i] = *(const u32x4*)(HL + o); }
#pragma unroll
        for (int i = 0; i < 4; ++i)
#pragma unroll
            for (int c = 0; c < 4; ++c) { carry[2 * c] = carry[2 * c] * bf2f(pp[i][c] & 0xffffu) + bf2f(hh4[i][c] & 0xffffu); carry[2 * c + 1] = carry[2 * c + 1] * bf2f(pp[i][c] >> 16) + bf2f(hh4[i][c] >> 16); } }
    for (; m0 < n; ++m0) { const size_t o = (size_t)(m0 * 64 + 63) * D; const u32x4 pp = *(const u32x4*)(PC + o), hh4 = *(const u32x4*)(HL + o);
#pragma unroll
        for (int c = 0; c < 4; ++c) { carry[2 * c] = carry[2 * c] * bf2f(pp[c] & 0xffffu) + bf2f(hh4[c] & 0xffffu); carry[2 * c + 1] = carry[2 * c + 1] * bf2f(pp[c] >> 16) + bf2f(hh4[c] >> 16); } }
#pragma unroll 4
    for (int tq = 0; tq < 8; ++tq) { const int t = 8 * tq + r8; const size_t o = (size_t)(n * 64 + t) * D;
        const u32x4 hv = __builtin_nontemporal_load((const u32x4*)(HL + o)), pv = __builtin_nontemporal_load((const u32x4*)(PC + o)), gv = __builtin_nontemporal_load((const u32x4*)(Z + (size_t)t * ZW + 1024)); u32x4 ov;
#pragma unroll
        for (int c = 0; c < 4; ++c) { const float h0 = bf2f(hv[c] & 0xffffu) + bf2f(pv[c] & 0xffffu) * carry[2 * c], h1 = bf2f(hv[c] >> 16) + bf2f(pv[c] >> 16) * carry[2 * c + 1];
            const float g0 = bf2f(gv[c] & 0xffffu), g1 = bf2f(gv[c] >> 16); ov[c] = pk2(h0 * g0 * sigmf(g0), h1 * g1 * sigmf(g1)); }
        *(u32x4*)(Z + (size_t)t * ZW) = ov; }
}
__device__ __forceinline__ float row16_sum_p4(float x) {
    x += __int_as_float(__builtin_amdgcn_update_dpp(0, __float_as_int(x), 0xB1, 0xf, 0xf, true)); x += __int_as_float(__builtin_amdgcn_update_dpp(0, __float_as_int(x), 0x4E, 0xf, 0xf, true));
    x += __int_as_float(__builtin_amdgcn_update_dpp(0, __float_as_int(x), 0x141, 0xf, 0xf, true)); x += __int_as_float(__builtin_amdgcn_update_dpp(0, __float_as_int(x), 0x140, 0xf, 0xf, true)); return x; }
__device__ __forceinline__ void p4_finalize(const Params& p, int G, int bid) {
    OPQ_TID; const int gw = bid * 8 + wave, ngw = G * 8;
    bf16_t* Z = (bf16_t*)(WSP + WS_Z); const bf16_t* OI = (const bf16_t*)(WSP + WS_OI);
    const int l16 = lane & 15, pr = lane >> 4;
    const f32x4 g0 = *(const f32x4*)(((const float*)p.in[I_HGG]) + 8 * l16), g1 = *(const f32x4*)(((const float*)p.in[I_HGG]) + 8 * l16 + 4);
    for (int it = gw; it < T * 2; it += ngw) { const int tok = it >> 1, h = (it & 1) * 4 + pr;
        const u32x4 ov = __builtin_nontemporal_load((const u32x4*)(OI + (size_t)tok * D + h * 128 + 8 * l16)); const u32x4 gv = __builtin_nontemporal_load((const u32x4*)(Z + (size_t)tok * ZW + 5120 + h * 128 + 8 * l16));
        float o[8], gb[8]; float ss = 0.f;
#pragma unroll
        for (int c = 0; c < 4; ++c) { o[2 * c] = bf2f(ov[c] & 0xffffu); o[2 * c + 1] = bf2f(ov[c] >> 16); gb[2 * c] = bf2f(gv[c] & 0xffffu); gb[2 * c + 1] = bf2f(gv[c] >> 16); ss += o[2 * c] * o[2 * c] + o[2 * c + 1] * o[2 * c + 1]; }
        const float rs = rsqrtf(row16_sum_p4(ss) * (1.0f / 128.0f) + 1e-6f);
        u32x4 w;
#pragma unroll
        for (int c = 0; c < 4; ++c) { const float ga = c < 2 ? g0[2 * c] : g1[2 * c - 4], gbq = c < 2 ? g0[2 * c + 1] : g1[2 * c - 3];
            w[c] = pk2(o[2 * c] * rs * ga * gb[2 * c] * sigmf(gb[2 * c]), o[2 * c + 1] * rs * gbq * gb[2 * c + 1] * sigmf(gb[2 * c + 1])); }
        *(u32x4*)(Z + (size_t)tok * ZW + 1024 + h * 128 + 8 * l16) = w; }
}
__device__ __forceinline__ void p6_prologue(const Params& p, LAS unsigned char* lds, int G, int bid) {
    OPQ_TID; const int gw = bid * 8 + wave, ngw = G * 8;
    LAS float* scr = (LAS float*)(lds + wave * 16384);
    constexpr int IP = 4096, IL = 0, IO = 1024, I2 = 128;
    for (int i = gw * 64 + lane; i < (int)(MiB / 16); i += ngw * 64) ((u32x4*)(WSP + WS_GR))[i] = (u32x4){0u, 0u, 0u, 0u};
    for (int i = gw * 64 + lane; i < (int)(MiB / 32); i += ngw * 64) ((u32x4*)(WSP + WS_XG))[i] = (u32x4){0u, 0u, 0u, 0u};
    for (int it = gw; it < IP + IL + IO + I2; it += ngw) {
        int r = it;
        if (r < IP) { const int pj = r >> 10, q = r & 1023;
            const int muidx = pj == 0 ? 0 : (pj == 1 ? 2 : (pj == 2 ? 3 : 5));
            bf16_t* dst = (bf16_t*)(WSP + WS_WC) + (size_t)(pj * 2048) * 2048;
            tr_item2(((const float*)p.in[I_WR + pj]), 2048, dst, dst + 1024, 2048, ((const float*)p.in[I_MU]) + muidx * 1024, scr, q >> 6, q & 63, lane); continue; }
        r -= IP;
        if (r >= IO) { r -= IO; const int wh = r >> 6, nb = r & 63; tr_item(wh ? ((const float*)p.in[I_A2]) : ((const float*)p.in[I_W2]), 2048, (bf16_t*)(WSP + (wh ? WS_A2T : WS_W2T)), 64, nullptr, 0, scr, 0, nb, lane); continue; }
        tr_item(((const float*)p.in[I_WO]), 1024, (bf16_t*)(WSP + WS_WO), 2048, nullptr, 0, scr, r >> 5, r & 31, lane);
    }
    bf16_t* A2 = (bf16_t*)(WSP + WS_A2);
    const int fr = lane & 15, fq = lane >> 4;
    for (int tile = bid; tile < T / 64; tile += G) {
        const int m0 = tile * 64;
        for (int i = (wave == 0 && (m0 & (SEQ - 1)) != 0) ? -1 : 0; i < 8; ++i) { const int m = (i < 0) ? m0 - 1 : m0 + 8 * wave + i;
            u32x2 o[4]; rms_row(((float*)p.out) + (size_t)m * D, ((const float*)p.in[I_CNG]), lane, o); const int bb = m >> 12, t = m & (SEQ - 1);
            const size_t cr = (size_t)(t >> 11) * PROWS6 + bb * 2048 + (t & 2047);
            const size_t cn = (size_t)((t + 1) >> 11) * PROWS6 + bb * 2048 + ((t + 1) & 2047);
#pragma unroll
            for (int j = 0; j < 4; ++j) { if (i >= 0) *((u32x2*)(A2 + cr * 2048) + lane + 64 * j) = o[j];
                if (t + 1 < SEQ) *((u32x2*)(A2 + cn * 2048 + 1024) + lane + 64 * j) = o[j];
                if (t == 0) *((u32x2*)(A2 + cr * 2048 + 1024) + lane + 64 * j) = (u32x2){0u, 0u}; } }
        __syncthreads();
        { const int t0 = m0 & (SEQ - 1), bb = m0 >> 12; const size_t cr0 = (size_t)(t0 >> 11) * PROWS6 + bb * 2048 + (t0 & 2047);
          const int mt = wave & 3, nh = wave >> 2;
          LAS bf16_t* LA_ = (LAS bf16_t*)lds; LAS bf16_t* LB_ = (LAS bf16_t*)(lds + 64 * 264 * 2);
          const bf16_t* ga = A2 + cr0 * 2048; const bf16_t* gb = (const bf16_t*)(WSP + WS_WL);
          u32x4 pa_[4], pb_[8];
#define LORA_LOAD(kc) do { _Pragma("unroll") for (int q = 0; q < 4; ++q) { const int i = tid + q * NT; pa_[q] = *(const u32x4*)(ga + (size_t)(i >> 5) * 2048 + (kc) * 256 + 8 * (i & 31)); } \
              _Pragma("unroll") for (int q = 0; q < 8; ++q) { const int i = tid + q * NT; pb_[q] = *(const u32x4*)(gb + (size_t)(i >> 5) * 2048 + (kc) * 256 + 8 * (i & 31)); } } while (0)
          LORA_LOAD(0);
          f32x4 acc[4];
#pragma unroll
          for (int nt = 0; nt < 4; ++nt) acc[nt] = (f32x4){0.f, 0.f, 0.f, 0.f};
#pragma unroll 1
          for (int kc = 0; kc < 8; ++kc) {
#pragma unroll
              for (int q = 0; q < 4; ++q) { const int i = tid + q * NT; *(LAS u32x4*)(LA_ + (i >> 5) * 264 + 8 * (i & 31)) = pa_[q]; }
#pragma unroll
              for (int q = 0; q < 8; ++q) { const int i = tid + q * NT; *(LAS u32x4*)(LB_ + (i >> 5) * 264 + 8 * (i & 31)) = pb_[q]; }
              __syncthreads();
              if (kc + 1 < 8) LORA_LOAD(kc + 1);
#pragma unroll
              for (int ks = 0; ks < 8; ++ks) { const bf16x8 a = *(const LAS bf16x8*)(LA_ + (16 * mt + fr) * 264 + 32 * ks + 8 * fq);
#pragma unroll
                  for (int nt = 0; nt < 4; ++nt) { const bf16x8 bfr = *(const LAS bf16x8*)(LB_ + (64 * nh + 16 * nt + fr) * 264 + 32 * ks + 8 * fq); acc[nt] = MFMA16(a, bfr, acc[nt]); } }
              __syncthreads();
          }
#undef LORA_LOAD
          bf16_t* dstb = (bf16_t*)(WSP + (nh ? WS_LA : WS_LW));
#pragma unroll
          for (int nt = 0; nt < 4; ++nt)
#pragma unroll
              for (int r = 0; r < 4; ++r) { const float v = acc[nt][r]; dstb[(cr0 + 16 * mt + 4 * fq + r) * 64 + 16 * nt + fr] = (bf16_t)f2bf(nh ? v : tanhf(v)); } }
        __syncthreads();
    }
}
template <int CTRL> __device__ __forceinline__ float dpp_add(float x) { const int y = __builtin_amdgcn_update_dpp(0, __float_as_int(x), CTRL, 0xf, 0xf, true); return x + __int_as_float(y); }
__device__ __forceinline__ f32x4 bf4(u32x2 v) { return (f32x4){bf2f(v.x & 0xffffu), bf2f(v.x >> 16), bf2f(v.y & 0xffffu), bf2f(v.y >> 16)}; }
__device__ __forceinline__ float afma(float a, float b, float c) { float d; asm("v_fma_f32 %0, %1, %2, %3" : "=v"(d) : "v"(a), "v"(b), "v"(c)); return d; }
__device__ __forceinline__ float anfma(float a, float b, float c) { float d; asm("v_fma_f32 %0, -%1, %2, %3" : "=v"(d) : "v"(a), "v"(b), "v"(c)); return d; }
__device__ __forceinline__ float amul(float a, float b) { float d; asm("v_mul_f32 %0, %1, %2" : "=v"(d) : "v"(a), "v"(b)); return d; }
__device__ __forceinline__ f32x2 pkmul(f32x2 a, f32x2 b) { f32x2 d; asm("v_pk_mul_f32 %0, %1, %2" : "=v"(d) : "v"(a), "v"(b)); return d; }
__device__ __forceinline__ f32x2 pkfma(f32x2 a, f32x2 b, f32x2 c) { f32x2 d; asm("v_pk_fma_f32 %0, %1, %2, %3" : "=v"(d) : "v"(a), "v"(b), "v"(c)); return d; }
__device__ __forceinline__ f32x2 pkmul_bl(f32x2 s, f32x2 b) { f32x2 d; asm("v_pk_mul_f32 %0, %1, %2 op_sel_hi:[0,1]" : "=v"(d) : "v"(s), "v"(b)); return d; }
__device__ __forceinline__ f32x2 pknfma_bl(f32x2 s, f32x2 b, f32x2 c) { f32x2 d; asm("v_pk_fma_f32 %0, %1, %2, %3 op_sel_hi:[0,1,1] neg_lo:[1,0,0] neg_hi:[1,0,0]" : "=v"(d) : "v"(s), "v"(b), "v"(c)); return d; }
#define VPKMUL(d, a, b) asm volatile("v_pk_mul_f32 %0, %1, %2" : "=v"(d) : "v"(a), "v"(b))
#define VPKFMA(d, a, b, c) asm volatile("v_pk_fma_f32 %0, %1, %2, %3" : "=v"(d) : "v"(a), "v"(b), "v"(c))
#define VPKMULBL(d, s, b) asm volatile("v_pk_mul_f32 %0, %1, %2 op_sel_hi:[0,1]" : "=v"(d) : "v"(s), "v"(b))
#define VPKNFMABL(d, s, b, c) asm volatile("v_pk_fma_f32 %0, %1, %2, %3 op_sel_hi:[0,1,1] neg_lo:[1,0,0] neg_hi:[1,0,0]" : "=v"(d) : "v"(s), "v"(b), "v"(c))
#define VADD(d, a, b) asm volatile("v_add_f32 %0, %1, %2" : "=v"(d) : "v"(a), "v"(b))
#define VDPP1(x) asm volatile("v_add_f32_dpp %0, %0, %0 quad_perm:[1,0,3,2] row_mask:0xf bank_mask:0xf bound_ctrl:1" : "+v"(x))
#define VDPP2(x) asm volatile("v_add_f32_dpp %0, %0, %0 quad_perm:[2,3,0,1] row_mask:0xf bank_mask:0xf bound_ctrl:1" : "+v"(x))
#define VDPP3(x) asm volatile("v_add_f32_dpp %0, %0, %0 row_half_mirror row_mask:0xf bank_mask:0xf bound_ctrl:1" : "+v"(x))
constexpr int RSTR = 68;
constexpr int REC_ARR = 32 * RSTR;
constexpr int REC_BUF = 5 * REC_ARR;
constexpr int L_REC = 0, L_YY = 87040, L_VV = 103424, L_GG = 119808, L_RKP = 136192, L_SSP = 137216, L_STT = 137728, L_CST = 137984;
constexpr int PROWS = 8192;
#define SCAN_BAR do { asm volatile("s_waitcnt lgkmcnt(0)" ::: "memory"); __builtin_amdgcn_s_barrier(); asm volatile("" ::: "memory"); } while (0)
__device__ __forceinline__ void scan_half(const Params& p, LAS unsigned char* lds, int pi, int rh, int pass) {
    OPQ_TID;
    LAS float* REC = (LAS float*)(lds + L_REC); LAS float* YY = (LAS float*)(lds + L_YY); LAS float* VV = (LAS float*)(lds + L_VV); LAS float* GG = (LAS float*)(lds + L_GG);
    LAS float* RKP = (LAS float*)(lds + L_RKP); LAS float* SSP = (LAS float*)(lds + L_SSP); LAS float* STT = (LAS float*)(lds + L_STT); LAS float* CST = (LAS float*)(lds + L_CST);
    const int b = pi >> 5, hg = pi & 31, colg = hg * 64;
    const bf16_t* Rb = (const bf16_t*)(WSP + WS_R); const bf16_t* Kb = Rb + (size_t)PROWS * 2048; bf16_t* Vb = (bf16_t*)(WSP + WS_V); const bf16_t* Gb = Vb + (size_t)PROWS * 2048;
    const bf16_t* LWb = (const bf16_t*)(WSP + WS_LW) + (size_t)pass * PROWS * 64; const bf16_t* LAb = (const bf16_t*)(WSP + WS_LA) + (size_t)pass * PROWS * 64;
    unsigned long long* GR = (unsigned long long*)(WSP + WS_GR);
    const size_t rowb = (size_t)b * 2048;
    __syncthreads();
    if (tid < 64) { CST[tid] = ((const float*)p.in[I_W0])[colg + tid]; CST[64 + tid] = ((const float*)p.in[I_A0])[colg + tid]; CST[128 + tid] = ((const float*)p.in[I_KK])[colg + tid]; CST[192 + tid] = ((const float*)p.in[I_KA])[colg + tid]; CST[256 + tid] = ((const float*)p.in[I_RK])[colg + tid];
                    CST[320 + tid] = ((const float*)p.in[I_LNG])[colg + tid]; CST[384 + tid] = ((const float*)p.in[I_LNB])[colg + tid]; }
    __syncthreads();
    const int fr = lane & 15, fq = lane >> 4;
    if (wave < 4) {
        const int j = lane & 7, rowl = 8 * wave + (lane >> 3);
        float* stp = (float*)(WSP + WS_ST) + ((size_t)(pi * 64 + 32 * rh + rowl)) * 64 + 8 * j;
        f32x2 P01 = (f32x2){0.f, 0.f}, P23 = P01, P45 = P01, P67 = P01;
        if (pass == 1) { const f32x4 a = *(const f32x4*)stp, c = *(const f32x4*)(stp + 4); P01 = a.xy; P23 = a.zw; P45 = c.xy; P67 = c.zw; }
        const bool first = (lane & 7) == 0;
        SCAN_BAR;
        for (int it = 0; it < 66; ++it) {
            if (it < 64) {
                const LAS float* rec = REC + (it & 1) * REC_BUF + 8 * j; const LAS float* vvp = VV + (it & 3) * 1024 + rowl; LAS float* yyp = YY + (it & 3) * 1024 + rowl;
                const LAS float* ssp = SSP + (it & 1) * 64 + 2 * (lane & 31);
                const float inv2 = __builtin_amdgcn_rcpf(fmaxf(ssp[0] + ssp[1], 1e-24f));
                f32x4 Rkk[2][2], Rw[2][2], Rka[2][2], Rkm[2][2], Rr[2][2]; float Rv[2];
#define LOADREC(slot, s) do { const LAS float* rs_ = rec + (s) * RSTR; \
                    Rkk[slot][0] = *(const LAS f32x4*)(rs_); Rkk[slot][1] = *(const LAS f32x4*)(rs_ + 4); Rw[slot][0] = *(const LAS f32x4*)(rs_ + REC_ARR); Rw[slot][1] = *(const LAS f32x4*)(rs_ + REC_ARR + 4); \
                    Rka[slot][0] = *(const LAS f32x4*)(rs_ + 2 * REC_ARR); Rka[slot][1] = *(const LAS f32x4*)(rs_ + 2 * REC_ARR + 4); Rkm[slot][0] = *(const LAS f32x4*)(rs_ + 3 * REC_ARR); Rkm[slot][1] = *(const LAS f32x4*)(rs_ + 3 * REC_ARR + 4); \
                    Rr[slot][0] = *(const LAS f32x4*)(rs_ + 4 * REC_ARR); Rr[slot][1] = *(const LAS f32x4*)(rs_ + 4 * REC_ARR + 4); Rv[slot] = vvp[(s) * 32]; } while (0)
                LOADREC(0, 0);
                float yp = 0.f, yk0 = 0.f, yk1 = 0.f, yk2 = 0.f, yk3 = 0.f;
#define YSHIFT(YK) do { YK = __int_as_float(__builtin_amdgcn_update_dpp(__float_as_int(yp), __float_as_int(YK), 0x111, 0xf, 0xf, false)); YK = first ? yp : YK; } while (0)
#pragma unroll
                for (int s = 0; s < 32; ++s) {
                    const int c = s & 1, pc = c ^ 1;
                    const float si = __int_as_float(__builtin_amdgcn_readlane(__float_as_int(inv2), s));
                    f32x2 px, py, t01, t23, t45, t67; float x;
                    f32x2 vv2; vv2.x = Rv[c]; asm volatile("" : "+v"(vv2));
                    if (s >= 1) {
                        VPKMUL(px, P01, Rkk[c][0].xy); VPKMUL(py, P01, Rr[pc][0].xy); VPKFMA(px, P23, Rkk[c][0].zw, px); VPKFMA(py, P23, Rr[pc][0].zw, py);
                        VPKFMA(px, P45, Rkk[c][1].xy, px); VPKFMA(py, P45, Rr[pc][1].xy, py); VPKFMA(px, P67, Rkk[c][1].zw, px); VPKFMA(py, P67, Rr[pc][1].zw, py);
                        VADD(x, px.x, px.y); VADD(yp, py.x, py.y);
                    } else {
                        VPKMUL(px, P01, Rkk[c][0].xy); VPKFMA(px, P23, Rkk[c][0].zw, px); VPKFMA(px, P45, Rkk[c][1].xy, px); VPKFMA(px, P67, Rkk[c][1].zw, px);
                        VADD(x, px.x, px.y);
                    }
                    asm volatile("" ::: "memory");
                    if (s + 1 < 32) LOADREC((s + 1) & 1, s + 1);
                    asm volatile("" ::: "memory");
                    VPKMULBL(t01, vv2, Rkm[c][0].xy); VPKMULBL(t23, vv2, Rkm[c][0].zw);
                    VDPP1(x); if (s >= 1) VDPP1(yp);
                    VPKMULBL(t45, vv2, Rkm[c][1].xy); VPKMULBL(t67, vv2, Rkm[c][1].zw);
                    VDPP2(x); if (s >= 1) VDPP2(yp);
                    VPKFMA(P01, P01, Rw[c][0].xy, t01); VPKFMA(P23, P23, Rw[c][0].zw, t23);
                    VDPP3(x); if (s >= 1) VDPP3(yp);
                    VPKFMA(P45, P45, Rw[c][1].xy, t45); VPKFMA(P67, P67, Rw[c][1].zw, t67);
                    if (s >= 1) { if (s - 1 < 8) YSHIFT(yk0); else if (s - 1 < 16) YSHIFT(yk1); else if (s - 1 < 24) YSHIFT(yk2); else YSHIFT(yk3); }
                    x = x * si;
                    f32x2 x2; x2.x = x; asm volatile("" : "+v"(x2));
                    VPKNFMABL(P01, x2, Rka[c][0].xy, P01); VPKNFMABL(P23, x2, Rka[c][0].zw, P23); VPKNFMABL(P45, x2, Rka[c][1].xy, P45); VPKNFMABL(P67, x2, Rka[c][1].zw, P67);
                }
                { f32x2 py; VPKMUL(py, P01, Rr[1][0].xy); VPKFMA(py, P23, Rr[1][0].zw, py); VPKFMA(py, P45, Rr[1][1].xy, py); VPKFMA(py, P67, Rr[1][1].zw, py); VADD(yp, py.x, py.y); }
                yp = dpp_add<0xB1>(yp); yp = dpp_add<0x4E>(yp); yp = dpp_add<0x141>(yp); YSHIFT(yk3);
                yyp[(7 - j) * 32] = yk0; yyp[(15 - j) * 32] = yk1; yyp[(23 - j) * 32] = yk2; yyp[(31 - j) * 32] = yk3;
#undef LOADREC
#undef YSHIFT
            }
            SCAN_BAR;
        }
        if (pass == 0) { *(f32x4*)stp = (f32x4){P01.x, P01.y, P23.x, P23.y}; *(f32x4*)(stp + 4) = (f32x4){P45.x, P45.y, P67.x, P67.y}; }
    } else {
        const int pw = wave - 4, tt = pw >> 1, kh = pw & 1;
        bf16x8 aWc[2][2], aAc[2][2];
#pragma unroll
        for (int kt = 0; kt < 2; ++kt)
#pragma unroll
            for (int ks = 0; ks < 2; ++ks) { const size_t o = (size_t)(colg + 32 * kh + 16 * kt + fr) * 64 + 32 * ks + 8 * fq; aWc[kt][ks] = *(const bf16x8*)((const bf16_t*)(WSP + WS_W2T) + o); aAc[kt][ks] = *(const bf16x8*)((const bf16_t*)(WSP + WS_A2T) + o); }
        bf16x8 lwf[2][2], laf[2][2]; u32x2 r2[2][2], k2[2][2];
#define ISSUE(SET, tbx) do { const size_t tok_ = rowb + (tbx) * 32 + 16 * tt + fr; \
            _Pragma("unroll") for (int ks = 0; ks < 2; ++ks) { lwf[SET][ks] = *(const bf16x8*)(LWb + tok_ * 64 + 32 * ks + 8 * fq); laf[SET][ks] = *(const bf16x8*)(LAb + tok_ * 64 + 32 * ks + 8 * fq); } \
            _Pragma("unroll") for (int kt = 0; kt < 2; ++kt) { r2[SET][kt] = *(const u32x2*)(Rb + tok_ * 2048 + colg + 32 * kh + 16 * kt + 4 * fq); k2[SET][kt] = *(const u32x2*)(Kb + tok_ * 2048 + colg + 32 * kh + 16 * kt + 4 * fq); } } while (0)
        ISSUE(0, 0); ISSUE(1, 1);
        const int t = lane >> 1, hf = lane & 1;
        const size_t vgo = (size_t)colg + 32 * rh + 16 * hf;
        u32x4 v8a = (u32x4){0u, 0u, 0u, 0u}, v8b = v8a, g8a = v8a, g8b = v8a;
        if (pw == 2) { const size_t eo = (rowb + t) * 2048 + vgo; v8a = *(const u32x4*)(Vb + eo); v8b = *(const u32x4*)(Vb + eo + 8); g8a = *(const u32x4*)(Gb + eo); g8b = *(const u32x4*)(Gb + eo + 8); }
        unsigned long long gx[2] = {0ull, 0ull};
#define PROD_ITER(it, PS) do { \
            { const int tb = (it) + 1; \
              if (tb < 64) { \
                LAS float* rec = REC + (tb & 1) * REC_BUF + (16 * tt + fr) * RSTR + 32 * kh + 4 * fq; \
                float ss = 0.f, rkp = 0.f; \
                _Pragma("unroll") for (int kt = 0; kt < 2; ++kt) { \
                    f32x4 accW = (f32x4){0.f, 0.f, 0.f, 0.f}, accA = (f32x4){0.f, 0.f, 0.f, 0.f}; \
                    _Pragma("unroll") for (int ks = 0; ks < 2; ++ks) { accW = MFMA16(aWc[kt][ks], lwf[PS][ks], accW); accA = MFMA16(aAc[kt][ks], laf[PS][ks], accA); } \
                    const int kc = 32 * kh + 16 * kt + 4 * fq; \
                    const f32x4 w0v = *(const LAS f32x4*)(CST + kc), a0v = *(const LAS f32x4*)(CST + 64 + kc), kkc = *(const LAS f32x4*)(CST + 128 + kc), kac = *(const LAS f32x4*)(CST + 192 + kc), rkc = *(const LAS f32x4*)(CST + 256 + kc); \
                    const f32x4 r4 = bf4(r2[PS][kt]), k4 = bf4(k2[PS][kt]); \
                    f32x4 w4, a4; \
                    _Pragma("unroll") for (int e = 0; e < 4; ++e) { w4[e] = __expf(-0.60653066f * sigmf(accW[e] + w0v[e])); a4[e] = sigmf(accA[e] + a0v[e]); } \
                    const f32x4 kkr = k4 * kkc; ss += (kkr.x * kkr.x + kkr.y * kkr.y) + (kkr.z * kkr.z + kkr.w * kkr.w); \
                    const f32x4 km = k4 * (1.0f + (a4 - 1.0f) * kac); const f32x4 rr = r4 * km * rkc; rkp += (rr.x + rr.y) + (rr.z + rr.w); \
                    *(LAS f32x4*)(rec + 16 * kt) = kkr; *(LAS f32x4*)(rec + REC_ARR + 16 * kt) = w4; *(LAS f32x4*)(rec + 2 * REC_ARR + 16 * kt) = kkr * a4; *(LAS f32x4*)(rec + 3 * REC_ARR + 16 * kt) = km; *(LAS f32x4*)(rec + 4 * REC_ARR + 16 * kt) = r4; \
                } \
                if (tb + 2 < 64) ISSUE(PS, tb + 2); \
                ss += __shfl_xor(ss, 16); ss += __shfl_xor(ss, 32); rkp += __shfl_xor(rkp, 16); rkp += __shfl_xor(rkp, 32); \
                if (fq == 0) { SSP[(tb & 1) * 64 + 2 * (16 * tt + fr) + kh] = ss; RKP[(tb & 3) * 64 + 2 * (16 * tt + fr) + kh] = rkp; } \
              } \
              if (pw == 2 && tb < 64) { \
                LAS float* vp = VV + (tb & 3) * 1024 + t * 32 + 16 * hf; LAS float* gp = GG + (tb & 3) * 1024 + t * 32 + 16 * hf; \
                *(LAS f32x4*)(vp) = bf4((u32x2){v8a.x, v8a.y}); *(LAS f32x4*)(vp + 4) = bf4((u32x2){v8a.z, v8a.w}); *(LAS f32x4*)(vp + 8) = bf4((u32x2){v8b.x, v8b.y}); *(LAS f32x4*)(vp + 12) = bf4((u32x2){v8b.z, v8b.w}); \
                *(LAS f32x4*)(gp) = bf4((u32x2){g8a.x, g8a.y}); *(LAS f32x4*)(gp + 4) = bf4((u32x2){g8a.z, g8a.w}); *(LAS f32x4*)(gp + 8) = bf4((u32x2){g8b.x, g8b.y}); *(LAS f32x4*)(gp + 12) = bf4((u32x2){g8b.z, g8b.w}); \
                if (tb + 1 < 64) { const size_t eo = (rowb + (tb + 1) * 32 + t) * 2048 + vgo; v8a = *(const u32x4*)(Vb + eo); v8b = *(const u32x4*)(Vb + eo + 8); g8a = *(const u32x4*)(Gb + eo); g8b = *(const u32x4*)(Gb + eo + 8); } \
              } \
            } \
            if (pw == 3) { \
              if ((it) >= 2 && (it) <= 65) { const int tb = (it) - 2; const unsigned long long* g = GR + ((size_t)(pi * 8 + (tb & 7)) * 2) * 64 + lane; \
                gx[0] = __hip_atomic_load(g, __ATOMIC_RELAXED, __HIP_MEMORY_SCOPE_AGENT); gx[1] = __hip_atomic_load(g + 64, __ATOMIC_RELAXED, __HIP_MEMORY_SCOPE_AGENT); } \
              if ((it) >= 1 && (it) <= 64) { const int tb = (it) - 1; const LAS float* yp_ = YY + (tb & 3) * 1024 + t * 32 + 16 * hf; float s1 = 0.f, s2 = 0.f; \
                _Pragma("unroll") for (int qd = 0; qd < 4; ++qd) { const f32x4 a = *(const LAS f32x4*)(yp_ + 4 * qd); s1 += (a.x + a.y) + (a.z + a.w); s2 += (a.x * a.x + a.y * a.y) + (a.z * a.z + a.w * a.w); } \
                s1 = dpp_add<0xB1>(s1); s2 = dpp_add<0xB1>(s2); \
                const unsigned epoch = (unsigned)(pass * 64 + tb + 1); \
                __hip_atomic_store(GR + ((size_t)((pi * 8 + (tb & 7)) * 2 + rh) * 64 + hf * 32 + t), ((unsigned long long)epoch << 32) | (unsigned long long)__float_as_uint(hf ? s2 : s1), __ATOMIC_RELAXED, __HIP_MEMORY_SCOPE_AGENT); } \
              if ((it) >= 2 && (it) <= 65) { const int tb = (it) - 2; const unsigned epoch = (unsigned)(pass * 64 + tb + 1); \
                const unsigned long long* g = GR + ((size_t)(pi * 8 + (tb & 7)) * 2) * 64 + lane; float tot; \
                for (unsigned spins = 0;; ++spins) { const bool ok = ((unsigned)(gx[0] >> 32) == epoch) && ((unsigned)(gx[1] >> 32) == epoch); tot = __uint_as_float((unsigned)gx[0]) + __uint_as_float((unsigned)gx[1]); \
                    if (__all(ok) || spins > (1u << 22)) break; \
                    __builtin_amdgcn_s_sleep(1); \
                    gx[0] = __hip_atomic_load(g, __ATOMIC_RELAXED, __HIP_MEMORY_SCOPE_AGENT); gx[1] = __hip_atomic_load(g + 64, __ATOMIC_RELAXED, __HIP_MEMORY_SCOPE_AGENT); } \
                const float oth = __shfl_xor(tot, 32); \
                const float mean = (lane < 32 ? tot : oth) * (1.0f / 64.0f), ex2 = (lane < 32 ? oth : tot) * (1.0f / 64.0f); \
                const float rstd = rsqrtf(fmaxf(ex2 - mean * mean, 0.f) + 64e-5f); \
                if (lane < 32) { STT[2 * lane] = mean; STT[2 * lane + 1] = rstd; } \
                const float mu = STT[2 * t], rsd = STT[2 * t + 1]; \
                const int ro = (tb & 3) * 1024 + t * 32 + 16 * hf; const float rk = RKP[(tb & 3) * 64 + 2 * t] + RKP[(tb & 3) * 64 + 2 * t + 1]; \
                unsigned ow[8]; \
                _Pragma("unroll") for (int qd = 0; qd < 4; ++qd) { const f32x4 lg = *(const LAS f32x4*)(CST + 320 + 32 * rh + 16 * hf + 4 * qd), lb = *(const LAS f32x4*)(CST + 384 + 32 * rh + 16 * hf + 4 * qd); \
                    const f32x4 o = ((*(const LAS f32x4*)(YY + ro + 4 * qd) - mu) * rsd * lg + lb + rk * *(const LAS f32x4*)(VV + ro + 4 * qd)) * *(const LAS f32x4*)(GG + ro + 4 * qd); \
                    ow[2 * qd] = pk2(o.x, o.y); ow[2 * qd + 1] = pk2(o.z, o.w); } \
                bf16_t* dst = (bf16_t*)(WSP + WS_A2) + ((size_t)pass * PROWS + rowb + tb * 32 + t) * 2048 + vgo; \
                *(u32x4*)(dst) = (u32x4){ow[0], ow[1], ow[2], ow[3]}; *(u32x4*)(dst + 8) = (u32x4){ow[4], ow[5], ow[6], ow[7]}; } \
            } \
            SCAN_BAR; } while (0)
        for (int it2 = -1; it2 < 65; it2 += 2) { PROD_ITER(it2, 0); PROD_ITER(it2 + 1, 1); }
        PROD_ITER(65, 0);
#undef PROD_ITER
#undef ISSUE
    }
}
__device__ __forceinline__ void p10_final(const Params& p, int G, int bid) {
    OPQ_TID; const int gw = bid * 8 + wave, ngw = G * 8;
    for (int m = gw; m < T; m += ngw) { float* xr = ((float*)p.out) + (size_t)m * D; f32x4 v[4]; float s = 0.f;
#pragma unroll
        for (int j = 0; j < 4; ++j) { v[j] = *((const f32x4*)xr + lane + 64 * j); s += (v[j].x * v[j].x + v[j].y * v[j].y) + (v[j].z * v[j].z + v[j].w * v[j].w); }
        const float rs = rsqrtf(wave_sum(s) * (1.0f / 1024.0f) + 1e-6f);
#pragma unroll
        for (int j = 0; j < 4; ++j) { const f32x4 gg = *((const f32x4*)((const float*)p.in[I_FG]) + lane + 64 * j); *((f32x4*)xr + lane + 64 * j) = v[j] * rs * gg; } }
}

#define XB_TMO      128
#define XB_XCNT(j)  (256  + 64 * (j))
#define XB_XSUB(j)  (1280 + 64 * (j))
#define XB_XGEN(j)  (2304 + 64 * (j))
#define XB_TOP      3328
#define XB_TOPGEN   3392
#define XCD_BAR_WORDS 3456
#define XB_SPIN_CAP (1u << 18)

__device__ __forceinline__ unsigned xb_ld(unsigned* p)              { return __hip_atomic_load(p, __ATOMIC_RELAXED, __HIP_MEMORY_SCOPE_AGENT); }
__device__ __forceinline__ unsigned xb_add(unsigned* p, unsigned v) { return __hip_atomic_fetch_add(p, v, __ATOMIC_RELAXED, __HIP_MEMORY_SCOPE_AGENT); }
__device__ __forceinline__ unsigned xb_xcc_id() { return (unsigned)__builtin_amdgcn_s_getreg((3 << 11) | 20) & 0xFu; }
#define XB_SPIN(cond, bar) do { unsigned _sp = 0; while (cond) { __builtin_amdgcn_s_sleep(1); \
    if ((++_sp & 255u) == 0u) { if (xb_ld(&(bar)[XB_TMO])) break; if (_sp > XB_SPIN_CAP) { atomicAdd(&(bar)[XB_TMO], 1u); break; } } } } while (0)

struct XcdBarrier {
    unsigned* bar; unsigned x;
    volatile LAS unsigned* st;
};

__device__ __forceinline__ XcdBarrier xcd_barrier_post(unsigned* bar, volatile LAS unsigned* st) {
    XcdBarrier b; b.bar = bar; b.x = xb_xcc_id(); b.st = st;
    if (threadIdx.x == 0) (void)xb_add(&bar[XB_XCNT(b.x)], 1u);
    return b;
}
__device__ __forceinline__ void xcd_barrier_complete(unsigned* bar, unsigned x, unsigned& nloc, unsigned& nx) {
    const unsigned G = gridDim.x * gridDim.y * gridDim.z;
    unsigned sum, cnt, mine, sp = 0u;
    for (;;) {
        sum = 0u; cnt = 0u; mine = 0u;
#pragma unroll
        for (unsigned j = 0; j < 16; ++j) { const unsigned c = xb_ld(&bar[XB_XCNT(j)]); sum += c; cnt += (c > 0u) ? 1u : 0u; mine = (j == x) ? c : mine; }
        if (sum == G) break;
        __builtin_amdgcn_s_sleep(1);
        if ((++sp & 255u) == 0u) { if (xb_ld(&bar[XB_TMO])) break; if (sp > XB_SPIN_CAP) { atomicAdd(&bar[XB_TMO], 1u); break; } }
    }
    nloc = mine > 0u ? mine : 1u; nx = cnt > 0u ? cnt : 1u;
}

__device__ __forceinline__ void xcd_barrier(const XcdBarrier& b) {
    asm volatile("s_waitcnt vmcnt(0)" ::: "memory");
    __syncthreads();
    if (threadIdx.x == 0) {
        unsigned* bar = (unsigned*)(*(volatile LAS unsigned long long*)(b.st + 4)); const unsigned bx_ = xb_xcc_id();
        __builtin_amdgcn_s_waitcnt(0);
        unsigned nloc = b.st[0], nx = b.st[1];
        if (nloc == 0u) { xcd_barrier_complete(bar, bx_, nloc, nx); b.st[0] = nloc; b.st[1] = nx; }
        const unsigned old = xb_add(&bar[XB_XSUB(bx_)], 1u);
        const unsigned gen = old / nloc;
        if (old + 1u == (gen + 1u) * nloc) {
            __builtin_amdgcn_fence(__ATOMIC_RELEASE, "agent");
            asm volatile("s_waitcnt vmcnt(0)" ::: "memory");
            const unsigned og = xb_add(&bar[XB_TOP], 1u);
            const unsigned tg = og / nx;
            if (og + 1u == (tg + 1u) * nx) xb_add(&bar[XB_TOPGEN], 1u);
            else XB_SPIN(xb_ld(&bar[XB_TOPGEN]) == tg, bar);
            __builtin_amdgcn_fence(__ATOMIC_ACQUIRE, "agent");
            xb_add(&bar[XB_XGEN(bx_)], 1u);
            asm volatile("s_waitcnt vmcnt(0)" ::: "memory");
        } else {
            XB_SPIN(xb_ld(&bar[XB_XGEN(bx_)]) == gen, bar);
            __builtin_amdgcn_fence(__ATOMIC_ACQUIRE, "agent");
            asm volatile("s_waitcnt vmcnt(0)" ::: "memory");
        }
    }
    __syncthreads();
}

__global__ void __launch_bounds__(NT, 2) mk_fwd(Params p) {
    auto wsl = [&]() { return launder_ws(((unsigned char*)p.ws)); };
    extern __shared__ __attribute__((aligned(16))) unsigned char lds_raw[];
    LAS unsigned char* lds = (LAS unsigned char*)lds_raw;
    cg::grid_group grid = cg::this_grid();
    const int G = gridDim.x, bid = blockIdx.x;
    if (threadIdx.x < 16) ((LAS unsigned*)(lds + LDS_MISC))[threadIdx.x] = 0u;
    __syncthreads();
    if (threadIdx.x == 0) *(LAS unsigned long long*)(lds + LDS_MISC + 16) = (unsigned long long)(((unsigned char*)p.ws) + WS_BAR);
    __syncthreads();
    if (bid == 0) for (int i = threadIdx.x; i < 4096; i += NT) ((unsigned*)(((unsigned char*)p.ws) + WS_BAR))[i] = 0u;
#define XBAR() do { XcdBarrier xb_; xb_.bar = nullptr; xb_.x = 0u; xb_.st = (volatile LAS unsigned*)(lds + LDS_MISC); xcd_barrier(xb_); } while (0)
#if PROBE == 7
    p0_prologue(p, lds, G, bid);
#endif
    p0_prologue(p, lds, G, bid);
    grid.sync();
    (void)xcd_barrier_post((unsigned*)(((unsigned char*)p.ws) + WS_BAR), (volatile LAS unsigned*)(lds + LDS_MISC));
    { pg8::Gemm g{(const bf16_t*)((float*)p.out), (const bf16_t*)(wsl() + WS_WIN), T, ZW, D, D}; pg8::StaticOrder S; S.init(T, ZW, G, bid); pg8::EpiBf16 E{(bf16_t*)(wsl() + WS_Z), ZW};
      pg8::gemm_phase<pg8::EpiBf16, pg8::StaticOrder, true, true>(lds, g, S, E); }
    XBAR();
#if PROBE == 3
    { u32x4 pre[3]; if (bid < 2048) rg_a_prefetch((const bf16_t*)(wsl() + WS_Z), bid, threadIdx.x, pre); for (int u = bid; u < 2048; u += G) rg_a_unit(p, lds, u, u + G, pre); }
    { u32x4 pre[6]; if (bid < 2048) hg_a_prefetch((const bf16_t*)(wsl() + WS_Z), bid, threadIdx.x, pre); for (int u = bid; u < 2048; u += G) hg_a_unit(p, lds, u, u + G, pre); }
    XBAR();
#endif
    { u32x4 pre[3]; if (bid < 2048) rg_a_prefetch((const bf16_t*)(wsl() + WS_Z), bid, threadIdx.x, pre); for (int u = bid; u < 2048; u += G) rg_a_unit(p, lds, u, u + G, pre); }
    { u32x4 pre[6]; if (bid < 2048) hg_a_prefetch((const bf16_t*)(wsl() + WS_Z), bid, threadIdx.x, pre); for (int u = bid; u < 2048; u += G) hg_a_unit(p, lds, u, u + G, pre); }
    XBAR();
#if PROBE == 2
    for (int u = bid; u < 256; u += G) hg_b_item(p, lds, u, p.dry != 0);
    XBAR();
#endif
#if PROBE == 6
    for (int u = bid; u < 512; u += G) rg_b_unit(p, u);
    XBAR();
#endif
#if PROBE == 4
    for (int q = 0; q < 16; ++q) XBAR();
#endif
    for (int u = bid; u < 256; u += G) { const int it_ = (G == 256) ? ((((u & 7) + 8 * (u >> 6)) << 3) | ((u >> 3) & 7)) : u; hg_b_item(p, lds, it_); }
    for (int u = bid; u < 512; u += G) rg_b_unit(p, u);
    XBAR();
#if PROBE == 8
    p4_finalize(p, G, bid);
#endif
    p4_finalize(p, G, bid);
    XBAR();
    { pg8::Gemm g{(const bf16_t*)(wsl() + WS_Z), (const bf16_t*)(wsl() + WS_WOUT), T, D, 2048, ZW}; pg8::StaticOrder S; S.init(T, D, G, bid); pg8::EpiResF32 E{((const float*)p.in[I_X]), ((float*)p.out), D, 0, 0};
      pg8::gemm_phase<pg8::EpiResF32, pg8::StaticOrder, true, true>(lds, g, S, E); }
    XBAR();
#if PROBE == 9
    p6_prologue(p, lds, G, bid);
#endif
    p6_prologue(p, lds, G, bid);
    XBAR();
#pragma unroll 1
    for (int pass = 0; pass < 2; ++pass) {
        { pg8::Gemm g{(const bf16_t*)(wsl() + WS_A2) + (size_t)pass * 8192 * 2048, (const bf16_t*)(wsl() + WS_WC), 8192, 8192, 2048, 2048}; pg8::StaticOrder S; S.init(8192, 8192, G, bid);
          pg8::EpiL1 E{(bf16_t*)(wsl() + WS_R), (bf16_t*)(wsl() + WS_LW), (bf16_t*)(wsl() + WS_LA)};
          pg8::gemm_phase<pg8::EpiL1, pg8::StaticOrder, true, true>(lds, g, S, E); }
        XBAR();
        for (int u0 = 0; u0 < 256; u0 += G) { const int u = u0 + bid; if (u < 256) { int pi, rh; if (G == 256) { pi = (u & 7) + 8 * (u >> 4); rh = (u >> 3) & 1; } else { pi = u >> 1; rh = u & 1; } scan_half(p, lds, pi, rh, pass); } }
        XBAR();
    }
    if (G == 256) {
        pg8::Gemm g{(const bf16_t*)(wsl() + WS_A2), (const bf16_t*)(wsl() + WS_WO), T, D, 2048, 2048}; pg8::StaticOrder S; S.init(T, D, G, bid); pg8::EpiFinalNorm E{((float*)p.out), ((const float*)p.in[I_FG]), (unsigned long long*)(wsl() + WS_XG), D};
        pg8::gemm_phase<pg8::EpiFinalNorm, pg8::StaticOrder, false, true>(lds, g, S, E);
    } else {
        { pg8::Gemm g{(const bf16_t*)(wsl() + WS_A2), (const bf16_t*)(wsl() + WS_WO), T, D, 2048, 2048}; pg8::StaticOrder S; S.init(T, D, G, bid); pg8::EpiResF32 E{((float*)p.out), ((float*)p.out), D, 1, 0};
          pg8::gemm_phase<pg8::EpiResF32, pg8::StaticOrder, true, true>(lds, g, S, E); }
        XBAR();
        p10_final(p, G, bid);
    }
}

extern "C" void kernel_launch(void* const* d_in, const int* in_sizes, int n_in, void* d_out, int out_size, void* d_ws, size_t ws_size, hipStream_t stream) {
    static int grid = 0;
    if (grid == 0) {
        int dev = 0, cus = 0, per_cu = 0;
        if (n_in != 32 || out_size != T * D || ws_size < 256 * MiB) { fprintf(stderr, "kernel_launch: unexpected shapes (n_in %d out %d ws %zu)\n", n_in, out_size, ws_size); grid = -1; return; }
        if (hipGetDevice(&dev) != hipSuccess || hipDeviceGetAttribute(&cus, hipDeviceAttributeMultiprocessorCount, dev) != hipSuccess) { grid = -1; return; }
        if (hipFuncSetAttribute((const void*)mk_fwd, hipFuncAttributeMaxDynamicSharedMemorySize, LDS_BYTES) != hipSuccess) { fprintf(stderr, "hipFuncSetAttribute failed\n"); grid = -1; return; }
        if (hipOccupancyMaxActiveBlocksPerMultiprocessor(&per_cu, (const void*)mk_fwd, NT, LDS_BYTES) != hipSuccess || per_cu < 1) fprintf(stderr, "occupancy query: %d\n", per_cu);
        (void)hipGetLastError();
        grid = cus;
    }
    if (grid < 0) return;
    Params p{};
    p.dry = 1;
    for (int i = 0; i < 32; ++i) memcpy(&p.in[i], &d_in[i], sizeof(void*));
    memcpy(&p.out, &d_out, sizeof(void*)); memcpy(&p.ws, &d_ws, sizeof(void*));
    void* args[] = {&p};
    hipError_t e = hipLaunchCooperativeKernel((const void*)mk_fwd, dim3(grid), dim3(NT), args, LDS_BYTES, stream);
    if (e != hipSuccess) fprintf(stderr, "cooperative launch failed: %s (grid %d)\n", hipGetErrorString(e), grid);
}
```

```cpp
#define PROBE 0
#include <hip/hip_runtime.h>
#include <hip/hip_cooperative_groups.h>
#include <cstdio>
#include <cstring>
#include <cstdint>
namespace cg = cooperative_groups;
namespace pg8 {
#define PG8_LAS __attribute__((address_space(3)))
typedef unsigned short bf16_t;
typedef short bf16x8 __attribute__((ext_vector_type(8)));
typedef float f32x4 __attribute__((ext_vector_type(4)));
typedef unsigned u32x4 __attribute__((ext_vector_type(4)));
constexpr int BM = 256, BK = 64, HALF = 128, HTB = HALF * BK * 2  , STAGE_BYTES = 8 * HTB, NXCD = 8, WGM = 8;

__host__ __device__ __forceinline__ int lds_byte(int r, int c) { const int st = (r >> 4) * 2 + (c >> 5), rr = r & 15, cc = c & 31, ob = rr * 64 + cc * 2; return st * 1024 + (ob ^ (((ob >> 9) & 1) << 5)); }
__host__ __device__ __forceinline__ void stage_rc(int b, int& R, int& C) { const int st = b / 1024, sb = b % 1024, swz = sb ^ (((sb >> 9) & 1) << 5); R = (st >> 1) * 16 + swz / 64; C = (st & 1) * 32 + (swz % 64) / 2; }
__host__ __device__ __forceinline__ int perm32(int rho) { const int n = rho >> 4, i = rho & 15; return 8 * (i >> 2) + 4 * n + (i & 3); }

struct Unit { int pm, pn; };
struct Gemm { const bf16_t* A; const bf16_t* Bt; int M, N, K, lda; };

struct StaticOrder {
    int nM, nN, nwg, G, c;
    __host__ __device__ void init(int M, int N, int G_, int c_) { nM = M / BM; nN = N / BM; nwg = nM * nN; G = G_; c = c_; }
    __host__ __device__ bool next(int i, Unit& u) const {
        const long L = (long)i * G + c; if (L >= nwg) return false;
        int wgid = (int)L; { const int q = nwg / NXCD, r = nwg % NXCD, xcd = wgid % NXCD, off = wgid / NXCD; wgid = (xcd < r ? xcd * (q + 1) : r * (q + 1) + (xcd - r) * q) + off; }
        const int nig = WGM * nN, gid = wgid / nig, fm = gid * WGM, gsz = (nM - fm) < WGM ? (nM - fm) : WGM;
        u.pm = fm + ((wgid % nig) % gsz); u.pn = (wgid % nig) / gsz; return true;
    }
    __device__ __forceinline__ void a_ready(const Unit&) const {}
    __device__ __forceinline__ void done(const Unit&) const {}
};


struct LoraOrder {
    StaticOrder so; int extra;
    __host__ __device__ void init(int M, int N, int G_, int c_, int extra_) { so.init(M, N, G_, c_); extra = extra_; }
    __host__ __device__ bool next(int i, Unit& u) const { const long L = (long)i * so.G + so.c; if (L < so.nwg) return so.next(i, u); if (L >= so.nwg + extra) return false; u.pm = so.nM + (int)(L - so.nwg); u.pn = so.nN - 1; return true; }
    __device__ __forceinline__ void a_ready(const Unit&) const {}
    __device__ __forceinline__ void done(const Unit&) const {}
};
__device__ __forceinline__ unsigned cvt_pk_bf16(float lo, float hi) { unsigned r; asm volatile("v_cvt_pk_bf16_f32 %0, %1, %2" : "=v"(r) : "v"(lo), "v"(hi)); return r; }
__device__ __forceinline__ float sigm(float x) { return __builtin_amdgcn_rcpf(1.0f + __expf(-x)); }
struct EpiBf16 {
    static constexpr bool PERM = true, AFTER_DRAIN = false;
    bf16_t* O; int ldc;
    __device__ __forceinline__ void operator()(const f32x4 (&acc)[2][2][4][2], const Unit& u, int wr, int wc, int fr, int fq) const {
        const int row0 = u.pm * BM + wr * 64 + fr; const int col0 = u.pn * BM + wc * 32 + 8 * fq;
#pragma unroll
        for (int ai = 0; ai < 2; ++ai)
#pragma unroll
            for (int m = 0; m < 4; ++m) { bf16_t* rowp = O + (size_t)(row0 + ai * HALF + m * 16) * ldc + col0;
#pragma unroll
                for (int bj = 0; bj < 2; ++bj) { const f32x4 v0 = acc[ai][bj][m][0], v1 = acc[ai][bj][m][1];
                    u32x4 w; w.x = cvt_pk_bf16(v0[0], v0[1]); w.y = cvt_pk_bf16(v0[2], v0[3]); w.z = cvt_pk_bf16(v1[0], v1[1]); w.w = cvt_pk_bf16(v1[2], v1[3]);
                    *(u32x4*)(rowp + bj * HALF) = w; } }
    }
};
struct EpiResF32 {
    static constexpr bool PERM = false, AFTER_DRAIN = false;
    const float* base; float* out; int ldc; int remap; int pass;
    __device__ __forceinline__ void operator()(const f32x4 (&acc)[2][2][4][2], const Unit& u, int wr, int wc, int fr, int fq) const {
        const int col0 = u.pn * BM + wc * 32 + 4 * fq; const int rbase = remap ? ((((u.pm >> 3) & 3) << 12) + (u.pm >> 5) * 2048 + (u.pm & 7) * BM) : u.pm * BM;
#pragma unroll
        for (int ai = 0; ai < 2; ++ai)
#pragma unroll
            for (int m = 0; m < 4; ++m) { const size_t off = (size_t)(rbase + ai * HALF + wr * 64 + m * 16 + fr) * ldc + col0;
#pragma unroll
                for (int bj = 0; bj < 2; ++bj)
#pragma unroll
                    for (int n = 0; n < 2; ++n) { const f32x4 bs = __builtin_nontemporal_load((const f32x4*)(base + off + bj * HALF + n * 16)); *(f32x4*)(out + off + bj * HALF + n * 16) = bs + acc[ai][bj][m][n]; } }
    }
};
struct EpiL1 {
    static constexpr bool PERM = true, AFTER_DRAIN = false;
    bf16_t* R; bf16_t* LW; bf16_t* LA;
    __device__ __forceinline__ void operator()(const f32x4 (&acc)[2][2][4][2], const Unit& u, int wr, int wc, int fr, int fq) const {
        const int row0 = u.pm * BM + wr * 64 + fr;
        if (u.pn < 32) {
            const int buf = u.pn >> 3; bf16_t* base = R + (size_t)buf * (8192u * 2048u); const int col0 = (u.pn & 7) * BM + wc * 32 + 8 * fq;
#pragma unroll
            for (int ai = 0; ai < 2; ++ai)
#pragma unroll
                for (int m = 0; m < 4; ++m) { bf16_t* rowp = base + (size_t)(row0 + ai * HALF + m * 16) * 2048 + col0;
#pragma unroll
                    for (int bj = 0; bj < 2; ++bj) { f32x4 v0 = acc[ai][bj][m][0], v1 = acc[ai][bj][m][1];
                        if (buf == 3) {
#pragma unroll
                            for (int q = 0; q < 4; ++q) { v0[q] = v0[q] * sigm(v0[q]); v1[q] = v1[q] * sigm(v1[q]); } }
                        u32x4 w; w.x = cvt_pk_bf16(v0[0], v0[1]); w.y = cvt_pk_bf16(v0[2], v0[3]); w.z = cvt_pk_bf16(v1[0], v1[1]); w.w = cvt_pk_bf16(v1[2], v1[3]);
                        *(u32x4*)(rowp + bj * HALF) = w; } }
        } else {
            const int c0 = wc * 32 + 8 * fq;
#pragma unroll
            for (int ai = 0; ai < 2; ++ai)
#pragma unroll
                for (int m = 0; m < 4; ++m) { const size_t row = (size_t)(row0 + ai * HALF + m * 16); f32x4 v0 = acc[ai][0][m][0], v1 = acc[ai][0][m][1];
                    if (c0 < 64) {
#pragma unroll
                        for (int q = 0; q < 4; ++q) { v0[q] = tanhf(v0[q]); v1[q] = tanhf(v1[q]); } }
                    u32x4 w; w.x = cvt_pk_bf16(v0[0], v0[1]); w.y = cvt_pk_bf16(v0[2], v0[3]); w.z = cvt_pk_bf16(v1[0], v1[1]); w.w = cvt_pk_bf16(v1[2], v1[3]);
                    if (c0 < 64) *(u32x4*)(LW + row * 64 + c0) = w; else *(u32x4*)(LA + row * 64 + c0 - 64) = w; }
        }
    }
};

struct EpiFinalNorm {
    static constexpr bool PERM = false, AFTER_DRAIN = true;
    float* out; const float* g; unsigned long long* xg; int ldc;
    __device__ __forceinline__ void fused(f32x4 (&acc)[2][2][4][2], const Unit& u, int wr, int wc, int fr, int fq, PG8_LAS unsigned char* lds, int wid, int lane) const {
        PG8_LAS float* P = (PG8_LAS float*)lds; PG8_LAS float* S = (PG8_LAS float*)(lds + 4096);
        const int col0 = u.pn * BM + wc * 32 + 4 * fq; const int rbase = (((u.pm >> 3) & 3) << 12) + (u.pm >> 5) * 2048 + (u.pm & 7) * BM;
#pragma unroll
        for (int ai = 0; ai < 2; ++ai)
#pragma unroll
            for (int m = 0; m < 4; ++m) { const size_t off = (size_t)(rbase + ai * HALF + wr * 64 + m * 16 + fr) * ldc + col0; float s = 0.f;
#pragma unroll
                for (int bj = 0; bj < 2; ++bj)
#pragma unroll
                    for (int n = 0; n < 2; ++n) { const f32x4 v = acc[ai][bj][m][n] + __builtin_nontemporal_load((const f32x4*)(out + off + bj * HALF + n * 16)); acc[ai][bj][m][n] = v; s += (v[0] * v[0] + v[1] * v[1]) + (v[2] * v[2] + v[3] * v[3]); }
                s += __shfl_xor(s, 16); s += __shfl_xor(s, 32);
                if (fq == 0) P[(ai * HALF + wr * 64 + m * 16 + fr) * 4 + wc] = s; }
        asm volatile("s_waitcnt lgkmcnt(0)" ::: "memory"); __builtin_amdgcn_s_barrier(); asm volatile("" ::: "memory");
        const int row = wid * 32 + (lane & 31);
        if (lane < 32) { const float tot = (P[row * 4] + P[row * 4 + 1]) + (P[row * 4 + 2] + P[row * 4 + 3]);
            __hip_atomic_store(xg + ((size_t)(u.pm * 4 + u.pn) * 256 + row), (1ull << 32) | (unsigned long long)__float_as_uint(tot), __ATOMIC_RELAXED, __HIP_MEMORY_SCOPE_AGENT); }
        {
            float tot = 0.f;
            for (unsigned spins = 0;; ++spins) { bool ok = true; tot = 0.f;
                if (lane < 32) {
#pragma unroll
                    for (int q = 0; q < 4; ++q) { const unsigned long long x = __hip_atomic_load(xg + ((size_t)(u.pm * 4 + q) * 256 + row), __ATOMIC_RELAXED, __HIP_MEMORY_SCOPE_AGENT); ok &= (unsigned)(x >> 32) == 1u; tot += __uint_as_float((unsigned)x); } }
                if (__all(ok) || spins > (1u << 22)) break;
                __builtin_amdgcn_s_sleep(1); }
            if (lane < 32) S[row] = rsqrtf(tot * (1.0f / 1024.0f) + 1e-6f);
        }
        asm volatile("s_waitcnt lgkmcnt(0)" ::: "memory"); __builtin_amdgcn_s_barrier(); asm volatile("" ::: "memory");
#pragma unroll
        for (int ai = 0; ai < 2; ++ai)
#pragma unroll
            for (int m = 0; m < 4; ++m) { const int r = ai * HALF + wr * 64 + m * 16 + fr; const float rs = S[r]; const size_t off = (size_t)(rbase + r) * ldc + col0;
#pragma unroll
                for (int bj = 0; bj < 2; ++bj)
#pragma unroll
                    for (int n = 0; n < 2; ++n) { const f32x4 gg = *(const f32x4*)(g + col0 + bj * HALF + n * 16); __builtin_nontemporal_store(acc[ai][bj][m][n] * rs * gg, (f32x4*)(out + off + bj * HALF + n * 16)); } }
    }
};
template <class Epi, class Sched, bool ALIGN_EPI = false, bool SP2 = false>
__device__ __forceinline__ void gemm_phase(PG8_LAS unsigned char* lds, const Gemm g, const Sched& S, const Epi& E) {
    int tid_o = threadIdx.x; asm volatile("" : "+v"(tid_o)); const int tid = tid_o, wid = __builtin_amdgcn_readfirstlane(tid >> 6), lane = tid & 63, wr = wid >> 2, wc = wid & 3, fr = lane & 15, fq = lane >> 4;
    const int K = g.K, nt = K / BK;
    unsigned voffA[2], voffB[2];
#pragma unroll
    for (int i = 0; i < 2; ++i) { int R, C; stage_rc(tid * 16 + i * 8192, R, C); const int Rb = Epi::PERM ? ((R & ~31) + perm32(R & 31)) : R;
        voffA[i] = (unsigned)(R * g.lda + C) * 2u; voffB[i] = (unsigned)(Rb * K + C) * 2u; }
    const size_t kstep = (size_t)(BK * 2);
    const size_t hstep = (size_t)HALF * K * 2;
    const size_t tstep = 2 * hstep; const size_t hstepA = (size_t)HALF * g.lda * 2, tstepA = 2 * hstepA;
    const unsigned ldsw = (unsigned)wid * 1024u;
    const int aoff = lds_byte(wr * 64 + fr, fq * 8), boff = lds_byte(wc * 32 + fr, fq * 8);
#define PG8_SA(b, h) (((b) * 2 + (h)) * HTB)
#define PG8_SB(b, h) ((4 + (b) * 2 + (h)) * HTB)
#define PG8_STAGE(bufoff, gbase, voff) do { _Pragma("unroll") for (int _i = 0; _i < 2; ++_i) \
        __builtin_amdgcn_global_load_lds((const unsigned*)((const char*)(gbase) + (voff)[_i]), (PG8_LAS unsigned*)(lds + (bufoff) + ldsw + _i * 8192), 16, 0, 0); } while (0)
#define PG8_LDA(dst, b, h) do { _Pragma("unroll") for (int m = 0; m < 4; ++m) _Pragma("unroll") for (int k = 0; k < 2; ++k) dst[m][k] = *(const PG8_LAS bf16x8*)(lds + PG8_SA(b, h) + aoff + m * 2048 + k * 1024); } while (0)
#define PG8_LDB(dst, b, h) do { _Pragma("unroll") for (int n = 0; n < 2; ++n) _Pragma("unroll") for (int k = 0; k < 2; ++k) dst[n][k] = *(const PG8_LAS bf16x8*)(lds + PG8_SB(b, h) + boff + n * 2048 + k * 1024); } while (0)
#define PG8_MMA(ai, bj, At, Bt) do { __builtin_amdgcn_s_setprio(1); _Pragma("unroll") for (int m = 0; m < 4; ++m) _Pragma("unroll") for (int n = 0; n < 2; ++n) _Pragma("unroll") for (int k = 0; k < 2; ++k) \
        acc[ai][bj][m][n] = __builtin_amdgcn_mfma_f32_16x16x32_bf16(Bt[n][k], At[m][k], acc[ai][bj][m][n], 0, 0, 0); __builtin_amdgcn_s_setprio(0); } while (0)
#define PG8_WAIT_V(n) asm volatile("s_waitcnt vmcnt(" #n ")" ::: "memory")
#define PG8_WAIT_L(n) asm volatile("s_waitcnt lgkmcnt(" #n ")" ::: "memory")
#define PG8_BAR __builtin_amdgcn_s_barrier()
#define PG8_SCHED __builtin_amdgcn_sched_barrier(0)
    Unit cur, nxt; int ui = 0;
    if (!S.next(0, cur)) return;
    f32x4 acc[2][2][4][2];
#pragma unroll
    for (int a = 0; a < 2; ++a)
#pragma unroll
        for (int b = 0; b < 2; ++b)
#pragma unroll
            for (int m = 0; m < 4; ++m)
#pragma unroll
                for (int n = 0; n < 2; ++n) acc[a][b][m][n] = (f32x4){0.f, 0.f, 0.f, 0.f};
    bf16x8 At[4][2], B0[2][2], B1[2][2];
    const char* cA = (const char*)g.A + (size_t)cur.pm * tstepA; const char* cB = (const char*)g.Bt + (size_t)cur.pn * tstep;
    S.a_ready(cur);
    if constexpr (SP2) {
        PG8_STAGE(PG8_SB(0, 0), cB, voffB); PG8_STAGE(PG8_SB(0, 1), cB + hstep, voffB); PG8_STAGE(PG8_SA(0, 0), cA, voffA); PG8_STAGE(PG8_SA(0, 1), cA + hstepA, voffA);
        if (wr == 1) PG8_BAR;
        PG8_WAIT_V(2); PG8_BAR;
        PG8_STAGE(PG8_SB(1, 0), cB + kstep, voffB); PG8_STAGE(PG8_SA(1, 0), cA + kstep, voffA); PG8_STAGE(PG8_SB(1, 1), cB + hstep + kstep, voffB);
        PG8_WAIT_V(6); PG8_BAR;
    } else {
        PG8_STAGE(PG8_SB(0, 0), cB, voffB); PG8_STAGE(PG8_SA(0, 0), cA, voffA); PG8_STAGE(PG8_SB(0, 1), cB + hstep, voffB); PG8_STAGE(PG8_SA(0, 1), cA + hstepA, voffA);
        if (wr == 1) PG8_BAR;
        PG8_WAIT_V(4); PG8_BAR;
        PG8_STAGE(PG8_SB(1, 0), cB + kstep, voffB); PG8_STAGE(PG8_SA(1, 0), cA + kstep, voffA); PG8_STAGE(PG8_SB(1, 1), cB + hstep + kstep, voffB);
        PG8_WAIT_V(6); PG8_BAR;
    }
    for (;;) {
        const bool has_next = S.next(ui + 1, nxt);
        const char* nA = has_next ? (const char*)g.A + (size_t)nxt.pm * tstepA : cA; const char* nB = has_next ? (const char*)g.Bt + (size_t)nxt.pn * tstep : cB;
        for (int t = 0; t < nt; t += 2) {
            const bool last = (t == nt - 2);
            const char* a1 = cA + (size_t)(t + 1) * kstep;
            const char* a2 = last ? nA : cA + (size_t)(t + 2) * kstep; const char* b2 = last ? nB : cB + (size_t)(t + 2) * kstep;
            const char* a3 = a2 + kstep; const char* b3 = b2 + kstep;
            if (last && has_next) S.a_ready(nxt);
            if constexpr (SP2) {
            PG8_LDB(B0, 0, 0); PG8_LDB(B1, 0, 1); PG8_SCHED; PG8_LDA(At, 0, 0); PG8_STAGE(PG8_SA(1, 1), a1 + hstepA, voffA);
            PG8_WAIT_V(8); PG8_WAIT_L(0); PG8_BAR; PG8_MMA(0, 0, At, B0); PG8_MMA(0, 1, At, B1); PG8_BAR; PG8_SCHED;
            PG8_LDA(At, 0, 1); PG8_STAGE(PG8_SB(0, 0), b2, voffB); PG8_STAGE(PG8_SB(0, 1), b2 + hstep, voffB); PG8_STAGE(PG8_SA(0, 0), a2, voffA);
            PG8_WAIT_V(8); PG8_WAIT_L(0); PG8_BAR; PG8_MMA(1, 0, At, B0); PG8_MMA(1, 1, At, B1); PG8_BAR; PG8_SCHED;
            PG8_LDB(B0, 1, 0); PG8_LDB(B1, 1, 1); PG8_SCHED; PG8_LDA(At, 1, 0); PG8_STAGE(PG8_SA(0, 1), a2 + hstepA, voffA);
            PG8_WAIT_V(8); PG8_WAIT_L(0); PG8_BAR; PG8_MMA(0, 0, At, B0); PG8_MMA(0, 1, At, B1); PG8_BAR; PG8_SCHED;
            PG8_LDA(At, 1, 1); PG8_STAGE(PG8_SB(1, 0), b3, voffB); PG8_STAGE(PG8_SB(1, 1), b3 + hstep, voffB); PG8_STAGE(PG8_SA(1, 0), a3, voffA);
            PG8_WAIT_V(8); PG8_WAIT_L(0); PG8_BAR; PG8_MMA(1, 0, At, B0); PG8_MMA(1, 1, At, B1); PG8_BAR; PG8_SCHED;
            } else {
            PG8_LDB(B0, 0, 0); PG8_SCHED; PG8_LDA(At, 0, 0); PG8_STAGE(PG8_SA(1, 1), a1 + hstepA, voffA);
            PG8_WAIT_L(8); PG8_BAR; PG8_WAIT_L(0); PG8_MMA(0, 0, At, B0); PG8_BAR; PG8_SCHED;
            PG8_LDB(B1, 0, 1); PG8_STAGE(PG8_SB(0, 0), b2, voffB);
            PG8_BAR; PG8_WAIT_L(0); PG8_MMA(0, 1, At, B1); PG8_BAR;
            PG8_LDA(At, 0, 1); PG8_STAGE(PG8_SA(0, 0), a2, voffA);
            PG8_BAR; PG8_WAIT_L(0); PG8_MMA(1, 0, At, B0); PG8_BAR; PG8_SCHED;
            PG8_STAGE(PG8_SB(0, 1), b2 + hstep, voffB);
            PG8_WAIT_V(6); PG8_BAR; PG8_MMA(1, 1, At, B1); PG8_BAR;
            PG8_LDB(B0, 1, 0); PG8_SCHED; PG8_LDA(At, 1, 0); PG8_STAGE(PG8_SA(0, 1), a2 + hstepA, voffA);
            PG8_WAIT_L(8); PG8_BAR; PG8_WAIT_L(0); PG8_MMA(0, 0, At, B0); PG8_BAR; PG8_SCHED;
            PG8_LDB(B1, 1, 1); PG8_STAGE(PG8_SB(1, 0), b3, voffB);
            PG8_BAR; PG8_WAIT_L(0); PG8_MMA(0, 1, At, B1); PG8_BAR;
            PG8_LDA(At, 1, 1); PG8_STAGE(PG8_SA(1, 0), a3, voffA);
            PG8_BAR; PG8_WAIT_L(0); PG8_MMA(1, 0, At, B0); PG8_BAR; PG8_SCHED;
            PG8_STAGE(PG8_SB(1, 1), b3 + hstep, voffB);
            PG8_WAIT_V(6); PG8_BAR; PG8_MMA(1, 1, At, B1); PG8_BAR;
            }
        }
        if constexpr (ALIGN_EPI) { if (wr == 0) PG8_BAR; }
        if constexpr (!Epi::AFTER_DRAIN) { E(acc, cur, wr, wc, fr, fq); S.done(cur); }
        if (!has_next) break;
#pragma unroll
        for (int a = 0; a < 2; ++a)
#pragma unroll
            for (int b = 0; b < 2; ++b)
#pragma unroll
                for (int m = 0; m < 4; ++m)
#pragma unroll
                    for (int n = 0; n < 2; ++n) acc[a][b][m][n] = (f32x4){0.f, 0.f, 0.f, 0.f};
        cur = nxt; cA = nA; cB = nB; ++ui;
        if constexpr (ALIGN_EPI) { if (wr == 1) PG8_BAR; }
    }
    PG8_WAIT_V(0);
    if constexpr (!ALIGN_EPI) { if (wr == 0) PG8_BAR; }
    PG8_BAR;
    if constexpr (Epi::AFTER_DRAIN) { E.fused(acc, cur, wr, wc, fr, fq, lds, wid, lane); S.done(cur); }
#undef PG8_SA
#undef PG8_SB
#undef PG8_STAGE
#undef PG8_LDA
#undef PG8_LDB
#undef PG8_MMA
#undef PG8_WAIT_V
#undef PG8_WAIT_L
#undef PG8_BAR
#undef PG8_SCHED
}
}
#define GAS __attribute__((address_space(1)))
#define LAS __attribute__((address_space(3)))
typedef unsigned short bf16_t;
typedef short bf16x8 __attribute__((ext_vector_type(8)));
typedef float f32x4 __attribute__((ext_vector_type(4)));
typedef unsigned u32x4 __attribute__((ext_vector_type(4)));
typedef unsigned u32x2 __attribute__((ext_vector_type(2)));
typedef float f32x2 __attribute__((ext_vector_type(2)));
constexpr int NT = 512, PROWS6 = 8192;
constexpr int T = 16384, SEQ = 4096, D = 1024, ZW = 6144;
constexpr size_t MiB = 1u << 20;
constexpr size_t WS_DEC = 0;
constexpr size_t WS_Z = 4 * MiB;
constexpr size_t WS_WIN = 196 * MiB, WS_WOUT = 208 * MiB, WS_RGA = 212 * MiB, WS_RGX = 212 * MiB + 256 * 1024;
constexpr size_t WS_OI = 213 * MiB;
constexpr size_t WS_A2 = 4 * MiB;
constexpr size_t WS_R = 68 * MiB;
constexpr size_t WS_V = 132 * MiB;
constexpr size_t WS_WC = 196 * MiB, WS_WO = 229 * MiB, WS_LW = 233 * MiB, WS_LA = 235 * MiB;
constexpr size_t WS_W2T = 237 * MiB, WS_A2T = 237 * MiB + 256 * 1024, WS_GR = 238 * MiB, WS_ST = 239 * MiB, WS_XG = 241 * MiB;
constexpr size_t WS_WL = 246 * MiB;
constexpr size_t WS_BAR = 2 * MiB;
constexpr int LDS_BYTES = 147456, LDS_MISC = 147456 - 64;

struct Params { const GAS float* in[32]; GAS float* out; GAS unsigned char* ws; long long dry; };
#ifndef PROBE
#define PROBE 0
#endif
enum { I_X = 0, I_ABG, I_WIN, I_CONVW, I_CONVB, I_RGWA, I_RGBA, I_RGWX, I_RGBX, I_LAM, I_LB, I_HGG, I_WOUT, I_CNG, I_MU, I_WR, I_WK, I_WV, I_WG, I_W0, I_W1, I_W2, I_A0, I_A1, I_A2, I_KK, I_KA, I_RK, I_LNG, I_LNB, I_WO, I_FG };

__device__ __forceinline__ unsigned f2bf(float f) { unsigned u = __float_as_uint(f); return (u + 0x7fffu + ((u >> 16) & 1u)) >> 16; }
__device__ __forceinline__ float bf2f(unsigned h) { return __uint_as_float(h << 16); }
__device__ __forceinline__ unsigned pk2(float lo, float hi) { return f2bf(lo) | (f2bf(hi) << 16); }
__device__ __forceinline__ float sigmf(float x) { return __builtin_amdgcn_rcpf(1.0f + __expf(-x)); }
__device__ __forceinline__ float wave_sum(float v) {
#pragma unroll
    for (int o = 1; o < 64; o <<= 1) v += __shfl_xor(v, o);
    return v;
}
#define OPQ_TID unsigned char* WSP = launder_ws(((unsigned char*)p.ws)); int tid = threadIdx.x; asm volatile("" : "+v"(tid)); const int lane = tid & 63, wave = __builtin_amdgcn_readfirstlane(tid >> 6); (void)lane; (void)wave
__device__ __forceinline__ unsigned char* launder_ws(unsigned char* w) { const unsigned long long v = (unsigned long long)w; unsigned lo = __builtin_amdgcn_readfirstlane((unsigned)v), hi = __builtin_amdgcn_readfirstlane((unsigned)(v >> 32)); asm volatile("" : "+s"(lo), "+s"(hi)); return (unsigned char*)(GAS unsigned char*)(((unsigned long long)hi << 32) | lo); }
#define MFMA16(a, b, c) __builtin_amdgcn_mfma_f32_16x16x32_bf16((a), (b), (c), 0, 0, 0)

__device__ __forceinline__ void tr_item(const float* src, int ld_src, bf16_t* dst, int ld_dst, const float* sc, int scmode, LAS float* scr, int kb, int nb, int lane) {
    const int k0 = 64 * kb, n0 = 32 * nb;
#pragma unroll
    for (int i = 0; i < 8; ++i) { const int kk = 8 * i + (lane >> 3), c4 = (lane & 7) * 4; f32x4 v = __builtin_nontemporal_load((const f32x4*)(src + (size_t)(k0 + kk) * ld_src + n0 + c4));
        if (sc) { const float m_ = sc[k0 + kk]; v = v * (scmode ? m_ : (1.0f - m_)); }
        scr[kk * 33 + c4] = v.x; scr[kk * 33 + c4 + 1] = v.y; scr[kk * 33 + c4 + 2] = v.z; scr[kk * 33 + c4 + 3] = v.w; }
    asm volatile("s_waitcnt lgkmcnt(0)" ::: "memory");
    const int c = lane & 7;
#pragma unroll
    for (int j = 0; j < 4; ++j) { const int n = (lane >> 3) + 8 * j; const LAS float* s = scr + (8 * c) * 33 + n;
        u32x4 o; o.x = pk2(s[0 * 33], s[1 * 33]); o.y = pk2(s[2 * 33], s[3 * 33]); o.z = pk2(s[4 * 33], s[5 * 33]); o.w = pk2(s[6 * 33], s[7 * 33]);
        *(u32x4*)(dst + (size_t)(n0 + n) * ld_dst + k0 + 8 * c) = o; }
    asm volatile("s_waitcnt lgkmcnt(0)" ::: "memory");
}
__device__ __forceinline__ void tr_item2(const float* src, int ld_src, bf16_t* dst0, bf16_t* dst1, int ld_dst, const float* mu, LAS float* scr, int kb, int nb, int lane) {
    const int k0 = 64 * kb, n0 = 32 * nb;
#pragma unroll
    for (int i = 0; i < 8; ++i) { const int kk = 8 * i + (lane >> 3), c4 = (lane & 7) * 4; const f32x4 v = __builtin_nontemporal_load((const f32x4*)(src + (size_t)(k0 + kk) * ld_src + n0 + c4));
        scr[kk * 33 + c4] = v.x; scr[kk * 33 + c4 + 1] = v.y; scr[kk * 33 + c4 + 2] = v.z; scr[kk * 33 + c4 + 3] = v.w; }
    asm volatile("s_waitcnt lgkmcnt(0)" ::: "memory");
    const int c = lane & 7;
    const f32x4 m0 = *(const f32x4*)(mu + k0 + 8 * c), m1 = *(const f32x4*)(mu + k0 + 8 * c + 4);
#pragma unroll
    for (int j = 0; j < 4; ++j) { const int n = (lane >> 3) + 8 * j; const LAS float* s = scr + (8 * c) * 33 + n;
        const float s0 = s[0], s1 = s[33], s2 = s[66], s3 = s[99], s4 = s[132], s5 = s[165], s6 = s[198], s7 = s[231];
        u32x4 o; o.x = pk2(s0 * m0.x, s1 * m0.y); o.y = pk2(s2 * m0.z, s3 * m0.w); o.z = pk2(s4 * m1.x, s5 * m1.y); o.w = pk2(s6 * m1.z, s7 * m1.w);
        *(u32x4*)(dst1 + (size_t)(n0 + n) * ld_dst + k0 + 8 * c) = o;
        o.x = pk2(s0 * (1.0f - m0.x), s1 * (1.0f - m0.y)); o.y = pk2(s2 * (1.0f - m0.z), s3 * (1.0f - m0.w)); o.z = pk2(s4 * (1.0f - m1.x), s5 * (1.0f - m1.y)); o.w = pk2(s6 * (1.0f - m1.z), s7 * (1.0f - m1.w));
        *(u32x4*)(dst0 + (size_t)(n0 + n) * ld_dst + k0 + 8 * c) = o; }
    asm volatile("s_waitcnt lgkmcnt(0)" ::: "memory");
}
__device__ __forceinline__ void rms_row(const float* xrow, const float* g, int lane, u32x2 (&o)[4]) {
    f32x4 v[4]; float s = 0.f;
#pragma unroll
    for (int j = 0; j < 4; ++j) { v[j] = __builtin_nontemporal_load((const f32x4*)xrow + lane + 64 * j); s += (v[j].x * v[j].x + v[j].y * v[j].y) + (v[j].z * v[j].z + v[j].w * v[j].w); }
    const float rs = rsqrtf(wave_sum(s) * (1.0f / 1024.0f) + 1e-6f);
#pragma unroll
    for (int j = 0; j < 4; ++j) { const f32x4 gg = *((const f32x4*)g + lane + 64 * j); o[j].x = pk2(v[j].x * rs * gg.x, v[j].y * rs * gg.y); o[j].y = pk2(v[j].z * rs * gg.z, v[j].w * rs * gg.w); }
}

__device__ __forceinline__ void p0_prologue(const Params& p, LAS unsigned char* lds, int G, int bid) {
    OPQ_TID; const int gw = bid * 8 + wave, ngw = G * 8;
    LAS float* scr = (LAS float*)(lds + wave * 16384);
    bf16_t* WinT = (bf16_t*)(WSP + WS_WIN); bf16_t* WoutT = (bf16_t*)(WSP + WS_WOUT); bf16_t* RGA = (bf16_t*)(WSP + WS_RGA); bf16_t* RGX = (bf16_t*)(WSP + WS_RGX);
    constexpr int IA = 16 * 192, IB = 32 * 32, IC = 64, IL0 = 64;
    for (int it = gw; it < IA + IB + 2 * IC + IL0; it += ngw) {
        int r = it;
        if (r >= IA + IB + 2 * IC) { r -= IA + IB + 2 * IC; const int wh = r >> 5, q = r & 31;
            bf16_t* dst = (bf16_t*)(WSP + WS_WL) + (size_t)(wh * 64) * 2048;
            tr_item2(wh ? ((const float*)p.in[I_A1]) : ((const float*)p.in[I_W1]), 64, dst, dst + 1024, 2048, ((const float*)p.in[I_MU]) + (wh ? 4 : 1) * 1024, scr, q >> 1, q & 1, lane); continue; }
        if (r < IA) { tr_item(((const float*)p.in[I_WIN]), ZW, WinT, 1024, nullptr, 0, scr, r / 192, r % 192, lane); continue; } r -= IA;
        if (r < IB) { tr_item(((const float*)p.in[I_WOUT]), 1024, WoutT, 2048, nullptr, 0, scr, r / 32, r % 32, lane); continue; } r -= IB;
        const float* src = (r < IC) ? ((const float*)p.in[I_RGWA]) : ((const float*)p.in[I_RGWX]); bf16_t* dst = (r < IC) ? RGA : RGX; if (r >= IC) r -= IC;
        const int blk = r >> 3, q = r & 7;
        tr_item(src + blk * 16384, 128, dst + blk * 16384, 128, nullptr, 0, scr, q >> 2, q & 3, lane);
    }
    bf16_t* U0 = (bf16_t*)((float*)p.out);
    for (int m = gw; m < T; m += ngw) { u32x2 o[4]; rms_row(((const float*)p.in[I_X]) + (size_t)m * D, ((const float*)p.in[I_ABG]), lane, o);
#pragma unroll
        for (int j = 0; j < 4; ++j) *((u32x2*)(U0 + (size_t)m * D) + lane + 64 * j) = o[j]; }
}

__device__ __forceinline__ void rg_a_prefetch(const bf16_t* Z, int unit, int tid, u32x4 (&pre)[3]) {
    const int b = unit >> 9, n = (unit >> 3) & 63, j = unit & 7; const int tok0 = b * SEQ + n * 64, ch0 = j * 128;
#pragma unroll
    for (int q = 0; q < 3; ++q) { const int i = tid + q * NT; const int row = i >> 4, cc = i & 15; pre[q] = (u32x4){0u, 0u, 0u, 0u};
        if (i < 67 * 16 && (n > 0 || row >= 3)) pre[q] = __builtin_nontemporal_load((const u32x4*)(Z + (size_t)(tok0 - 3 + row) * ZW + ch0 + 8 * cc)); }
}
struct RgaConst { bf16x8 bA[4], bX[4]; float w0, w1, w2, w3, cb, ba, bx, sp; };
__device__ __forceinline__ void rg_a_consts(const Params& p, int j, RgaConst& K) {
    OPQ_TID;
    const int fr = lane & 15, fq = lane >> 4, ch0 = j * 128;
    const bf16_t* WA = (const bf16_t*)(WSP + WS_RGA) + j * 16384 + (16 * wave + fr) * 128 + 8 * fq;
    const bf16_t* WX = (const bf16_t*)(WSP + WS_RGX) + j * 16384 + (16 * wave + fr) * 128 + 8 * fq;
#pragma unroll
    for (int k = 0; k < 4; ++k) { K.bA[k] = *(const bf16x8*)(WA + 32 * k); K.bX[k] = *(const bf16x8*)(WX + 32 * k); }
    const int chc = ch0 + (tid & 127), che = ch0 + 16 * wave + fr;
    K.w0 = ((const float*)p.in[I_CONVW])[chc]; K.w1 = ((const float*)p.in[I_CONVW])[1024 + chc]; K.w2 = ((const float*)p.in[I_CONVW])[2048 + chc]; K.w3 = ((const float*)p.in[I_CONVW])[3072 + chc]; K.cb = ((const float*)p.in[I_CONVB])[chc];
    K.ba = ((const float*)p.in[I_RGBA])[che]; K.bx = ((const float*)p.in[I_RGBX])[che]; K.sp = log1pf(expf(-((const float*)p.in[I_LAM])[che]));
}
__device__ __forceinline__ void rg_a_unit(const Params& p, LAS unsigned char* lds, int unit, int next_unit, u32x4 (&pre)[3], const RgaConst& K) {
    OPQ_TID;
    LAS float* XC = (LAS float*)lds; LAS float* AA = (LAS float*)(lds + 34816); LAS bf16_t* XB = (LAS bf16_t*)(lds + 69632); LAS bf16_t* XR = (LAS bf16_t*)(lds + 87040);
    LAS float* SUMP = (LAS float*)(lds + 87040); LAS float* SUMH = SUMP + 512; LAS bf16_t* HT = XB; LAS bf16_t* PT = (LAS bf16_t*)(lds + 91136);
    const int b = unit >> 9, n = (unit >> 3) & 63, j = unit & 7;
    const int tok0 = b * SEQ + n * 64, ch0 = j * 128;
    const bf16_t* Z = (const bf16_t*)(WSP + WS_Z);
#pragma unroll
    for (int q = 0; q < 3; ++q) { const int i = tid + q * NT; if (i < 67 * 16) *(LAS u32x4*)(XR + (i >> 4) * 136 + 8 * (i & 15)) = pre[q]; }
    __syncthreads();
    if (next_unit < 2048) rg_a_prefetch(Z, next_unit, tid, pre);
    const int c = tid & 127, sub = tid >> 7;
    {
        const int ch = ch0 + c;
        const float w0 = K.w0, w1 = K.w1, w2 = K.w2, w3 = K.w3, cb = K.cb; (void)ch;
        const LAS bf16_t* xr = XR + (sub * 16) * 136 + c;
        float xm3 = bf2f(xr[0]), xm2 = bf2f(xr[136]), xm1 = bf2f(xr[272]);
        f32x4 yq[4];
#pragma unroll
        for (int i = 0; i < 16; ++i) { const float x = bf2f(xr[(i + 3) * 136]); const float y = w0 * xm3 + w1 * xm2 + w2 * xm1 + w3 * x + cb;
            yq[i >> 2][i & 3] = y; XB[(sub * 16 + i) * 136 + c] = (bf16_t)f2bf(y); xm3 = xm2; xm2 = xm1; xm1 = x; }
#pragma unroll
        for (int q = 0; q < 4; ++q) *(LAS f32x4*)(XC + c * 68 + sub * 16 + 4 * q) = yq[q];
    }
    __syncthreads();
    {
        const int fr = lane & 15, fq = lane >> 4;
        f32x4 accA[4], accX[4];
#pragma unroll
        for (int m = 0; m < 4; ++m) { accA[m] = (f32x4){0.f, 0.f, 0.f, 0.f}; accX[m] = (f32x4){0.f, 0.f, 0.f, 0.f}; }
#pragma unroll
        for (int k = 0; k < 4; ++k) { const bf16x8 bA = K.bA[k], bX = K.bX[k];
#pragma unroll
            for (int m = 0; m < 4; ++m) { const bf16x8 a = *(const LAS bf16x8*)(XB + (16 * m + fr) * 136 + 32 * k + 8 * fq); accA[m] = MFMA16(a, bA, accA[m]); accX[m] = MFMA16(a, bX, accX[m]); } }
        const int cl = 16 * wave + fr, ch = ch0 + cl;
        const float ba = K.ba, bx = K.bx, sp = K.sp; (void)ch;
#pragma unroll
        for (int m = 0; m < 4; ++m) { const f32x4 xc4 = *(const LAS f32x4*)(XC + cl * 68 + 16 * m + 4 * fq); f32x4 a4, u4;
#pragma unroll
            for (int r = 0; r < 4; ++r) { const float gr = sigmf(accA[m][r] + ba), gi = sigmf(accX[m][r] + bx);
                const float la = -8.0f * gr * sp; const float a = __expf(la); const float mult = __builtin_amdgcn_sqrtf(fmaxf(1.0f - a * a, 0.f));
                a4[r] = a; u4[r] = mult * gi * xc4[r]; }
            *(LAS f32x4*)(AA + cl * 68 + 16 * m + 4 * fq) = a4; *(LAS f32x4*)(XC + cl * 68 + 16 * m + 4 * fq) = u4; }
    }
    __syncthreads();
    {
        float hl[16], pl[16]; float h = 0.f, P = 1.f;
        f32x4 aq[4], uq[4];
#pragma unroll
        for (int q = 0; q < 4; ++q) { aq[q] = *(const LAS f32x4*)(AA + c * 68 + sub * 16 + 4 * q); uq[q] = *(const LAS f32x4*)(XC + c * 68 + sub * 16 + 4 * q); }
#pragma unroll
        for (int i = 0; i < 16; ++i) { const float a = aq[i >> 2][i & 3], u = uq[i >> 2][i & 3]; h = a * h + u; P *= a; hl[i] = h; pl[i] = P; }
        SUMP[sub * 128 + c] = P; SUMH[sub * 128 + c] = h;
        __syncthreads();
        float chh = 0.f, cp = 1.f;
#pragma unroll
        for (int s = 0; s < 3; ++s) if (s < sub) { const float sp_ = SUMP[s * 128 + c]; chh = chh * sp_ + SUMH[s * 128 + c]; cp *= sp_; }
#pragma unroll
        for (int i = 0; i < 16; ++i) { HT[(sub * 16 + i) * 136 + c] = (bf16_t)f2bf(hl[i] + pl[i] * chh); PT[(sub * 16 + i) * 136 + c] = (bf16_t)f2bf(pl[i] * cp); }
    }
    __syncthreads();
    {
        bf16_t* HL = (bf16_t*)((float*)p.out) + (size_t)tok0 * D + ch0; bf16_t* PC = HL + (size_t)T * D;
        for (int i = tid; i < 1024; i += NT) { const int row = i >> 4, cc = i & 15;
            *(u32x4*)(HL + (size_t)row * D + 8 * cc) = *(const LAS u32x4*)(HT + row * 136 + 8 * cc); *(u32x4*)(PC + (size_t)row * D + 8 * cc) = *(const LAS u32x4*)(PT + row * 136 + 8 * cc); }
    }
    __syncthreads();
}

__device__ __forceinline__ void hg_a_prefetch(const bf16_t* Z, int unit, int tid, u32x4 (&pre)[6]) {
    const int b = unit >> 9, h = (unit >> 6) & 7, n = unit & 63; const int tok0 = b * SEQ + n * 64;
#pragma unroll
    for (int q = 0; q < 6; ++q) { const int i = tid + q * NT; const int arr = i >> 10, row = (i >> 4) & 63, cc = i & 15; pre[q] = __builtin_nontemporal_load((const u32x4*)(Z + (size_t)(tok0 + row) * ZW + 2048 + 1024 * arr + h * 128 + 8 * cc)); }
}
__device__ __forceinline__ void hg_a_unit(const Params& p, LAS unsigned char* lds, int unit, int next_unit, u32x4 (&pre)[6]) {
    OPQ_TID;
    LAS bf16_t* QD = (LAS bf16_t*)lds; LAS bf16_t* KI = (LAS bf16_t*)(lds + 17408); LAS bf16_t* VR = (LAS bf16_t*)(lds + 34816); LAS bf16_t* VT = (LAS bf16_t*)(lds + 52224);
    LAS bf16_t* SC = (LAS bf16_t*)(lds + 70656); LAS float* ST = (LAS float*)(lds + 79872); LAS bf16_t* OT = VR;
    const int b = unit >> 9, h = (unit >> 6) & 7, n = unit & 63;
    const int tok0 = b * SEQ + n * 64;
    bf16_t* Z = (bf16_t*)(WSP + WS_Z);
    const int fr = lane & 15, fq = lane >> 4;
#pragma unroll
    for (int q = 0; q < 6; ++q) { const int i = tid + q * NT; const int arr = i >> 10, row = (i >> 4) & 63, cc = i & 15;
        *(LAS u32x4*)((arr == 0 ? QD : (arr == 1 ? KI : VR)) + row * 136 + 8 * cc) = pre[q]; }
    __syncthreads();
    {
        const int d = tid & 127, sub = tid >> 7, hd = h * 128 + d;
        const float lb = sigmf(((const float*)p.in[I_LB])[hd] - ((const float*)p.in[I_LB])[1024 + hd]), omlb = 1.0f - lb;
        float q[16], kq[16], cl[16]; unsigned short vv[16]; float run = 0.f;
#pragma unroll
        for (int i = 0; i < 16; ++i) { const int t = sub * 16 + i; const float f = bf2f(KI[t * 136 + d]); const float sg = sigmf(f);
            run += __logf(lb + omlb * sg); cl[i] = run; kq[i] = omlb * (1.0f - sg); q[i] = bf2f(QD[t * 136 + d]); vv[i] = VR[t * 136 + d]; }
        ST[sub * 128 + d] = run;
        __syncthreads();
        float off = 0.f, total = 0.f;
#pragma unroll
        for (int s = 0; s < 4; ++s) { const float x = ST[s * 128 + d]; total += x; if (s < sub) off += x; }
        unsigned ke[8], vp[8];
#pragma unroll
        for (int i = 0; i < 16; ++i) { const float cum = off + cl[i]; const unsigned qd = f2bf(q[i] * __expf(cum)), ki = f2bf(kq[i] * __expf(-cum)), kE = f2bf(kq[i] * __expf(total - cum));
            QD[(sub * 16 + i) * 136 + d] = (bf16_t)qd; KI[(sub * 16 + i) * 136 + d] = (bf16_t)ki;
            if (i & 1) { ke[i >> 1] |= kE << 16; vp[i >> 1] |= (unsigned)vv[i] << 16; } else { ke[i >> 1] = kE; vp[i >> 1] = vv[i]; } }
        *(LAS u32x4*)(VT + d * 72 + sub * 16) = (u32x4){vp[0], vp[1], vp[2], vp[3]}; *(LAS u32x4*)(VT + d * 72 + sub * 16 + 8) = (u32x4){vp[4], vp[5], vp[6], vp[7]};
        bf16_t* tb = Z + (size_t)(tok0 + (d >> 1)) * ZW + h * 128 + (d & 1) * 64 + sub * 16;
        *(u32x4*)(tb + 3072) = (u32x4){ke[0], ke[1], ke[2], ke[3]}; *(u32x4*)(tb + 3072 + 8) = (u32x4){ke[4], ke[5], ke[6], ke[7]};
        *(u32x4*)(tb + 4096) = (u32x4){vp[0], vp[1], vp[2], vp[3]}; *(u32x4*)(tb + 4096 + 8) = (u32x4){vp[4], vp[5], vp[6], vp[7]};
        if (sub == 0) ((float*)(WSP + WS_DEC))[unit * 128 + d] = __expf(total);
    }
    __syncthreads();
    if (next_unit < 2048) hg_a_prefetch(Z, next_unit, tid, pre);
    for (int i = tid; i < 1024; i += NT) { const int row = i >> 4, cc = i & 15; *(u32x4*)(Z + (size_t)(tok0 + row) * ZW + 2048 + h * 128 + 8 * cc) = *(const LAS u32x4*)(QD + row * 136 + 8 * cc); }
    {
        const int lt = wave >> 1;
#pragma unroll
        for (int x = 0; x < 2; ++x) { const int mt = (wave & 1) * 2 + x; f32x4 acc = (f32x4){0.f, 0.f, 0.f, 0.f};
            if (mt <= lt) {
#pragma unroll
                for (int k = 0; k < 4; ++k) { const bf16x8 a = *(const LAS bf16x8*)(QD + (16 * lt + fr) * 136 + 32 * k + 8 * fq), bb = *(const LAS bf16x8*)(KI + (16 * mt + fr) * 136 + 32 * k + 8 * fq); acc = MFMA16(a, bb, acc); } }
#pragma unroll
            for (int r = 0; r < 4; ++r) { const int l = 16 * lt + 4 * fq + r, mm = 16 * mt + fr; SC[l * 72 + mm] = (bf16_t)f2bf(mm <= l ? acc[r] : 0.f); } }
    }
    __syncthreads();
    {
#pragma unroll
        for (int lt = 0; lt < 4; ++lt) { f32x4 acc = (f32x4){0.f, 0.f, 0.f, 0.f};
#pragma unroll
            for (int k = 0; k < 2; ++k) { const bf16x8 a = *(const LAS bf16x8*)(SC + (16 * lt + fr) * 72 + 32 * k + 8 * fq), bb = *(const LAS bf16x8*)(VT + (16 * wave + fr) * 72 + 32 * k + 8 * fq); acc = MFMA16(a, bb, acc); }
#pragma unroll
            for (int r = 0; r < 4; ++r) OT[(16 * lt + 4 * fq + r) * 136 + 16 * wave + fr] = (bf16_t)f2bf(acc[r]); }
    }
    __syncthreads();
    { bf16_t* OI = (bf16_t*)(WSP + WS_OI) + (size_t)tok0 * D + h * 128;
      for (int i = tid; i < 1024; i += NT) { const int row = i >> 4, cc = i & 15; *(u32x4*)(OI + (size_t)row * D + 8 * cc) = *(const LAS u32x4*)(OT + row * 136 + 8 * cc); } }
    __syncthreads();
}

__device__ __forceinline__ void hg_b_item(const Params& p, LAS unsigned char* lds, int item, bool dry = false) {
    OPQ_TID;
    LAS bf16_t* SB = (LAS bf16_t*)lds;
    const int b = item >> 6, h = (item >> 3) & 7, es = item & 7;
    const int fr = lane & 15, fq = lane >> 4;
    const bf16_t* Z = (const bf16_t*)(WSP + WS_Z); bf16_t* OI = (bf16_t*)(WSP + WS_OI); const float* DEC = (const float*)(WSP + WS_DEC);
    f32x4 S = (f32x4){0.f, 0.f, 0.f, 0.f};
    const int eg = 16 * es + fr, dg = 16 * wave + fr;
    const bf16_t* pV = Z + (size_t)(b * SEQ + (eg >> 1)) * ZW + 4096 + h * 128 + (eg & 1) * 64 + 8 * fq;
    const bf16_t* pK = Z + (size_t)(b * SEQ + (dg >> 1)) * ZW + 3072 + h * 128 + (dg & 1) * 64 + 8 * fq;
    const bf16_t* pQ = Z + (size_t)(b * SEQ + fr) * ZW + 2048 + h * 128 + 8 * fq;
    bf16_t* pO = OI + (size_t)(b * SEQ + 4 * fq) * D + h * 128 + 16 * es + fr;
    const float* pD = DEC + (size_t)((b * 8 + h) * 64) * 128 + dg;
    __syncthreads();
#pragma unroll 1
    for (int G16 = 0; G16 < 4; ++G16) {
#pragma unroll 8
        for (int g = 0; g < 16; ++g) { const int n = 16 * G16 + g; const size_t ro = (size_t)n * 64 * ZW;
            const float dec = pD[n * 128];
            bf16x8 aV[2], bK[2];
#pragma unroll
            for (int k = 0; k < 2; ++k) { aV[k] = *(const bf16x8*)(pV + ro + 32 * k); bK[k] = *(const bf16x8*)(pK + ro + 32 * k); }
#pragma unroll
            for (int r = 0; r < 4; ++r) SB[g * 2176 + (4 * fq + r) * 136 + dg] = (bf16_t)f2bf(S[r]);
            S = S * dec;
#pragma unroll
            for (int k = 0; k < 2; ++k) S = MFMA16(aV[k], bK[k], S); }
        asm volatile("s_waitcnt lgkmcnt(0)" ::: "memory"); __builtin_amdgcn_s_barrier(); asm volatile("" ::: "memory");
#pragma unroll
        for (int c2 = 0; c2 < 2; ++c2) { const int g = wave + 8 * c2, nB = 16 * G16 + g; const size_t roB = (size_t)nB * 64 * ZW;
            bf16x8 bS[4];
#pragma unroll
            for (int k = 0; k < 4; ++k) bS[k] = *(const LAS bf16x8*)(SB + g * 2176 + fr * 136 + 32 * k + 8 * fq);
#pragma unroll
            for (int lt = 0; lt < 4; ++lt) { f32x4 acc = (f32x4){0.f, 0.f, 0.f, 0.f}; unsigned short oO[4];
#pragma unroll
                for (int r = 0; r < 4; ++r) oO[r] = pO[(size_t)(nB * 64 + 16 * lt + r) * D];
#pragma unroll
                for (int k = 0; k < 4; ++k) { const bf16x8 a = *(const bf16x8*)(pQ + roB + (size_t)(16 * lt) * ZW + 32 * k); acc = MFMA16(a, bS[k], acc); }
#pragma unroll
                for (int r = 0; r < 4; ++r) { const float nv = bf2f(oO[r]) + acc[r]; if (!dry) pO[(size_t)(nB * 64 + 16 * lt + r) * D] = (bf16_t)f2bf(nv); else if (nv == 123456.0f) pO[0] = 0; } } }
        asm volatile("s_waitcnt lgkmcnt(0)" ::: "memory"); __builtin_amdgcn_s_barrier(); asm volatile("" ::: "memory");
    }
}
__device__ __forceinline__ void rg_b_unit(const Params& p, int unit) {
    OPQ_TID;
    const int b = unit >> 7, n = (unit >> 1) & 63, ch = (unit & 1) * 512 + 8 * (tid & 63), r8 = tid >> 6;
    const bf16_t* HL = (const bf16_t*)((float*)p.out) + (size_t)b * SEQ * D + ch; const bf16_t* PC = HL + (size_t)T * D;
    bf16_t* Z = (bf16_t*)(WSP + WS_Z) + (size_t)(b * SEQ + n * 64) * ZW + ch;
    float carry[8];
#pragma unroll
    for (int i = 0; i < 8; ++i) carry[i] = 0.f;
    int m0 = 0;
    for (; m0 + 4 <= n; m0 += 4) { u32x4 pp[4], hh4[4];
#pragma unroll
        for (int i = 0; i < 4; ++i) { const size_t o = (size_t)((m0 + i) * 64 + 63) * D; pp[i] = *(const u32x4*)(PC + o); hh4[i] = *(const u32x4*)(HL + o); }
#pragma unroll
        for (int i = 0; i < 4; ++i)
#pragma unroll
            for (int c = 0; c < 4; ++c) { carry[2 * c] = carry[2 * c] * bf2f(pp[i][c] & 0xffffu) + bf2f(hh4[i][c] & 0xffffu); carry[2 * c + 1] = carry[2 * c + 1] * bf2f(pp[i][c] >> 16) + bf2f(hh4[i][c] >> 16); } }
    for (; m0 < n; ++m0) { const size_t o = (size_t)(m0 * 64 + 63) * D; const u32x4 pp = *(const u32x4*)(PC + o), hh4 = *(const u32x4*)(HL + o);
#pragma unroll
        for (int c = 0; c < 4; ++c) { carry[2 * c] = carry[2 * c] * bf2f(pp[c] & 0xffffu) + bf2f(hh4[c] & 0xffffu); carry[2 * c + 1] = carry[2 * c + 1] * bf2f(pp[c] >> 16) + bf2f(hh4[c] >> 16); } }
#pragma unroll 4
    for (int tq = 0; tq < 8; ++tq) { const int t = 8 * tq + r8; const size_t o = (size_t)(n * 64 + t) * D;
        const u32x4 hv = __builtin_nontemporal_load((const u32x4*)(HL + o)), pv = __builtin_nontemporal_load((const u32x4*)(PC + o)), gv = __builtin_nontemporal_load((const u32x4*)(Z + (size_t)t * ZW + 1024)); u32x4 ov;
#pragma unroll
        for (int c = 0; c < 4; ++c) { const float h0 = bf2f(hv[c] & 0xffffu) + bf2f(pv[c] & 0xffffu) * carry[2 * c], h1 = bf2f(hv[c] >> 16) + bf2f(pv[c] >> 16) * carry[2 * c + 1];
            const float g0 = bf2f(gv[c] & 0xffffu), g1 = bf2f(gv[c] >> 16); ov[c] = pk2(h0 * g0 * sigmf(g0), h1 * g1 * sigmf(g1)); }
        *(u32x4*)(Z + (size_t)t * ZW) = ov; }
}
__device__ __forceinline__ float row16_sum_p4(float x) {
    x += __int_as_float(__builtin_amdgcn_update_dpp(0, __float_as_int(x), 0xB1, 0xf, 0xf, true)); x += __int_as_float(__builtin_amdgcn_update_dpp(0, __float_as_int(x), 0x4E, 0xf, 0xf, true));
    x += __int_as_float(__builtin_amdgcn_update_dpp(0, __float_as_int(x), 0x141, 0xf, 0xf, true)); x += __int_as_float(__builtin_amdgcn_update_dpp(0, __float_as_int(x), 0x140, 0xf, 0xf, true)); return x; }
__device__ __forceinline__ void p4_finalize(const Params& p, int G, int bid) {
    OPQ_TID; const int gw = bid * 8 + wave, ngw = G * 8;
    bf16_t* Z = (bf16_t*)(WSP + WS_Z); const bf16_t* OI = (const bf16_t*)(WSP + WS_OI);
    const int l16 = lane & 15, pr = lane >> 4;
    const f32x4 g0 = *(const f32x4*)(((const float*)p.in[I_HGG]) + 8 * l16), g1 = *(const f32x4*)(((const float*)p.in[I_HGG]) + 8 * l16 + 4);
    for (int it = gw; it < T * 2; it += ngw) { const int tok = it >> 1, h = (it & 1) * 4 + pr;
        const u32x4 ov = __builtin_nontemporal_load((const u32x4*)(OI + (size_t)tok * D + h * 128 + 8 * l16)); const u32x4 gv = __builtin_nontemporal_load((const u32x4*)(Z + (size_t)tok * ZW + 5120 + h * 128 + 8 * l16));
        float o[8], gb[8]; float ss = 0.f;
#pragma unroll
        for (int c = 0; c < 4; ++c) { o[2 * c] = bf2f(ov[c] & 0xffffu); o[2 * c + 1] = bf2f(ov[c] >> 16); gb[2 * c] = bf2f(gv[c] & 0xffffu); gb[2 * c + 1] = bf2f(gv[c] >> 16); ss += o[2 * c] * o[2 * c] + o[2 * c + 1] * o[2 * c + 1]; }
        const float rs = rsqrtf(row16_sum_p4(ss) * (1.0f / 128.0f) + 1e-6f);
        u32x4 w;
#pragma unroll
        for (int c = 0; c < 4; ++c) { const float ga = c < 2 ? g0[2 * c] : g1[2 * c - 4], gbq = c < 2 ? g0[2 * c + 1] : g1[2 * c - 3];
            w[c] = pk2(o[2 * c] * rs * ga * gb[2 * c] * sigmf(gb[2 * c]), o[2 * c + 1] * rs * gbq * gb[2 * c + 1] * sigmf(gb[2 * c + 1])); }
        *(u32x4*)(Z + (size_t)tok * ZW + 1024 + h * 128 + 8 * l16) = w; }
}
__device__ __forceinline__ void p6_prologue(const Params& p, LAS unsigned char* lds, int G, int bid) {
    OPQ_TID; const int gw = bid * 8 + wave, ngw = G * 8;
    LAS float* scr = (LAS float*)(lds + wave * 16384);
    constexpr int IP = 4096, IL = 0, IO = 1024, I2 = 128;
    for (int i = gw * 64 + lane; i < (int)(MiB / 16); i += ngw * 64) ((u32x4*)(WSP + WS_GR))[i] = (u32x4){0u, 0u, 0u, 0u};
    for (int i = gw * 64 + lane; i < (int)(MiB / 32); i += ngw * 64) ((u32x4*)(WSP + WS_XG))[i] = (u32x4){0u, 0u, 0u, 0u};
    for (int it = gw; it < IP + IL + IO + I2; it += ngw) {
        int r = it;
        if (r < IP) { const int pj = r >> 10, q = r & 1023;
            const int muidx = pj == 0 ? 0 : (pj == 1 ? 2 : (pj == 2 ? 3 : 5));
            bf16_t* dst = (bf16_t*)(WSP + WS_WC) + (size_t)(pj * 2048) * 2048;
            tr_item2(((const float*)p.in[I_WR + pj]), 2048, dst, dst + 1024, 2048, ((const float*)p.in[I_MU]) + muidx * 1024, scr, q >> 6, q & 63, lane); continue; }
        r -= IP;
        if (r >= IO) { r -= IO; const int wh = r >> 6, nb = r & 63; tr_item(wh ? ((const float*)p.in[I_A2]) : ((const float*)p.in[I_W2]), 2048, (bf16_t*)(WSP + (wh ? WS_A2T : WS_W2T)), 64, nullptr, 0, scr, 0, nb, lane); continue; }
        tr_item(((const float*)p.in[I_WO]), 1024, (bf16_t*)(WSP + WS_WO), 2048, nullptr, 0, scr, r >> 5, r & 31, lane);
    }
    bf16_t* A2 = (bf16_t*)(WSP + WS_A2);
    const int fr = lane & 15, fq = lane >> 4;
    for (int tile = bid; tile < T / 64; tile += G) {
        const int m0 = tile * 64;
        for (int i = (wave == 0 && (m0 & (SEQ - 1)) != 0) ? -1 : 0; i < 8; ++i) { const int m = (i < 0) ? m0 - 1 : m0 + 8 * wave + i;
            u32x2 o[4]; rms_row(((float*)p.out) + (size_t)m * D, ((const float*)p.in[I_CNG]), lane, o); const int bb = m >> 12, t = m & (SEQ - 1);
            const size_t cr = (size_t)(t >> 11) * PROWS6 + bb * 2048 + (t & 2047);
            const size_t cn = (size_t)((t + 1) >> 11) * PROWS6 + bb * 2048 + ((t + 1) & 2047);
#pragma unroll
            for (int j = 0; j < 4; ++j) { if (i >= 0) *((u32x2*)(A2 + cr * 2048) + lane + 64 * j) = o[j];
                if (t + 1 < SEQ) *((u32x2*)(A2 + cn * 2048 + 1024) + lane + 64 * j) = o[j];
                if (t == 0) *((u32x2*)(A2 + cr * 2048 + 1024) + lane + 64 * j) = (u32x2){0u, 0u}; } }
        __syncthreads();
        { const int t0 = m0 & (SEQ - 1), bb = m0 >> 12; const size_t cr0 = (size_t)(t0 >> 11) * PROWS6 + bb * 2048 + (t0 & 2047);
          const int mt = wave & 3, nh = wave >> 2;
          LAS bf16_t* LA_ = (LAS bf16_t*)lds; LAS bf16_t* LB_ = (LAS bf16_t*)(lds + 64 * 264 * 2);
          const bf16_t* ga = A2 + cr0 * 2048; const bf16_t* gb = (const bf16_t*)(WSP + WS_WL);
          u32x4 pa_[4], pb_[8];
#define LORA_LOAD(kc) do { _Pragma("unroll") for (int q = 0; q < 4; ++q) { const int i = tid + q * NT; pa_[q] = *(const u32x4*)(ga + (size_t)(i >> 5) * 2048 + (kc) * 256 + 8 * (i & 31)); } \
              _Pragma("unroll") for (int q = 0; q < 8; ++q) { const int i = tid + q * NT; pb_[q] = *(const u32x4*)(gb + (size_t)(i >> 5) * 2048 + (kc) * 256 + 8 * (i & 31)); } } while (0)
          LORA_LOAD(0);
          f32x4 acc[4];
#pragma unroll
          for (int nt = 0; nt < 4; ++nt) acc[nt] = (f32x4){0.f, 0.f, 0.f, 0.f};
#pragma unroll 1
          for (int kc = 0; kc < 8; ++kc) {
#pragma unroll
              for (int q = 0; q < 4; ++q) { const int i = tid + q * NT; *(LAS u32x4*)(LA_ + (i >> 5) * 264 + 8 * (i & 31)) = pa_[q]; }
#pragma unroll
              for (int q = 0; q < 8; ++q) { const int i = tid + q * NT; *(LAS u32x4*)(LB_ + (i >> 5) * 264 + 8 * (i & 31)) = pb_[q]; }
              __syncthreads();
              if (kc + 1 < 8) LORA_LOAD(kc + 1);
#pragma unroll
              for (int ks = 0; ks < 8; ++ks) { const bf16x8 a = *(const LAS bf16x8*)(LA_ + (16 * mt + fr) * 264 + 32 * ks + 8 * fq);
#pragma unroll
                  for (int nt = 0; nt < 4; ++nt) { const bf16x8 bfr = *(const LAS bf16x8*)(LB_ + (64 * nh + 16 * nt + fr) * 264 + 32 * ks + 8 * fq); acc[nt] = MFMA16(a, bfr, acc[nt]); } }
              __syncthreads();
          }
#undef LORA_LOAD
          bf16_t* dstb = (bf16_t*)(WSP + (nh ? WS_LA : WS_LW));
#pragma unroll
          for (int nt = 0; nt < 4; ++nt)
#pragma unroll
              for (int r = 0; r < 4; ++r) { const float v = acc[nt][r]; dstb[(cr0 + 16 * mt + 4 * fq + r) * 64 + 16 * nt + fr] = (bf16_t)f2bf(nh ? v : tanhf(v)); } }
        __syncthreads();
    }
}
template <int CTRL> __device__ __forceinline__ float dpp_add(float x) { const int y = __builtin_amdgcn_update_dpp(0, __float_as_int(x), CTRL, 0xf, 0xf, true); return x + __int_as_float(y); }
__device__ __forceinline__ f32x4 bf4(u32x2 v) { return (f32x4){bf2f(v.x & 0xffffu), bf2f(v.x >> 16), bf2f(v.y & 0xffffu), bf2f(v.y >> 16)}; }
__device__ __forceinline__ float afma(float a, float b, float c) { float d; asm("v_fma_f32 %0, %1, %2, %3" : "=v"(d) : "v"(a), "v"(b), "v"(c)); return d; }
__device__ __forceinline__ float anfma(float a, float b, float c) { float d; asm("v_fma_f32 %0, -%1, %2, %3" : "=v"(d) : "v"(a), "v"(b), "v"(c)); return d; }
__device__ __forceinline__ float amul(float a, float b) { float d; asm("v_mul_f32 %0, %1, %2" : "=v"(d) : "v"(a), "v"(b)); return d; }
__device__ __forceinline__ f32x2 pkmul(f32x2 a, f32x2 b) { f32x2 d; asm("v_pk_mul_f32 %0, %1, %2" : "=v"(d) : "v"(a), "v"(b)); return d; }
__device__ __forceinline__ f32x2 pkfma(f32x2 a, f32x2 b, f32x2 c) { f32x2 d; asm("v_pk_fma_f32 %0, %1, %2, %3" : "=v"(d) : "v"(a), "v"(b), "v"(c)); return d; }
__device__ __forceinline__ f32x2 pkmul_bl(f32x2 s, f32x2 b) { f32x2 d; asm("v_pk_mul_f32 %0, %1, %2 op_sel_hi:[0,1]" : "=v"(d) : "v"(s), "v"(b)); return d; }
__device__ __forceinline__ f32x2 pknfma_bl(f32x2 s, f32x2 b, f32x2 c) { f32x2 d; asm("v_pk_fma_f32 %0, %1, %2, %3 op_sel_hi:[0,1,1] neg_lo:[1,0,0] neg_hi:[1,0,0]" : "=v"(d) : "v"(s), "v"(b), "v"(c)); return d; }
#define VPKMUL(d, a, b) asm volatile("v_pk_mul_f32 %0, %1, %2" : "=v"(d) : "v"(a), "v"(b))
#define VPKFMA(d, a, b, c) asm volatile("v_pk_fma_f32 %0, %1, %2, %3" : "=v"(d) : "v"(a), "v"(b), "v"(c))
#define VPKMULBL(d, s, b) asm volatile("v_pk_mul_f32 %0, %1, %2 op_sel_hi:[0,1]" : "=v"(d) : "v"(s), "v"(b))
#define VPKNFMABL(d, s, b, c) asm volatile("v_pk_fma_f32 %0, %1, %2, %3 op_sel_hi:[0,1,1] neg_lo:[1,0,0] neg_hi:[1,0,0]" : "=v"(d) : "v"(s), "v"(b), "v"(c))
#define VADD(d, a, b) asm volatile("v_add_f32 %0, %1, %2" : "=v"(d) : "v"(a), "v"(b))
#define VDPP1(x) asm volatile("v_add_f32_dpp %0, %0, %0 quad_perm:[1,0,3,2] row_mask:0xf bank_mask:0xf bound_ctrl:1" : "+v"(x))
#define VDPP2(x) asm volatile("v_add_f32_dpp %0, %0, %0 quad_perm:[2,3,0,1] row_mask:0xf bank_mask:0xf bound_ctrl:1" : "+v"(x))
#define VDPP3(x) asm volatile("v_add_f32_dpp %0, %0, %0 row_half_mirror row_mask:0xf bank_mask:0xf bound_ctrl:1" : "+v"(x))
constexpr int RSTR = 68;
constexpr int REC_ARR = 32 * RSTR;
constexpr int REC_BUF = 5 * REC_ARR;
constexpr int L_REC = 0, L_YY = 87040, L_VV = 103424, L_GG = 119808, L_RKP = 136192, L_SSP = 137216, L_STT = 137728, L_CST = 137984;
constexpr int PROWS = 8192;
#define SCAN_BAR do { asm volatile("s_waitcnt lgkmcnt(0)" ::: "memory"); __builtin_amdgcn_s_barrier(); asm volatile("" ::: "memory"); } while (0)
__device__ __forceinline__ void scan_half(const Params& p, LAS unsigned char* lds, int pi, int rh, int pass) {
    OPQ_TID;
    LAS float* REC = (LAS float*)(lds + L_REC); LAS float* YY = (LAS float*)(lds + L_YY); LAS float* VV = (LAS float*)(lds + L_VV); LAS float* GG = (LAS float*)(lds + L_GG);
    LAS float* RKP = (LAS float*)(lds + L_RKP); LAS float* SSP = (LAS float*)(lds + L_SSP); LAS float* STT = (LAS float*)(lds + L_STT); LAS float* CST = (LAS float*)(lds + L_CST);
    const int b = pi >> 5, hg = pi & 31, colg = hg * 64;
    const bf16_t* Rb = (const bf16_t*)(WSP + WS_R); const bf16_t* Kb = Rb + (size_t)PROWS * 2048; bf16_t* Vb = (bf16_t*)(WSP + WS_V); const bf16_t* Gb = Vb + (size_t)PROWS * 2048;
    const bf16_t* LWb = (const bf16_t*)(WSP + WS_LW) + (size_t)pass * PROWS * 64; const bf16_t* LAb = (const bf16_t*)(WSP + WS_LA) + (size_t)pass * PROWS * 64;
    unsigned long long* GR = (unsigned long long*)(WSP + WS_GR);
    const size_t rowb = (size_t)b * 2048;
    __syncthreads();
    if (tid < 64) { CST[tid] = ((const float*)p.in[I_W0])[colg + tid]; CST[64 + tid] = ((const float*)p.in[I_A0])[colg + tid]; CST[128 + tid] = ((const float*)p.in[I_KK])[colg + tid]; CST[192 + tid] = ((const float*)p.in[I_KA])[colg + tid]; CST[256 + tid] = ((const float*)p.in[I_RK])[colg + tid];
                    CST[320 + tid] = ((const float*)p.in[I_LNG])[colg + tid]; CST[384 + tid] = ((const float*)p.in[I_LNB])[colg + tid]; }
    __syncthreads();
    const int fr = lane & 15, fq = lane >> 4;
    if (wave < 4) {
        const int j = lane & 7, rowl = 8 * wave + (lane >> 3);
        float* stp = (float*)(WSP + WS_ST) + ((size_t)(pi * 64 + 32 * rh + rowl)) * 64 + 8 * j;
        f32x2 P01 = (f32x2){0.f, 0.f}, P23 = P01, P45 = P01, P67 = P01;
        if (pass == 1) { const f32x4 a = *(const f32x4*)stp, c = *(const f32x4*)(stp + 4); P01 = a.xy; P23 = a.zw; P45 = c.xy; P67 = c.zw; }
        const bool first = (lane & 7) == 0;
        SCAN_BAR;
        for (int it = 0; it < 66; ++it) {
            if (it < 64) {
                const LAS float* rec = REC + (it & 1) * REC_BUF + 8 * j; const LAS float* vvp = VV + (it & 3) * 1024 + rowl; LAS float* yyp = YY + (it & 3) * 1024 + rowl;
                const LAS float* ssp = SSP + (it & 1) * 64 + 2 * (lane & 31);
                const float inv2 = __builtin_amdgcn_rcpf(fmaxf(ssp[0] + ssp[1], 1e-24f));
                f32x4 Rkk[2][2], Rw[2][2], Rka[2][2], Rkm[2][2], Rr[2][2]; float Rv[2];
#define LOADREC(slot, s) do { const LAS float* rs_ = rec + (s) * RSTR; \
                    Rkk[slot][0] = *(const LAS f32x4*)(rs_); Rkk[slot][1] = *(const LAS f32x4*)(rs_ + 4); Rw[slot][0] = *(const LAS f32x4*)(rs_ + REC_ARR); Rw[slot][1] = *(const LAS f32x4*)(rs_ + REC_ARR + 4); \
                    Rka[slot][0] = *(const LAS f32x4*)(rs_ + 2 * REC_ARR); Rka[slot][1] = *(const LAS f32x4*)(rs_ + 2 * REC_ARR + 4); Rkm[slot][0] = *(const LAS f32x4*)(rs_ + 3 * REC_ARR); Rkm[slot][1] = *(const LAS f32x4*)(rs_ + 3 * REC_ARR + 4); \
                    Rr[slot][0] = *(const LAS f32x4*)(rs_ + 4 * REC_ARR); Rr[slot][1] = *(const LAS f32x4*)(rs_ + 4 * REC_ARR + 4); Rv[slot] = vvp[(s) * 32]; } while (0)
                LOADREC(0, 0);
                float yp = 0.f, yk0 = 0.f, yk1 = 0.f, yk2 = 0.f, yk3 = 0.f;
#define YSHIFT(YK) do { YK = __int_as_float(__builtin_amdgcn_update_dpp(__float_as_int(yp), __float_as_int(YK), 0x111, 0xf, 0xf, false)); YK = first ? yp : YK; } while (0)
#pragma unroll
                for (int s = 0; s < 32; ++s) {
                    const int c = s & 1, pc = c ^ 1;
                    const float si = __int_as_float(__builtin_amdgcn_readlane(__float_as_int(inv2), s));
                    f32x2 px, py, t01, t23, t45, t67; float x;
                    f32x2 vv2; vv2.x = Rv[c]; asm volatile("" : "+v"(vv2));
                    if (s >= 1) {
                        VPKMUL(px, P01, Rkk[c][0].xy); VPKMUL(py, P01, Rr[pc][0].xy); VPKFMA(px, P23, Rkk[c][0].zw, px); VPKFMA(py, P23, Rr[pc][0].zw, py);
                        VPKFMA(px, P45, Rkk[c][1].xy, px); VPKFMA(py, P45, Rr[pc][1].xy, py); VPKFMA(px, P67, Rkk[c][1].zw, px); VPKFMA(py, P67, Rr[pc][1].zw, py);
                        VADD(x, px.x, px.y); VADD(yp, py.x, py.y);
                    } else {
                        VPKMUL(px, P01, Rkk[c][0].xy); VPKFMA(px, P23, Rkk[c][0].zw, px); VPKFMA(px, P45, Rkk[c][1].xy, px); VPKFMA(px, P67, Rkk[c][1].zw, px);
                        VADD(x, px.x, px.y);
                    }
                    asm volatile("" ::: "memory");
                    if (s + 1 < 32) LOADREC((s + 1) & 1, s + 1);
                    asm volatile("" ::: "memory");
                    VPKMULBL(t01, vv2, Rkm[c][0].xy); VPKMULBL(t23, vv2, Rkm[c][0].zw);
                    VDPP1(x); if (s >= 1) VDPP1(yp);
                    VPKMULBL(t45, vv2, Rkm[c][1].xy); VPKMULBL(t67, vv2, Rkm[c][1].zw);
                    VDPP2(x); if (s >= 1) VDPP2(yp);
                    VPKFMA(P01, P01, Rw[c][0].xy, t01); VPKFMA(P23, P23, Rw[c][0].zw, t23);
                    VDPP3(x); if (s >= 1) VDPP3(yp);
                    VPKFMA(P45, P45, Rw[c][1].xy, t45); VPKFMA(P67, P67, Rw[c][1].zw, t67);
                    if (s >= 1) { if (s - 1 < 8) YSHIFT(yk0); else if (s - 1 < 16) YSHIFT(yk1); else if (s - 1 < 24) YSHIFT(yk2); else YSHIFT(yk3); }
                    x = x * si;
                    f32x2 x2; x2.x = x; asm volatile("" : "+v"(x2));
                    VPKNFMABL(P01, x2, Rka[c][0].xy, P01); VPKNFMABL(P23, x2, Rka[c][0].zw, P23); VPKNFMABL(P45, x2, Rka[c][1].xy, P45); VPKNFMABL(P67, x2, Rka[c][1].zw, P67);
                }
                { f32x2 py; VPKMUL(py, P01, Rr[1][0].xy); VPKFMA(py, P23, Rr[1][0].zw, py); VPKFMA(py, P45, Rr[1][1].xy, py); VPKFMA(py, P67, Rr[1][1].zw, py); VADD(yp, py.x, py.y); }
                yp = dpp_add<0xB1>(yp); yp = dpp_add<0x4E>(yp); yp = dpp_add<0x141>(yp); YSHIFT(yk3);
                yyp[(7 - j) * 32] = yk0; yyp[(15 - j) * 32] = yk1; yyp[(23 - j) * 32] = yk2; yyp[(31 - j) * 32] = yk3;
#undef LOADREC
#undef YSHIFT
            }
            SCAN_BAR;
        }
        if (pass == 0) { *(f32x4*)stp = (f32x4){P01.x, P01.y, P23.x, P23.y}; *(f32x4*)(stp + 4) = (f32x4){P45.x, P45.y, P67.x, P67.y}; }
    } else {
        const int pw = wave - 4, tt = pw >> 1, kh = pw & 1;
        bf16x8 aWc[2][2], aAc[2][2];
#pragma unroll
        for (int kt = 0; kt < 2; ++kt)
#pragma unroll
            for (int ks = 0; ks < 2; ++ks) { const size_t o = (size_t)(colg + 32 * kh + 16 * kt + fr) * 64 + 32 * ks + 8 * fq; aWc[kt][ks] = *(const bf16x8*)((const bf16_t*)(WSP + WS_W2T) + o); aAc[kt][ks] = *(const bf16x8*)((const bf16_t*)(WSP + WS_A2T) + o); }
        bf16x8 lwf[2][2], laf[2][2]; u32x2 r2[2][2], k2[2][2];
#define ISSUE(SET, tbx) do { const size_t tok_ = rowb + (tbx) * 32 + 16 * tt + fr; \
            _Pragma("unroll") for (int ks = 0; ks < 2; ++ks) { lwf[SET][ks] = *(const bf16x8*)(LWb + tok_ * 64 + 32 * ks + 8 * fq); laf[SET][ks] = *(const bf16x8*)(LAb + tok_ * 64 + 32 * ks + 8 * fq); } \
            _Pragma("unroll") for (int kt = 0; kt < 2; ++kt) { r2[SET][kt] = *(const u32x2*)(Rb + tok_ * 2048 + colg + 32 * kh + 16 * kt + 4 * fq); k2[SET][kt] = *(const u32x2*)(Kb + tok_ * 2048 + colg + 32 * kh + 16 * kt + 4 * fq); } } while (0)
        ISSUE(0, 0); ISSUE(1, 1);
        const int t = lane >> 1, hf = lane & 1;
        const size_t vgo = (size_t)colg + 32 * rh + 16 * hf;
        u32x4 v8a = (u32x4){0u, 0u, 0u, 0u}, v8b = v8a, g8a = v8a, g8b = v8a;
        if (pw == 2) { const size_t eo = (rowb + t) * 2048 + vgo; v8a = *(const u32x4*)(Vb + eo); v8b = *(const u32x4*)(Vb + eo + 8); g8a = *(const u32x4*)(Gb + eo); g8b = *(const u32x4*)(Gb + eo + 8); }
        unsigned long long gx[2] = {0ull, 0ull};
#define PROD_ITER(it, PS) do { \
            { const int tb = (it) + 1; \
              if (tb < 64) { \
                LAS float* rec = REC + (tb & 1) * REC_BUF + (16 * tt + fr) * RSTR + 32 * kh + 4 * fq; \
                float ss = 0.f, rkp = 0.f; \
                _Pragma("unroll") for (int kt = 0; kt < 2; ++kt) { \
                    f32x4 accW = (f32x4){0.f, 0.f, 0.f, 0.f}, accA = (f32x4){0.f, 0.f, 0.f, 0.f}; \
                    _Pragma("unroll") for (int ks = 0; ks < 2; ++ks) { accW = MFMA16(aWc[kt][ks], lwf[PS][ks], accW); accA = MFMA16(aAc[kt][ks], laf[PS][ks], accA); } \
                    const int kc = 32 * kh + 16 * kt + 4 * fq; \
                    const f32x4 w0v = *(const LAS f32x4*)(CST + kc), a0v = *(const LAS f32x4*)(CST + 64 + kc), kkc = *(const LAS f32x4*)(CST + 128 + kc), kac = *(const LAS f32x4*)(CST + 192 + kc), rkc = *(const LAS f32x4*)(CST + 256 + kc); \
                    const f32x4 r4 = bf4(r2[PS][kt]), k4 = bf4(k2[PS][kt]); \
                    f32x4 w4, a4; \
                    _Pragma("unroll") for (int e = 0; e < 4; ++e) { w4[e] = __expf(-0.60653066f * sigmf(accW[e] + w0v[e])); a4[e] = sigmf(accA[e] + a0v[e]); } \
                    const f32x4 kkr = k4 * kkc; ss += (kkr.x * kkr.x + kkr.y * kkr.y) + (kkr.z * kkr.z + kkr.w * kkr.w); \
                    const f32x4 km = k4 * (1.0f + (a4 - 1.0f) * kac); const f32x4 rr = r4 * km * rkc; rkp += (rr.x + rr.y) + (rr.z + rr.w); \
                    *(LAS f32x4*)(rec + 16 * kt) = kkr; *(LAS f32x4*)(rec + REC_ARR + 16 * kt) = w4; *(LAS f32x4*)(rec + 2 * REC_ARR + 16 * kt) = kkr * a4; *(LAS f32x4*)(rec + 3 * REC_ARR + 16 * kt) = km; *(LAS f32x4*)(rec + 4 * REC_ARR + 16 * kt) = r4; \
                } \
                if (tb + 2 < 64) ISSUE(PS, tb + 2); \
                ss += __shfl_xor(ss, 16); ss += __shfl_xor(ss, 32); rkp += __shfl_xor(rkp, 16); rkp += __shfl_xor(rkp, 32); \
                if (fq == 0) { SSP[(tb & 1) * 64 + 2 * (16 * tt + fr) + kh] = ss; RKP[(tb & 3) * 64 + 2 * (16 * tt + fr) + kh] = rkp; } \
              } \
              if (pw == 2 && tb < 64) { \
                LAS float* vp = VV + (tb & 3) * 1024 + t * 32 + 16 * hf; LAS float* gp = GG + (tb & 3) * 1024 + t * 32 + 16 * hf; \
                *(LAS f32x4*)(vp) = bf4((u32x2){v8a.x, v8a.y}); *(LAS f32x4*)(vp + 4) = bf4((u32x2){v8a.z, v8a.w}); *(LAS f32x4*)(vp + 8) = bf4((u32x2){v8b.x, v8b.y}); *(LAS f32x4*)(vp + 12) = bf4((u32x2){v8b.z, v8b.w}); \
                *(LAS f32x4*)(gp) = bf4((u32x2){g8a.x, g8a.y}); *(LAS f32x4*)(gp + 4) = bf4((u32x2){g8a.z, g8a.w}); *(LAS f32x4*)(gp + 8) = bf4((u32x2){g8b.x, g8b.y}); *(LAS f32x4*)(gp + 12) = bf4((u32x2){g8b.z, g8b.w}); \
                if (tb + 1 < 64) { const size_t eo = (rowb + (tb + 1) * 32 + t) * 2048 + vgo; v8a = *(const u32x4*)(Vb + eo); v8b = *(const u32x4*)(Vb + eo + 8); g8a = *(const u32x4*)(Gb + eo); g8b = *(const u32x4*)(Gb + eo + 8); } \
              } \
            } \
            if (pw == 3) { \
              if ((it) >= 2 && (it) <= 65) { const int tb = (it) - 2; const unsigned long long* g = GR + ((size_t)(pi * 8 + (tb & 7)) * 2) * 64 + lane; \
                gx[0] = __hip_atomic_load(g, __ATOMIC_RELAXED, __HIP_MEMORY_SCOPE_AGENT); gx[1] = __hip_atomic_load(g + 64, __ATOMIC_RELAXED, __HIP_MEMORY_SCOPE_AGENT); } \
              if ((it) >= 1 && (it) <= 64) { const int tb = (it) - 1; const LAS float* yp_ = YY + (tb & 3) * 1024 + t * 32 + 16 * hf; float s1 = 0.f, s2 = 0.f; \
                _Pragma("unroll") for (int qd = 0; qd < 4; ++qd) { const f32x4 a = *(const LAS f32x4*)(yp_ + 4 * qd); s1 += (a.x + a.y) + (a.z + a.w); s2 += (a.x * a.x + a.y * a.y) + (a.z * a.z + a.w * a.w); } \
                s1 = dpp_add<0xB1>(s1); s2 = dpp_add<0xB1>(s2); \
                const unsigned epoch = (unsigned)(pass * 64 + tb + 1); \
                __hip_atomic_store(GR + ((size_t)((pi * 8 + (tb & 7)) * 2 + rh) * 64 + hf * 32 + t), ((unsigned long long)epoch << 32) | (unsigned long long)__float_as_uint(hf ? s2 : s1), __ATOMIC_RELAXED, __HIP_MEMORY_SCOPE_AGENT); } \
              if ((it) >= 2 && (it) <= 65) { const int tb = (it) - 2; const unsigned epoch = (unsigned)(pass * 64 + tb + 1); \
                const unsigned long long* g = GR + ((size_t)(pi * 8 + (tb & 7)) * 2) * 64 + lane; float tot; \
                for (unsigned spins = 0;; ++spins) { const bool ok = ((unsigned)(gx[0] >> 32) == epoch) && ((unsigned)(gx[1] >> 32) == epoch); tot = __uint_as_float((unsigned)gx[0]) + __uint_as_float((unsigned)gx[1]); \
                    if (__all(ok) || spins > (1u << 22)) break; \
                    __builtin_amdgcn_s_sleep(1); \
                    gx[0] = __hip_atomic_load(g, __ATOMIC_RELAXED, __HIP_MEMORY_SCOPE_AGENT); gx[1] = __hip_atomic_load(g + 64, __ATOMIC_RELAXED, __HIP_MEMORY_SCOPE_AGENT); } \
                const float oth = __shfl_xor(tot, 32); \
                const float mean = (lane < 32 ? tot : oth) * (1.0f / 64.0f), ex2 = (lane < 32 ? oth : tot) * (1.0f / 64.0f); \
                const float rstd = rsqrtf(fmaxf(ex2 - mean * mean, 0.f) + 64e-5f); \
                if (lane < 32) { STT[2 * lane] = mean; STT[2 * lane + 1] = rstd; } \
                const float mu = STT[2 * t], rsd = STT[2 * t + 1]; \
                const int ro = (tb & 3) * 1024 + t * 32 + 16 * hf; const float rk = RKP[(tb & 3) * 64 + 2 * t] + RKP[(tb & 3) * 64 + 2 * t + 1]; \
                unsigned ow[8]; \
                _Pragma("unroll") for (int qd = 0; qd < 4; ++qd) { const f32x4 lg = *(const LAS f32x4*)(CST + 320 + 32 * rh + 16 * hf + 4 * qd), lb = *(const LAS f32x4*)(CST + 384 + 32 * rh + 16 * hf + 4 * qd); \
                    const f32x4 o = ((*(const LAS f32x4*)(YY + ro + 4 * qd) - mu) * rsd * lg + lb + rk * *(const LAS f32x4*)(VV + ro + 4 * qd)) * *(const LAS f32x4*)(GG + ro + 4 * qd); \
                    ow[2 * qd] = pk2(o.x, o.y); ow[2 * qd + 1] = pk2(o.z, o.w); } \
                bf16_t* dst = (bf16_t*)(WSP + WS_A2) + ((size_t)pass * PROWS + rowb + tb * 32 + t) * 2048 + vgo; \
                *(u32x4*)(dst) = (u32x4){ow[0], ow[1], ow[2], ow[3]}; *(u32x4*)(dst + 8) = (u32x4){ow[4], ow[5], ow[6], ow[7]}; } \
            } \
            SCAN_BAR; } while (0)
        for (int it2 = -1; it2 < 65; it2 += 2) { PROD_ITER(it2, 0); PROD_ITER(it2 + 1, 1); }
        PROD_ITER(65, 0);
#undef PROD_ITER
#undef ISSUE
    }
}
__device__ __forceinline__ void p10_final(const Params& p, int G, int bid) {
    OPQ_TID; const int gw = bid * 8 + wave, ngw = G * 8;
    for (int m = gw; m < T; m += ngw) { float* xr = ((float*)p.out) + (size_t)m * D; f32x4 v[4]; float s = 0.f;
#pragma unroll
        for (int j = 0; j < 4; ++j) { v[j] = *((const f32x4*)xr + lane + 64 * j); s += (v[j].x * v[j].x + v[j].y * v[j].y) + (v[j].z * v[j].z + v[j].w * v[j].w); }
        const float rs = rsqrtf(wave_sum(s) * (1.0f / 1024.0f) + 1e-6f);
#pragma unroll
        for (int j = 0; j < 4; ++j) { const f32x4 gg = *((const f32x4*)((const float*)p.in[I_FG]) + lane + 64 * j); *((f32x4*)xr + lane + 64 * j) = v[j] * rs * gg; } }
}

#define XB_TMO      128
#define XB_XCNT(j)  (256  + 64 * (j))
#define XB_XSUB(j)  (1280 + 64 * (j))
#define XB_XGEN(j)  (2304 + 64 * (j))
#define XB_TOP      3328
#define XB_TOPGEN   3392
#define XCD_BAR_WORDS 3456
#define XB_SPIN_CAP (1u << 18)

__device__ __forceinline__ unsigned xb_ld(unsigned* p)              { return __hip_atomic_load(p, __ATOMIC_RELAXED, __HIP_MEMORY_SCOPE_AGENT); }
__device__ __forceinline__ unsigned xb_add(unsigned* p, unsigned v) { return __hip_atomic_fetch_add(p, v, __ATOMIC_RELAXED, __HIP_MEMORY_SCOPE_AGENT); }
__device__ __forceinline__ unsigned xb_xcc_id() { return (unsigned)__builtin_amdgcn_s_getreg((3 << 11) | 20) & 0xFu; }
#define XB_SPIN(cond, bar) do { unsigned _sp = 0; while (cond) { __builtin_amdgcn_s_sleep(1); \
    if ((++_sp & 255u) == 0u) { if (xb_ld(&(bar)[XB_TMO])) break; if (_sp > XB_SPIN_CAP) { atomicAdd(&(bar)[XB_TMO], 1u); break; } } } } while (0)

struct XcdBarrier {
    unsigned* bar; unsigned x;
    volatile LAS unsigned* st;
};

__device__ __forceinline__ XcdBarrier xcd_barrier_post(unsigned* bar, volatile LAS unsigned* st) {
    XcdBarrier b; b.bar = bar; b.x = xb_xcc_id(); b.st = st;
    if (threadIdx.x == 0) (void)xb_add(&bar[XB_XCNT(b.x)], 1u);
    return b;
}
__device__ __forceinline__ void xcd_barrier_complete(unsigned* bar, unsigned x, unsigned& nloc, unsigned& nx) {
    const unsigned G = gridDim.x * gridDim.y * gridDim.z;
    unsigned sum, cnt, mine, sp = 0u;
    for (;;) {
        sum = 0u; cnt = 0u; mine = 0u;
#pragma unroll
        for (unsigned j = 0; j < 16; ++j) { const unsigned c = xb_ld(&bar[XB_XCNT(j)]); sum += c; cnt += (c > 0u) ? 1u : 0u; mine = (j == x) ? c : mine; }
        if (sum == G) break;
        __builtin_amdgcn_s_sleep(1);
        if ((++sp & 255u) == 0u) { if (xb_ld(&bar[XB_TMO])) break; if (sp > XB_SPIN_CAP) { atomicAdd(&bar[XB_TMO], 1u); break; } }
    }
    nloc = mine > 0u ? mine : 1u; nx = cnt > 0u ? cnt : 1u;
}

__device__ __forceinline__ void xcd_barrier(const XcdBarrier& b) {
    asm volatile("s_waitcnt vmcnt(0)" ::: "memory");
    __syncthreads();
    if (threadIdx.x == 0) {
        unsigned* bar = (unsigned*)(*(volatile LAS unsigned long long*)(b.st + 4)); const unsigned bx_ = xb_xcc_id();
        __builtin_amdgcn_s_waitcnt(0);
        unsigned nloc = b.st[0], nx = b.st[1];
        if (nloc == 0u) { xcd_barrier_complete(bar, bx_, nloc, nx); b.st[0] = nloc; b.st[1] = nx; }
        const unsigned old = xb_add(&bar[XB_XSUB(bx_)], 1u);
        const unsigned gen = old / nloc;
        if (old + 1u == (gen + 1u) * nloc) {
            __builtin_amdgcn_fence(__ATOMIC_RELEASE, "agent");
            asm volatile("s_waitcnt vmcnt(0)" ::: "memory");
            const unsigned og = xb_add(&bar[XB_TOP], 1u);
            const unsigned tg = og / nx;
            if (og + 1u == (tg + 1u) * nx) xb_add(&bar[XB_TOPGEN], 1u);
            else XB_SPIN(xb_ld(&bar[XB_TOPGEN]) == tg, bar);
            __builtin_amdgcn_fence(__ATOMIC_ACQUIRE, "agent");
            xb_add(&bar[XB_XGEN(bx_)], 1u);
            asm volatile("s_waitcnt vmcnt(0)" ::: "memory");
        } else {
            XB_SPIN(xb_ld(&bar[XB_XGEN(bx_)]) == gen, bar);
            __builtin_amdgcn_fence(__ATOMIC_ACQUIRE, "agent");
            asm volatile("s_waitcnt vmcnt(0)" ::: "memory");
        }
    }
    __syncthreads();
}

__global__ void __launch_bounds__(NT, 2) mk_fwd(Params p) {
    auto wsl = [&]() { return launder_ws(((unsigned char*)p.ws)); };
    extern __shared__ __attribute__((aligned(16))) unsigned char lds_raw[];
    LAS unsigned char* lds = (LAS unsigned char*)lds_raw;
    cg::grid_group grid = cg::this_grid();
    const int G = gridDim.x, bid = blockIdx.x;
    if (threadIdx.x < 16) ((LAS unsigned*)(lds + LDS_MISC))[threadIdx.x] = 0u;
    __syncthreads();
    if (threadIdx.x == 0) *(LAS unsigned long long*)(lds + LDS_MISC + 16) = (unsigned long long)(((unsigned char*)p.ws) + WS_BAR);
    __syncthreads();
    if (bid == 0) for (int i = threadIdx.x; i < 4096; i += NT) ((unsigned*)(((unsigned char*)p.ws) + WS_BAR))[i] = 0u;
#define XBAR() do { XcdBarrier xb_; xb_.bar = nullptr; xb_.x = 0u; xb_.st = (volatile LAS unsigned*)(lds + LDS_MISC); xcd_barrier(xb_); } while (0)
#if PROBE == 7
    p0_prologue(p, lds, G, bid);
#endif
    p0_prologue(p, lds, G, bid);
    grid.sync();
    (void)xcd_barrier_post((unsigned*)(((unsigned char*)p.ws) + WS_BAR), (volatile LAS unsigned*)(lds + LDS_MISC));
    { pg8::Gemm g{(const bf16_t*)((float*)p.out), (const bf16_t*)(wsl() + WS_WIN), T, ZW, D, D}; pg8::StaticOrder S; S.init(T, ZW, G, bid); pg8::EpiBf16 E{(bf16_t*)(wsl() + WS_Z), ZW};
      pg8::gemm_phase<pg8::EpiBf16, pg8::StaticOrder, true, true>(lds, g, S, E); }
    XBAR();
#if PROBE == 3
    { u32x4 pre[3]; if (bid < 2048) rg_a_prefetch((const bf16_t*)(wsl() + WS_Z), bid, threadIdx.x, pre); RgaConst K; int jc = -1; for (int u = bid; u < 2048; u += G) { if ((u & 7) != jc) { jc = u & 7; rg_a_consts(p, jc, K); } rg_a_unit(p, lds, u, u + G, pre, K); } }
    { u32x4 pre[6]; if (bid < 2048) hg_a_prefetch((const bf16_t*)(wsl() + WS_Z), bid, threadIdx.x, pre); for (int u = bid; u < 2048; u += G) hg_a_unit(p, lds, u, u + G, pre); }
    XBAR();
#endif
    { u32x4 pre[3]; if (bid < 2048) rg_a_prefetch((const bf16_t*)(wsl() + WS_Z), bid, threadIdx.x, pre); RgaConst K; int jc = -1; for (int u = bid; u < 2048; u += G) { if ((u & 7) != jc) { jc = u & 7; rg_a_consts(p, jc, K); } rg_a_unit(p, lds, u, u + G, pre, K); } }
    { u32x4 pre[6]; if (bid < 2048) hg_a_prefetch((const bf16_t*)(wsl() + WS_Z), bid, threadIdx.x, pre); for (int u = bid; u < 2048; u += G) hg_a_unit(p, lds, u, u + G, pre); }
    XBAR();
#if PROBE == 2
    for (int u = bid; u < 256; u += G) hg_b_item(p, lds, u, p.dry != 0);
    XBAR();
#endif
#if PROBE == 6
    for (int u = bid; u < 512; u += G) rg_b_unit(p, u);
    XBAR();
#endif
#if PROBE == 4
    for (int q = 0; q < 16; ++q) XBAR();
#endif
    for (int u = bid; u < 256; u += G) { const int it_ = (G == 256) ? ((((u & 7) + 8 * (u >> 6)) << 3) | ((u >> 3) & 7)) : u; hg_b_item(p, lds, it_); }
    for (int u = bid; u < 512; u += G) rg_b_unit(p, u);
    XBAR();
#if PROBE == 8
    p4_finalize(p, G, bid);
#endif
    p4_finalize(p, G, bid);
    XBAR();
    { pg8::Gemm g{(const bf16_t*)(wsl() + WS_Z), (const bf16_t*)(wsl() + WS_WOUT), T, D, 2048, ZW}; pg8::StaticOrder S; S.init(T, D, G, bid); pg8::EpiResF32 E{((const float*)p.in[I_X]), ((float*)p.out), D, 0, 0};
      pg8::gemm_phase<pg8::EpiResF32, pg8::StaticOrder, true, true>(lds, g, S, E); }
    XBAR();
#if PROBE == 9
    p6_prologue(p, lds, G, bid);
#endif
    p6_prologue(p, lds, G, bid);
    XBAR();
#pragma unroll 1
    for (int pass = 0; pass < 2; ++pass) {
        { pg8::Gemm g{(const bf16_t*)(wsl() + WS_A2) + (size_t)pass * 8192 * 2048, (const bf16_t*)(wsl() + WS_WC), 8192, 8192, 2048, 2048}; pg8::StaticOrder S; S.init(8192, 8192, G, bid);
          pg8::EpiL1 E{(bf16_t*)(wsl() + WS_R), (bf16_t*)(wsl() + WS_LW), (bf16_t*)(wsl() + WS_LA)};
          pg8::gemm_phase<pg8::EpiL1, pg8::StaticOrder, true, true>(lds, g, S, E); }
        XBAR();
        for (int u0 = 0; u0 < 256; u0 += G) { const int u = u0 + bid; if (u < 256) { int pi, rh; if (G == 256) { pi = (u & 7) + 8 * (u >> 4); rh = (u >> 3) & 1; } else { pi = u >> 1; rh = u & 1; } scan_half(p, lds, pi, rh, pass); } }
        XBAR();
    }
    if (G == 256) {
        pg8::Gemm g{(const bf16_t*)(wsl() + WS_A2), (const bf16_t*)(wsl() + WS_WO), T, D, 2048, 2048}; pg8::StaticOrder S; S.init(T, D, G, bid); pg8::EpiFinalNorm E{((float*)p.out), ((const float*)p.in[I_FG]), (unsigned long long*)(wsl() + WS_XG), D};
        pg8::gemm_phase<pg8::EpiFinalNorm, pg8::StaticOrder, false, true>(lds, g, S, E);
    } else {
        { pg8::Gemm g{(const bf16_t*)(wsl() + WS_A2), (const bf16_t*)(wsl() + WS_WO), T, D, 2048, 2048}; pg8::StaticOrder S; S.init(T, D, G, bid); pg8::EpiResF32 E{((float*)p.out), ((float*)p.out), D, 1, 0};
          pg8::gemm_phase<pg8::EpiResF32, pg8::StaticOrder, true, true>(lds, g, S, E); }
        XBAR();
        p10_final(p, G, bid);
    }
}

extern "C" void kernel_launch(void* const* d_in, const int* in_sizes, int n_in, void* d_out, int out_size, void* d_ws, size_t ws_size, hipStream_t stream) {
    static int grid = 0;
    if (grid == 0) {
        int dev = 0, cus = 0, per_cu = 0;
        if (n_in != 32 || out_size != T * D || ws_size < 256 * MiB) { fprintf(stderr, "kernel_launch: unexpected shapes (n_in %d out %d ws %zu)\n", n_in, out_size, ws_size); grid = -1; return; }
        if (hipGetDevice(&dev) != hipSuccess || hipDeviceGetAttribute(&cus, hipDeviceAttributeMultiprocessorCount, dev) != hipSuccess) { grid = -1; return; }
        if (hipFuncSetAttribute((const void*)mk_fwd, hipFuncAttributeMaxDynamicSharedMemorySize, LDS_BYTES) != hipSuccess) { fprintf(stderr, "hipFuncSetAttribute failed\n"); grid = -1; return; }
        if (hipOccupancyMaxActiveBlocksPerMultiprocessor(&per_cu, (const void*)mk_fwd, NT, LDS_BYTES) != hipSuccess || per_cu < 1) fprintf(stderr, "occupancy query: %d\n", per_cu);
        (void)hipGetLastError();
        grid = cus;
    }
    if (grid < 0) return;
    Params p{};
    p.dry = 1;
    for (int i = 0; i < 32; ++i) memcpy(&p.in[i], &d_in[i], sizeof(void*));
    memcpy(&p.out, &d_out, sizeof(void*)); memcpy(&p.ws, &d_ws, sizeof(void*));
    void* args[] = {&p};
    hipError_t e = hipLaunchCooperativeKernel((const void*)mk_fwd, dim3(grid), dim3(NT), args, LDS_BYTES, stream);
    if (e != hipSuccess) fprintf(stderr, "cooperative launch failed: %s (grid %d)\n", hipGetErrorString(e), grid);
}
```

```cpp
#define PROBE 0
#include <hip/hip_runtime.h>
#include <hip/hip_cooperative_groups.h>
#include <cstdio>
#include <cstring>
#include <cstdint>
namespace cg = cooperative_groups;
namespace pg8 {
#define PG8_LAS __attribute__((address_space(3)))
typedef unsigned short bf16_t;
typedef short bf16x8 __attribute__((ext_vector_type(8)));
typedef float f32x4 __attribute__((ext_vector_type(4)));
typedef unsigned u32x4 __attribute__((ext_vector_type(4)));
constexpr int BM = 256, BK = 64, HALF = 128, HTB = HALF * BK * 2  , STAGE_BYTES = 8 * HTB, NXCD = 8, WGM = 8;

__host__ __device__ __forceinline__ int lds_byte(int r, int c) { const int st = (r >> 4) * 2 + (c >> 5), rr = r & 15, cc = c & 31, ob = rr * 64 + cc * 2; return st * 1024 + (ob ^ (((ob >> 9) & 1) << 5)); }
__host__ __device__ __forceinline__ void stage_rc(int b, int& R, int& C) { const int st = b / 1024, sb = b % 1024, swz = sb ^ (((sb >> 9) & 1) << 5); R = (st >> 1) * 16 + swz / 64; C = (st & 1) * 32 + (swz % 64) / 2; }
__host__ __device__ __forceinline__ int perm32(int rho) { const int n = rho >> 4, i = rho & 15; return 8 * (i >> 2) + 4 * n + (i & 3); }

struct Unit { int pm, pn; };
struct Gemm { const bf16_t* A; const bf16_t* Bt; int M, N, K, lda; };

struct StaticOrder {
    int nM, nN, nwg, G, c;
    __host__ __device__ void init(int M, int N, int G_, int c_) { nM = M / BM; nN = N / BM; nwg = nM * nN; G = G_; c = c_; }
    __host__ __device__ bool next(int i, Unit& u) const {
        const long L = (long)i * G + c; if (L >= nwg) return false;
        int wgid = (int)L; { const int q = nwg / NXCD, r = nwg % NXCD, xcd = wgid % NXCD, off = wgid / NXCD; wgid = (xcd < r ? xcd * (q + 1) : r * (q + 1) + (xcd - r) * q) + off; }
        const int nig = WGM * nN, gid = wgid / nig, fm = gid * WGM, gsz = (nM - fm) < WGM ? (nM - fm) : WGM;
        u.pm = fm + ((wgid % nig) % gsz); u.pn = (wgid % nig) / gsz; return true;
    }
    __device__ __forceinline__ void a_ready(const Unit&) const {}
    __device__ __forceinline__ void done(const Unit&) const {}
};


struct LoraOrder {
    StaticOrder so; int extra;
    __host__ __device__ void init(int M, int N, int G_, int c_, int extra_) { so.init(M, N, G_, c_); extra = extra_; }
    __host__ __device__ bool next(int i, Unit& u) const { const long L = (long)i * so.G + so.c; if (L < so.nwg) return so.next(i, u); if (L >= so.nwg + extra) return false; u.pm = so.nM + (int)(L - so.nwg); u.pn = so.nN - 1; return true; }
    __device__ __forceinline__ void a_ready(const Unit&) const {}
    __device__ __forceinline__ void done(const Unit&) const {}
};
__device__ __forceinline__ unsigned cvt_pk_bf16(float lo, float hi) { unsigned r; asm volatile("v_cvt_pk_bf16_f32 %0, %1, %2" : "=v"(r) : "v"(lo), "v"(hi)); return r; }
__device__ __forceinline__ float sigm(float x) { return __builtin_amdgcn_rcpf(1.0f + __expf(-x)); }
struct EpiBf16 {
    static constexpr bool PERM = true, AFTER_DRAIN = false;
    bf16_t* O; int ldc;
    __device__ __forceinline__ void operator()(const f32x4 (&acc)[2][2][4][2], const Unit& u, int wr, int wc, int fr, int fq) const {
        const int row0 = u.pm * BM + wr * 64 + fr; const int col0 = u.pn * BM + wc * 32 + 8 * fq;
#pragma unroll
        for (int ai = 0; ai < 2; ++ai)
#pragma unroll
            for (int m = 0; m < 4; ++m) { bf16_t* rowp = O + (size_t)(row0 + ai * HALF + m * 16) * ldc + col0;
#pragma unroll
                for (int bj = 0; bj < 2; ++bj) { const f32x4 v0 = acc[ai][bj][m][0], v1 = acc[ai][bj][m][1];
                    u32x4 w; w.x = cvt_pk_bf16(v0[0], v0[1]); w.y = cvt_pk_bf16(v0[2], v0[3]); w.z = cvt_pk_bf16(v1[0], v1[1]); w.w = cvt_pk_bf16(v1[2], v1[3]);
                    *(u32x4*)(rowp + bj * HALF) = w; } }
    }
};
struct EpiResF32 {
    static constexpr bool PERM = false, AFTER_DRAIN = false;
    const float* base; float* out; int ldc; int remap; int pass;
    __device__ __forceinline__ void operator()(const f32x4 (&acc)[2][2][4][2], const Unit& u, int wr, int wc, int fr, int fq) const {
        const int col0 = u.pn * BM + wc * 32 + 4 * fq; const int rbase = remap ? ((((u.pm >> 3) & 3) << 12) + (u.pm >> 5) * 2048 + (u.pm & 7) * BM) : u.pm * BM;
#pragma unroll
        for (int ai = 0; ai < 2; ++ai)
#pragma unroll
            for (int m = 0; m < 4; ++m) { const size_t off = (size_t)(rbase + ai * HALF + wr * 64 + m * 16 + fr) * ldc + col0;
#pragma unroll
                for (int bj = 0; bj < 2; ++bj)
#pragma unroll
                    for (int n = 0; n < 2; ++n) { const f32x4 bs = __builtin_nontemporal_load((const f32x4*)(base + off + bj * HALF + n * 16)); *(f32x4*)(out + off + bj * HALF + n * 16) = bs + acc[ai][bj][m][n]; } }
    }
};
struct EpiL1 {
    static constexpr bool PERM = true, AFTER_DRAIN = false;
    bf16_t* R; bf16_t* LW; bf16_t* LA;
    __device__ __forceinline__ void operator()(const f32x4 (&acc)[2][2][4][2], const Unit& u, int wr, int wc, int fr, int fq) const {
        const int row0 = u.pm * BM + wr * 64 + fr;
        if (u.pn < 32) {
            const int buf = u.pn >> 3; bf16_t* base = R + (size_t)buf * (8192u * 2048u); const int col0 = (u.pn & 7) * BM + wc * 32 + 8 * fq;
#pragma unroll
            for (int ai = 0; ai < 2; ++ai)
#pragma unroll
                for (int m = 0; m < 4; ++m) { bf16_t* rowp = base + (size_t)(row0 + ai * HALF + m * 16) * 2048 + col0;
#pragma unroll
                    for (int bj = 0; bj < 2; ++bj) { f32x4 v0 = acc[ai][bj][m][0], v1 = acc[ai][bj][m][1];
                        if (buf == 3) {
#pragma unroll
                            for (int q = 0; q < 4; ++q) { v0[q] = v0[q] * sigm(v0[q]); v1[q] = v1[q] * sigm(v1[q]); } }
                        u32x4 w; w.x = cvt_pk_bf16(v0[0], v0[1]); w.y = cvt_pk_bf16(v0[2], v0[3]); w.z = cvt_pk_bf16(v1[0], v1[1]); w.w = cvt_pk_bf16(v1[2], v1[3]);
                        *(u32x4*)(rowp + bj * HALF) = w; } }
        } else {
            const int c0 = wc * 32 + 8 * fq;
#pragma unroll
            for (int ai = 0; ai < 2; ++ai)
#pragma unroll
                for (int m = 0; m < 4; ++m) { const size_t row = (size_t)(row0 + ai * HALF + m * 16); f32x4 v0 = acc[ai][0][m][0], v1 = acc[ai][0][m][1];
                    if (c0 < 64) {
#pragma unroll
                        for (int q = 0; q < 4; ++q) { v0[q] = tanhf(v0[q]); v1[q] = tanhf(v1[q]); } }
                    u32x4 w; w.x = cvt_pk_bf16(v0[0], v0[1]); w.y = cvt_pk_bf16(v0[2], v0[3]); w.z = cvt_pk_bf16(v1[0], v1[1]); w.w = cvt_pk_bf16(v1[2], v1[3]);
                    if (c0 < 64) *(u32x4*)(LW + row * 64 + c0) = w; else *(u32x4*)(LA + row * 64 + c0 - 64) = w; }
        }
    }
};

struct EpiFinalNorm {
    static constexpr bool PERM = false, AFTER_DRAIN = true;
    float* out; const float* g; unsigned long long* xg; int ldc;
    __device__ __forceinline__ void fused(f32x4 (&acc)[2][2][4][2], const Unit& u, int wr, int wc, int fr, int fq, PG8_LAS unsigned char* lds, int wid, int lane) const {
        PG8_LAS float* P = (PG8_LAS float*)lds; PG8_LAS float* S = (PG8_LAS float*)(lds + 4096);
        const int col0 = u.pn * BM + wc * 32 + 4 * fq; const int rbase = (((u.pm >> 3) & 3) << 12) + (u.pm >> 5) * 2048 + (u.pm & 7) * BM;
#pragma unroll
        for (int ai = 0; ai < 2; ++ai)
#pragma unroll
            for (int m = 0; m < 4; ++m) { const size_t off = (size_t)(rbase + ai * HALF + wr * 64 + m * 16 + fr) * ldc + col0; float s = 0.f;
#pragma unroll
                for (int bj = 0; bj < 2; ++bj)
#pragma unroll
                    for (int n = 0; n < 2; ++n) { const f32x4 v = acc[ai][bj][m][n] + __builtin_nontemporal_load((const f32x4*)(out + off + bj * HALF + n * 16)); acc[ai][bj][m][n] = v; s += (v[0] * v[0] + v[1] * v[1]) + (v[2] * v[2] + v[3] * v[3]); }
                s += __shfl_xor(s, 16); s += __shfl_xor(s, 32);
                if (fq == 0) P[(ai * HALF + wr * 64 + m * 16 + fr) * 4 + wc] = s; }
        asm volatile("s_waitcnt lgkmcnt(0)" ::: "memory"); __builtin_amdgcn_s_barrier(); asm volatile("" ::: "memory");
        const int row = wid * 32 + (lane & 31);
        if (lane < 32) { const float tot = (P[row * 4] + P[row * 4 + 1]) + (P[row * 4 + 2] + P[row * 4 + 3]);
            __hip_atomic_store(xg + ((size_t)(u.pm * 4 + u.pn) * 256 + row), (1ull << 32) | (unsigned long long)__float_as_uint(tot), __ATOMIC_RELAXED, __HIP_MEMORY_SCOPE_AGENT); }
        {
            float tot = 0.f;
            for (unsigned spins = 0;; ++spins) { bool ok = true; tot = 0.f;
                if (lane < 32) {
#pragma unroll
                    for (int q = 0; q < 4; ++q) { const unsigned long long x = __hip_atomic_load(xg + ((size_t)(u.pm * 4 + q) * 256 + row), __ATOMIC_RELAXED, __HIP_MEMORY_SCOPE_AGENT); ok &= (unsigned)(x >> 32) == 1u; tot += __uint_as_float((unsigned)x); } }
                if (__all(ok) || spins > (1u << 22)) break;
                __builtin_amdgcn_s_sleep(1); }
            if (lane < 32) S[row] = rsqrtf(tot * (1.0f / 1024.0f) + 1e-6f);
        }
        asm volatile("s_waitcnt lgkmcnt(0)" ::: "memory"); __builtin_amdgcn_s_barrier(); asm volatile("" ::: "memory");
#pragma unroll
        for (int ai = 0; ai < 2; ++ai)
#pragma unroll
            for (int m = 0; m < 4; ++m) { const int r = ai * HALF + wr * 64 + m * 16 + fr; const float rs = S[r]; const size_t off = (size_t)(rbase + r) * ldc + col0;
#pragma unroll
                for (int bj = 0; bj < 2; ++bj)
#pragma unroll
                    for (int n = 0; n < 2; ++n) { const f32x4 gg = *(const f32x4*)(g + col0 + bj * HALF + n * 16); __builtin_nontemporal_store(acc[ai][bj][m][n] * rs * gg, (f32x4*)(out + off + bj * HALF + n * 16)); } }
    }
};
template <class Epi, class Sched, bool ALIGN_EPI = false, bool SP2 = false>
__device__ __forceinline__ void gemm_phase(PG8_LAS unsigned char* lds, const Gemm g, const Sched& S, const Epi& E) {
    int tid_o = threadIdx.x; asm volatile("" : "+v"(tid_o)); const int tid = tid_o, wid = __builtin_amdgcn_readfirstlane(tid >> 6), lane = tid & 63, wr = wid >> 2, wc = wid & 3, fr = lane & 15, fq = lane >> 4;
    const int K = g.K, nt = K / BK;
    unsigned voffA[2], voffB[2];
#pragma unroll
    for (int i = 0; i < 2; ++i) { int R, C; stage_rc(tid * 16 + i * 8192, R, C); const int Rb = Epi::PERM ? ((R & ~31) + perm32(R & 31)) : R;
        voffA[i] = (unsigned)(R * g.lda + C) * 2u; voffB[i] = (unsigned)(Rb * K + C) * 2u; }
    const size_t kstep = (size_t)(BK * 2);
    const size_t hstep = (size_t)HALF * K * 2;
    const size_t tstep = 2 * hstep; const size_t hstepA = (size_t)HALF * g.lda * 2, tstepA = 2 * hstepA;
    const unsigned ldsw = (unsigned)wid * 1024u;
    const int aoff = lds_byte(wr * 64 + fr, fq * 8), boff = lds_byte(wc * 32 + fr, fq * 8);
#define PG8_SA(b, h) (((b) * 2 + (h)) * HTB)
#define PG8_SB(b, h) ((4 + (b) * 2 + (h)) * HTB)
#define PG8_STAGE(bufoff, gbase, voff) do { _Pragma("unroll") for (int _i = 0; _i < 2; ++_i) \
        __builtin_amdgcn_global_load_lds((const unsigned*)((const char*)(gbase) + (voff)[_i]), (PG8_LAS unsigned*)(lds + (bufoff) + ldsw + _i * 8192), 16, 0, 0); } while (0)
#define PG8_LDA(dst, b, h) do { _Pragma("unroll") for (int m = 0; m < 4; ++m) _Pragma("unroll") for (int k = 0; k < 2; ++k) dst[m][k] = *(const PG8_LAS bf16x8*)(lds + PG8_SA(b, h) + aoff + m * 2048 + k * 1024); } while (0)
#define PG8_LDB(dst, b, h) do { _Pragma("unroll") for (int n = 0; n < 2; ++n) _Pragma("unroll") for (int k = 0; k < 2; ++k) dst[n][k] = *(const PG8_LAS bf16x8*)(lds + PG8_SB(b, h) + boff + n * 2048 + k * 1024); } while (0)
#define PG8_MMA(ai, bj, At, Bt) do { __builtin_amdgcn_s_setprio(1); _Pragma("unroll") for (int m = 0; m < 4; ++m) _Pragma("unroll") for (int n = 0; n < 2; ++n) _Pragma("unroll") for (int k = 0; k < 2; ++k) \
        acc[ai][bj][m][n] = __builtin_amdgcn_mfma_f32_16x16x32_bf16(Bt[n][k], At[m][k], acc[ai][bj][m][n], 0, 0, 0); __builtin_amdgcn_s_setprio(0); } while (0)
#define PG8_WAIT_V(n) asm volatile("s_waitcnt vmcnt(" #n ")" ::: "memory")
#define PG8_WAIT_L(n) asm volatile("s_waitcnt lgkmcnt(" #n ")" ::: "memory")
#define PG8_BAR __builtin_amdgcn_s_barrier()
#define PG8_SCHED __builtin_amdgcn_sched_barrier(0)
    Unit cur, nxt; int ui = 0;
    if (!S.next(0, cur)) return;
    f32x4 acc[2][2][4][2];
#pragma unroll
    for (int a = 0; a < 2; ++a)
#pragma unroll
        for (int b = 0; b < 2; ++b)
#pragma unroll
            for (int m = 0; m < 4; ++m)
#pragma unroll
                for (int n = 0; n < 2; ++n) acc[a][b][m][n] = (f32x4){0.f, 0.f, 0.f, 0.f};
    bf16x8 At[4][2], B0[2][2], B1[2][2];
    const char* cA = (const char*)g.A + (size_t)cur.pm * tstepA; const char* cB = (const char*)g.Bt + (size_t)cur.pn * tstep;
    S.a_ready(cur);
    if constexpr (SP2) {
        PG8_STAGE(PG8_SB(0, 0), cB, voffB); PG8_STAGE(PG8_SB(0, 1), cB + hstep, voffB); PG8_STAGE(PG8_SA(0, 0), cA, voffA); PG8_STAGE(PG8_SA(0, 1), cA + hstepA, voffA);
        if (wr == 1) PG8_BAR;
        PG8_WAIT_V(2); PG8_BAR;
        PG8_STAGE(PG8_SB(1, 0), cB + kstep, voffB); PG8_STAGE(PG8_SA(1, 0), cA + kstep, voffA); PG8_STAGE(PG8_SB(1, 1), cB + hstep + kstep, voffB);
        PG8_WAIT_V(6); PG8_BAR;
    } else {
        PG8_STAGE(PG8_SB(0, 0), cB, voffB); PG8_STAGE(PG8_SA(0, 0), cA, voffA); PG8_STAGE(PG8_SB(0, 1), cB + hstep, voffB); PG8_STAGE(PG8_SA(0, 1), cA + hstepA, voffA);
        if (wr == 1) PG8_BAR;
        PG8_WAIT_V(4); PG8_BAR;
        PG8_STAGE(PG8_SB(1, 0), cB + kstep, voffB); PG8_STAGE(PG8_SA(1, 0), cA + kstep, voffA); PG8_STAGE(PG8_SB(1, 1), cB + hstep + kstep, voffB);
        PG8_WAIT_V(6); PG8_BAR;
    }
    for (;;) {
        const bool has_next = S.next(ui + 1, nxt);
        const char* nA = has_next ? (const char*)g.A + (size_t)nxt.pm * tstepA : cA; const char* nB = has_next ? (const char*)g.Bt + (size_t)nxt.pn * tstep : cB;
        for (int t = 0; t < nt; t += 2) {
            const bool last = (t == nt - 2);
            const char* a1 = cA + (size_t)(t + 1) * kstep;
            const char* a2 = last ? nA : cA + (size_t)(t + 2) * kstep; const char* b2 = last ? nB : cB + (size_t)(t + 2) * kstep;
            const char* a3 = a2 + kstep; const char* b3 = b2 + kstep;
            if (last && has_next) S.a_ready(nxt);
            if constexpr (SP2) {
            PG8_LDB(B0, 0, 0); PG8_LDB(B1, 0, 1); PG8_SCHED; PG8_LDA(At, 0, 0); PG8_STAGE(PG8_SA(1, 1), a1 + hstepA, voffA);
            PG8_WAIT_V(8); PG8_WAIT_L(0); PG8_BAR; PG8_MMA(0, 0, At, B0); PG8_MMA(0, 1, At, B1); PG8_BAR; PG8_SCHED;
            PG8_LDA(At, 0, 1); PG8_STAGE(PG8_SB(0, 0), b2, voffB); PG8_STAGE(PG8_SB(0, 1), b2 + hstep, voffB); PG8_STAGE(PG8_SA(0, 0), a2, voffA);
            PG8_WAIT_V(8); PG8_WAIT_L(0); PG8_BAR; PG8_MMA(1, 0, At, B0); PG8_MMA(1, 1, At, B1); PG8_BAR; PG8_SCHED;
            PG8_LDB(B0, 1, 0); PG8_LDB(B1, 1, 1); PG8_SCHED; PG8_LDA(At, 1, 0); PG8_STAGE(PG8_SA(0, 1), a2 + hstepA, voffA);
            PG8_WAIT_V(8); PG8_WAIT_L(0); PG8_BAR; PG8_MMA(0, 0, At, B0); PG8_MMA(0, 1, At, B1); PG8_BAR; PG8_SCHED;
            PG8_LDA(At, 1, 1); PG8_STAGE(PG8_SB(1, 0), b3, voffB); PG8_STAGE(PG8_SB(1, 1), b3 + hstep, voffB); PG8_STAGE(PG8_SA(1, 0), a3, voffA);
            PG8_WAIT_V(8); PG8_WAIT_L(0); PG8_BAR; PG8_MMA(1, 0, At, B0); PG8_MMA(1, 1, At, B1); PG8_BAR; PG8_SCHED;
            } else {
            PG8_LDB(B0, 0, 0); PG8_SCHED; PG8_LDA(At, 0, 0); PG8_STAGE(PG8_SA(1, 1), a1 + hstepA, voffA);
            PG8_WAIT_L(8); PG8_BAR; PG8_WAIT_L(0); PG8_MMA(0, 0, At, B0); PG8_BAR; PG8_SCHED;
            PG8_LDB(B1, 0, 1); PG8_STAGE(PG8_SB(0, 0), b2, voffB);
            PG8_BAR; PG8_WAIT_L(0); PG8_MMA(0, 1, At, B1); PG8_BAR;
            PG8_LDA(At, 0, 1); PG8_STAGE(PG8_SA(0, 0), a2, voffA);
            PG8_BAR; PG8_WAIT_L(0); PG8_MMA(1, 0, At, B0); PG8_BAR; PG8_SCHED;
            PG8_STAGE(PG8_SB(0, 1), b2 + hstep, voffB);
            PG8_WAIT_V(6); PG8_BAR; PG8_MMA(1, 1, At, B1); PG8_BAR;
            PG8_LDB(B0, 1, 0); PG8_SCHED; PG8_LDA(At, 1, 0); PG8_STAGE(PG8_SA(0, 1), a2 + hstepA, voffA);
            PG8_WAIT_L(8); PG8_BAR; PG8_WAIT_L(0); PG8_MMA(0, 0, At, B0); PG8_BAR; PG8_SCHED;
            PG8_LDB(B1, 1, 1); PG8_STAGE(PG8_SB(1, 0), b3, voffB);
            PG8_BAR; PG8_WAIT_L(0); PG8_MMA(0, 1, At, B1); PG8_BAR;
            PG8_LDA(At, 1, 1); PG8_STAGE(PG8_SA(1, 0), a3, voffA);
            PG8_BAR; PG8_WAIT_L(0); PG8_MMA(1, 0, At, B0); PG8_BAR; PG8_SCHED;
            PG8_STAGE(PG8_SB(1, 1), b3 + hstep, voffB);
            PG8_WAIT_V(6); PG8_BAR; PG8_MMA(1, 1, At, B1); PG8_BAR;
            }
        }
        if constexpr (ALIGN_EPI) { if (wr == 0) PG8_BAR; }
        if constexpr (!Epi::AFTER_DRAIN) { E(acc, cur, wr, wc, fr, fq); S.done(cur); }
        if (!has_next) break;
#pragma unroll
        for (int a = 0; a < 2; ++a)
#pragma unroll
            for (int b = 0; b < 2; ++b)
#pragma unroll
                for (int m = 0; m < 4; ++m)
#pragma unroll
                    for (int n = 0; n < 2; ++n) acc[a][b][m][n] = (f32x4){0.f, 0.f, 0.f, 0.f};
        cur = nxt; cA = nA; cB = nB; ++ui;
        if constexpr (ALIGN_EPI) { if (wr == 1) PG8_BAR; }
    }
    PG8_WAIT_V(0);
    if constexpr (!ALIGN_EPI) { if (wr == 0) PG8_BAR; }
    PG8_BAR;
    if constexpr (Epi::AFTER_DRAIN) { E.fused(acc, cur, wr, wc, fr, fq, lds, wid, lane); S.done(cur); }
#undef PG8_SA
#undef PG8_SB
#undef PG8_STAGE
#undef PG8_LDA
#undef PG8_LDB
#undef PG8_MMA
#undef PG8_WAIT_V
#undef PG8_WAIT_L
#undef PG8_BAR
#undef PG8_SCHED
}
}
#define GAS __attribute__((address_space(1)))
#define LAS __attribute__((address_space(3)))
typedef unsigned short bf16_t;
typedef short bf16x8 __attribute__((ext_vector_type(8)));
typedef float f32x4 __attribute__((ext_vector_type(4)));
typedef unsigned u32x4 __attribute__((ext_vector_type(4)));
typedef unsigned u32x2 __attribute__((ext_vector_type(2)));
typedef float f32x2 __attribute__((ext_vector_type(2)));
constexpr int NT = 512, PROWS6 = 8192;
constexpr int T = 16384, SEQ = 4096, D = 1024, ZW = 6144;
constexpr size_t MiB = 1u << 20;
constexpr size_t WS_DEC = 0;
constexpr size_t WS_Z = 4 * MiB;
constexpr size_t WS_WIN = 196 * MiB, WS_WOUT = 208 * MiB, WS_RGA = 212 * MiB, WS_RGX = 212 * MiB + 256 * 1024;
constexpr size_t WS_OI = 213 * MiB;
constexpr size_t WS_A2 = 4 * MiB;
constexpr size_t WS_R = 68 * MiB;
constexpr size_t WS_V = 132 * MiB;
constexpr size_t WS_WC = 196 * MiB, WS_WO = 229 * MiB, WS_LW = 233 * MiB, WS_LA = 235 * MiB;
constexpr size_t WS_W2T = 237 * MiB, WS_A2T = 237 * MiB + 256 * 1024, WS_GR = 238 * MiB, WS_ST = 239 * MiB, WS_XG = 241 * MiB;
constexpr size_t WS_WL = 246 * MiB;
constexpr size_t WS_BAR = 2 * MiB;
constexpr int LDS_BYTES = 147456, LDS_MISC = 147456 - 64;

struct Params { const GAS float* in[32]; GAS float* out; GAS unsigned char* ws; long long dry; };
#ifndef PROBE
#define PROBE 0
#endif
enum { I_X = 0, I_ABG, I_WIN, I_CONVW, I_CONVB, I_RGWA, I_RGBA, I_RGWX, I_RGBX, I_LAM, I_LB, I_HGG, I_WOUT, I_CNG, I_MU, I_WR, I_WK, I_WV, I_WG, I_W0, I_W1, I_W2, I_A0, I_A1, I_A2, I_KK, I_KA, I_RK, I_LNG, I_LNB, I_WO, I_FG };

__device__ __forceinline__ unsigned f2bf(float f) { unsigned u = __float_as_uint(f); return (u + 0x7fffu + ((u >> 16) & 1u)) >> 16; }
__device__ __forceinline__ float bf2f(unsigned h) { return __uint_as_float(h << 16); }
__device__ __forceinline__ unsigned pk2(float lo, float hi) { return f2bf(lo) | (f2bf(hi) << 16); }
__device__ __forceinline__ float sigmf(float x) { return __builtin_amdgcn_rcpf(1.0f + __expf(-x)); }
__device__ __forceinline__ float wave_sum(float v) {
#pragma unroll
    for (int o = 1; o < 64; o <<= 1) v += __shfl_xor(v, o);
    return v;
}
#define OPQ_TID unsigned char* WSP = launder_ws(((unsigned char*)p.ws)); int tid = threadIdx.x; asm volatile("" : "+v"(tid)); const int lane = tid & 63, wave = __builtin_amdgcn_readfirstlane(tid >> 6); (void)lane; (void)wave
__device__ __forceinline__ unsigned char* launder_ws(unsigned char* w) { const unsigned long long v = (unsigned long long)w; unsigned lo = __builtin_amdgcn_readfirstlane((unsigned)v), hi = __builtin_amdgcn_readfirstlane((unsigned)(v >> 32)); asm volatile("" : "+s"(lo), "+s"(hi)); return (unsigned char*)(GAS unsigned char*)(((unsigned long long)hi << 32) | lo); }
#define MFMA16(a, b, c) __builtin_amdgcn_mfma_f32_16x16x32_bf16((a), (b), (c), 0, 0, 0)

__device__ __forceinline__ void tr_item(const float* src, int ld_src, bf16_t* dst, int ld_dst, const float* sc, int scmode, LAS float* scr, int kb, int nb, int lane) {
    const int k0 = 64 * kb, n0 = 32 * nb;
#pragma unroll
    for (int i = 0; i < 8; ++i) { const int kk = 8 * i + (lane >> 3), c4 = (lane & 7) * 4; f32x4 v = __builtin_nontemporal_load((const f32x4*)(src + (size_t)(k0 + kk) * ld_src + n0 + c4));
        if (sc) { const float m_ = sc[k0 + kk]; v = v * (scmode ? m_ : (1.0f - m_)); }
        scr[kk * 33 + c4] = v.x; scr[kk * 33 + c4 + 1] = v.y; scr[kk * 33 + c4 + 2] = v.z; scr[kk * 33 + c4 + 3] = v.w; }
    asm volatile("s_waitcnt lgkmcnt(0)" ::: "memory");
    const int c = lane & 7;
#pragma unroll
    for (int j = 0; j < 4; ++j) { const int n = (lane >> 3) + 8 * j; const LAS float* s = scr + (8 * c) * 33 + n;
        u32x4 o; o.x = pk2(s[0 * 33], s[1 * 33]); o.y = pk2(s[2 * 33], s[3 * 33]); o.z = pk2(s[4 * 33], s[5 * 33]); o.w = pk2(s[6 * 33], s[7 * 33]);
        *(u32x4*)(dst + (size_t)(n0 + n) * ld_dst + k0 + 8 * c) = o; }
    asm volatile("s_waitcnt lgkmcnt(0)" ::: "memory");
}
__device__ __forceinline__ void tr_item2(const float* src, int ld_src, bf16_t* dst0, bf16_t* dst1, int ld_dst, const float* mu, LAS float* scr, int kb, int nb, int lane) {
    const int k0 = 64 * kb, n0 = 32 * nb;
#pragma unroll
    for (int i = 0; i < 8; ++i) { const int kk = 8 * i + (lane >> 3), c4 = (lane & 7) * 4; const f32x4 v = __builtin_nontemporal_load((const f32x4*)(src + (size_t)(k0 + kk) * ld_src + n0 + c4));
        scr[kk * 33 + c4] = v.x; scr[kk * 33 + c4 + 1] = v.y; scr[kk * 33 + c4 + 2] = v.z; scr[kk * 33 + c4 + 3] = v.w; }
    asm volatile("s_waitcnt lgkmcnt(0)" ::: "memory");
    const int c = lane & 7;
    const f32x4 m0 = *(const f32x4*)(mu + k0 + 8 * c), m1 = *(const f32x4*)(mu + k0 + 8 * c + 4);
#pragma unroll
    for (int j = 0; j < 4; ++j) { const int n = (lane >> 3) + 8 * j; const LAS float* s = scr + (8 * c) * 33 + n;
        const float s0 = s[0], s1 = s[33], s2 = s[66], s3 = s[99], s4 = s[132], s5 = s[165], s6 = s[198], s7 = s[231];
        u32x4 o; o.x = pk2(s0 * m0.x, s1 * m0.y); o.y = pk2(s2 * m0.z, s3 * m0.w); o.z = pk2(s4 * m1.x, s5 * m1.y); o.w = pk2(s6 * m1.z, s7 * m1.w);
        *(u32x4*)(dst1 + (size_t)(n0 + n) * ld_dst + k0 + 8 * c) = o;
        o.x = pk2(s0 * (1.0f - m0.x), s1 * (1.0f - m0.y)); o.y = pk2(s2 * (1.0f - m0.z), s3 * (1.0f - m0.w)); o.z = pk2(s4 * (1.0f - m1.x), s5 * (1.0f - m1.y)); o.w = pk2(s6 * (1.0f - m1.z), s7 * (1.0f - m1.w));
        *(u32x4*)(dst0 + (size_t)(n0 + n) * ld_dst + k0 + 8 * c) = o; }
    asm volatile("s_waitcnt lgkmcnt(0)" ::: "memory");
}
__device__ __forceinline__ void rms_row(const float* xrow, const float* g, int lane, u32x2 (&o)[4]) {
    f32x4 v[4]; float s = 0.f;
#pragma unroll
    for (int j = 0; j < 4; ++j) { v[j] = __builtin_nontemporal_load((const f32x4*)xrow + lane + 64 * j); s += (v[j].x * v[j].x + v[j].y * v[j].y) + (v[j].z * v[j].z + v[j].w * v[j].w); }
    const float rs = rsqrtf(wave_sum(s) * (1.0f / 1024.0f) + 1e-6f);
#pragma unroll
    for (int j = 0; j < 4; ++j) { const f32x4 gg = *((const f32x4*)g + lane + 64 * j); o[j].x = pk2(v[j].x * rs * gg.x, v[j].y * rs * gg.y); o[j].y = pk2(v[j].z * rs * gg.z, v[j].w * rs * gg.w); }
}

__device__ __forceinline__ void p0_prologue(const Params& p, LAS unsigned char* lds, int G, int bid) {
    OPQ_TID; const int gw = bid * 8 + wave, ngw = G * 8;
    LAS float* scr = (LAS float*)(lds + wave * 16384);
    bf16_t* WinT = (bf16_t*)(WSP + WS_WIN); bf16_t* WoutT = (bf16_t*)(WSP + WS_WOUT); bf16_t* RGA = (bf16_t*)(WSP + WS_RGA); bf16_t* RGX = (bf16_t*)(WSP + WS_RGX);
    constexpr int IA = 16 * 192, IB = 32 * 32, IC = 64, IL0 = 64;
    for (int it = gw; it < IA + IB + 2 * IC + IL0; it += ngw) {
        int r = it;
        if (r >= IA + IB + 2 * IC) { r -= IA + IB + 2 * IC; const int wh = r >> 5, q = r & 31;
            bf16_t* dst = (bf16_t*)(WSP + WS_WL) + (size_t)(wh * 64) * 2048;
            tr_item2(wh ? ((const float*)p.in[I_A1]) : ((const float*)p.in[I_W1]), 64, dst, dst + 1024, 2048, ((const float*)p.in[I_MU]) + (wh ? 4 : 1) * 1024, scr, q >> 1, q & 1, lane); continue; }
        if (r < IA) { tr_item(((const float*)p.in[I_WIN]), ZW, WinT, 1024, nullptr, 0, scr, r / 192, r % 192, lane); continue; } r -= IA;
        if (r < IB) { tr_item(((const float*)p.in[I_WOUT]), 1024, WoutT, 2048, nullptr, 0, scr, r / 32, r % 32, lane); continue; } r -= IB;
        const float* src = (r < IC) ? ((const float*)p.in[I_RGWA]) : ((const float*)p.in[I_RGWX]); bf16_t* dst = (r < IC) ? RGA : RGX; if (r >= IC) r -= IC;
        const int blk = r >> 3, q = r & 7;
        tr_item(src + blk * 16384, 128, dst + blk * 16384, 128, nullptr, 0, scr, q >> 2, q & 3, lane);
    }
    bf16_t* U0 = (bf16_t*)((float*)p.out);
    for (int m = gw; m < T; m += ngw) { u32x2 o[4]; rms_row(((const float*)p.in[I_X]) + (size_t)m * D, ((const float*)p.in[I_ABG]), lane, o);
#pragma unroll
        for (int j = 0; j < 4; ++j) *((u32x2*)(U0 + (size_t)m * D) + lane + 64 * j) = o[j]; }
}

__device__ __forceinline__ void rg_a_prefetch(const bf16_t* Z, int unit, int tid, u32x4 (&pre)[3]) {
    const int b = unit >> 9, n = (unit >> 3) & 63, j = unit & 7; const int tok0 = b * SEQ + n * 64, ch0 = j * 128;
#pragma unroll
    for (int q = 0; q < 3; ++q) { const int i = tid + q * NT; const int row = i >> 4, cc = i & 15; pre[q] = (u32x4){0u, 0u, 0u, 0u};
        if (i < 67 * 16 && (n > 0 || row >= 3)) pre[q] = __builtin_nontemporal_load((const u32x4*)(Z + (size_t)(tok0 - 3 + row) * ZW + ch0 + 8 * cc)); }
}
struct RgaConst { bf16x8 bA[4], bX[4]; float w0, w1, w2, w3, cb, ba, bx, sp; };
__device__ __forceinline__ void rg_a_consts(const Params& p, int j, RgaConst& K) {
    OPQ_TID;
    const int fr = lane & 15, fq = lane >> 4, ch0 = j * 128;
    const bf16_t* WA = (const bf16_t*)(WSP + WS_RGA) + j * 16384 + (16 * wave + fr) * 128 + 8 * fq;
    const bf16_t* WX = (const bf16_t*)(WSP + WS_RGX) + j * 16384 + (16 * wave + fr) * 128 + 8 * fq;
#pragma unroll
    for (int k = 0; k < 4; ++k) { K.bA[k] = *(const bf16x8*)(WA + 32 * k); K.bX[k] = *(const bf16x8*)(WX + 32 * k); }
    const int chc = ch0 + (tid & 127), che = ch0 + 16 * wave + fr;
    K.w0 = ((const float*)p.in[I_CONVW])[chc]; K.w1 = ((const float*)p.in[I_CONVW])[1024 + chc]; K.w2 = ((const float*)p.in[I_CONVW])[2048 + chc]; K.w3 = ((const float*)p.in[I_CONVW])[3072 + chc]; K.cb = ((const float*)p.in[I_CONVB])[chc];
    K.ba = ((const float*)p.in[I_RGBA])[che]; K.bx = ((const float*)p.in[I_RGBX])[che]; K.sp = log1pf(expf(-((const float*)p.in[I_LAM])[che]));
}
__device__ __forceinline__ void rg_a_unit(const Params& p, LAS unsigned char* lds, int unit, int next_unit, u32x4 (&pre)[3], const RgaConst& K) {
    OPQ_TID;
    LAS float* XC = (LAS float*)lds; LAS float* AA = (LAS float*)(lds + 34816); LAS bf16_t* XB = (LAS bf16_t*)(lds + 69632); LAS bf16_t* XR = (LAS bf16_t*)(lds + 87040);
    LAS float* SUMP = (LAS float*)(lds + 87040); LAS float* SUMH = SUMP + 512; LAS bf16_t* HT = XB; LAS bf16_t* PT = (LAS bf16_t*)(lds + 91136);
    const int b = unit >> 9, n = (unit >> 3) & 63, j = unit & 7;
    const int tok0 = b * SEQ + n * 64, ch0 = j * 128;
    const bf16_t* Z = (const bf16_t*)(WSP + WS_Z);
#pragma unroll
    for (int q = 0; q < 3; ++q) { const int i = tid + q * NT; if (i < 67 * 16) *(LAS u32x4*)(XR + (i >> 4) * 136 + 8 * (i & 15)) = pre[q]; }
    __syncthreads();
    if (next_unit < 2048) rg_a_prefetch(Z, next_unit, tid, pre);
    const int c = tid & 127, sub = tid >> 7;
    {
        const int ch = ch0 + c;
        const float w0 = K.w0, w1 = K.w1, w2 = K.w2, w3 = K.w3, cb = K.cb; (void)ch;
        const LAS bf16_t* xr = XR + (sub * 16) * 136 + c;
        float xm3 = bf2f(xr[0]), xm2 = bf2f(xr[136]), xm1 = bf2f(xr[272]);
        f32x4 yq[4];
#pragma unroll
        for (int i = 0; i < 16; ++i) { const float x = bf2f(xr[(i + 3) * 136]); const float y = w0 * xm3 + w1 * xm2 + w2 * xm1 + w3 * x + cb;
            yq[i >> 2][i & 3] = y; XB[(sub * 16 + i) * 136 + c] = (bf16_t)f2bf(y); xm3 = xm2; xm2 = xm1; xm1 = x; }
#pragma unroll
        for (int q = 0; q < 4; ++q) *(LAS f32x4*)(XC + c * 68 + sub * 16 + 4 * q) = yq[q];
    }
    __syncthreads();
    {
        const int fr = lane & 15, fq = lane >> 4;
        f32x4 accA[4], accX[4];
#pragma unroll
        for (int m = 0; m < 4; ++m) { accA[m] = (f32x4){0.f, 0.f, 0.f, 0.f}; accX[m] = (f32x4){0.f, 0.f, 0.f, 0.f}; }
#pragma unroll
        for (int k = 0; k < 4; ++k) { const bf16x8 bA = K.bA[k], bX = K.bX[k];
#pragma unroll
            for (int m = 0; m < 4; ++m) { const bf16x8 a = *(const LAS bf16x8*)(XB + (16 * m + fr) * 136 + 32 * k + 8 * fq); accA[m] = MFMA16(a, bA, accA[m]); accX[m] = MFMA16(a, bX, accX[m]); } }
        const int cl = 16 * wave + fr, ch = ch0 + cl;
        const float ba = K.ba, bx = K.bx, sp = K.sp; (void)ch;
#pragma unroll
        for (int m = 0; m < 4; ++m) { const f32x4 xc4 = *(const LAS f32x4*)(XC + cl * 68 + 16 * m + 4 * fq); f32x4 a4, u4;
#pragma unroll
            for (int r = 0; r < 4; ++r) { const float gr = sigmf(accA[m][r] + ba), gi = sigmf(accX[m][r] + bx);
                const float la = -8.0f * gr * sp; const float a = __expf(la); const float mult = __builtin_amdgcn_sqrtf(fmaxf(1.0f - a * a, 0.f));
                a4[r] = a; u4[r] = mult * gi * xc4[r]; }
            *(LAS f32x4*)(AA + cl * 68 + 16 * m + 4 * fq) = a4; *(LAS f32x4*)(XC + cl * 68 + 16 * m + 4 * fq) = u4; }
    }
    __syncthreads();
    {
        float hl[16], pl[16]; float h = 0.f, P = 1.f;
        f32x4 aq[4], uq[4];
#pragma unroll
        for (int q = 0; q < 4; ++q) { aq[q] = *(const LAS f32x4*)(AA + c * 68 + sub * 16 + 4 * q); uq[q] = *(const LAS f32x4*)(XC + c * 68 + sub * 16 + 4 * q); }
#pragma unroll
        for (int i = 0; i < 16; ++i) { const float a = aq[i >> 2][i & 3], u = uq[i >> 2][i & 3]; h = a * h + u; P *= a; hl[i] = h; pl[i] = P; }
        SUMP[sub * 128 + c] = P; SUMH[sub * 128 + c] = h;
        __syncthreads();
        float chh = 0.f, cp = 1.f;
#pragma unroll
        for (int s = 0; s < 3; ++s) if (s < sub) { const float sp_ = SUMP[s * 128 + c]; chh = chh * sp_ + SUMH[s * 128 + c]; cp *= sp_; }
        { bf16_t* HL = (bf16_t*)((float*)p.out) + (size_t)(tok0 + sub * 16) * D + ch0 + c; bf16_t* PC = HL + (size_t)T * D;
#pragma unroll
          for (int i = 0; i < 16; ++i) { HL[(size_t)i * D] = (bf16_t)f2bf(hl[i] + pl[i] * chh); PC[(size_t)i * D] = (bf16_t)f2bf(pl[i] * cp); } }
    }
    __syncthreads();
}

__device__ __forceinline__ void hg_a_prefetch(const bf16_t* Z, int unit, int tid, u32x4 (&pre)[6]) {
    const int b = unit >> 9, h = (unit >> 6) & 7, n = unit & 63; const int tok0 = b * SEQ + n * 64;
#pragma unroll
    for (int q = 0; q < 6; ++q) { const int i = tid + q * NT; const int arr = i >> 10, row = (i >> 4) & 63, cc = i & 15; pre[q] = __builtin_nontemporal_load((const u32x4*)(Z + (size_t)(tok0 + row) * ZW + 2048 + 1024 * arr + h * 128 + 8 * cc)); }
}
__device__ __forceinline__ void hg_a_unit(const Params& p, LAS unsigned char* lds, int unit, int next_unit, u32x4 (&pre)[6]) {
    OPQ_TID;
    LAS bf16_t* QD = (LAS bf16_t*)lds; LAS bf16_t* KI = (LAS bf16_t*)(lds + 17408); LAS bf16_t* VR = (LAS bf16_t*)(lds + 34816); LAS bf16_t* VT = (LAS bf16_t*)(lds + 52224);
    LAS bf16_t* SC = (LAS bf16_t*)(lds + 70656); LAS float* ST = (LAS float*)(lds + 79872); LAS bf16_t* OT = VR;
    const int b = unit >> 9, h = (unit >> 6) & 7, n = unit & 63;
    const int tok0 = b * SEQ + n * 64;
    bf16_t* Z = (bf16_t*)(WSP + WS_Z);
    const int fr = lane & 15, fq = lane >> 4;
#pragma unroll
    for (int q = 0; q < 6; ++q) { const int i = tid + q * NT; const int arr = i >> 10, row = (i >> 4) & 63, cc = i & 15;
        *(LAS u32x4*)((arr == 0 ? QD : (arr == 1 ? KI : VR)) + row * 136 + 8 * cc) = pre[q]; }
    __syncthreads();
    {
        const int d = tid & 127, sub = tid >> 7, hd = h * 128 + d;
        const float lb = sigmf(((const float*)p.in[I_LB])[hd] - ((const float*)p.in[I_LB])[1024 + hd]), omlb = 1.0f - lb;
        float q[16], kq[16], cl[16]; unsigned short vv[16]; float run = 0.f;
#pragma unroll
        for (int i = 0; i < 16; ++i) { const int t = sub * 16 + i; const float f = bf2f(KI[t * 136 + d]); const float sg = sigmf(f);
            run += __logf(lb + omlb * sg); cl[i] = run; kq[i] = omlb * (1.0f - sg); q[i] = bf2f(QD[t * 136 + d]); vv[i] = VR[t * 136 + d]; }
        ST[sub * 128 + d] = run;
        __syncthreads();
        float off = 0.f, total = 0.f;
#pragma unroll
        for (int s = 0; s < 4; ++s) { const float x = ST[s * 128 + d]; total += x; if (s < sub) off += x; }
        unsigned ke[8], vp[8];
#pragma unroll
        for (int i = 0; i < 16; ++i) { const float cum = off + cl[i]; const unsigned qd = f2bf(q[i] * __expf(cum)), ki = f2bf(kq[i] * __expf(-cum)), kE = f2bf(kq[i] * __expf(total - cum));
            QD[(sub * 16 + i) * 136 + d] = (bf16_t)qd; KI[(sub * 16 + i) * 136 + d] = (bf16_t)ki;
            if (i & 1) { ke[i >> 1] |= kE << 16; vp[i >> 1] |= (unsigned)vv[i] << 16; } else { ke[i >> 1] = kE; vp[i >> 1] = vv[i]; } }
        *(LAS u32x4*)(VT + d * 72 + sub * 16) = (u32x4){vp[0], vp[1], vp[2], vp[3]}; *(LAS u32x4*)(VT + d * 72 + sub * 16 + 8) = (u32x4){vp[4], vp[5], vp[6], vp[7]};
        bf16_t* tb = Z + (size_t)(tok0 + (d >> 1)) * ZW + h * 128 + (d & 1) * 64 + sub * 16;
        *(u32x4*)(tb + 3072) = (u32x4){ke[0], ke[1], ke[2], ke[3]}; *(u32x4*)(tb + 3072 + 8) = (u32x4){ke[4], ke[5], ke[6], ke[7]};
        *(u32x4*)(tb + 4096) = (u32x4){vp[0], vp[1], vp[2], vp[3]}; *(u32x4*)(tb + 4096 + 8) = (u32x4){vp[4], vp[5], vp[6], vp[7]};
        if (sub == 0) ((float*)(WSP + WS_DEC))[unit * 128 + d] = __expf(total);
    }
    __syncthreads();
    if (next_unit < 2048) hg_a_prefetch(Z, next_unit, tid, pre);
    for (int i = tid; i < 1024; i += NT) { const int row = i >> 4, cc = i & 15; *(u32x4*)(Z + (size_t)(tok0 + row) * ZW + 2048 + h * 128 + 8 * cc) = *(const LAS u32x4*)(QD + row * 136 + 8 * cc); }
    {
        const int lt = wave >> 1;
#pragma unroll
        for (int x = 0; x < 2; ++x) { const int mt = (wave & 1) * 2 + x; f32x4 acc = (f32x4){0.f, 0.f, 0.f, 0.f};
            if (mt <= lt) {
#pragma unroll
                for (int k = 0; k < 4; ++k) { const bf16x8 a = *(const LAS bf16x8*)(QD + (16 * lt + fr) * 136 + 32 * k + 8 * fq), bb = *(const LAS bf16x8*)(KI + (16 * mt + fr) * 136 + 32 * k + 8 * fq); acc = MFMA16(a, bb, acc); } }
#pragma unroll
            for (int r = 0; r < 4; ++r) { const int l = 16 * lt + 4 * fq + r, mm = 16 * mt + fr; SC[l * 72 + mm] = (bf16_t)f2bf(mm <= l ? acc[r] : 0.f); } }
    }
    __syncthreads();
    {
#pragma unroll
        for (int lt = 0; lt < 4; ++lt) { f32x4 acc = (f32x4){0.f, 0.f, 0.f, 0.f};
#pragma unroll
            for (int k = 0; k < 2; ++k) { const bf16x8 a = *(const LAS bf16x8*)(SC + (16 * lt + fr) * 72 + 32 * k + 8 * fq), bb = *(const LAS bf16x8*)(VT + (16 * wave + fr) * 72 + 32 * k + 8 * fq); acc = MFMA16(a, bb, acc); }
#pragma unroll
            for (int r = 0; r < 4; ++r) OT[(16 * lt + 4 * fq + r) * 136 + 16 * wave + fr] = (bf16_t)f2bf(acc[r]); }
    }
    __syncthreads();
    { bf16_t* OI = (bf16_t*)(WSP + WS_OI) + (size_t)tok0 * D + h * 128;
      for (int i = tid; i < 1024; i += NT) { const int row = i >> 4, cc = i & 15; *(u32x4*)(OI + (size_t)row * D + 8 * cc) = *(const LAS u32x4*)(OT + row * 136 + 8 * cc); } }
    __syncthreads();
}

__device__ __forceinline__ void hg_b_item(const Params& p, LAS unsigned char* lds, int item, bool dry = false) {
    OPQ_TID;
    LAS bf16_t* SB = (LAS bf16_t*)lds;
    const int b = item >> 6, h = (item >> 3) & 7, es = item & 7;
    const int fr = lane & 15, fq = lane >> 4;
    const bf16_t* Z = (const bf16_t*)(WSP + WS_Z); bf16_t* OI = (bf16_t*)(WSP + WS_OI); const float* DEC = (const float*)(WSP + WS_DEC);
    f32x4 S = (f32x4){0.f, 0.f, 0.f, 0.f};
    const int eg = 16 * es + fr, dg = 16 * wave + fr;
    const bf16_t* pV = Z + (size_t)(b * SEQ + (eg >> 1)) * ZW + 4096 + h * 128 + (eg & 1) * 64 + 8 * fq;
    const bf16_t* pK = Z + (size_t)(b * SEQ + (dg >> 1)) * ZW + 3072 + h * 128 + (dg & 1) * 64 + 8 * fq;
    const bf16_t* pQ = Z + (size_t)(b * SEQ + fr) * ZW + 2048 + h * 128 + 8 * fq;
    bf16_t* pO = OI + (size_t)(b * SEQ + 4 * fq) * D + h * 128 + 16 * es + fr;
    const float* pD = DEC + (size_t)((b * 8 + h) * 64) * 128 + dg;
    __syncthreads();
#pragma unroll 1
    for (int G16 = 0; G16 < 4; ++G16) {
#pragma unroll 8
        for (int g = 0; g < 16; ++g) { const int n = 16 * G16 + g; const size_t ro = (size_t)n * 64 * ZW;
            const float dec = pD[n * 128];
            bf16x8 aV[2], bK[2];
#pragma unroll
            for (int k = 0; k < 2; ++k) { aV[k] = *(const bf16x8*)(pV + ro + 32 * k); bK[k] = *(const bf16x8*)(pK + ro + 32 * k); }
#pragma unroll
            for (int r = 0; r < 4; ++r) SB[g * 2176 + (4 * fq + r) * 136 + dg] = (bf16_t)f2bf(S[r]);
            S = S * dec;
#pragma unroll
            for (int k = 0; k < 2; ++k) S = MFMA16(aV[k], bK[k], S); }
        asm volatile("s_waitcnt lgkmcnt(0)" ::: "memory"); __builtin_amdgcn_s_barrier(); asm volatile("" ::: "memory");
#pragma unroll
        for (int c2 = 0; c2 < 2; ++c2) { const int g = wave + 8 * c2, nB = 16 * G16 + g; const size_t roB = (size_t)nB * 64 * ZW;
            bf16x8 bS[4];
#pragma unroll
            for (int k = 0; k < 4; ++k) bS[k] = *(const LAS bf16x8*)(SB + g * 2176 + fr * 136 + 32 * k + 8 * fq);
#pragma unroll
            for (int lt = 0; lt < 4; ++lt) { f32x4 acc = (f32x4){0.f, 0.f, 0.f, 0.f}; unsigned short oO[4];
#pragma unroll
                for (int r = 0; r < 4; ++r) oO[r] = pO[(size_t)(nB * 64 + 16 * lt + r) * D];
#pragma unroll
                for (int k = 0; k < 4; ++k) { const bf16x8 a = *(const bf16x8*)(pQ + roB + (size_t)(16 * lt) * ZW + 32 * k); acc = MFMA16(a, bS[k], acc); }
#pragma unroll
                for (int r = 0; r < 4; ++r) { const float nv = bf2f(oO[r]) + acc[r]; if (!dry) pO[(size_t)(nB * 64 + 16 * lt + r) * D] = (bf16_t)f2bf(nv); else if (nv == 123456.0f) pO[0] = 0; } } }
        asm volatile("s_waitcnt lgkmcnt(0)" ::: "memory"); __builtin_amdgcn_s_barrier(); asm volatile("" ::: "memory");
    }
}
__device__ __forceinline__ void rg_b_unit(const Params& p, int unit) {
    OPQ_TID;
    const int b = unit >> 7, n = (unit >> 1) & 63, ch = (unit & 1) * 512 + 8 * (tid & 63), r8 = tid >> 6;
    const bf16_t* HL = (const bf16_t*)((float*)p.out) + (size_t)b * SEQ * D + ch; const bf16_t* PC = HL + (size_t)T * D;
    bf16_t* Z = (bf16_t*)(WSP + WS_Z) + (size_t)(b * SEQ + n * 64) * ZW + ch;
    float carry[8];
#pragma unroll
    for (int i = 0; i < 8; ++i) carry[i] = 0.f;
    int m0 = 0;
    for (; m0 + 4 <= n; m0 += 4) { u32x4 pp[4], hh4[4];
#pragma unroll
        for (int i = 0; i < 4; ++i) { const size_t o = (size_t)((m0 + i) * 64 + 63) * D; pp[i] = *(const u32x4*)(PC + o); hh4[i] = *(const u32x4*)(HL + o); }
#pragma unroll
        for (int i = 0; i < 4; ++i)
#pragma unroll
            for (int c = 0; c < 4; ++c) { carry[2 * c] = carry[2 * c] * bf2f(pp[i][c] & 0xffffu) + bf2f(hh4[i][c] & 0xffffu); carry[2 * c + 1] = carry[2 * c + 1] * bf2f(pp[i][c] >> 16) + bf2f(hh4[i][c] >> 16); } }
    for (; m0 < n; ++m0) { const size_t o = (size_t)(m0 * 64 + 63) * D; const u32x4 pp = *(const u32x4*)(PC + o), hh4 = *(const u32x4*)(HL + o);
#pragma unroll
        for (int c = 0; c < 4; ++c) { carry[2 * c] = carry[2 * c] * bf2f(pp[c] & 0xffffu) + bf2f(hh4[c] & 0xffffu); carry[2 * c + 1] = carry[2 * c + 1] * bf2f(pp[c] >> 16) + bf2f(hh4[c] >> 16); } }
#pragma unroll 4
    for (int tq = 0; tq < 8; ++tq) { const int t = 8 * tq + r8; const size_t o = (size_t)(n * 64 + t) * D;
        const u32x4 hv = __builtin_nontemporal_load((const u32x4*)(HL + o)), pv = __builtin_nontemporal_load((const u32x4*)(PC + o)), gv = __builtin_nontemporal_load((const u32x4*)(Z + (size_t)t * ZW + 1024)); u32x4 ov;
#pragma unroll
        for (int c = 0; c < 4; ++c) { const float h0 = bf2f(hv[c] & 0xffffu) + bf2f(pv[c] & 0xffffu) * carry[2 * c], h1 = bf2f(hv[c] >> 16) + bf2f(pv[c] >> 16) * carry[2 * c + 1];
            const float g0 = bf2f(gv[c] & 0xffffu), g1 = bf2f(gv[c] >> 16); ov[c] = pk2(h0 * g0 * sigmf(g0), h1 * g1 * sigmf(g1)); }
        *(u32x4*)(Z + (size_t)t * ZW) = ov; }
}
__device__ __forceinline__ float row16_sum_p4(float x) {
    x += __int_as_float(__builtin_amdgcn_update_dpp(0, __float_as_int(x), 0xB1, 0xf, 0xf, true)); x += __int_as_float(__builtin_amdgcn_update_dpp(0, __float_as_int(x), 0x4E, 0xf, 0xf, true));
    x += __int_as_float(__builtin_amdgcn_update_dpp(0, __float_as_int(x), 0x141, 0xf, 0xf, true)); x += __int_as_float(__builtin_amdgcn_update_dpp(0, __float_as_int(x), 0x140, 0xf, 0xf, true)); return x; }
__device__ __forceinline__ void p4_finalize(const Params& p, int G, int bid) {
    OPQ_TID; const int gw = bid * 8 + wave, ngw = G * 8;
    bf16_t* Z = (bf16_t*)(WSP + WS_Z); const bf16_t* OI = (const bf16_t*)(WSP + WS_OI);
    const int l16 = lane & 15, pr = lane >> 4;
    const f32x4 g0 = *(const f32x4*)(((const float*)p.in[I_HGG]) + 8 * l16), g1 = *(const f32x4*)(((const float*)p.in[I_HGG]) + 8 * l16 + 4);
    for (int it = gw; it < T * 2; it += ngw) { const int tok = it >> 1, h = (it & 1) * 4 + pr;
        const u32x4 ov = __builtin_nontemporal_load((const u32x4*)(OI + (size_t)tok * D + h * 128 + 8 * l16)); const u32x4 gv = __builtin_nontemporal_load((const u32x4*)(Z + (size_t)tok * ZW + 5120 + h * 128 + 8 * l16));
        float o[8], gb[8]; float ss = 0.f;
#pragma unroll
        for (int c = 0; c < 4; ++c) { o[2 * c] = bf2f(ov[c] & 0xffffu); o[2 * c + 1] = bf2f(ov[c] >> 16); gb[2 * c] = bf2f(gv[c] & 0xffffu); gb[2 * c + 1] = bf2f(gv[c] >> 16); ss += o[2 * c] * o[2 * c] + o[2 * c + 1] * o[2 * c + 1]; }
        const float rs = rsqrtf(row16_sum_p4(ss) * (1.0f / 128.0f) + 1e-6f);
        u32x4 w;
#pragma unroll
        for (int c = 0; c < 4; ++c) { const float ga = c < 2 ? g0[2 * c] : g1[2 * c - 4], gbq = c < 2 ? g0[2 * c + 1] : g1[2 * c - 3];
            w[c] = pk2(o[2 * c] * rs * ga * gb[2 * c] * sigmf(gb[2 * c]), o[2 * c + 1] * rs * gbq * gb[2 * c + 1] * sigmf(gb[2 * c + 1])); }
        *(u32x4*)(Z + (size_t)tok * ZW + 1024 + h * 128 + 8 * l16) = w; }
}
__device__ __forceinline__ void p6_prologue(const Params& p, LAS unsigned char* lds, int G, int bid) {
    OPQ_TID; const int gw = bid * 8 + wave, ngw = G * 8;
    LAS float* scr = (LAS float*)(lds + wave * 16384);
    constexpr int IP = 4096, IL = 0, IO = 1024, I2 = 128;
    for (int i = gw * 64 + lane; i < (int)(MiB / 16); i += ngw * 64) ((u32x4*)(WSP + WS_GR))[i] = (u32x4){0u, 0u, 0u, 0u};
    for (int i = gw * 64 + lane; i < (int)(MiB / 32); i += ngw * 64) ((u32x4*)(WSP + WS_XG))[i] = (u32x4){0u, 0u, 0u, 0u};
    for (int it = gw; it < IP + IL + IO + I2; it += ngw) {
        int r = it;
        if (r < IP) { const int pj = r >> 10, q = r & 1023;
            const int muidx = pj == 0 ? 0 : (pj == 1 ? 2 : (pj == 2 ? 3 : 5));
            bf16_t* dst = (bf16_t*)(WSP + WS_WC) + (size_t)(pj * 2048) * 2048;
            tr_item2(((const float*)p.in[I_WR + pj]), 2048, dst, dst + 1024, 2048, ((const float*)p.in[I_MU]) + muidx * 1024, scr, q >> 6, q & 63, lane); continue; }
        r -= IP;
        if (r >= IO) { r -= IO; const int wh = r >> 6, nb = r & 63; tr_item(wh ? ((const float*)p.in[I_A2]) : ((const float*)p.in[I_W2]), 2048, (bf16_t*)(WSP + (wh ? WS_A2T : WS_W2T)), 64, nullptr, 0, scr, 0, nb, lane); continue; }
        tr_item(((const float*)p.in[I_WO]), 1024, (bf16_t*)(WSP + WS_WO), 2048, nullptr, 0, scr, r >> 5, r & 31, lane);
    }
    bf16_t* A2 = (bf16_t*)(WSP + WS_A2);
    const int fr = lane & 15, fq = lane >> 4;
    for (int tile = bid; tile < T / 64; tile += G) {
        const int m0 = tile * 64;
        for (int i = (wave == 0 && (m0 & (SEQ - 1)) != 0) ? -1 : 0; i < 8; ++i) { const int m = (i < 0) ? m0 - 1 : m0 + 8 * wave + i;
            u32x2 o[4]; rms_row(((float*)p.out) + (size_t)m * D, ((const float*)p.in[I_CNG]), lane, o); const int bb = m >> 12, t = m & (SEQ - 1);
            const size_t cr = (size_t)(t >> 11) * PROWS6 + bb * 2048 + (t & 2047);
            const size_t cn = (size_t)((t + 1) >> 11) * PROWS6 + bb * 2048 + ((t + 1) & 2047);
#pragma unroll
            for (int j = 0; j < 4; ++j) { if (i >= 0) *((u32x2*)(A2 + cr * 2048) + lane + 64 * j) = o[j];
                if (t + 1 < SEQ) *((u32x2*)(A2 + cn * 2048 + 1024) + lane + 64 * j) = o[j];
                if (t == 0) *((u32x2*)(A2 + cr * 2048 + 1024) + lane + 64 * j) = (u32x2){0u, 0u}; } }
        __syncthreads();
        { const int t0 = m0 & (SEQ - 1), bb = m0 >> 12; const size_t cr0 = (size_t)(t0 >> 11) * PROWS6 + bb * 2048 + (t0 & 2047);
          const int mt = wave & 3, nh = wave >> 2;
          LAS bf16_t* LA_ = (LAS bf16_t*)lds; LAS bf16_t* LB_ = (LAS bf16_t*)(lds + 64 * 264 * 2);
          const bf16_t* ga = A2 + cr0 * 2048; const bf16_t* gb = (const bf16_t*)(WSP + WS_WL);
          u32x4 pa_[4], pb_[8];
#define LORA_LOAD(kc) do { _Pragma("unroll") for (int q = 0; q < 4; ++q) { const int i = tid + q * NT; pa_[q] = *(const u32x4*)(ga + (size_t)(i >> 5) * 2048 + (kc) * 256 + 8 * (i & 31)); } \
              _Pragma("unroll") for (int q = 0; q < 8; ++q) { const int i = tid + q * NT; pb_[q] = *(const u32x4*)(gb + (size_t)(i >> 5) * 2048 + (kc) * 256 + 8 * (i & 31)); } } while (0)
          LORA_LOAD(0);
          f32x4 acc[4];
#pragma unroll
          for (int nt = 0; nt < 4; ++nt) acc[nt] = (f32x4){0.f, 0.f, 0.f, 0.f};
#pragma unroll 1
          for (int kc = 0; kc < 8; ++kc) {
#pragma unroll
              for (int q = 0; q < 4; ++q) { const int i = tid + q * NT; *(LAS u32x4*)(LA_ + (i >> 5) * 264 + 8 * (i & 31)) = pa_[q]; }
#pragma unroll
              for (int q = 0; q < 8; ++q) { const int i = tid + q * NT; *(LAS u32x4*)(LB_ + (i >> 5) * 264 + 8 * (i & 31)) = pb_[q]; }
              __syncthreads();
              if (kc + 1 < 8) LORA_LOAD(kc + 1);
#pragma unroll
              for (int ks = 0; ks < 8; ++ks) { const bf16x8 a = *(const LAS bf16x8*)(LA_ + (16 * mt + fr) * 264 + 32 * ks + 8 * fq);
#pragma unroll
                  for (int nt = 0; nt < 4; ++nt) { const bf16x8 bfr = *(const LAS bf16x8*)(LB_ + (64 * nh + 16 * nt + fr) * 264 + 32 * ks + 8 * fq); acc[nt] = MFMA16(a, bfr, acc[nt]); } }
              __syncthreads();
          }
#undef LORA_LOAD
          bf16_t* dstb = (bf16_t*)(WSP + (nh ? WS_LA : WS_LW));
#pragma unroll
          for (int nt = 0; nt < 4; ++nt)
#pragma unroll
              for (int r = 0; r < 4; ++r) { const float v = acc[nt][r]; dstb[(cr0 + 16 * mt + 4 * fq + r) * 64 + 16 * nt + fr] = (bf16_t)f2bf(nh ? v : tanhf(v)); } }
        __syncthreads();
    }
}
template <int CTRL> __device__ __forceinline__ float dpp_add(float x) { const int y = __builtin_amdgcn_update_dpp(0, __float_as_int(x), CTRL, 0xf, 0xf, true); return x + __int_as_float(y); }
__device__ __forceinline__ f32x4 bf4(u32x2 v) { return (f32x4){bf2f(v.x & 0xffffu), bf2f(v.x >> 16), bf2f(v.y & 0xffffu), bf2f(v.y >> 16)}; }
__device__ __forceinline__ float afma(float a, float b, float c) { float d; asm("v_fma_f32 %0, %1, %2, %3" : "=v"(d) : "v"(a), "v"(b), "v"(c)); return d; }
__device__ __forceinline__ float anfma(float a, float b, float c) { float d; asm("v_fma_f32 %0, -%1, %2, %3" : "=v"(d) : "v"(a), "v"(b), "v"(c)); return d; }
__device__ __forceinline__ float amul(float a, float b) { float d; asm("v_mul_f32 %0, %1, %2" : "=v"(d) : "v"(a), "v"(b)); return d; }
__device__ __forceinline__ f32x2 pkmul(f32x2 a, f32x2 b) { f32x2 d; asm("v_pk_mul_f32 %0, %1, %2" : "=v"(d) : "v"(a), "v"(b)); return d; }
__device__ __forceinline__ f32x2 pkfma(f32x2 a, f32x2 b, f32x2 c) { f32x2 d; asm("v_pk_fma_f32 %0, %1, %2, %3" : "=v"(d) : "v"(a), "v"(b), "v"(c)); return d; }
__device__ __forceinline__ f32x2 pkmul_bl(f32x2 s, f32x2 b) { f32x2 d; asm("v_pk_mul_f32 %0, %1, %2 op_sel_hi:[0,1]" : "=v"(d) : "v"(s), "v"(b)); return d; }
__device__ __forceinline__ f32x2 pknfma_bl(f32x2 s, f32x2 b, f32x2 c) { f32x2 d; asm("v_pk_fma_f32 %0, %1, %2, %3 op_sel_hi:[0,1,1] neg_lo:[1,0,0] neg_hi:[1,0,0]" : "=v"(d) : "v"(s), "v"(b), "v"(c)); return d; }
#define VPKMUL(d, a, b) asm volatile("v_pk_mul_f32 %0, %1, %2" : "=v"(d) : "v"(a), "v"(b))
#define VPKFMA(d, a, b, c) asm volatile("v_pk_fma_f32 %0, %1, %2, %3" : "=v"(d) : "v"(a), "v"(b), "v"(c))
#define VPKMULBL(d, s, b) asm volatile("v_pk_mul_f32 %0, %1, %2 op_sel_hi:[0,1]" : "=v"(d) : "v"(s), "v"(b))
#define VPKNFMABL(d, s, b, c) asm volatile("v_pk_fma_f32 %0, %1, %2, %3 op_sel_hi:[0,1,1] neg_lo:[1,0,0] neg_hi:[1,0,0]" : "=v"(d) : "v"(s), "v"(b), "v"(c))
#define VADD(d, a, b) asm volatile("v_add_f32 %0, %1, %2" : "=v"(d) : "v"(a), "v"(b))
#define VDPP1(x) asm volatile("v_add_f32_dpp %0, %0, %0 quad_perm:[1,0,3,2] row_mask:0xf bank_mask:0xf bound_ctrl:1" : "+v"(x))
#define VDPP2(x) asm volatile("v_add_f32_dpp %0, %0, %0 quad_perm:[2,3,0,1] row_mask:0xf bank_mask:0xf bound_ctrl:1" : "+v"(x))
#define VDPP3(x) asm volatile("v_add_f32_dpp %0, %0, %0 row_half_mirror row_mask:0xf bank_mask:0xf bound_ctrl:1" : "+v"(x))
constexpr int RSTR = 68;
constexpr int REC_ARR = 32 * RSTR;
constexpr int REC_BUF = 5 * REC_ARR;
constexpr int L_REC = 0, L_YY = 87040, L_VV = 103424, L_GG = 119808, L_RKP = 136192, L_SSP = 137216, L_STT = 137728, L_CST = 137984;
constexpr int PROWS = 8192;
#define SCAN_BAR do { asm volatile("s_waitcnt lgkmcnt(0)" ::: "memory"); __builtin_amdgcn_s_barrier(); asm volatile("" ::: "memory"); } while (0)
__device__ __forceinline__ void scan_half(const Params& p, LAS unsigned char* lds, int pi, int rh, int pass) {
    OPQ_TID;
    LAS float* REC = (LAS float*)(lds + L_REC); LAS float* YY = (LAS float*)(lds + L_YY); LAS float* VV = (LAS float*)(lds + L_VV); LAS float* GG = (LAS float*)(lds + L_GG);
    LAS float* RKP = (LAS float*)(lds + L_RKP); LAS float* SSP = (LAS float*)(lds + L_SSP); LAS float* STT = (LAS float*)(lds + L_STT); LAS float* CST = (LAS float*)(lds + L_CST);
    const int b = pi >> 5, hg = pi & 31, colg = hg * 64;
    const bf16_t* Rb = (const bf16_t*)(WSP + WS_R); const bf16_t* Kb = Rb + (size_t)PROWS * 2048; bf16_t* Vb = (bf16_t*)(WSP + WS_V); const bf16_t* Gb = Vb + (size_t)PROWS * 2048;
    const bf16_t* LWb = (const bf16_t*)(WSP + WS_LW) + (size_t)pass * PROWS * 64; const bf16_t* LAb = (const bf16_t*)(WSP + WS_LA) + (size_t)pass * PROWS * 64;
    unsigned long long* GR = (unsigned long long*)(WSP + WS_GR);
    const size_t rowb = (size_t)b * 2048;
    __syncthreads();
    if (tid < 64) { CST[tid] = ((const float*)p.in[I_W0])[colg + tid]; CST[64 + tid] = ((const float*)p.in[I_A0])[colg + tid]; CST[128 + tid] = ((const float*)p.in[I_KK])[colg + tid]; CST[192 + tid] = ((const float*)p.in[I_KA])[colg + tid]; CST[256 + tid] = ((const float*)p.in[I_RK])[colg + tid];
                    CST[320 + tid] = ((const float*)p.in[I_LNG])[colg + tid]; CST[384 + tid] = ((const float*)p.in[I_LNB])[colg + tid]; }
    __syncthreads();
    const int fr = lane & 15, fq = lane >> 4;
    if (wave < 4) {
        const int j = lane & 7, rowl = 8 * wave + (lane >> 3);
        float* stp = (float*)(WSP + WS_ST) + ((size_t)(pi * 64 + 32 * rh + rowl)) * 64 + 8 * j;
        f32x2 P01 = (f32x2){0.f, 0.f}, P23 = P01, P45 = P01, P67 = P01;
        if (pass == 1) { const f32x4 a = *(const f32x4*)stp, c = *(const f32x4*)(stp + 4); P01 = a.xy; P23 = a.zw; P45 = c.xy; P67 = c.zw; }
        const bool first = (lane & 7) == 0;
        SCAN_BAR;
        for (int it = 0; it < 66; ++it) {
            if (it < 64) {
                const LAS float* rec = REC + (it & 1) * REC_BUF + 8 * j; const LAS float* vvp = VV + (it & 3) * 1024 + rowl; LAS float* yyp = YY + (it & 3) * 1024 + rowl;
                const LAS float* ssp = SSP + (it & 1) * 64 + 2 * (lane & 31);
                const float inv2 = __builtin_amdgcn_rcpf(fmaxf(ssp[0] + ssp[1], 1e-24f));
                f32x4 Rkk[2][2], Rw[2][2], Rka[2][2], Rkm[2][2], Rr[2][2]; float Rv[2];
#define LOADREC(slot, s) do { const LAS float* rs_ = rec + (s) * RSTR; \
                    Rkk[slot][0] = *(const LAS f32x4*)(rs_); Rkk[slot][1] = *(const LAS f32x4*)(rs_ + 4); Rw[slot][0] = *(const LAS f32x4*)(rs_ + REC_ARR); Rw[slot][1] = *(const LAS f32x4*)(rs_ + REC_ARR + 4); \
                    Rka[slot][0] = *(const LAS f32x4*)(rs_ + 2 * REC_ARR); Rka[slot][1] = *(const LAS f32x4*)(rs_ + 2 * REC_ARR + 4); Rkm[slot][0] = *(const LAS f32x4*)(rs_ + 3 * REC_ARR); Rkm[slot][1] = *(const LAS f32x4*)(rs_ + 3 * REC_ARR + 4); \
                    Rr[slot][0] = *(const LAS f32x4*)(rs_ + 4 * REC_ARR); Rr[slot][1] = *(const LAS f32x4*)(rs_ + 4 * REC_ARR + 4); Rv[slot] = vvp[(s) * 32]; } while (0)
                LOADREC(0, 0);
                float yp = 0.f, yk0 = 0.f, yk1 = 0.f, yk2 = 0.f, yk3 = 0.f;
#define YSHIFT(YK) do { YK = __int_as_float(__builtin_amdgcn_update_dpp(__float_as_int(yp), __float_as_int(YK), 0x111, 0xf, 0xf, false)); YK = first ? yp : YK; } while (0)
#pragma unroll
                for (int s = 0; s < 32; ++s) {
                    const int c = s & 1, pc = c ^ 1;
                    const float si = __int_as_float(__builtin_amdgcn_readlane(__float_as_int(inv2), s));
                    f32x2 px, py, t01, t23, t45, t67; float x;
                    f32x2 vv2; vv2.x = Rv[c]; asm volatile("" : "+v"(vv2));
                    if (s >= 1) {
                        VPKMUL(px, P01, Rkk[c][0].xy); VPKMUL(py, P01, Rr[pc][0].xy); VPKFMA(px, P23, Rkk[c][0].zw, px); VPKFMA(py, P23, Rr[pc][0].zw, py);
                        VPKFMA(px, P45, Rkk[c][1].xy, px); VPKFMA(py, P45, Rr[pc][1].xy, py); VPKFMA(px, P67, Rkk[c][1].zw, px); VPKFMA(py, P67, Rr[pc][1].zw, py);
                        VADD(x, px.x, px.y); VADD(yp, py.x, py.y);
                    } else {
                        VPKMUL(px, P01, Rkk[c][0].xy); VPKFMA(px, P23, Rkk[c][0].zw, px); VPKFMA(px, P45, Rkk[c][1].xy, px); VPKFMA(px, P67, Rkk[c][1].zw, px);
                        VADD(x, px.x, px.y);
                    }
                    asm volatile("" ::: "memory");
                    if (s + 1 < 32) LOADREC((s + 1) & 1, s + 1);
                    asm volatile("" ::: "memory");
                    VPKMULBL(t01, vv2, Rkm[c][0].xy); VPKMULBL(t23, vv2, Rkm[c][0].zw);
                    VDPP1(x); if (s >= 1) VDPP1(yp);
                    VPKMULBL(t45, vv2, Rkm[c][1].xy); VPKMULBL(t67, vv2, Rkm[c][1].zw);
                    VDPP2(x); if (s >= 1) VDPP2(yp);
                    VPKFMA(P01, P01, Rw[c][0].xy, t01); VPKFMA(P23, P23, Rw[c][0].zw, t23);
                    VDPP3(x); if (s >= 1) VDPP3(yp);
                    VPKFMA(P45, P45, Rw[c][1].xy, t45); VPKFMA(P67, P67, Rw[c][1].zw, t67);
                    if (s >= 1) { if (s - 1 < 8) YSHIFT(yk0); else if (s - 1 < 16) YSHIFT(yk1); else if (s - 1 < 24) YSHIFT(yk2); else YSHIFT(yk3); }
                    x = x * si;
                    f32x2 x2; x2.x = x; asm volatile("" : "+v"(x2));
                    VPKNFMABL(P01, x2, Rka[c][0].xy, P01); VPKNFMABL(P23, x2, Rka[c][0].zw, P23); VPKNFMABL(P45, x2, Rka[c][1].xy, P45); VPKNFMABL(P67, x2, Rka[c][1].zw, P67);
                }
                { f32x2 py; VPKMUL(py, P01, Rr[1][0].xy); VPKFMA(py, P23, Rr[1][0].zw, py); VPKFMA(py, P45, Rr[1][1].xy, py); VPKFMA(py, P67, Rr[1][1].zw, py); VADD(yp, py.x, py.y); }
                yp = dpp_add<0xB1>(yp); yp = dpp_add<0x4E>(yp); yp = dpp_add<0x141>(yp); YSHIFT(yk3);
                yyp[(7 - j) * 32] = yk0; yyp[(15 - j) * 32] = yk1; yyp[(23 - j) * 32] = yk2; yyp[(31 - j) * 32] = yk3;
#undef LOADREC
#undef YSHIFT
            }
            SCAN_BAR;
        }
        if (pass == 0) { *(f32x4*)stp = (f32x4){P01.x, P01.y, P23.x, P23.y}; *(f32x4*)(stp + 4) = (f32x4){P45.x, P45.y, P67.x, P67.y}; }
    } else {
        const int pw = wave - 4, tt = pw >> 1, kh = pw & 1;
        bf16x8 aWc[2][2], aAc[2][2];
#pragma unroll
        for (int kt = 0; kt < 2; ++kt)
#pragma unroll
            for (int ks = 0; ks < 2; ++ks) { const size_t o = (size_t)(colg + 32 * kh + 16 * kt + fr) * 64 + 32 * ks + 8 * fq; aWc[kt][ks] = *(const bf16x8*)((const bf16_t*)(WSP + WS_W2T) + o); aAc[kt][ks] = *(const bf16x8*)((const bf16_t*)(WSP + WS_A2T) + o); }
        bf16x8 lwf[2][2], laf[2][2]; u32x2 r2[2][2], k2[2][2];
#define ISSUE(SET, tbx) do { const size_t tok_ = rowb + (tbx) * 32 + 16 * tt + fr; \
            _Pragma("unroll") for (int ks = 0; ks < 2; ++ks) { lwf[SET][ks] = *(const bf16x8*)(LWb + tok_ * 64 + 32 * ks + 8 * fq); laf[SET][ks] = *(const bf16x8*)(LAb + tok_ * 64 + 32 * ks + 8 * fq); } \
            _Pragma("unroll") for (int kt = 0; kt < 2; ++kt) { r2[SET][kt] = *(const u32x2*)(Rb + tok_ * 2048 + colg + 32 * kh + 16 * kt + 4 * fq); k2[SET][kt] = *(const u32x2*)(Kb + tok_ * 2048 + colg + 32 * kh + 16 * kt + 4 * fq); } } while (0)
        ISSUE(0, 0); ISSUE(1, 1);
        const int t = lane >> 1, hf = lane & 1;
        const size_t vgo = (size_t)colg + 32 * rh + 16 * hf;
        u32x4 v8a = (u32x4){0u, 0u, 0u, 0u}, v8b = v8a, g8a = v8a, g8b = v8a;
        if (pw == 2) { const size_t eo = (rowb + t) * 2048 + vgo; v8a = *(const u32x4*)(Vb + eo); v8b = *(const u32x4*)(Vb + eo + 8); g8a = *(const u32x4*)(Gb + eo); g8b = *(const u32x4*)(Gb + eo + 8); }
        unsigned long long gx[2] = {0ull, 0ull};
#define PROD_ITER(it, PS) do { \
            { const int tb = (it) + 1; \
              if (tb < 64) { \
                LAS float* rec = REC + (tb & 1) * REC_BUF + (16 * tt + fr) * RSTR + 32 * kh + 4 * fq; \
                float ss = 0.f, rkp = 0.f; \
                _Pragma("unroll") for (int kt = 0; kt < 2; ++kt) { \
                    f32x4 accW = (f32x4){0.f, 0.f, 0.f, 0.f}, accA = (f32x4){0.f, 0.f, 0.f, 0.f}; \
                    _Pragma("unroll") for (int ks = 0; ks < 2; ++ks) { accW = MFMA16(aWc[kt][ks], lwf[PS][ks], accW); accA = MFMA16(aAc[kt][ks], laf[PS][ks], accA); } \
                    const int kc = 32 * kh + 16 * kt + 4 * fq; \
                    const f32x4 w0v = *(const LAS f32x4*)(CST + kc), a0v = *(const LAS f32x4*)(CST + 64 + kc), kkc = *(const LAS f32x4*)(CST + 128 + kc), kac = *(const LAS f32x4*)(CST + 192 + kc), rkc = *(const LAS f32x4*)(CST + 256 + kc); \
                    const f32x4 r4 = bf4(r2[PS][kt]), k4 = bf4(k2[PS][kt]); \
                    f32x4 w4, a4; \
                    _Pragma("unroll") for (int e = 0; e < 4; ++e) { w4[e] = __expf(-0.60653066f * sigmf(accW[e] + w0v[e])); a4[e] = sigmf(accA[e] + a0v[e]); } \
                    const f32x4 kkr = k4 * kkc; ss += (kkr.x * kkr.x + kkr.y * kkr.y) + (kkr.z * kkr.z + kkr.w * kkr.w); \
                    const f32x4 km = k4 * (1.0f + (a4 - 1.0f) * kac); const f32x4 rr = r4 * km * rkc; rkp += (rr.x + rr.y) + (rr.z + rr.w); \
                    *(LAS f32x4*)(rec + 16 * kt) = kkr; *(LAS f32x4*)(rec + REC_ARR + 16 * kt) = w4; *(LAS f32x4*)(rec + 2 * REC_ARR + 16 * kt) = kkr * a4; *(LAS f32x4*)(rec + 3 * REC_ARR + 16 * kt) = km; *(LAS f32x4*)(rec + 4 * REC_ARR + 16 * kt) = r4; \
                } \
                if (tb + 2 < 64) ISSUE(PS, tb + 2); \
                ss += __shfl_xor(ss, 16); ss += __shfl_xor(ss, 32); rkp += __shfl_xor(rkp, 16); rkp += __shfl_xor(rkp, 32); \
                if (fq == 0) { SSP[(tb & 1) * 64 + 2 * (16 * tt + fr) + kh] = ss; RKP[(tb & 3) * 64 + 2 * (16 * tt + fr) + kh] = rkp; } \
              } \
              if (pw == 2 && tb < 64) { \
                LAS float* vp = VV + (tb & 3) * 1024 + t * 32 + 16 * hf; LAS float* gp = GG + (tb & 3) * 1024 + t * 32 + 16 * hf; \
                *(LAS f32x4*)(vp) = bf4((u32x2){v8a.x, v8a.y}); *(LAS f32x4*)(vp + 4) = bf4((u32x2){v8a.z, v8a.w}); *(LAS f32x4*)(vp + 8) = bf4((u32x2){v8b.x, v8b.y}); *(LAS f32x4*)(vp + 12) = bf4((u32x2){v8b.z, v8b.w}); \
                *(LAS f32x4*)(gp) = bf4((u32x2){g8a.x, g8a.y}); *(LAS f32x4*)(gp + 4) = bf4((u32x2){g8a.z, g8a.w}); *(LAS f32x4*)(gp + 8) = bf4((u32x2){g8b.x, g8b.y}); *(LAS f32x4*)(gp + 12) = bf4((u32x2){g8b.z, g8b.w}); \
                if (tb + 1 < 64) { const size_t eo = (rowb + (tb + 1) * 32 + t) * 2048 + vgo; v8a = *(const u32x4*)(Vb + eo); v8b = *(const u32x4*)(Vb + eo + 8); g8a = *(const u32x4*)(Gb + eo); g8b = *(const u32x4*)(Gb + eo + 8); } \
              } \
            } \
            if (pw == 3) { \
              if ((it) >= 2 && (it) <= 65) { const int tb = (it) - 2; const unsigned long long* g = GR + ((size_t)(pi * 8 + (tb & 7)) * 2) * 64 + lane; \
                gx[0] = __hip_atomic_load(g, __ATOMIC_RELAXED, __HIP_MEMORY_SCOPE_AGENT); gx[1] = __hip_atomic_load(g + 64, __ATOMIC_RELAXED, __HIP_MEMORY_SCOPE_AGENT); } \
              if ((it) >= 1 && (it) <= 64) { const int tb = (it) - 1; const LAS float* yp_ = YY + (tb & 3) * 1024 + t * 32 + 16 * hf; float s1 = 0.f, s2 = 0.f; \
                _Pragma("unroll") for (int qd = 0; qd < 4; ++qd) { const f32x4 a = *(const LAS f32x4*)(yp_ + 4 * qd); s1 += (a.x + a.y) + (a.z + a.w); s2 += (a.x * a.x + a.y * a.y) + (a.z * a.z + a.w * a.w); } \
                s1 = dpp_add<0xB1>(s1); s2 = dpp_add<0xB1>(s2); \
                const unsigned epoch = (unsigned)(pass * 64 + tb + 1); \
                __hip_atomic_store(GR + ((size_t)((pi * 8 + (tb & 7)) * 2 + rh) * 64 + hf * 32 + t), ((unsigned long long)epoch << 32) | (unsigned long long)__float_as_uint(hf ? s2 : s1), __ATOMIC_RELAXED, __HIP_MEMORY_SCOPE_AGENT); } \
              if ((it) >= 2 && (it) <= 65) { const int tb = (it) - 2; const unsigned epoch = (unsigned)(pass * 64 + tb + 1); \
                const unsigned long long* g = GR + ((size_t)(pi * 8 + (tb & 7)) * 2) * 64 + lane; float tot; \
                for (unsigned spins = 0;; ++spins) { const bool ok = ((unsigned)(gx[0] >> 32) == epoch) && ((unsigned)(gx[1] >> 32) == epoch); tot = __uint_as_float((unsigned)gx[0]) + __uint_as_float((unsigned)gx[1]); \
                    if (__all(ok) || spins > (1u << 22)) break; \
                    __builtin_amdgcn_s_sleep(1); \
                    gx[0] = __hip_atomic_load(g, __ATOMIC_RELAXED, __HIP_MEMORY_SCOPE_AGENT); gx[1] = __hip_atomic_load(g + 64, __ATOMIC_RELAXED, __HIP_MEMORY_SCOPE_AGENT); } \
                const float oth = __shfl_xor(tot, 32); \
                const float mean = (lane < 32 ? tot : oth) * (1.0f / 64.0f), ex2 = (lane < 32 ? oth : tot) * (1.0f / 64.0f); \
                const float rstd = rsqrtf(fmaxf(ex2 - mean * mean, 0.f) + 64e-5f); \
                if (lane < 32) { STT[2 * lane] = mean; STT[2 * lane + 1] = rstd; } \
                const float mu = STT[2 * t], rsd = STT[2 * t + 1]; \
                const int ro = (tb & 3) * 1024 + t * 32 + 16 * hf; const float rk = RKP[(tb & 3) * 64 + 2 * t] + RKP[(tb & 3) * 64 + 2 * t + 1]; \
                unsigned ow[8]; \
                _Pragma("unroll") for (int qd = 0; qd < 4; ++qd) { const f32x4 lg = *(const LAS f32x4*)(CST + 320 + 32 * rh + 16 * hf + 4 * qd), lb = *(const LAS f32x4*)(CST + 384 + 32 * rh + 16 * hf + 4 * qd); \
                    const f32x4 o = ((*(const LAS f32x4*)(YY + ro + 4 * qd) - mu) * rsd * lg + lb + rk * *(const LAS f32x4*)(VV + ro + 4 * qd)) * *(const LAS f32x4*)(GG + ro + 4 * qd); \
                    ow[2 * qd] = pk2(o.x, o.y); ow[2 * qd + 1] = pk2(o.z, o.w); } \
                bf16_t* dst = (bf16_t*)(WSP + WS_A2) + ((size_t)pass * PROWS + rowb + tb * 32 + t) * 2048 + vgo; \
                *(u32x4*)(dst) = (u32x4){ow[0], ow[1], ow[2], ow[3]}; *(u32x4*)(dst + 8) = (u32x4){ow[4], ow[5], ow[6], ow[7]}; } \
            } \
            SCAN_BAR; } while (0)
        for (int it2 = -1; it2 < 65; it2 += 2) { PROD_ITER(it2, 0); PROD_ITER(it2 + 1, 1); }
        PROD_ITER(65, 0);
#undef PROD_ITER
#undef ISSUE
    }
}
__device__ __forceinline__ void p10_final(const Params& p, int G, int bid) {
    OPQ_TID; const int gw = bid * 8 + wave, ngw = G * 8;
    for (int m = gw; m < T; m += ngw) { float* xr = ((float*)p.out) + (size_t)m * D; f32x4 v[4]; float s = 0.f;
#pragma unroll
        for (int j = 0; j < 4; ++j) { v[j] = *((const f32x4*)xr + lane + 64 * j); s += (v[j].x * v[j].x + v[j].y * v[j].y) + (v[j].z * v[j].z + v[j].w * v[j].w); }
        const float rs = rsqrtf(wave_sum(s) * (1.0f / 1024.0f) + 1e-6f);
#pragma unroll
        for (int j = 0; j < 4; ++j) { const f32x4 gg = *((const f32x4*)((const float*)p.in[I_FG]) + lane + 64 * j); *((f32x4*)xr + lane + 64 * j) = v[j] * rs * gg; } }
}

#define XB_TMO      128
#define XB_XCNT(j)  (256  + 64 * (j))
#define XB_XSUB(j)  (1280 + 64 * (j))
#define XB_XGEN(j)  (2304 + 64 * (j))
#define XB_TOP      3328
#define XB_TOPGEN   3392
#define XCD_BAR_WORDS 3456
#define XB_SPIN_CAP (1u << 18)

__device__ __forceinline__ unsigned xb_ld(unsigned* p)              { return __hip_atomic_load(p, __ATOMIC_RELAXED, __HIP_MEMORY_SCOPE_AGENT); }
__device__ __forceinline__ unsigned xb_add(unsigned* p, unsigned v) { return __hip_atomic_fetch_add(p, v, __ATOMIC_RELAXED, __HIP_MEMORY_SCOPE_AGENT); }
__device__ __forceinline__ unsigned xb_xcc_id() { return (unsigned)__builtin_amdgcn_s_getreg((3 << 11) | 20) & 0xFu; }
#define XB_SPIN(cond, bar) do { unsigned _sp = 0; while (cond) { __builtin_amdgcn_s_sleep(1); \
    if ((++_sp & 255u) == 0u) { if (xb_ld(&(bar)[XB_TMO])) break; if (_sp > XB_SPIN_CAP) { atomicAdd(&(bar)[XB_TMO], 1u); break; } } } } while (0)

struct XcdBarrier {
    unsigned* bar; unsigned x;
    volatile LAS unsigned* st;
};

__device__ __forceinline__ XcdBarrier xcd_barrier_post(unsigned* bar, volatile LAS unsigned* st) {
    XcdBarrier b; b.bar = bar; b.x = xb_xcc_id(); b.st = st;
    if (threadIdx.x == 0) (void)xb_add(&bar[XB_XCNT(b.x)], 1u);
    return b;
}
__device__ __forceinline__ void xcd_barrier_complete(unsigned* bar, unsigned x, unsigned& nloc, unsigned& nx) {
    const unsigned G = gridDim.x * gridDim.y * gridDim.z;
    unsigned sum, cnt, mine, sp = 0u;
    for (;;) {
        sum = 0u; cnt = 0u; mine = 0u;
#pragma unroll
        for (unsigned j = 0; j < 16; ++j) { const unsigned c = xb_ld(&bar[XB_XCNT(j)]); sum += c; cnt += (c > 0u) ? 1u : 0u; mine = (j == x) ? c : mine; }
        if (sum == G) break;
        __builtin_amdgcn_s_sleep(1);
        if ((++sp & 255u) == 0u) { if (xb_ld(&bar[XB_TMO])) break; if (sp > XB_SPIN_CAP) { atomicAdd(&bar[XB_TMO], 1u); break; } }
    }
    nloc = mine > 0u ? mine : 1u; nx = cnt > 0u ? cnt : 1u;
}

__device__ __forceinline__ void xcd_barrier(const XcdBarrier& b) {
    asm volatile("s_waitcnt vmcnt(0)" ::: "memory");
    __syncthreads();
    if (threadIdx.x == 0) {
        unsigned* bar = (unsigned*)(*(volatile LAS unsigned long long*)(b.st + 4)); const unsigned bx_ = xb_xcc_id();
        __builtin_amdgcn_s_waitcnt(0);
        unsigned nloc = b.st[0], nx = b.st[1];
        if (nloc == 0u) { xcd_barrier_complete(bar, bx_, nloc, nx); b.st[0] = nloc; b.st[1] = nx; }
        const unsigned old = xb_add(&bar[XB_XSUB(bx_)], 1u);
        const unsigned gen = old / nloc;
        if (old + 1u == (gen + 1u) * nloc) {
            __builtin_amdgcn_fence(__ATOMIC_RELEASE, "agent");
            asm volatile("s_waitcnt vmcnt(0)" ::: "memory");
            const unsigned og = xb_add(&bar[XB_TOP], 1u);
            const unsigned tg = og / nx;
            if (og + 1u == (tg + 1u) * nx) xb_add(&bar[XB_TOPGEN], 1u);
            else XB_SPIN(xb_ld(&bar[XB_TOPGEN]) == tg, bar);
            __builtin_amdgcn_fence(__ATOMIC_ACQUIRE, "agent");
            xb_add(&bar[XB_XGEN(bx_)], 1u);
            asm volatile("s_waitcnt vmcnt(0)" ::: "memory");
        } else {
            XB_SPIN(xb_ld(&bar[XB_XGEN(bx_)]) == gen, bar);
            __builtin_amdgcn_fence(__ATOMIC_ACQUIRE, "agent");
            asm volatile("s_waitcnt vmcnt(0)" ::: "memory");
        }
    }
    __syncthreads();
}

__global__ void __launch_bounds__(NT, 2) mk_fwd(Params p) {
    auto wsl = [&]() { return launder_ws(((unsigned char*)p.ws)); };
    extern __shared__ __attribute__((aligned(16))) unsigned char lds_raw[];
    LAS unsigned char* lds = (LAS unsigned char*)lds_raw;
    cg::grid_group grid = cg::this_grid();
    const int G = gridDim.x, bid = blockIdx.x;
    if (threadIdx.x < 16) ((LAS unsigned*)(lds + LDS_MISC))[threadIdx.x] = 0u;
    __syncthreads();
    if (threadIdx.x == 0) *(LAS unsigned long long*)(lds + LDS_MISC + 16) = (unsigned long long)(((unsigned char*)p.ws) + WS_BAR);
    __syncthreads();
    if (bid == 0) for (int i = threadIdx.x; i < 4096; i += NT) ((unsigned*)(((unsigned char*)p.ws) + WS_BAR))[i] = 0u;
#define XBAR() do { XcdBarrier xb_; xb_.bar = nullptr; xb_.x = 0u; xb_.st = (volatile LAS unsigned*)(lds + LDS_MISC); xcd_barrier(xb_); } while (0)
#if PROBE == 7
    p0_prologue(p, lds, G, bid);
#endif
    p0_prologue(p, lds, G, bid);
    grid.sync();
    (void)xcd_barrier_post((unsigned*)(((unsigned char*)p.ws) + WS_BAR), (volatile LAS unsigned*)(lds + LDS_MISC));
    { pg8::Gemm g{(const bf16_t*)((float*)p.out), (const bf16_t*)(wsl() + WS_WIN), T, ZW, D, D}; pg8::StaticOrder S; S.init(T, ZW, G, bid); pg8::EpiBf16 E{(bf16_t*)(wsl() + WS_Z), ZW};
      pg8::gemm_phase<pg8::EpiBf16, pg8::StaticOrder, true, true>(lds, g, S, E); }
    XBAR();
#if PROBE == 3
    { u32x4 pre[3]; if (bid < 2048) rg_a_prefetch((const bf16_t*)(wsl() + WS_Z), bid, threadIdx.x, pre); RgaConst K; int jc = -1; for (int u = bid; u < 2048; u += G) { if ((u & 7) != jc) { jc = u & 7; rg_a_consts(p, jc, K); } rg_a_unit(p, lds, u, u + G, pre, K); } }
    { u32x4 pre[6]; if (bid < 2048) hg_a_prefetch((const bf16_t*)(wsl() + WS_Z), bid, threadIdx.x, pre); for (int u = bid; u < 2048; u += G) hg_a_unit(p, lds, u, u + G, pre); }
    XBAR();
#endif
    { u32x4 pre[3]; if (bid < 2048) rg_a_prefetch((const bf16_t*)(wsl() + WS_Z), bid, threadIdx.x, pre); RgaConst K; int jc = -1; for (int u = bid; u < 2048; u += G) { if ((u & 7) != jc) { jc = u & 7; rg_a_consts(p, jc, K); } rg_a_unit(p, lds, u, u + G, pre, K); } }
    { u32x4 pre[6]; if (bid < 2048) hg_a_prefetch((const bf16_t*)(wsl() + WS_Z), bid, threadIdx.x, pre); for (int u = bid; u < 2048; u += G) hg_a_unit(p, lds, u, u + G, pre); }
    XBAR();
#if PROBE == 2
    for (int u = bid; u < 256; u += G) hg_b_item(p, lds, u, p.dry != 0);
    XBAR();
#endif
#if PROBE == 6
    for (int u = bid; u < 512; u += G) rg_b_unit(p, u);
    XBAR();
#endif
#if PROBE == 4
    for (int q = 0; q < 16; ++q) XBAR();
#endif
    for (int u = bid; u < 256; u += G) { const int it_ = (G == 256) ? ((((u & 7) + 8 * (u >> 6)) << 3) | ((u >> 3) & 7)) : u; hg_b_item(p, lds, it_); }
    for (int u = bid; u < 512; u += G) rg_b_unit(p, u);
    XBAR();
#if PROBE == 8
    p4_finalize(p, G, bid);
#endif
    p4_finalize(p, G, bid);
    XBAR();
    { pg8::Gemm g{(const bf16_t*)(wsl() + WS_Z), (const bf16_t*)(wsl() + WS_WOUT), T, D, 2048, ZW}; pg8::StaticOrder S; S.init(T, D, G, bid); pg8::EpiResF32 E{((const float*)p.in[I_X]), ((float*)p.out), D, 0, 0};
      pg8::gemm_phase<pg8::EpiResF32, pg8::StaticOrder, true, true>(lds, g, S, E); }
    XBAR();
#if PROBE == 9
    p6_prologue(p, lds, G, bid);
#endif
    p6_prologue(p, lds, G, bid);
    XBAR();
#pragma unroll 1
    for (int pass = 0; pass < 2; ++pass) {
        { pg8::Gemm g{(const bf16_t*)(wsl() + WS_A2) + (size_t)pass * 8192 * 2048, (const bf16_t*)(wsl() + WS_WC), 8192, 8192, 2048, 2048}; pg8::StaticOrder S; S.init(8192, 8192, G, bid);
          pg8::EpiL1 E{(bf16_t*)(wsl() + WS_R), (bf16_t*)(wsl() + WS_LW), (bf16_t*)(wsl() + WS_LA)};
          pg8::gemm_phase<pg8::EpiL1, pg8::StaticOrder, true, true>(lds, g, S, E); }
        XBAR();
        for (int u0 = 0; u0 < 256; u0 += G) { const int u = u0 + bid; if (u < 256) { int pi, rh; if (G == 256) { pi = (u & 7) + 8 * (u >> 4); rh = (u >> 3) & 1; } else { pi = u >> 1; rh = u & 1; } scan_half(p, lds, pi, rh, pass); } }
        XBAR();
    }
    if (G == 256) {
        pg8::Gemm g{(const bf16_t*)(wsl() + WS_A2), (const bf16_t*)(wsl() + WS_WO), T, D, 2048, 2048}; pg8::StaticOrder S; S.init(T, D, G, bid); pg8::EpiFinalNorm E{((float*)p.out), ((const float*)p.in[I_FG]), (unsigned long long*)(wsl() + WS_XG), D};
        pg8::gemm_phase<pg8::EpiFinalNorm, pg8::StaticOrder, false, true>(lds, g, S, E);
    } else {
        { pg8::Gemm g{(const bf16_t*)(wsl() + WS_A2), (const bf16_t*)(wsl() + WS_WO), T, D, 2048, 2048}; pg8::StaticOrder S; S.init(T, D, G, bid); pg8::EpiResF32 E{((float*)p.out), ((float*)p.out), D, 1, 0};
          pg8::gemm_phase<pg8::EpiResF32, pg8::StaticOrder, true, true>(lds, g, S, E); }
        XBAR();
        p10_final(p, G, bid);
    }
}

extern "C" void kernel_launch(void* const* d_in, const int* in_sizes, int n_in, void* d_out, int out_size, void* d_ws, size_t ws_size, hipStream_t stream) {
    static int grid = 0;
    if (grid == 0) {
        int dev = 0, cus = 0, per_cu = 0;
        if (n_in != 32 || out_size != T * D || ws_size < 256 * MiB) { fprintf(stderr, "kernel_launch: unexpected shapes (n_in %d out %d ws %zu)\n", n_in, out_size, ws_size); grid = -1; return; }
        if (hipGetDevice(&dev) != hipSuccess || hipDeviceGetAttribute(&cus, hipDeviceAttributeMultiprocessorCount, dev) != hipSuccess) { grid = -1; return; }
        if (hipFuncSetAttribute((const void*)mk_fwd, hipFuncAttributeMaxDynamicSharedMemorySize, LDS_BYTES) != hipSuccess) { fprintf(stderr, "hipFuncSetAttribute failed\n"); grid = -1; return; }
        if (hipOccupancyMaxActiveBlocksPerMultiprocessor(&per_cu, (const void*)mk_fwd, NT, LDS_BYTES) != hipSuccess || per_cu < 1) fprintf(stderr, "occupancy query: %d\n", per_cu);
        (void)hipGetLastError();
        grid = cus;
    }
    if (grid < 0) return;
    Params p{};
    p.dry = 1;
    for (int i = 0; i < 32; ++i) memcpy(&p.in[i], &d_in[i], sizeof(void*));
    memcpy(&p.out, &d_out, sizeof(void*)); memcpy(&p.ws, &d_ws, sizeof(void*));
    void* args[] = {&p};
    hipError_t e = hipLaunchCooperativeKernel((const void*)mk_fwd, dim3(grid), dim3(NT), args, LDS_BYTES, stream);
    if (e != hipSuccess) fprintf(stderr, "cooperative launch failed: %s (grid %d)\n", hipGetErrorString(e), grid);
}
```
